# Optimizing an MI355X kernel written in HIP

```python
import jax, jax.numpy as jnp
from jax import lax
import numpy as np

D_MODEL = 1024
BATCH = 8
SEQ = 4096
DEPTH = 2

CTX_LEN = 256
GRID_W = 64
NORM_EPS = 1e-6

GLA_HEADS = 4
GLA_DK = 64
GLA_DV = 128
GLA_RANK = 16
GLA_TAU = 16.0
GLA_CHUNK = 64
GLA_QK = GLA_HEADS * GLA_DK
GLA_V = GLA_HEADS * GLA_DV

ATT_HEADS = 8
ATT_KV_HEADS = 2
ATT_DH = 64
ATT_BLOCK = 128
ROPE_THETA = 10000.0
ROPE_AXIS_DIM = ATT_DH // 2
ATT_Q = ATT_HEADS * ATT_DH
ATT_KV = ATT_KV_HEADS * ATT_DH

POOL_WINDOWS = (2, 4, 8, 16)
POOL_GROUP = 128
POOL_WIDTH = POOL_GROUP * len(POOL_WINDOWS)

N_BRANCH = 3
BRANCH_WIDTH = 512

N_GROUPS = 4
EXP_PER_GROUP = 8
N_EXPERTS = N_GROUPS * EXP_PER_GROUP
TOP_K = 2
D_EXPERT = 512
MOE_BLOCK = 128

IN_SIZES = (GLA_QK, GLA_QK, GLA_V, GLA_V, GLA_RANK, GLA_RANK, ATT_Q, ATT_KV, ATT_KV, POOL_WIDTH, N_BRANCH * D_MODEL)
IN_WIDTH = int(sum(IN_SIZES))
IN_SPLITS = tuple(int(s) for s in np.cumsum(IN_SIZES)[:-1])

kernel_name = 'hybrid_gla_gqa_pool_hmoe_dit'

F32 = jnp.float32


def rmsnorm(x, g):
    xf = x.astype(F32)
    y = xf * lax.rsqrt(jnp.mean(xf * xf, axis=-1, keepdims=True) + NORM_EPS)
    return (y * g.astype(F32)).astype(x.dtype)


def modulate(h, shift, scale):
    return h * (1 + scale[:, None]) + shift[:, None]


def axial_rope_angles(rows):
    row = jnp.repeat(jnp.arange(rows), GRID_W).astype(F32)
    col = jnp.tile(jnp.arange(GRID_W), rows).astype(F32)
    inv = ROPE_THETA ** (-jnp.arange(0, ROPE_AXIS_DIM, 2, dtype=F32) / ROPE_AXIS_DIM)
    return row[:, None] * inv, col[:, None] * inv


def _rotate(x, ang):
    x1, x2 = jnp.split(x, 2, axis=-1)
    cos = jnp.cos(ang)[None, :, None, :]
    sin = jnp.sin(ang)[None, :, None, :]
    return jnp.concatenate([x1 * cos - x2 * sin, x1 * sin + x2 * cos], axis=-1)


def rope_2d(x, ang_row, ang_col):
    xf = x.astype(F32)
    out = jnp.concatenate([_rotate(xf[..., :ROPE_AXIS_DIM], ang_row),
                           _rotate(xf[..., ROPE_AXIS_DIM:], ang_col)], axis=-1)
    return out.astype(x.dtype)


def gla_direction(q, k, v, log_a, s0):
    B, T, H, DK = k.shape
    DV = v.shape[-1]
    L = GLA_CHUNK
    n = T // L
    kc = k.astype(F32).reshape(B, n, L, H, DK)
    vc = v.astype(F32).reshape(B, n, L, H, DV)
    b = jnp.cumsum(log_a.astype(F32).reshape(B, n, L, H, DK), axis=2)
    b_last = b[:, :, -1:]
    d_state = jnp.einsum('bnshd,bnshv->bnhdv', kc * jnp.exp(b_last - b), vc)
    a_chunk = jnp.exp(b_last[:, :, 0])
    emit = q is not None

    def step(s, inp):
        a, d = inp
        return a[..., None] * s + d, (s if emit else None)

    s_fin, s_start = lax.scan(step, s0, (jnp.moveaxis(a_chunk, 1, 0), jnp.moveaxis(d_state, 1, 0)))
    if not emit:
        return None, s_fin
    s_start = jnp.moveaxis(s_start, 0, 1)
    qc = q.astype(F32).reshape(B, n, L, H, DK)
    b_ref = b[:, :, L // 2:L // 2 + 1]
    scores = jnp.einsum('bnthd,bnshd->bnhts', qc * jnp.exp(b - b_ref), kc * jnp.exp(b_ref - b))
    lower = jnp.tril(jnp.ones((L, L), dtype=bool))
    scores = jnp.where(lower, scores, 0.0)
    o = (jnp.einsum('bnhts,bnshv->bnthv', scores, vc)
         + jnp.einsum('bnthd,bnhdv->bnthv', qc * jnp.exp(b), s_start))
    return o.reshape(B, T, H, DV).astype(v.dtype), s_fin


def gla_bidir(q, k, v, la_f, la_b, s0_f, s0_b, want_out):
    flip = lambda t: jnp.flip(t, axis=1)
    o_f, s_f = gla_direction(q if want_out else None, k, v, la_f, s0_f)
    o_b, s_b = gla_direction(flip(q) if want_out else None, flip(k), flip(v), flip(la_b), s0_b)
    o = (o_f + flip(o_b)) if want_out else None
    return o, s_f, s_b


def gla_inputs(gq, gk, gv, glf, glb, up_f, bias_f, up_b, bias_b):
    B, T, _ = gq.shape
    shp = (B, T, GLA_HEADS, GLA_DK)
    q = gq.reshape(shp) * GLA_DK ** -0.5
    k = gk.reshape(shp)
    v = gv.reshape(B, T, GLA_HEADS, GLA_DV)
    la_f = (jax.nn.log_sigmoid((glf @ up_f + bias_f).astype(F32)) / GLA_TAU).reshape(shp)
    la_b = (jax.nn.log_sigmoid((glb @ up_b + bias_b).astype(F32)) / GLA_TAU).reshape(shp)
    return q, k, v, la_f, la_b


def gla_output(o, r, norm_g):
    B, T, H, DV = o.shape
    return rmsnorm(o, norm_g).reshape(B, T, H * DV) * jax.nn.silu(r)


def gqa_blocks(q, k, v):
    B, T, H, DH = q.shape
    HKV = k.shape[2]
    G = H // HKV
    nb = T // ATT_BLOCK
    qb = jnp.moveaxis(q.reshape(B, nb, ATT_BLOCK, HKV, G, DH), 1, 0)

    def one(qblk):
        s = jnp.einsum('bqkgd,bskd->bkgqs', qblk, k).astype(F32) * DH ** -0.5
        p = jax.nn.softmax(s, axis=-1).astype(v.dtype)
        return jnp.einsum('bkgqs,bskd->bqkgd', p, v)

    o = lax.map(one, qb)
    return jnp.moveaxis(o, 0, 1).reshape(B, T, H * DH)


def pool_mix(u, pool_w, pool_scale):
    B, T, W = u.shape
    uf = u.astype(F32)
    cs = jnp.concatenate([jnp.zeros((B, 1, W), F32), jnp.cumsum(uf, axis=1)], axis=1)
    t = jnp.arange(T)
    diffs = []
    for gi, win in enumerate(POOL_WINDOWS):
        sl = slice(gi * POOL_GROUP, (gi + 1) * POOL_GROUP)
        lo = jnp.clip(t - win // 2, 0, T)
        hi = jnp.clip(t + win // 2, 0, T)
        csg = cs[..., sl]
        mean = (csg[:, hi] - csg[:, lo]) / (hi - lo).astype(F32)[None, :, None]
        diffs.append(mean - uf[..., sl])
    d = jnp.stack(diffs, axis=2)
    y = jnp.einsum('btgc,gce->btge', d, pool_w.astype(F32)).reshape(B, T, W) * pool_scale.astype(F32)
    return y.astype(u.dtype)


def branch_merge(y_gla, y_att, y_pool, gt, w_branch, w_out):
    g = jax.nn.sigmoid(gt.reshape(gt.shape[:-1] + (N_BRANCH, -1)))
    z = (g[..., 0, :] * (y_gla @ w_branch[0])
         + g[..., 1, :] * (y_att @ w_branch[1])
         + g[..., 2, :] * (y_pool @ w_branch[2]))
    return z @ w_out


def mixing(h, hc, ang_row, ang_col, w_in, gla_a_up_f, gla_a_bias_f, gla_a_up_b, gla_a_bias_b,
           gla_norm_g, att_qn_g, att_kn_g, pool_w, pool_scale, w_branch, w_out, want_ctx):
    B, T, _ = h.shape
    C = hc.shape[1]
    (gq, gk, gv, gr, glf, glb, aq, ak, av, pu, gt) = jnp.split(h @ w_in, IN_SPLITS, axis=-1)
    (gq_c, gk_c, gv_c, gr_c, glf_c, glb_c, aq_c, ak_c, av_c, pu_c, gt_c) = jnp.split(hc @ w_in, IN_SPLITS, axis=-1)
    q_c, k_c, v_c, laf_c, lab_c = gla_inputs(gq_c, gk_c, gv_c, glf_c, glb_c, gla_a_up_f, gla_a_bias_f, gla_a_up_b, gla_a_bias_b)
    s0 = jnp.zeros((B, GLA_HEADS, GLA_DK, GLA_DV), F32)
    o_c, sf_c, sb_c = gla_bidir(q_c, k_c, v_c, laf_c, lab_c, s0, s0, want_ctx)
    q, k, v, laf, lab = gla_inputs(gq, gk, gv, glf, glb, gla_a_up_f, gla_a_bias_f, gla_a_up_b, gla_a_bias_b)
    o, _, _ = gla_bidir(q, k, v, laf, lab, sf_c, sb_c, True)
    y_gla = gla_output(o, gr, gla_norm_g)
    ka_c = rmsnorm(ak_c.reshape(B, C, ATT_KV_HEADS, ATT_DH), att_kn_g)
    va_c = av_c.reshape(B, C, ATT_KV_HEADS, ATT_DH)
    qa = rope_2d(rmsnorm(aq.reshape(B, T, ATT_HEADS, ATT_DH), att_qn_g), ang_row, ang_col)
    ka = rope_2d(rmsnorm(ak.reshape(B, T, ATT_KV_HEADS, ATT_DH), att_kn_g), ang_row, ang_col)
    va = av.reshape(B, T, ATT_KV_HEADS, ATT_DH)
    y_att = gqa_blocks(qa, jnp.concatenate([ka, ka_c], axis=1), jnp.concatenate([va, va_c], axis=1))
    y_pool = pool_mix(pu, pool_w, pool_scale)
    y = branch_merge(y_gla, y_att, y_pool, gt, w_branch, w_out)
    if not want_ctx:
        return y, None
    qa_c = rmsnorm(aq_c.reshape(B, C, ATT_HEADS, ATT_DH), att_qn_g)
    yc = branch_merge(gla_output(o_c, gr_c, gla_norm_g), gqa_blocks(qa_c, ka_c, va_c),
                      pool_mix(pu_c, pool_w, pool_scale), gt_c, w_branch, w_out)
    return y, yc


def routed_ffn(h, w_group, b_group, w_expert, b_expert, w_gate, w_up, w_down):
    B, S, D = h.shape
    N = B * S
    xt = h.reshape(N, D)
    p_group = jax.nn.softmax((xt @ w_group).astype(F32) + b_group, axis=-1)
    p_top_group, grp = lax.top_k(p_group, 1)
    grp = grp[:, 0]
    logits_e = ((xt @ w_expert).astype(F32) + b_expert).reshape(N, N_GROUPS, EXP_PER_GROUP)
    p_in = jax.nn.softmax(logits_e[jnp.arange(N), grp], axis=-1)
    p_top, idx = lax.top_k(p_in, TOP_K)
    wts = (p_top_group * p_top / jnp.sum(p_top, axis=-1, keepdims=True)).reshape(-1)
    eid = (grp[:, None] * EXP_PER_GROUP + idx).reshape(-1)
    M = N * TOP_K
    tok = jnp.arange(M) // TOP_K
    order = jnp.argsort(eid)
    e_s, tok_s, w_s = eid[order], tok[order], wts[order]
    counts = jnp.bincount(eid, length=N_EXPERTS)
    padded = (counts + MOE_BLOCK - 1) // MOE_BLOCK * MOE_BLOCK
    seg_start = jnp.cumsum(counts) - counts
    pad_end = jnp.cumsum(padded)
    pad_start = pad_end - padded
    dest = pad_start[e_s] + jnp.arange(M) - seg_start[e_s]
    n_blocks = -(-(M + N_EXPERTS * (MOE_BLOCK - 1)) // MOE_BLOCK)
    P = n_blocks * MOE_BLOCK
    buf_tok = jnp.full((P,), N, jnp.int32).at[dest].set(tok_s)
    buf_w = jnp.zeros((P,), F32).at[dest].set(w_s)
    blk_expert = jnp.minimum(jnp.searchsorted(pad_end, jnp.arange(n_blocks) * MOE_BLOCK, side='right'), N_EXPERTS - 1)
    x_pad = jnp.concatenate([xt, jnp.zeros((1, D), xt.dtype)], axis=0)

    def expert_block(args):
        tb, e = args
        xb = x_pad[tb]
        return (jax.nn.silu(xb @ w_gate[e]) * (xb @ w_up[e])) @ w_down[e]

    yb = lax.map(expert_block, (buf_tok.reshape(n_blocks, MOE_BLOCK), blk_expert))
    yb = yb.reshape(P, D) * buf_w[:, None].astype(yb.dtype)
    out = jnp.zeros((N + 1, D), yb.dtype).at[buf_tok].add(yb)[:N]
    return out.reshape(B, S, D).astype(h.dtype)


def setup_inputs(seed: int = 0) -> dict:
    key = jax.random.key(seed)
    ks = jax.random.split(key, 32)
    L = DEPTH
    D = D_MODEL
    nrm = lambda k, shape, s: jax.random.normal(k, shape, F32) * s
    return {
        'x': nrm(ks[0], (BATCH, SEQ, D), 1.0),
        'c': nrm(ks[1], (BATCH, D), 1.0),
        'ctx': nrm(ks[2], (BATCH, CTX_LEN, D), 1.0),
        'c_ctx': nrm(ks[3], (D,), 1.0),
        'w_mod': nrm(ks[4], (L, D, 6 * D), 0.5 * D ** -0.5),
        'b_mod': nrm(ks[5], (L, 6 * D), 0.02),
        'norm1_g': 1.0 + nrm(ks[6], (L, D), 0.02),
        'norm2_g': 1.0 + nrm(ks[7], (L, D), 0.02),
        'w_in': nrm(ks[8], (L, D, IN_WIDTH), D ** -0.5),
        'gla_a_up_f': nrm(ks[9], (L, GLA_RANK, GLA_QK), GLA_RANK ** -0.5),
        'gla_a_bias_f': nrm(ks[10], (L, GLA_QK), 0.1),
        'gla_a_up_b': nrm(ks[11], (L, GLA_RANK, GLA_QK), GLA_RANK ** -0.5),
        'gla_a_bias_b': nrm(ks[12], (L, GLA_QK), 0.1),
        'gla_norm_g': 1.0 + nrm(ks[13], (L, GLA_DV), 0.02),
        'att_qn_g': 1.0 + nrm(ks[14], (L, ATT_DH), 0.02),
        'att_kn_g': 1.0 + nrm(ks[15], (L, ATT_DH), 0.02),
        'pool_w': nrm(ks[16], (L, len(POOL_WINDOWS), POOL_GROUP, POOL_GROUP), POOL_GROUP ** -0.5),
        'pool_scale': 1.0 + nrm(ks[17], (L, POOL_WIDTH), 0.02),
        'w_branch': nrm(ks[18], (L, N_BRANCH, BRANCH_WIDTH, D), BRANCH_WIDTH ** -0.5),
        'w_out': nrm(ks[19], (L, D, D), D ** -0.5),
        'moe_w_group': nrm(ks[20], (L, D, N_GROUPS), D ** -0.5),
        'moe_b_group': nrm(ks[21], (L, N_GROUPS), 0.01),
        'moe_w_expert': nrm(ks[22], (L, D, N_EXPERTS), D ** -0.5),
        'moe_b_expert': nrm(ks[23], (L, N_EXPERTS), 0.01),
        'moe_w_gate': nrm(ks[24], (L, N_EXPERTS, D, D_EXPERT), D ** -0.5),
        'moe_w_up': nrm(ks[25], (L, N_EXPERTS, D, D_EXPERT), D ** -0.5),
        'moe_w_down': nrm(ks[26], (L, N_EXPERTS, D_EXPERT, D), D_EXPERT ** -0.5),
        'final_g': 1.0 + nrm(ks[27], (D,), 0.02),
    }


def reference(x, c, ctx, c_ctx, w_mod, b_mod, norm1_g, norm2_g, w_in, gla_a_up_f, gla_a_bias_f,
              gla_a_up_b, gla_a_bias_b, gla_norm_g, att_qn_g, att_kn_g, pool_w, pool_scale,
              w_branch, w_out, moe_w_group, moe_b_group, moe_w_expert, moe_b_expert,
              moe_w_gate, moe_w_up, moe_w_down, final_g):
    B, T, D = x.shape
    rows = T // GRID_W
    ang_row, ang_col = axial_rope_angles(rows)
    xc = ctx
    s_lat = jax.nn.silu(c)
    s_ctx = jax.nn.silu(c_ctx)[None]
    for l in range(DEPTH):
        want_ctx = l < DEPTH - 1
        sh1, sc1, g1, sh2, sc2, g2 = jnp.split(s_lat @ w_mod[l] + b_mod[l], 6, axis=-1)
        csh1, csc1, cg1, csh2, csc2, cg2 = jnp.split(s_ctx @ w_mod[l] + b_mod[l], 6, axis=-1)
        h = modulate(rmsnorm(x, norm1_g[l]), sh1, sc1)
        hc = modulate(rmsnorm(xc, norm1_g[l]), csh1, csc1)
        y, yc = mixing(h, hc, ang_row, ang_col, w_in[l], gla_a_up_f[l], gla_a_bias_f[l],
                       gla_a_up_b[l], gla_a_bias_b[l], gla_norm_g[l], att_qn_g[l], att_kn_g[l],
                       pool_w[l], pool_scale[l], w_branch[l], w_out[l], want_ctx)
        x = x + g1[:, None] * y
        h2 = modulate(rmsnorm(x, norm2_g[l]), sh2, sc2)
        moe_par = (moe_w_group[l], moe_b_group[l], moe_w_expert[l], moe_b_expert[l],
                   moe_w_gate[l], moe_w_up[l], moe_w_down[l])
        if want_ctx:
            xc = xc + cg1[:, None] * yc
            h2c = modulate(rmsnorm(xc, norm2_g[l]), csh2, csc2)
            m = routed_ffn(jnp.concatenate([h2, h2c], axis=1), *moe_par)
            x = x + g2[:, None] * m[:, :T]
            xc = xc + cg2[:, None] * m[:, T:]
        else:
            x = x + g2[:, None] * routed_ffn(h2, *moe_par)
    return rmsnorm(x, final_g)
```

```cpp
#include <hip/hip_runtime.h>
#include <cstdio>
#include <cstdint>

typedef unsigned short bf16;

constexpr int D = 1024, NB = 8, T = 4096, CL = 256, NL = NB * T, NC = NB * CL, NTOK = NL + NC;
constexpr int INW = 5920;
constexpr int O_GQ = 0, O_GK = 256, O_GV = 512, O_GR = 1024, O_GLF = 1536, O_GLB = 1552, O_AQ = 1568, O_AK = 2080,
              O_AV = 2208, O_PU = 2336, O_GT = 2848;
constexpr float EPS = 1e-6f;

constexpr size_t MiB = 1u << 20;
constexpr size_t WS_CTL = 0;
constexpr size_t WS_MODV = 1 * MiB;
constexpr size_t WS_ROPE = 1 * MiB + 512 * 1024;
constexpr size_t WS_WT = 2 * MiB;
constexpr size_t WS_LIST = 3 * MiB;
constexpr size_t WS_XC = 8 * MiB;
constexpr size_t WS_H = 16 * MiB;
constexpr size_t WS_PROJ = 84 * MiB;
constexpr size_t WS_R2 = 478 * MiB;
constexpr size_t WS_END = 580 * MiB;
constexpr size_t SZ_Y512 = (size_t)NTOK * 512 * 2;
constexpr size_t WS_ACT = WS_PROJ;
constexpr size_t WS_Y0 = WS_PROJ + 68 * MiB;
constexpr size_t WS_Y1 = WS_PROJ + 136 * MiB;

struct Params {
    const float* in[28];
    float* out;
    unsigned char* ws;
};
enum { I_X = 0, I_C, I_CTX, I_CCTX, I_WMOD, I_BMOD, I_N1G, I_N2G, I_WIN, I_UPF, I_BIASF, I_UPB, I_BIASB, I_GLANG, I_QNG, I_KNG,
       I_POOLW, I_POOLS, I_WBR, I_WOUT, I_WGRP, I_BGRP, I_WEXP, I_BEXP, I_WGATE, I_WUP, I_WDOWN, I_FING };

__device__ __forceinline__ float bf2f(bf16 v) { return __uint_as_float(((unsigned)v) << 16); }
__device__ __forceinline__ bf16 f2bf(float f) { unsigned u = __float_as_uint(f); return (bf16)((u + 0x7fffu + ((u >> 16) & 1u)) >> 16); }
__device__ __forceinline__ float4 ld_bf4(const bf16* p) {
    uint2 u = *(const uint2*)p;
    return make_float4(__uint_as_float(u.x << 16), __uint_as_float(u.x & 0xffff0000u), __uint_as_float(u.y << 16), __uint_as_float(u.y & 0xffff0000u));
}
__device__ __forceinline__ void st_bf4(bf16* p, float a, float b, float c, float d) {
    uint2 u; u.x = (unsigned)f2bf(a) | ((unsigned)f2bf(b) << 16); u.y = (unsigned)f2bf(c) | ((unsigned)f2bf(d) << 16);
    *(uint2*)p = u;
}
__device__ __forceinline__ float wave_sum(float v) {
#pragma unroll
    for (int o = 1; o < 64; o <<= 1) v += __shfl_xor(v, o);
    return v;
}
__device__ __forceinline__ float silu_f(float x) { return x / (1.f + __expf(-x)); }
__device__ __forceinline__ float sigmoid_f(float x) { return 1.f / (1.f + __expf(-x)); }
__device__ __forceinline__ int modrow(int r) { return r < NL ? r / T : 8; }
__device__ __forceinline__ const float* xrow(const Params& p, int l, int r) {
    if (l == 0) return r < NL ? p.in[I_X] + (size_t)r * D : p.in[I_CTX] + (size_t)(r - NL) * D;
    return r < NL ? p.out + (size_t)r * D : (const float*)(p.ws + WS_XC) + (size_t)(r - NL) * D;
}
__device__ __forceinline__ const float* modv(const Params& p, int l, int mb, int which) {
    return (const float*)(p.ws + WS_MODV) + ((size_t)(l * 9 + mb) * 6 + which) * D;
}

template <class AF, class BF>
__device__ __forceinline__ void gemm64(float (&acc)[4][4], int K, AF aload, BF bload, float* sA, float* sB) {
    const int tid = threadIdx.x, ty = tid >> 4, tx = tid & 15;
    const int am = tid >> 2, ak = (tid & 3) * 4;
    const int bk = tid >> 4, bn = (tid & 15) * 4;
    for (int k0 = 0; k0 < K; k0 += 16) {
        float4 av = aload(am, k0 + ak);
        float4 bv = bload(k0 + bk, bn);
        __syncthreads();
        sA[(ak + 0) * 68 + am] = av.x; sA[(ak + 1) * 68 + am] = av.y; sA[(ak + 2) * 68 + am] = av.z; sA[(ak + 3) * 68 + am] = av.w;
        *(float4*)&sB[bk * 64 + bn] = bv;
        __syncthreads();
#pragma unroll
        for (int kk = 0; kk < 16; ++kk) {
            float4 a = *(float4*)&sA[kk * 68 + ty * 4];
            float4 b = *(float4*)&sB[kk * 64 + tx * 4];
            float aa[4] = {a.x, a.y, a.z, a.w}, bb[4] = {b.x, b.y, b.z, b.w};
#pragma unroll
            for (int i = 0; i < 4; ++i)
#pragma unroll
                for (int j = 0; j < 4; ++j) acc[i][j] += aa[i] * bb[j];
        }
    }
    __syncthreads();
}
__device__ __forceinline__ void zero_acc(float (&acc)[4][4]) {
#pragma unroll
    for (int i = 0; i < 4; ++i)
#pragma unroll
        for (int j = 0; j < 4; ++j) acc[i][j] = 0.f;
}

__device__ void ph_init(const Params& p, float* sm) {
    const int tid = threadIdx.x;
    for (int it = blockIdx.x; it < 49; it += gridDim.x) {
        if (it == 48) {
            float2* rope = (float2*)(p.ws + WS_ROPE);
            for (int e = tid; e < 64 * 16; e += 256) {
                const int pos = e >> 4, i = e & 15;
                const float invf = powf(10000.0f, -(float)(2 * i) / 32.0f);
                const float angf = (float)pos * invf;
                const double ang = (double)angf;
                const double twopi = 6.283185307179586476925286766559;
                const double n = rint(ang / twopi);
                const double r = ang - n * twopi, r2 = r * r;
                double s = 1.0, c = 1.0;
                for (int q = 14; q >= 1; --q) { s = 1.0 - r2 / (double)((2 * q) * (2 * q + 1)) * s; c = 1.0 - r2 / (double)((2 * q - 1) * (2 * q)) * c; }
                s *= r;
                rope[e] = make_float2((float)c, (float)s);
            }
            continue;
        }
        const int l = it / 24, cb = it % 24;
        __syncthreads();
        for (int e = tid; e < 9 * D; e += 256) {
            const int mb = e / D, k = e % D;
            const float v = mb < 8 ? p.in[I_C][mb * D + k] : p.in[I_CCTX][k];
            sm[e] = silu_f(v);
        }
        __syncthreads();
        const int col = cb * 256 + tid;
        const float* w = p.in[I_WMOD] + (size_t)l * D * 6144 + col;
        float acc[9];
#pragma unroll
        for (int m = 0; m < 9; ++m) acc[m] = 0.f;
#pragma unroll 4
        for (int k = 0; k < D; ++k) {
            const float wv = w[(size_t)k * 6144];
#pragma unroll
            for (int m = 0; m < 9; ++m) acc[m] += sm[m * D + k] * wv;
        }
        const float bias = p.in[I_BMOD][l * 6144 + col];
        float* mv = (float*)(p.ws + WS_MODV);
#pragma unroll
        for (int m = 0; m < 9; ++m) mv[(size_t)(l * 9 + m) * 6144 + col] = acc[m] + bias;
    }
}

__device__ void ph_norm1(const Params& p, int l) {
    const int lane = threadIdx.x & 63, gw = blockIdx.x * 4 + (threadIdx.x >> 6), ngw = gridDim.x * 4;
    bf16* H = (bf16*)(p.ws + WS_H);
    const float* g = p.in[I_N1G] + l * D;
    for (int r = gw; r < NTOK; r += ngw) {
        const float* x = xrow(p, l, r);
        const int mb = modrow(r);
        const float* sh = modv(p, l, mb, 0); const float* sc = modv(p, l, mb, 1);
        float4 v[4]; float ss = 0.f;
#pragma unroll
        for (int j = 0; j < 4; ++j) { v[j] = *(const float4*)(x + j * 256 + lane * 4); ss += v[j].x * v[j].x + v[j].y * v[j].y + v[j].z * v[j].z + v[j].w * v[j].w; }
        const float inv = rsqrtf(wave_sum(ss) * (1.f / D) + EPS);
#pragma unroll
        for (int j = 0; j < 4; ++j) {
            const int c = j * 256 + lane * 4;
            const float4 gg = *(const float4*)(g + c), s1 = *(const float4*)(sh + c), s2 = *(const float4*)(sc + c);
            st_bf4(H + (size_t)r * D + c, v[j].x * inv * gg.x * (1.f + s2.x) + s1.x, v[j].y * inv * gg.y * (1.f + s2.y) + s1.y,
                   v[j].z * inv * gg.z * (1.f + s2.z) + s1.z, v[j].w * inv * gg.w * (1.f + s2.w) + s1.w);
        }
    }
}

__device__ void ph_gemm_in(const Params& p, int l, float* sm) {
    float* sA = sm; float* sB = sm + 16 * 68;
    const bf16* H = (const bf16*)(p.ws + WS_H);
    bf16* PROJ = (bf16*)(p.ws + WS_PROJ);
    const float* W = p.in[I_WIN] + (size_t)l * D * INW;
    const int nN = (INW + 63) / 64, nM = NTOK / 64;
    const int tid = threadIdx.x, ty = tid >> 4, tx = tid & 15;
    for (int it = blockIdx.x; it < nM * nN; it += gridDim.x) {
        const int tm = it / nN, tn = it % nN, r0 = tm * 64, c0 = tn * 64;
        float acc[4][4]; zero_acc(acc);
        gemm64(acc, D,
               [&](int m, int k) { return ld_bf4(H + (size_t)(r0 + m) * D + k); },
               [&](int k, int n) { return (c0 + n < INW) ? *(const float4*)(W + (size_t)k * INW + c0 + n) : make_float4(0.f, 0.f, 0.f, 0.f); },
               sA, sB);
        if (c0 + tx * 4 < INW) {
#pragma unroll
            for (int i = 0; i < 4; ++i) st_bf4(PROJ + (size_t)(r0 + ty * 4 + i) * INW + c0 + tx * 4, acc[i][0], acc[i][1], acc[i][2], acc[i][3]);
        }
    }
}

__device__ void ph_prep(const Params& p, int l) {
    bf16* PROJ = (bf16*)(p.ws + WS_PROJ);
    const float2* rope = (const float2*)(p.ws + WS_ROPE);
    const long total = (long)NTOK * 10;
    for (long id = (long)blockIdx.x * 256 + threadIdx.x; id < total; id += (long)gridDim.x * 256) {
        const int r = (int)(id / 10), j = (int)(id % 10);
        const bool isq = j < 8;
        if (l == 1 && r >= NL && isq) continue;
        bf16* ptr = PROJ + (size_t)r * INW + (isq ? O_AQ + j * 64 : O_AK + (j - 8) * 64);
        const float* g = p.in[isq ? I_QNG : I_KNG] + l * 64;
        float v[64]; float ss = 0.f;
#pragma unroll
        for (int q = 0; q < 16; ++q) { float4 t = ld_bf4(ptr + q * 4); v[q * 4] = t.x; v[q * 4 + 1] = t.y; v[q * 4 + 2] = t.z; v[q * 4 + 3] = t.w; }
#pragma unroll
        for (int d = 0; d < 64; ++d) ss += v[d] * v[d];
        const float inv = rsqrtf(ss * (1.f / 64.f) + EPS);
#pragma unroll
        for (int d = 0; d < 64; ++d) v[d] = v[d] * inv * g[d];
        if (r < NL) {
            const int t = r % T, row = t >> 6, col = t & 63;
#pragma unroll
            for (int i = 0; i < 16; ++i) {
                const float2 a = rope[row * 16 + i]; const float x1 = v[i], x2 = v[16 + i];
                v[i] = x1 * a.x - x2 * a.y; v[16 + i] = x1 * a.y + x2 * a.x;
                const float2 b = rope[col * 16 + i]; const float y1 = v[32 + i], y2 = v[48 + i];
                v[32 + i] = y1 * b.x - y2 * b.y; v[48 + i] = y1 * b.y + y2 * b.x;
            }
        }
        const float sc = isq ? 0.125f : 1.f;
#pragma unroll
        for (int q = 0; q < 16; ++q) st_bf4(ptr + q * 4, v[q * 4] * sc, v[q * 4 + 1] * sc, v[q * 4 + 2] * sc, v[q * 4 + 3] * sc);
    }
}

__device__ void ph_attn(const Params& p, int l, float* sm) {
    float* sQ = sm;
    float* sK = sQ + 64 * 65;
    float* sV = sK + 64 * 65;
    float* sP = sV + 64 * 64;
    bf16* PROJ = (bf16*)(p.ws + WS_PROJ);
    const int tid = threadIdx.x, ty = tid >> 4, tx = tid & 15;
    float mq = 0.f, mk = 0.f;
    for (int d = 0; d < 64; ++d) { mq = fmaxf(mq, fabsf(p.in[I_QNG][l * 64 + d])); mk = fmaxf(mk, fabsf(p.in[I_KNG][l * 64 + d])); }
    const float shift = 8.f * mq * mk;
    const int nlat = NB * 8 * 64, nctx = (l == 0) ? NB * 8 * 4 : 0;
    for (int it = blockIdx.x; it < nlat + nctx; it += gridDim.x) {
        int b, head, qrow0, nkt; bool lat = it < nlat;
        if (lat) { b = it / 512; head = (it / 64) % 8; qrow0 = b * T + (it % 64) * 64; nkt = 68; }
        else { const int j = it - nlat; b = j / 32; head = (j / 4) % 8; qrow0 = NL + b * CL + (j % 4) * 64; nkt = 4; }
        const int kvh = head >> 2;
        __syncthreads();
        {
            const int m = tid >> 2, d0 = (tid & 3) * 16;
            const bf16* src = PROJ + (size_t)(qrow0 + m) * INW + O_AQ + head * 64 + d0;
#pragma unroll
            for (int q = 0; q < 4; ++q) { float4 t = ld_bf4(src + q * 4); sQ[m * 65 + d0 + q * 4] = t.x; sQ[m * 65 + d0 + q * 4 + 1] = t.y; sQ[m * 65 + d0 + q * 4 + 2] = t.z; sQ[m * 65 + d0 + q * 4 + 3] = t.w; }
        }
        float o[4][4]; zero_acc(o);
        float lsum[4] = {0.f, 0.f, 0.f, 0.f};
        for (int kt = 0; kt < nkt; ++kt) {
            int krow0;
            if (lat) krow0 = (kt < 64) ? b * T + kt * 64 : NL + b * CL + (kt - 64) * 64;
            else krow0 = NL + b * CL + kt * 64;
            __syncthreads();
            {
                const int m = tid >> 2, d0 = (tid & 3) * 16;
                const bf16* ks = PROJ + (size_t)(krow0 + m) * INW + O_AK + kvh * 64 + d0;
                const bf16* vs = PROJ + (size_t)(krow0 + m) * INW + O_AV + kvh * 64 + d0;
#pragma unroll
                for (int q = 0; q < 4; ++q) {
                    float4 t = ld_bf4(ks + q * 4); sK[m * 65 + d0 + q * 4] = t.x; sK[m * 65 + d0 + q * 4 + 1] = t.y; sK[m * 65 + d0 + q * 4 + 2] = t.z; sK[m * 65 + d0 + q * 4 + 3] = t.w;
                    float4 u = ld_bf4(vs + q * 4); *(float4*)&sV[m * 64 + d0 + q * 4] = u;
                }
            }
            __syncthreads();
            float s[4][4]; zero_acc(s);
#pragma unroll 8
            for (int d = 0; d < 64; ++d) {
                float a[4], bb[4];
#pragma unroll
                for (int i = 0; i < 4; ++i) { a[i] = sQ[(ty * 4 + i) * 65 + d]; bb[i] = sK[(tx * 4 + i) * 65 + d]; }
#pragma unroll
                for (int i = 0; i < 4; ++i)
#pragma unroll
                    for (int j = 0; j < 4; ++j) s[i][j] += a[i] * bb[j];
            }
#pragma unroll
            for (int i = 0; i < 4; ++i)
#pragma unroll
                for (int j = 0; j < 4; ++j) { const float e = __expf(s[i][j] - shift); lsum[i] += e; sP[(ty * 4 + i) * 65 + tx * 4 + j] = e; }
            __syncthreads();
#pragma unroll 8
            for (int k = 0; k < 64; ++k) {
                const float4 vv = *(const float4*)&sV[k * 64 + tx * 4];
#pragma unroll
                for (int i = 0; i < 4; ++i) {
                    const float pp = sP[(ty * 4 + i) * 65 + k];
                    o[i][0] += pp * vv.x; o[i][1] += pp * vv.y; o[i][2] += pp * vv.z; o[i][3] += pp * vv.w;
                }
            }
        }
#pragma unroll
        for (int i = 0; i < 4; ++i) {
            float ls = lsum[i];
            ls += __shfl_xor(ls, 1); ls += __shfl_xor(ls, 2); ls += __shfl_xor(ls, 4); ls += __shfl_xor(ls, 8);
            const float inv = 1.f / ls;
            st_bf4(PROJ + (size_t)(qrow0 + ty * 4 + i) * INW + O_AQ + head * 64 + tx * 4, o[i][0] * inv, o[i][1] * inv, o[i][2] * inv, o[i][3] * inv);
        }
    }
}

__device__ void ph_gla(const Params& p, int l, float* sm) {
    constexpr int DVS = 64;
    float* sB = sm;
    float* sQ = sB + 4096;
    float* sK = sQ + 4096;
    float* sV = sK + 4096;
    float* sS = sV + 64 * DVS;
    float* sP = sS + 64 * DVS;
    const bf16* PROJ = (const bf16*)(p.ws + WS_PROJ);
    const int tid = threadIdx.x, ti = tid >> 2, part = tid & 3;
    for (int it = blockIdx.x; it < NB * 4 * 2 * 2; it += gridDim.x) {
        const int b = it >> 4, h = (it >> 2) & 3, dir = (it >> 1) & 1, sl = it & 1;
        bf16* OG = (bf16*)(p.ws + WS_R2 + (size_t)dir * SZ_Y512);
        const float* up = p.in[dir ? I_UPB : I_UPF] + (size_t)l * 16 * 256;
        const float* bias = p.in[dir ? I_BIASB : I_BIASF] + l * 256;
        const int ogl = dir ? O_GLB : O_GLF;
        __syncthreads();
        for (int e = tid; e < 64 * DVS; e += 256) sS[e] = 0.f;
        for (int n = 0; n < 68; ++n) {
            int base;
            if (n < 4) base = NL + b * CL + (dir ? 3 - n : n) * 64;
            else base = b * T + (dir ? 63 - (n - 4) : (n - 4)) * 64;
            const int tok = dir ? base + 63 - ti : base + ti;
            const bf16* prow = PROJ + (size_t)tok * INW;
            __syncthreads();
            {
                float g[16];
#pragma unroll
                for (int q = 0; q < 4; ++q) { float4 t = ld_bf4(prow + ogl + q * 4); g[q * 4] = t.x; g[q * 4 + 1] = t.y; g[q * 4 + 2] = t.z; g[q * 4 + 3] = t.w; }
#pragma unroll 4
                for (int dd = 0; dd < 16; ++dd) {
                    const int dk = part * 16 + dd, col = h * 64 + dk;
                    float a = bias[col];
#pragma unroll
                    for (int j = 0; j < 16; ++j) a += g[j] * up[j * 256 + col];
                    const float ls = fminf(a, 0.f) - log1pf(__expf(-fabsf(a)));
                    sB[ti * 64 + dk] = ls * (1.f / 16.f);
                }
            }
            __syncthreads();
            if (tid < 64) { float run = 0.f; for (int i = 0; i < 64; ++i) { run += sB[i * 64 + tid]; sB[i * 64 + tid] = run; } }
            __syncthreads();
            {
#pragma unroll
                for (int q = 0; q < 4; ++q) {
                    const int dk = part * 16 + q * 4;
                    float4 qq = ld_bf4(prow + O_GQ + h * 64 + dk), kk = ld_bf4(prow + O_GK + h * 64 + dk);
                    const float qa[4] = {qq.x, qq.y, qq.z, qq.w}, ka[4] = {kk.x, kk.y, kk.z, kk.w};
#pragma unroll
                    for (int e = 0; e < 4; ++e) {
                        const float bi = sB[ti * 64 + dk + e], br = sB[32 * 64 + dk + e];
                        sQ[ti * 64 + dk + e] = qa[e] * 0.125f * __expf(bi - br);
                        sK[ti * 64 + dk + e] = ka[e] * __expf(br - bi);
                    }
                }
#pragma unroll
                for (int q = 0; q < DVS / 16; ++q) {
                    const int dv = part * (DVS / 4) + q * 4;
                    float4 vv = ld_bf4(prow + O_GV + h * 128 + sl * DVS + dv);
                    *(float4*)&sV[ti * DVS + dv] = vv;
                }
            }
            __syncthreads();
            {
#pragma unroll 4
                for (int ss = 0; ss < 16; ++ss) {
                    const int s = part * 16 + ss;
                    float a = 0.f;
                    if (s <= ti) { for (int dk = 0; dk < 64; ++dk) a += sQ[ti * 64 + dk] * sK[s * 64 + dk]; }
                    sP[ti * 64 + s] = a;
                }
            }
            __syncthreads();
            {
                float o[DVS / 4];
#pragma unroll
                for (int e = 0; e < DVS / 4; ++e) o[e] = 0.f;
                for (int s = 0; s <= ti; ++s) {
                    const float pp = sP[ti * 64 + s];
#pragma unroll
                    for (int e = 0; e < DVS / 4; ++e) o[e] += pp * sV[s * DVS + part * (DVS / 4) + e];
                }
                for (int dk = 0; dk < 64; ++dk) {
                    const float qq = sQ[ti * 64 + dk] * __expf(sB[32 * 64 + dk]);
#pragma unroll
                    for (int e = 0; e < DVS / 4; ++e) o[e] += qq * sS[dk * DVS + part * (DVS / 4) + e];
                }
                bf16* dst = OG + (size_t)tok * 512 + h * 128 + sl * DVS + part * (DVS / 4);
#pragma unroll
                for (int e = 0; e < DVS / 4; e += 4) st_bf4(dst + e, o[e], o[e + 1], o[e + 2], o[e + 3]);
            }
            __syncthreads();
            {
                const int dk = ti;
                const float bl = sB[63 * 64 + dk], br = sB[32 * 64 + dk];
                const float al = __expf(bl), ar = __expf(bl - br);
                float acc[DVS / 4];
#pragma unroll
                for (int e = 0; e < DVS / 4; ++e) acc[e] = 0.f;
                for (int s = 0; s < 64; ++s) {
                    const float kk = sK[s * 64 + dk];
#pragma unroll
                    for (int e = 0; e < DVS / 4; ++e) acc[e] += kk * sV[s * DVS + part * (DVS / 4) + e];
                }
#pragma unroll
                for (int e = 0; e < DVS / 4; ++e) { const int ix = dk * DVS + part * (DVS / 4) + e; sS[ix] = al * sS[ix] + ar * acc[e]; }
            }
        }
    }
}

__device__ void ph_pool(const Params& p, int l, float* sm) {
    float* sA = sm; float* sB = sm + 16 * 68;
    const bf16* PROJ = (const bf16*)(p.ws + WS_PROJ);
    bf16* YP = (bf16*)(p.ws + WS_R2 + 2 * SZ_Y512);
    const int nrows = (l == 0) ? NTOK : NL;
    const int nM = nrows / 64;
    const int tid = threadIdx.x, ty = tid >> 4, tx = tid & 15;
    for (int it = blockIdx.x; it < nM * 8; it += gridDim.x) {
        const int tm = it >> 3, g = (it >> 1) & 3, tn = it & 1, r0 = tm * 64, win = 2 << g, hw = win >> 1;
        const float* W = p.in[I_POOLW] + ((size_t)(l * 4 + g) * 128) * 128;
        float acc[4][4]; zero_acc(acc);
        gemm64(acc, 128,
               [&](int m, int k) {
                   const int r = r0 + m;
                   int t, base, tl;
                   if (r < NL) { t = r % T; base = r - t; tl = T; } else { t = (r - NL) % CL; base = r - t; tl = CL; }
                   const int lo = max(t - hw, 0), hi = min(t + hw, tl);
                   float4 s = make_float4(0.f, 0.f, 0.f, 0.f);
                   for (int u = lo; u < hi; ++u) { float4 v = ld_bf4(PROJ + (size_t)(base + u) * INW + O_PU + g * 128 + k); s.x += v.x; s.y += v.y; s.z += v.z; s.w += v.w; }
                   const float inv = 1.f / (float)(hi - lo);
                   float4 c = ld_bf4(PROJ + (size_t)r * INW + O_PU + g * 128 + k);
                   return make_float4(s.x * inv - c.x, s.y * inv - c.y, s.z * inv - c.z, s.w * inv - c.w);
               },
               [&](int k, int n) { return *(const float4*)(W + (size_t)k * 128 + tn * 64 + n); },
               sA, sB);
        const float4 sc = *(const float4*)(p.in[I_POOLS] + l * 512 + g * 128 + tn * 64 + tx * 4);
#pragma unroll
        for (int i = 0; i < 4; ++i)
            st_bf4(YP + (size_t)(r0 + ty * 4 + i) * 512 + g * 128 + tn * 64 + tx * 4, acc[i][0] * sc.x, acc[i][1] * sc.y, acc[i][2] * sc.z, acc[i][3] * sc.w);
    }
}

__device__ void ph_ygla(const Params& p, int l) {
    const int lane = threadIdx.x & 63, gw = blockIdx.x * 4 + (threadIdx.x >> 6), ngw = gridDim.x * 4;
    bf16* O0 = (bf16*)(p.ws + WS_R2);
    const bf16* O1 = (const bf16*)(p.ws + WS_R2 + SZ_Y512);
    const bf16* PROJ = (const bf16*)(p.ws + WS_PROJ);
    const float* g = p.in[I_GLANG] + l * 128;
    const int nrows = (l == 0) ? NTOK : NL;
    for (int r = gw; r < nrows; r += ngw) {
        const int c = lane * 8;
        float v[8];
        { float4 a = ld_bf4(O0 + (size_t)r * 512 + c), b2 = ld_bf4(O0 + (size_t)r * 512 + c + 4), d = ld_bf4(O1 + (size_t)r * 512 + c), e = ld_bf4(O1 + (size_t)r * 512 + c + 4);
          v[0] = a.x + d.x; v[1] = a.y + d.y; v[2] = a.z + d.z; v[3] = a.w + d.w; v[4] = b2.x + e.x; v[5] = b2.y + e.y; v[6] = b2.z + e.z; v[7] = b2.w + e.w; }
        float ss = 0.f;
#pragma unroll
        for (int e = 0; e < 8; ++e) ss += v[e] * v[e];
        ss += __shfl_xor(ss, 1); ss += __shfl_xor(ss, 2); ss += __shfl_xor(ss, 4); ss += __shfl_xor(ss, 8);
        const float inv = rsqrtf(ss * (1.f / 128.f) + EPS);
        float4 r0 = ld_bf4(PROJ + (size_t)r * INW + O_GR + c), r1 = ld_bf4(PROJ + (size_t)r * INW + O_GR + c + 4);
        const float gr[8] = {r0.x, r0.y, r0.z, r0.w, r1.x, r1.y, r1.z, r1.w};
        float o[8];
#pragma unroll
        for (int e = 0; e < 8; ++e) o[e] = v[e] * inv * g[(c + e) & 127] * silu_f(gr[e]);
        st_bf4(O0 + (size_t)r * 512 + c, o[0], o[1], o[2], o[3]);
        st_bf4(O0 + (size_t)r * 512 + c + 4, o[4], o[5], o[6], o[7]);
    }
}

__device__ void ph_merge(const Params& p, int l, float* sm) {
    float* sA = sm; float* sB = sm + 16 * 68;
    const bf16* PROJ = (const bf16*)(p.ws + WS_PROJ);
    const bf16* YG = (const bf16*)(p.ws + WS_R2);
    const bf16* YP = (const bf16*)(p.ws + WS_R2 + 2 * SZ_Y512);
    bf16* Z = (bf16*)(p.ws + WS_H);
    const int nrows = (l == 0) ? NTOK : NL, nM = nrows / 64;
    const int tid = threadIdx.x, ty = tid >> 4, tx = tid & 15;
    for (int it = blockIdx.x; it < nM * 16; it += gridDim.x) {
        const int tm = it >> 4, tn = it & 15, r0 = tm * 64, c0 = tn * 64;
        float tot[4][4]; zero_acc(tot);
        for (int br = 0; br < 3; ++br) {
            const float* W = p.in[I_WBR] + ((size_t)(l * 3 + br) * 512) * D;
            float acc[4][4]; zero_acc(acc);
            gemm64(acc, 512,
                   [&](int m, int k) {
                       const int r = r0 + m;
                       if (br == 0) return ld_bf4(YG + (size_t)r * 512 + k);
                       if (br == 1) return ld_bf4(PROJ + (size_t)r * INW + O_AQ + k);
                       return ld_bf4(YP + (size_t)r * 512 + k);
                   },
                   [&](int k, int n) { return *(const float4*)(W + (size_t)k * D + c0 + n); },
                   sA, sB);
#pragma unroll
            for (int i = 0; i < 4; ++i) {
                float4 gt = ld_bf4(PROJ + (size_t)(r0 + ty * 4 + i) * INW + O_GT + br * D + c0 + tx * 4);
                tot[i][0] += sigmoid_f(gt.x) * acc[i][0]; tot[i][1] += sigmoid_f(gt.y) * acc[i][1];
                tot[i][2] += sigmoid_f(gt.z) * acc[i][2]; tot[i][3] += sigmoid_f(gt.w) * acc[i][3];
            }
        }
#pragma unroll
        for (int i = 0; i < 4; ++i) st_bf4(Z + (size_t)(r0 + ty * 4 + i) * D + c0 + tx * 4, tot[i][0], tot[i][1], tot[i][2], tot[i][3]);
    }
}

__device__ void ph_outproj(const Params& p, int l, float* sm) {
    float* sA = sm; float* sB = sm + 16 * 68;
    const bf16* Z = (const bf16*)(p.ws + WS_H);
    const float* W = p.in[I_WOUT] + (size_t)l * D * D;
    const int nrows = (l == 0) ? NTOK : NL, nM = nrows / 64;
    const int tid = threadIdx.x, ty = tid >> 4, tx = tid & 15;
    for (int it = blockIdx.x; it < nM * 16; it += gridDim.x) {
        const int tm = it >> 4, tn = it & 15, r0 = tm * 64, c0 = tn * 64;
        float acc[4][4]; zero_acc(acc);
        gemm64(acc, D,
               [&](int m, int k) { return ld_bf4(Z + (size_t)(r0 + m) * D + k); },
               [&](int k, int n) { return *(const float4*)(W + (size_t)k * D + c0 + n); },
               sA, sB);
#pragma unroll
        for (int i = 0; i < 4; ++i) {
            const int r = r0 + ty * 4 + i, c = c0 + tx * 4;
            const float4 xo = *(const float4*)(xrow(p, l, r) + c);
            const float4 g1 = *(const float4*)(modv(p, l, modrow(r), 2) + c);
            float* dst = r < NL ? p.out + (size_t)r * D + c : (float*)(p.ws + WS_XC) + (size_t)(r - NL) * D + c;
            *(float4*)dst = make_float4(xo.x + g1.x * acc[i][0], xo.y + g1.y * acc[i][1], xo.z + g1.z * acc[i][2], xo.w + g1.w * acc[i][3]);
        }
    }
}

__device__ __forceinline__ const float* x1row(const Params& p, int r) {
    return r < NL ? p.out + (size_t)r * D : (const float*)(p.ws + WS_XC) + (size_t)(r - NL) * D;
}
__device__ void ph_router(const Params& p, int l) {
    const int lane = threadIdx.x & 63, gw = blockIdx.x * 4 + (threadIdx.x >> 6), ngw = gridDim.x * 4;
    bf16* H = (bf16*)(p.ws + WS_H);
    const float* g = p.in[I_N2G] + l * D;
    const float* wg = p.in[I_WGRP] + (size_t)l * D * 4;
    const float* we = p.in[I_WEXP] + (size_t)l * D * 32;
    unsigned* cnt = (unsigned*)(p.ws + WS_CTL) + l * 32;
    int* list = (int*)(p.ws + WS_LIST);
    float* wt = (float*)(p.ws + WS_WT);
    const int nrows = (l == 0) ? NTOK : NL;
    for (int r = gw; r < nrows; r += ngw) {
        const float* x = x1row(p, r);
        const int mb = modrow(r);
        const float* sh = modv(p, l, mb, 3); const float* sc = modv(p, l, mb, 4);
        float4 v[4]; float ss = 0.f;
#pragma unroll
        for (int j = 0; j < 4; ++j) { v[j] = *(const float4*)(x + j * 256 + lane * 4); ss += v[j].x * v[j].x + v[j].y * v[j].y + v[j].z * v[j].z + v[j].w * v[j].w; }
        const float inv = rsqrtf(wave_sum(ss) * (1.f / D) + EPS);
        float hv[16];
#pragma unroll
        for (int j = 0; j < 4; ++j) {
            const int c = j * 256 + lane * 4;
            const float4 gg = *(const float4*)(g + c), s1 = *(const float4*)(sh + c), s2 = *(const float4*)(sc + c);
            hv[j * 4 + 0] = v[j].x * inv * gg.x * (1.f + s2.x) + s1.x; hv[j * 4 + 1] = v[j].y * inv * gg.y * (1.f + s2.y) + s1.y;
            hv[j * 4 + 2] = v[j].z * inv * gg.z * (1.f + s2.z) + s1.z; hv[j * 4 + 3] = v[j].w * inv * gg.w * (1.f + s2.w) + s1.w;
            st_bf4(H + (size_t)r * D + c, hv[j * 4], hv[j * 4 + 1], hv[j * 4 + 2], hv[j * 4 + 3]);
        }
        float lg[4];
#pragma unroll
        for (int o = 0; o < 4; ++o) {
            float a = 0.f;
#pragma unroll
            for (int j = 0; j < 4; ++j)
#pragma unroll
                for (int e = 0; e < 4; ++e) a += hv[j * 4 + e] * wg[(size_t)(j * 256 + lane * 4 + e) * 4 + o];
            lg[o] = wave_sum(a) + p.in[I_BGRP][l * 4 + o];
        }
        int grp = 0; float gmax = lg[0];
#pragma unroll
        for (int o = 1; o < 4; ++o) if (lg[o] > gmax) { gmax = lg[o]; grp = o; }
        float gden = 0.f;
#pragma unroll
        for (int o = 0; o < 4; ++o) gden += __expf(lg[o] - gmax);
        const float ptg = 1.f / gden;
        float le[8];
#pragma unroll
        for (int o = 0; o < 8; ++o) {
            float a = 0.f;
            const int col = grp * 8 + o;
#pragma unroll
            for (int j = 0; j < 4; ++j)
#pragma unroll
                for (int e = 0; e < 4; ++e) a += hv[j * 4 + e] * we[(size_t)(j * 256 + lane * 4 + e) * 32 + col];
            le[o] = wave_sum(a) + p.in[I_BEXP][l * 32 + col];
        }
        int i1 = 0; float m1 = le[0];
#pragma unroll
        for (int o = 1; o < 8; ++o) if (le[o] > m1) { m1 = le[o]; i1 = o; }
        int i2 = -1; float m2 = -3.0e38f;
#pragma unroll
        for (int o = 0; o < 8; ++o) if (o != i1 && le[o] > m2) { m2 = le[o]; i2 = o; }
        const float e2 = __expf(m2 - m1);
        const float w1 = ptg / (1.f + e2), w2 = ptg * e2 / (1.f + e2);
        if (lane == 0) {
            const int ea = grp * 8 + i1, eb = grp * 8 + i2;
            const unsigned pa = atomicAdd(&cnt[ea], 1u); list[(size_t)ea * NTOK + pa] = r * 2;
            const unsigned pb = atomicAdd(&cnt[eb], 1u); list[(size_t)eb * NTOK + pb] = r * 2 + 1;
            wt[r * 2] = w1; wt[r * 2 + 1] = w2;
        }
    }
}

__device__ void ph_moe1(const Params& p, int l, float* sm) {
    float* sA = sm; float* sB = sm + 16 * 68;
    const bf16* H = (const bf16*)(p.ws + WS_H);
    bf16* ACT = (bf16*)(p.ws + WS_ACT);
    const unsigned* cnt = (const unsigned*)(p.ws + WS_CTL) + l * 32;
    const int* list = (const int*)(p.ws + WS_LIST);
    const int tid = threadIdx.x, ty = tid >> 4, tx = tid & 15;
    int tstart[33]; tstart[0] = 0;
#pragma unroll
    for (int e = 0; e < 32; ++e) tstart[e + 1] = tstart[e] + (int)((cnt[e] + 63u) >> 6);
    const int ntiles = tstart[32];
    for (int it = blockIdx.x; it < ntiles * 8; it += gridDim.x) {
        const int trow = it >> 3, tn = it & 7, c0 = tn * 64;
        int e = 0;
#pragma unroll
        for (int q = 1; q < 32; ++q) if (trow >= tstart[q]) e = q;
        int tbase = 0;
#pragma unroll
        for (int q = 0; q < 32; ++q) if (q == e) tbase = tstart[q];
        const int i0 = (trow - tbase) * 64, ce = (int)cnt[e];
        const int* le = list + (size_t)e * NTOK;
        const float* Wg = p.in[I_WGATE] + ((size_t)(l * 32 + e) * D) * 512;
        const float* Wu = p.in[I_WUP] + ((size_t)(l * 32 + e) * D) * 512;
        float ag[4][4], au[4][4]; zero_acc(ag); zero_acc(au);
        auto al = [&](int m, int k) { const int ii = min(i0 + m, ce - 1); const int tok = le[ii] >> 1; return ld_bf4(H + (size_t)tok * D + k); };
        gemm64(ag, D, al, [&](int k, int n) { return *(const float4*)(Wg + (size_t)k * 512 + c0 + n); }, sA, sB);
        gemm64(au, D, al, [&](int k, int n) { return *(const float4*)(Wu + (size_t)k * 512 + c0 + n); }, sA, sB);
#pragma unroll
        for (int i = 0; i < 4; ++i) {
            const int ii = i0 + ty * 4 + i;
            if (ii < ce) {
                const int asg = le[ii];
                st_bf4(ACT + (size_t)asg * 512 + c0 + tx * 4, silu_f(ag[i][0]) * au[i][0], silu_f(ag[i][1]) * au[i][1], silu_f(ag[i][2]) * au[i][2], silu_f(ag[i][3]) * au[i][3]);
            }
        }
    }
}

__device__ void ph_moe2(const Params& p, int l, float* sm) {
    float* sA = sm; float* sB = sm + 16 * 68;
    const bf16* ACT = (const bf16*)(p.ws + WS_ACT);
    const unsigned* cnt = (const unsigned*)(p.ws + WS_CTL) + l * 32;
    const int* list = (const int*)(p.ws + WS_LIST);
    const float* wt = (const float*)(p.ws + WS_WT);
    const int tid = threadIdx.x, ty = tid >> 4, tx = tid & 15;
    int tstart[33]; tstart[0] = 0;
#pragma unroll
    for (int e = 0; e < 32; ++e) tstart[e + 1] = tstart[e] + (int)((cnt[e] + 63u) >> 6);
    const int ntiles = tstart[32];
    for (int it = blockIdx.x; it < ntiles * 16; it += gridDim.x) {
        const int trow = it >> 4, tn = it & 15, c0 = tn * 64;
        int e = 0;
#pragma unroll
        for (int q = 1; q < 32; ++q) if (trow >= tstart[q]) e = q;
        int tbase = 0;
#pragma unroll
        for (int q = 0; q < 32; ++q) if (q == e) tbase = tstart[q];
        const int i0 = (trow - tbase) * 64, ce = (int)cnt[e];
        const int* le = list + (size_t)e * NTOK;
        const float* Wd = p.in[I_WDOWN] + ((size_t)(l * 32 + e) * 512) * D;
        float acc[4][4]; zero_acc(acc);
        gemm64(acc, 512,
               [&](int m, int k) { const int ii = min(i0 + m, ce - 1); return ld_bf4(ACT + (size_t)le[ii] * 512 + k); },
               [&](int k, int n) { return *(const float4*)(Wd + (size_t)k * D + c0 + n); }, sA, sB);
#pragma unroll
        for (int i = 0; i < 4; ++i) {
            const int ii = i0 + ty * 4 + i;
            if (ii < ce) {
                const int asg = le[ii], tok = asg >> 1, kk = asg & 1;
                const float w = wt[asg];
                bf16* Y = (bf16*)(p.ws + (kk ? WS_Y1 : WS_Y0));
                st_bf4(Y + (size_t)tok * D + c0 + tx * 4, w * acc[i][0], w * acc[i][1], w * acc[i][2], w * acc[i][3]);
            }
        }
    }
}

__device__ void ph_combine(const Params& p, int l) {
    const int lane = threadIdx.x & 63, gw = blockIdx.x * 4 + (threadIdx.x >> 6), ngw = gridDim.x * 4;
    const bf16* Y0 = (const bf16*)(p.ws + WS_Y0);
    const bf16* Y1 = (const bf16*)(p.ws + WS_Y1);
    const int nrows = (l == 0) ? NTOK : NL;
    for (int r = gw; r < nrows; r += ngw) {
        const float* x = x1row(p, r);
        float* xo = r < NL ? p.out + (size_t)r * D : (float*)(p.ws + WS_XC) + (size_t)(r - NL) * D;
        const float* g2 = modv(p, l, modrow(r), 5);
        float4 v[4]; float ss = 0.f;
#pragma unroll
        for (int j = 0; j < 4; ++j) {
            const int c = j * 256 + lane * 4;
            const float4 xv = *(const float4*)(x + c), gg = *(const float4*)(g2 + c);
            const float4 a = ld_bf4(Y0 + (size_t)r * D + c), b = ld_bf4(Y1 + (size_t)r * D + c);
            v[j] = make_float4(xv.x + gg.x * (a.x + b.x), xv.y + gg.y * (a.y + b.y), xv.z + gg.z * (a.z + b.z), xv.w + gg.w * (a.w + b.w));
            ss += v[j].x * v[j].x + v[j].y * v[j].y + v[j].z * v[j].z + v[j].w * v[j].w;
        }
        if (l == 0) {
#pragma unroll
            for (int j = 0; j < 4; ++j) *(float4*)(xo + j * 256 + lane * 4) = v[j];
        } else {
            const float inv = rsqrtf(wave_sum(ss) * (1.f / D) + EPS);
            const float* fg = p.in[I_FING];
#pragma unroll
            for (int j = 0; j < 4; ++j) {
                const int c = j * 256 + lane * 4;
                const float4 gg = *(const float4*)(fg + c);
                *(float4*)(xo + c) = make_float4(v[j].x * inv * gg.x, v[j].y * inv * gg.y, v[j].z * inv * gg.z, v[j].w * inv * gg.w);
            }
        }
    }
}

constexpr int lds_bytes(int ph) { return ph == 0 ? 40 * 1024 : ph == 4 ? 66 * 1024 : ph == 5 ? 96 * 1024 : 10 * 1024; }
template <int PH>
__global__ void __launch_bounds__(256) k_phase(Params p, int l) {
    extern __shared__ __attribute__((aligned(16))) unsigned char smem_raw[];
    float* sm = (float*)smem_raw;
    if (PH == 0) ph_init(p, sm);
    if (PH == 1) ph_norm1(p, l);
    if (PH == 2) ph_gemm_in(p, l, sm);
    if (PH == 3) ph_prep(p, l);
    if (PH == 4) ph_attn(p, l, sm);
    if (PH == 5) ph_gla(p, l, sm);
    if (PH == 6) ph_pool(p, l, sm);
    if (PH == 7) ph_ygla(p, l);
    if (PH == 8) ph_merge(p, l, sm);
    if (PH == 9) ph_outproj(p, l, sm);
    if (PH == 10) ph_router(p, l);
    if (PH == 11) ph_moe1(p, l, sm);
    if (PH == 12) ph_moe2(p, l, sm);
    if (PH == 13) ph_combine(p, l);
}

template <int PH>
static void launch_phase(const Params& p, int l, int grid, hipStream_t stream) {
    static bool attr_set = false;
    if (!attr_set) { (void)hipFuncSetAttribute((const void*)k_phase<PH>, hipFuncAttributeMaxDynamicSharedMemorySize, lds_bytes(PH)); attr_set = true; }
    hipLaunchKernelGGL(k_phase<PH>, dim3(grid), dim3(256), lds_bytes(PH), stream, p, l);
}

extern "C" void kernel_launch(void* const* d_in, const int* in_sizes, int n_in, void* d_out, int out_size, void* d_ws, size_t ws_size,
                              hipStream_t stream) {
    if (n_in != 28 || ws_size < WS_END) { fprintf(stderr, "kernel_launch: bad n_in %d or ws_size %zu (< %zu)\n", n_in, ws_size, (size_t)WS_END); return; }
    Params p{};
    for (int i = 0; i < 28; ++i) p.in[i] = (const float*)d_in[i];
    p.out = (float*)d_out; p.ws = (unsigned char*)d_ws;
    (void)hipMemsetAsync((char*)d_ws + WS_CTL, 0, 1 * MiB, stream);
    const int G = 2048;
    launch_phase<0>(p, 0, 49, stream);
    for (int l = 0; l < 2; ++l) {
        launch_phase<1>(p, l, G, stream);
        launch_phase<2>(p, l, G, stream);
        launch_phase<3>(p, l, G, stream);
        launch_phase<4>(p, l, G, stream);
        launch_phase<5>(p, l, 256, stream);
        launch_phase<6>(p, l, G, stream);
        launch_phase<7>(p, l, G, stream);
        launch_phase<8>(p, l, G, stream);
        launch_phase<9>(p, l, G, stream);
        launch_phase<10>(p, l, G, stream);
        launch_phase<11>(p, l, G, stream);
        launch_phase<12>(p, l, G, stream);
        launch_phase<13>(p, l, G, stream);
    }
}
```

```cpp
#include <hip/hip_runtime.h>
#include <hip/hip_cooperative_groups.h>
namespace cg = cooperative_groups;
#include <cstdio>
#include <cstdint>

typedef unsigned short bf16;

constexpr int D = 1024, NB = 8, T = 4096, CL = 256, NL = NB * T, NC = NB * CL, NTOK = NL + NC;
constexpr int INW = 5920;
constexpr int O_GQ = 0, O_GK = 256, O_GV = 512, O_GR = 1024, O_GLF = 1536, O_GLB = 1552, O_AQ = 1568, O_AK = 2080,
              O_AV = 2208, O_PU = 2336, O_GT = 2848;
constexpr float EPS = 1e-6f;

constexpr size_t MiB = 1u << 20;
constexpr size_t WS_CTL = 0;
constexpr size_t WS_MODV = 1 * MiB;
constexpr size_t WS_ROPE = 1 * MiB + 512 * 1024;
constexpr size_t WS_WT = 2 * MiB;
constexpr size_t WS_LIST = 3 * MiB;
constexpr size_t WS_XC = 8 * MiB;
constexpr size_t WS_H = 16 * MiB;
constexpr size_t WS_PROJ = 84 * MiB;
constexpr size_t WS_R2 = 478 * MiB;
constexpr size_t WS_END = 580 * MiB;
constexpr size_t SZ_Y512 = (size_t)NTOK * 512 * 2;
constexpr size_t WS_ACT = WS_PROJ;
constexpr size_t WS_Y0 = WS_PROJ + 68 * MiB;
constexpr size_t WS_Y1 = WS_PROJ + 136 * MiB;

struct Params {
    const float* in[28];
    float* out;
    unsigned char* ws;
};
enum { I_X = 0, I_C, I_CTX, I_CCTX, I_WMOD, I_BMOD, I_N1G, I_N2G, I_WIN, I_UPF, I_BIASF, I_UPB, I_BIASB, I_GLANG, I_QNG, I_KNG,
       I_POOLW, I_POOLS, I_WBR, I_WOUT, I_WGRP, I_BGRP, I_WEXP, I_BEXP, I_WGATE, I_WUP, I_WDOWN, I_FING };

__device__ __forceinline__ float bf2f(bf16 v) { return __uint_as_float(((unsigned)v) << 16); }
__device__ __forceinline__ bf16 f2bf(float f) { unsigned u = __float_as_uint(f); return (bf16)((u + 0x7fffu + ((u >> 16) & 1u)) >> 16); }
__device__ __forceinline__ float4 ld_bf4(const bf16* p) {
    uint2 u = *(const uint2*)p;
    return make_float4(__uint_as_float(u.x << 16), __uint_as_float(u.x & 0xffff0000u), __uint_as_float(u.y << 16), __uint_as_float(u.y & 0xffff0000u));
}
__device__ __forceinline__ void st_bf4(bf16* p, float a, float b, float c, float d) {
    uint2 u; u.x = (unsigned)f2bf(a) | ((unsigned)f2bf(b) << 16); u.y = (unsigned)f2bf(c) | ((unsigned)f2bf(d) << 16);
    *(uint2*)p = u;
}
__device__ __forceinline__ float wave_sum(float v) {
#pragma unroll
    for (int o = 1; o < 64; o <<= 1) v += __shfl_xor(v, o);
    return v;
}
__device__ __forceinline__ float silu_f(float x) { return x / (1.f + __expf(-x)); }
__device__ __forceinline__ float sigmoid_f(float x) { return 1.f / (1.f + __expf(-x)); }
__device__ __forceinline__ int modrow(int r) { return r < NL ? r / T : 8; }
__device__ __forceinline__ const float* xrow(const Params& p, int l, int r) {
    if (l == 0) return r < NL ? p.in[I_X] + (size_t)r * D : p.in[I_CTX] + (size_t)(r - NL) * D;
    return r < NL ? p.out + (size_t)r * D : (const float*)(p.ws + WS_XC) + (size_t)(r - NL) * D;
}
__device__ __forceinline__ const float* modv(const Params& p, int l, int mb, int which) {
    return (const float*)(p.ws + WS_MODV) + ((size_t)(l * 9 + mb) * 6 + which) * D;
}

template <class AF, class BF>
__device__ __forceinline__ void gemm64(float (&acc)[4][4], int K, AF aload, BF bload, float* sA, float* sB) {
    const int tid = threadIdx.x, ty = tid >> 4, tx = tid & 15;
    const int am = tid >> 2, ak = (tid & 3) * 4;
    const int bk = tid >> 4, bn = (tid & 15) * 4;
    for (int k0 = 0; k0 < K; k0 += 16) {
        float4 av = aload(am, k0 + ak);
        float4 bv = bload(k0 + bk, bn);
        __syncthreads();
        sA[(ak + 0) * 68 + am] = av.x; sA[(ak + 1) * 68 + am] = av.y; sA[(ak + 2) * 68 + am] = av.z; sA[(ak + 3) * 68 + am] = av.w;
        *(float4*)&sB[bk * 64 + bn] = bv;
        __syncthreads();
#pragma unroll
        for (int kk = 0; kk < 16; ++kk) {
            float4 a = *(float4*)&sA[kk * 68 + ty * 4];
            float4 b = *(float4*)&sB[kk * 64 + tx * 4];
            float aa[4] = {a.x, a.y, a.z, a.w}, bb[4] = {b.x, b.y, b.z, b.w};
#pragma unroll
            for (int i = 0; i < 4; ++i)
#pragma unroll
                for (int j = 0; j < 4; ++j) acc[i][j] += aa[i] * bb[j];
        }
    }
    __syncthreads();
}
__device__ __forceinline__ void zero_acc(float (&acc)[4][4]) {
#pragma unroll
    for (int i = 0; i < 4; ++i)
#pragma unroll
        for (int j = 0; j < 4; ++j) acc[i][j] = 0.f;
}

__device__ void ph_init(const Params& p, float* sm) {
    const int tid = threadIdx.x;
    for (int it = blockIdx.x; it < 49; it += gridDim.x) {
        if (it == 48) {
            float2* rope = (float2*)(p.ws + WS_ROPE);
            for (int e = tid; e < 64 * 16; e += 256) {
                const int pos = e >> 4, i = e & 15;
                const float invf = powf(10000.0f, -(float)(2 * i) / 32.0f);
                const float angf = (float)pos * invf;
                const double ang = (double)angf;
                const double twopi = 6.283185307179586476925286766559;
                const double n = rint(ang / twopi);
                const double r = ang - n * twopi, r2 = r * r;
                double s = 1.0, c = 1.0;
                for (int q = 14; q >= 1; --q) { s = 1.0 - r2 / (double)((2 * q) * (2 * q + 1)) * s; c = 1.0 - r2 / (double)((2 * q - 1) * (2 * q)) * c; }
                s *= r;
                rope[e] = make_float2((float)c, (float)s);
            }
            continue;
        }
        const int l = it / 24, cb = it % 24;
        __syncthreads();
        for (int e = tid; e < 9 * D; e += 256) {
            const int mb = e / D, k = e % D;
            const float v = mb < 8 ? p.in[I_C][mb * D + k] : p.in[I_CCTX][k];
            sm[e] = silu_f(v);
        }
        __syncthreads();
        const int col = cb * 256 + tid;
        const float* w = p.in[I_WMOD] + (size_t)l * D * 6144 + col;
        float acc[9];
#pragma unroll
        for (int m = 0; m < 9; ++m) acc[m] = 0.f;
#pragma unroll 4
        for (int k = 0; k < D; ++k) {
            const float wv = w[(size_t)k * 6144];
#pragma unroll
            for (int m = 0; m < 9; ++m) acc[m] += sm[m * D + k] * wv;
        }
        const float bias = p.in[I_BMOD][l * 6144 + col];
        float* mv = (float*)(p.ws + WS_MODV);
#pragma unroll
        for (int m = 0; m < 9; ++m) mv[(size_t)(l * 9 + m) * 6144 + col] = acc[m] + bias;
    }
}

__device__ void ph_norm1(const Params& p, int l) {
    const int lane = threadIdx.x & 63, gw = blockIdx.x * 4 + (threadIdx.x >> 6), ngw = gridDim.x * 4;
    bf16* H = (bf16*)(p.ws + WS_H);
    const float* g = p.in[I_N1G] + l * D;
    for (int r = gw; r < NTOK; r += ngw) {
        const float* x = xrow(p, l, r);
        const int mb = modrow(r);
        const float* sh = modv(p, l, mb, 0); const float* sc = modv(p, l, mb, 1);
        float4 v[4]; float ss = 0.f;
#pragma unroll
        for (int j = 0; j < 4; ++j) { v[j] = *(const float4*)(x + j * 256 + lane * 4); ss += v[j].x * v[j].x + v[j].y * v[j].y + v[j].z * v[j].z + v[j].w * v[j].w; }
        const float inv = rsqrtf(wave_sum(ss) * (1.f / D) + EPS);
#pragma unroll
        for (int j = 0; j < 4; ++j) {
            const int c = j * 256 + lane * 4;
            const float4 gg = *(const float4*)(g + c), s1 = *(const float4*)(sh + c), s2 = *(const float4*)(sc + c);
            st_bf4(H + (size_t)r * D + c, v[j].x * inv * gg.x * (1.f + s2.x) + s1.x, v[j].y * inv * gg.y * (1.f + s2.y) + s1.y,
                   v[j].z * inv * gg.z * (1.f + s2.z) + s1.z, v[j].w * inv * gg.w * (1.f + s2.w) + s1.w);
        }
    }
}

__device__ void ph_gemm_in(const Params& p, int l, float* sm) {
    float* sA = sm; float* sB = sm + 16 * 68;
    const bf16* H = (const bf16*)(p.ws + WS_H);
    bf16* PROJ = (bf16*)(p.ws + WS_PROJ);
    const float* W = p.in[I_WIN] + (size_t)l * D * INW;
    const int nN = (INW + 63) / 64, nM = NTOK / 64;
    const int tid = threadIdx.x, ty = tid >> 4, tx = tid & 15;
    for (int it = blockIdx.x; it < nM * nN; it += gridDim.x) {
        const int tm = it / nN, tn = it % nN, r0 = tm * 64, c0 = tn * 64;
        float acc[4][4]; zero_acc(acc);
        gemm64(acc, D,
               [&](int m, int k) { return ld_bf4(H + (size_t)(r0 + m) * D + k); },
               [&](int k, int n) { return (c0 + n < INW) ? *(const float4*)(W + (size_t)k * INW + c0 + n) : make_float4(0.f, 0.f, 0.f, 0.f); },
               sA, sB);
        if (c0 + tx * 4 < INW) {
#pragma unroll
            for (int i = 0; i < 4; ++i) st_bf4(PROJ + (size_t)(r0 + ty * 4 + i) * INW + c0 + tx * 4, acc[i][0], acc[i][1], acc[i][2], acc[i][3]);
        }
    }
}

__device__ void ph_prep(const Params& p, int l) {
    bf16* PROJ = (bf16*)(p.ws + WS_PROJ);
    const float2* rope = (const float2*)(p.ws + WS_ROPE);
    const long total = (long)NTOK * 10;
    for (long id = (long)blockIdx.x * 256 + threadIdx.x; id < total; id += (long)gridDim.x * 256) {
        const int r = (int)(id / 10), j = (int)(id % 10);
        const bool isq = j < 8;
        if (l == 1 && r >= NL && isq) continue;
        bf16* ptr = PROJ + (size_t)r * INW + (isq ? O_AQ + j * 64 : O_AK + (j - 8) * 64);
        const float* g = p.in[isq ? I_QNG : I_KNG] + l * 64;
        float v[64]; float ss = 0.f;
#pragma unroll
        for (int q = 0; q < 16; ++q) { float4 t = ld_bf4(ptr + q * 4); v[q * 4] = t.x; v[q * 4 + 1] = t.y; v[q * 4 + 2] = t.z; v[q * 4 + 3] = t.w; }
#pragma unroll
        for (int d = 0; d < 64; ++d) ss += v[d] * v[d];
        const float inv = rsqrtf(ss * (1.f / 64.f) + EPS);
#pragma unroll
        for (int d = 0; d < 64; ++d) v[d] = v[d] * inv * g[d];
        if (r < NL) {
            const int t = r % T, row = t >> 6, col = t & 63;
#pragma unroll
            for (int i = 0; i < 16; ++i) {
                const float2 a = rope[row * 16 + i]; const float x1 = v[i], x2 = v[16 + i];
                v[i] = x1 * a.x - x2 * a.y; v[16 + i] = x1 * a.y + x2 * a.x;
                const float2 b = rope[col * 16 + i]; const float y1 = v[32 + i], y2 = v[48 + i];
                v[32 + i] = y1 * b.x - y2 * b.y; v[48 + i] = y1 * b.y + y2 * b.x;
            }
        }
        const float sc = isq ? 0.125f : 1.f;
#pragma unroll
        for (int q = 0; q < 16; ++q) st_bf4(ptr + q * 4, v[q * 4] * sc, v[q * 4 + 1] * sc, v[q * 4 + 2] * sc, v[q * 4 + 3] * sc);
    }
}

__device__ void ph_attn(const Params& p, int l, float* sm) {
    float* sQ = sm;
    float* sK = sQ + 64 * 65;
    float* sV = sK + 64 * 65;
    float* sP = sV + 64 * 64;
    bf16* PROJ = (bf16*)(p.ws + WS_PROJ);
    const int tid = threadIdx.x, ty = tid >> 4, tx = tid & 15;
    float mq = 0.f, mk = 0.f;
    for (int d = 0; d < 64; ++d) { mq = fmaxf(mq, fabsf(p.in[I_QNG][l * 64 + d])); mk = fmaxf(mk, fabsf(p.in[I_KNG][l * 64 + d])); }
    const float shift = 8.f * mq * mk;
    const int nlat = NB * 8 * 64, nctx = (l == 0) ? NB * 8 * 4 : 0;
    for (int it = blockIdx.x; it < nlat + nctx; it += gridDim.x) {
        int b, head, qrow0, nkt; bool lat = it < nlat;
        if (lat) { b = it / 512; head = (it / 64) % 8; qrow0 = b * T + (it % 64) * 64; nkt = 68; }
        else { const int j = it - nlat; b = j / 32; head = (j / 4) % 8; qrow0 = NL + b * CL + (j % 4) * 64; nkt = 4; }
        const int kvh = head >> 2;
        __syncthreads();
        {
            const int m = tid >> 2, d0 = (tid & 3) * 16;
            const bf16* src = PROJ + (size_t)(qrow0 + m) * INW + O_AQ + head * 64 + d0;
#pragma unroll
            for (int q = 0; q < 4; ++q) { float4 t = ld_bf4(src + q * 4); sQ[m * 65 + d0 + q * 4] = t.x; sQ[m * 65 + d0 + q * 4 + 1] = t.y; sQ[m * 65 + d0 + q * 4 + 2] = t.z; sQ[m * 65 + d0 + q * 4 + 3] = t.w; }
        }
        float o[4][4]; zero_acc(o);
        float lsum[4] = {0.f, 0.f, 0.f, 0.f};
        for (int kt = 0; kt < nkt; ++kt) {
            int krow0;
            if (lat) krow0 = (kt < 64) ? b * T + kt * 64 : NL + b * CL + (kt - 64) * 64;
            else krow0 = NL + b * CL + kt * 64;
            __syncthreads();
            {
                const int m = tid >> 2, d0 = (tid & 3) * 16;
                const bf16* ks = PROJ + (size_t)(krow0 + m) * INW + O_AK + kvh * 64 + d0;
                const bf16* vs = PROJ + (size_t)(krow0 + m) * INW + O_AV + kvh * 64 + d0;
#pragma unroll
                for (int q = 0; q < 4; ++q) {
                    float4 t = ld_bf4(ks + q * 4); sK[m * 65 + d0 + q * 4] = t.x; sK[m * 65 + d0 + q * 4 + 1] = t.y; sK[m * 65 + d0 + q * 4 + 2] = t.z; sK[m * 65 + d0 + q * 4 + 3] = t.w;
                    float4 u = ld_bf4(vs + q * 4); *(float4*)&sV[m * 64 + d0 + q * 4] = u;
                }
            }
            __syncthreads();
            float s[4][4]; zero_acc(s);
#pragma unroll 8
            for (int d = 0; d < 64; ++d) {
                float a[4], bb[4];
#pragma unroll
                for (int i = 0; i < 4; ++i) { a[i] = sQ[(ty * 4 + i) * 65 + d]; bb[i] = sK[(tx * 4 + i) * 65 + d]; }
#pragma unroll
                for (int i = 0; i < 4; ++i)
#pragma unroll
                    for (int j = 0; j < 4; ++j) s[i][j] += a[i] * bb[j];
            }
#pragma unroll
            for (int i = 0; i < 4; ++i)
#pragma unroll
                for (int j = 0; j < 4; ++j) { const float e = __expf(s[i][j] - shift); lsum[i] += e; sP[(ty * 4 + i) * 65 + tx * 4 + j] = e; }
            __syncthreads();
#pragma unroll 8
            for (int k = 0; k < 64; ++k) {
                const float4 vv = *(const float4*)&sV[k * 64 + tx * 4];
#pragma unroll
                for (int i = 0; i < 4; ++i) {
                    const float pp = sP[(ty * 4 + i) * 65 + k];
                    o[i][0] += pp * vv.x; o[i][1] += pp * vv.y; o[i][2] += pp * vv.z; o[i][3] += pp * vv.w;
                }
            }
        }
#pragma unroll
        for (int i = 0; i < 4; ++i) {
            float ls = lsum[i];
            ls += __shfl_xor(ls, 1); ls += __shfl_xor(ls, 2); ls += __shfl_xor(ls, 4); ls += __shfl_xor(ls, 8);
            const float inv = 1.f / ls;
            st_bf4(PROJ + (size_t)(qrow0 + ty * 4 + i) * INW + O_AQ + head * 64 + tx * 4, o[i][0] * inv, o[i][1] * inv, o[i][2] * inv, o[i][3] * inv);
        }
    }
}

__device__ void ph_gla(const Params& p, int l, float* sm) {
    constexpr int DVS = 64;
    float* sB = sm;
    float* sQ = sB + 4096;
    float* sK = sQ + 4096;
    float* sV = sK + 4096;
    float* sS = sV + 64 * DVS;
    float* sP = sS + 64 * DVS;
    const bf16* PROJ = (const bf16*)(p.ws + WS_PROJ);
    const int tid = threadIdx.x, ti = tid >> 2, part = tid & 3;
    for (int it = blockIdx.x; it < NB * 4 * 2 * 2; it += gridDim.x) {
        const int b = it >> 4, h = (it >> 2) & 3, dir = (it >> 1) & 1, sl = it & 1;
        bf16* OG = (bf16*)(p.ws + WS_R2 + (size_t)dir * SZ_Y512);
        const float* up = p.in[dir ? I_UPB : I_UPF] + (size_t)l * 16 * 256;
        const float* bias = p.in[dir ? I_BIASB : I_BIASF] + l * 256;
        const int ogl = dir ? O_GLB : O_GLF;
        __syncthreads();
        for (int e = tid; e < 64 * DVS; e += 256) sS[e] = 0.f;
        for (int n = 0; n < 68; ++n) {
            int base;
            if (n < 4) base = NL + b * CL + (dir ? 3 - n : n) * 64;
            else base = b * T + (dir ? 63 - (n - 4) : (n - 4)) * 64;
            const int tok = dir ? base + 63 - ti : base + ti;
            const bf16* prow = PROJ + (size_t)tok * INW;
            __syncthreads();
            {
                float g[16];
#pragma unroll
                for (int q = 0; q < 4; ++q) { float4 t = ld_bf4(prow + ogl + q * 4); g[q * 4] = t.x; g[q * 4 + 1] = t.y; g[q * 4 + 2] = t.z; g[q * 4 + 3] = t.w; }
#pragma unroll 4
                for (int dd = 0; dd < 16; ++dd) {
                    const int dk = part * 16 + dd, col = h * 64 + dk;
                    float a = bias[col];
#pragma unroll
                    for (int j = 0; j < 16; ++j) a += g[j] * up[j * 256 + col];
                    const float ls = fminf(a, 0.f) - log1pf(__expf(-fabsf(a)));
                    sB[ti * 64 + dk] = ls * (1.f / 16.f);
                }
            }
            __syncthreads();
            if (tid < 64) { float run = 0.f; for (int i = 0; i < 64; ++i) { run += sB[i * 64 + tid]; sB[i * 64 + tid] = run; } }
            __syncthreads();
            {
#pragma unroll
                for (int q = 0; q < 4; ++q) {
                    const int dk = part * 16 + q * 4;
                    float4 qq = ld_bf4(prow + O_GQ + h * 64 + dk), kk = ld_bf4(prow + O_GK + h * 64 + dk);
                    const float qa[4] = {qq.x, qq.y, qq.z, qq.w}, ka[4] = {kk.x, kk.y, kk.z, kk.w};
#pragma unroll
                    for (int e = 0; e < 4; ++e) {
                        const float bi = sB[ti * 64 + dk + e], br = sB[32 * 64 + dk + e];
                        sQ[ti * 64 + dk + e] = qa[e] * 0.125f * __expf(bi - br);
                        sK[ti * 64 + dk + e] = ka[e] * __expf(br - bi);
                    }
                }
#pragma unroll
                for (int q = 0; q < DVS / 16; ++q) {
                    const int dv = part * (DVS / 4) + q * 4;
                    float4 vv = ld_bf4(prow + O_GV + h * 128 + sl * DVS + dv);
                    *(float4*)&sV[ti * DVS + dv] = vv;
                }
            }
            __syncthreads();
            {
#pragma unroll 4
                for (int ss = 0; ss < 16; ++ss) {
                    const int s = part * 16 + ss;
                    float a = 0.f;
                    if (s <= ti) { for (int dk = 0; dk < 64; ++dk) a += sQ[ti * 64 + dk] * sK[s * 64 + dk]; }
                    sP[ti * 64 + s] = a;
                }
            }
            __syncthreads();
            {
                float o[DVS / 4];
#pragma unroll
                for (int e = 0; e < DVS / 4; ++e) o[e] = 0.f;
                for (int s = 0; s <= ti; ++s) {
                    const float pp = sP[ti * 64 + s];
#pragma unroll
                    for (int e = 0; e < DVS / 4; ++e) o[e] += pp * sV[s * DVS + part * (DVS / 4) + e];
                }
                for (int dk = 0; dk < 64; ++dk) {
                    const float qq = sQ[ti * 64 + dk] * __expf(sB[32 * 64 + dk]);
#pragma unroll
                    for (int e = 0; e < DVS / 4; ++e) o[e] += qq * sS[dk * DVS + part * (DVS / 4) + e];
                }
                bf16* dst = OG + (size_t)tok * 512 + h * 128 + sl * DVS + part * (DVS / 4);
#pragma unroll
                for (int e = 0; e < DVS / 4; e += 4) st_bf4(dst + e, o[e], o[e + 1], o[e + 2], o[e + 3]);
            }
            __syncthreads();
            {
                const int dk = ti;
                const float bl = sB[63 * 64 + dk], br = sB[32 * 64 + dk];
                const float al = __expf(bl), ar = __expf(bl - br);
                float acc[DVS / 4];
#pragma unroll
                for (int e = 0; e < DVS / 4; ++e) acc[e] = 0.f;
                for (int s = 0; s < 64; ++s) {
                    const float kk = sK[s * 64 + dk];
#pragma unroll
                    for (int e = 0; e < DVS / 4; ++e) acc[e] += kk * sV[s * DVS + part * (DVS / 4) + e];
                }
#pragma unroll
                for (int e = 0; e < DVS / 4; ++e) { const int ix = dk * DVS + part * (DVS / 4) + e; sS[ix] = al * sS[ix] + ar * acc[e]; }
            }
        }
    }
}

__device__ void ph_pool(const Params& p, int l, float* sm) {
    float* sA = sm; float* sB = sm + 16 * 68;
    const bf16* PROJ = (const bf16*)(p.ws + WS_PROJ);
    bf16* YP = (bf16*)(p.ws + WS_R2 + 2 * SZ_Y512);
    const int nrows = (l == 0) ? NTOK : NL;
    const int nM = nrows / 64;
    const int tid = threadIdx.x, ty = tid >> 4, tx = tid & 15;
    for (int it = blockIdx.x; it < nM * 8; it += gridDim.x) {
        const int tm = it >> 3, g = (it >> 1) & 3, tn = it & 1, r0 = tm * 64, win = 2 << g, hw = win >> 1;
        const float* W = p.in[I_POOLW] + ((size_t)(l * 4 + g) * 128) * 128;
        float acc[4][4]; zero_acc(acc);
        gemm64(acc, 128,
               [&](int m, int k) {
                   const int r = r0 + m;
                   int t, base, tl;
                   if (r < NL) { t = r % T; base = r - t; tl = T; } else { t = (r - NL) % CL; base = r - t; tl = CL; }
                   const int lo = max(t - hw, 0), hi = min(t + hw, tl);
                   float4 s = make_float4(0.f, 0.f, 0.f, 0.f);
                   for (int u = lo; u < hi; ++u) { float4 v = ld_bf4(PROJ + (size_t)(base + u) * INW + O_PU + g * 128 + k); s.x += v.x; s.y += v.y; s.z += v.z; s.w += v.w; }
                   const float inv = 1.f / (float)(hi - lo);
                   float4 c = ld_bf4(PROJ + (size_t)r * INW + O_PU + g * 128 + k);
                   return make_float4(s.x * inv - c.x, s.y * inv - c.y, s.z * inv - c.z, s.w * inv - c.w);
               },
               [&](int k, int n) { return *(const float4*)(W + (size_t)k * 128 + tn * 64 + n); },
               sA, sB);
        const float4 sc = *(const float4*)(p.in[I_POOLS] + l * 512 + g * 128 + tn * 64 + tx * 4);
#pragma unroll
        for (int i = 0; i < 4; ++i)
            st_bf4(YP + (size_t)(r0 + ty * 4 + i) * 512 + g * 128 + tn * 64 + tx * 4, acc[i][0] * sc.x, acc[i][1] * sc.y, acc[i][2] * sc.z, acc[i][3] * sc.w);
    }
}

__device__ void ph_ygla(const Params& p, int l) {
    const int lane = threadIdx.x & 63, gw = blockIdx.x * 4 + (threadIdx.x >> 6), ngw = gridDim.x * 4;
    bf16* O0 = (bf16*)(p.ws + WS_R2);
    const bf16* O1 = (const bf16*)(p.ws + WS_R2 + SZ_Y512);
    const bf16* PROJ = (const bf16*)(p.ws + WS_PROJ);
    const float* g = p.in[I_GLANG] + l * 128;
    const int nrows = (l == 0) ? NTOK : NL;
    for (int r = gw; r < nrows; r += ngw) {
        const int c = lane * 8;
        float v[8];
        { float4 a = ld_bf4(O0 + (size_t)r * 512 + c), b2 = ld_bf4(O0 + (size_t)r * 512 + c + 4), d = ld_bf4(O1 + (size_t)r * 512 + c), e = ld_bf4(O1 + (size_t)r * 512 + c + 4);
          v[0] = a.x + d.x; v[1] = a.y + d.y; v[2] = a.z + d.z; v[3] = a.w + d.w; v[4] = b2.x + e.x; v[5] = b2.y + e.y; v[6] = b2.z + e.z; v[7] = b2.w + e.w; }
        float ss = 0.f;
#pragma unroll
        for (int e = 0; e < 8; ++e) ss += v[e] * v[e];
        ss += __shfl_xor(ss, 1); ss += __shfl_xor(ss, 2); ss += __shfl_xor(ss, 4); ss += __shfl_xor(ss, 8);
        const float inv = rsqrtf(ss * (1.f / 128.f) + EPS);
        float4 r0 = ld_bf4(PROJ + (size_t)r * INW + O_GR + c), r1 = ld_bf4(PROJ + (size_t)r * INW + O_GR + c + 4);
        const float gr[8] = {r0.x, r0.y, r0.z, r0.w, r1.x, r1.y, r1.z, r1.w};
        float o[8];
#pragma unroll
        for (int e = 0; e < 8; ++e) o[e] = v[e] * inv * g[(c + e) & 127] * silu_f(gr[e]);
        st_bf4(O0 + (size_t)r * 512 + c, o[0], o[1], o[2], o[3]);
        st_bf4(O0 + (size_t)r * 512 + c + 4, o[4], o[5], o[6], o[7]);
    }
}

__device__ void ph_merge(const Params& p, int l, float* sm) {
    float* sA = sm; float* sB = sm + 16 * 68;
    const bf16* PROJ = (const bf16*)(p.ws + WS_PROJ);
    const bf16* YG = (const bf16*)(p.ws + WS_R2);
    const bf16* YP = (const bf16*)(p.ws + WS_R2 + 2 * SZ_Y512);
    bf16* Z = (bf16*)(p.ws + WS_H);
    const int nrows = (l == 0) ? NTOK : NL, nM = nrows / 64;
    const int tid = threadIdx.x, ty = tid >> 4, tx = tid & 15;
    for (int it = blockIdx.x; it < nM * 16; it += gridDim.x) {
        const int tm = it >> 4, tn = it & 15, r0 = tm * 64, c0 = tn * 64;
        float tot[4][4]; zero_acc(tot);
        for (int br = 0; br < 3; ++br) {
            const float* W = p.in[I_WBR] + ((size_t)(l * 3 + br) * 512) * D;
            float acc[4][4]; zero_acc(acc);
            gemm64(acc, 512,
                   [&](int m, int k) {
                       const int r = r0 + m;
                       if (br == 0) return ld_bf4(YG + (size_t)r * 512 + k);
                       if (br == 1) return ld_bf4(PROJ + (size_t)r * INW + O_AQ + k);
                       return ld_bf4(YP + (size_t)r * 512 + k);
                   },
                   [&](int k, int n) { return *(const float4*)(W + (size_t)k * D + c0 + n); },
                   sA, sB);
#pragma unroll
            for (int i = 0; i < 4; ++i) {
                float4 gt = ld_bf4(PROJ + (size_t)(r0 + ty * 4 + i) * INW + O_GT + br * D + c0 + tx * 4);
                tot[i][0] += sigmoid_f(gt.x) * acc[i][0]; tot[i][1] += sigmoid_f(gt.y) * acc[i][1];
                tot[i][2] += sigmoid_f(gt.z) * acc[i][2]; tot[i][3] += sigmoid_f(gt.w) * acc[i][3];
            }
        }
#pragma unroll
        for (int i = 0; i < 4; ++i) st_bf4(Z + (size_t)(r0 + ty * 4 + i) * D + c0 + tx * 4, tot[i][0], tot[i][1], tot[i][2], tot[i][3]);
    }
}

__device__ void ph_outproj(const Params& p, int l, float* sm) {
    float* sA = sm; float* sB = sm + 16 * 68;
    const bf16* Z = (const bf16*)(p.ws + WS_H);
    const float* W = p.in[I_WOUT] + (size_t)l * D * D;
    const int nrows = (l == 0) ? NTOK : NL, nM = nrows / 64;
    const int tid = threadIdx.x, ty = tid >> 4, tx = tid & 15;
    for (int it = blockIdx.x; it < nM * 16; it += gridDim.x) {
        const int tm = it >> 4, tn = it & 15, r0 = tm * 64, c0 = tn * 64;
        float acc[4][4]; zero_acc(acc);
        gemm64(acc, D,
               [&](int m, int k) { return ld_bf4(Z + (size_t)(r0 + m) * D + k); },
               [&](int k, int n) { return *(const float4*)(W + (size_t)k * D + c0 + n); },
               sA, sB);
#pragma unroll
        for (int i = 0; i < 4; ++i) {
            const int r = r0 + ty * 4 + i, c = c0 + tx * 4;
            const float4 xo = *(const float4*)(xrow(p, l, r) + c);
            const float4 g1 = *(const float4*)(modv(p, l, modrow(r), 2) + c);
            float* dst = r < NL ? p.out + (size_t)r * D + c : (float*)(p.ws + WS_XC) + (size_t)(r - NL) * D + c;
            *(float4*)dst = make_float4(xo.x + g1.x * acc[i][0], xo.y + g1.y * acc[i][1], xo.z + g1.z * acc[i][2], xo.w + g1.w * acc[i][3]);
        }
    }
}

__device__ __forceinline__ const float* x1row(const Params& p, int r) {
    return r < NL ? p.out + (size_t)r * D : (const float*)(p.ws + WS_XC) + (size_t)(r - NL) * D;
}
__device__ void ph_router(const Params& p, int l) {
    const int lane = threadIdx.x & 63, gw = blockIdx.x * 4 + (threadIdx.x >> 6), ngw = gridDim.x * 4;
    bf16* H = (bf16*)(p.ws + WS_H);
    const float* g = p.in[I_N2G] + l * D;
    const float* wg = p.in[I_WGRP] + (size_t)l * D * 4;
    const float* we = p.in[I_WEXP] + (size_t)l * D * 32;
    unsigned* cnt = (unsigned*)(p.ws + WS_CTL) + l * 32;
    int* list = (int*)(p.ws + WS_LIST);
    float* wt = (float*)(p.ws + WS_WT);
    const int nrows = (l == 0) ? NTOK : NL;
    for (int r = gw; r < nrows; r += ngw) {
        const float* x = x1row(p, r);
        const int mb = modrow(r);
        const float* sh = modv(p, l, mb, 3); const float* sc = modv(p, l, mb, 4);
        float4 v[4]; float ss = 0.f;
#pragma unroll
        for (int j = 0; j < 4; ++j) { v[j] = *(const float4*)(x + j * 256 + lane * 4); ss += v[j].x * v[j].x + v[j].y * v[j].y + v[j].z * v[j].z + v[j].w * v[j].w; }
        const float inv = rsqrtf(wave_sum(ss) * (1.f / D) + EPS);
        float hv[16];
#pragma unroll
        for (int j = 0; j < 4; ++j) {
            const int c = j * 256 + lane * 4;
            const float4 gg = *(const float4*)(g + c), s1 = *(const float4*)(sh + c), s2 = *(const float4*)(sc + c);
            hv[j * 4 + 0] = v[j].x * inv * gg.x * (1.f + s2.x) + s1.x; hv[j * 4 + 1] = v[j].y * inv * gg.y * (1.f + s2.y) + s1.y;
            hv[j * 4 + 2] = v[j].z * inv * gg.z * (1.f + s2.z) + s1.z; hv[j * 4 + 3] = v[j].w * inv * gg.w * (1.f + s2.w) + s1.w;
            st_bf4(H + (size_t)r * D + c, hv[j * 4], hv[j * 4 + 1], hv[j * 4 + 2], hv[j * 4 + 3]);
        }
        float lg[4];
#pragma unroll
        for (int o = 0; o < 4; ++o) {
            float a = 0.f;
#pragma unroll
            for (int j = 0; j < 4; ++j)
#pragma unroll
                for (int e = 0; e < 4; ++e) a += hv[j * 4 + e] * wg[(size_t)(j * 256 + lane * 4 + e) * 4 + o];
            lg[o] = wave_sum(a) + p.in[I_BGRP][l * 4 + o];
        }
        int grp = 0; float gmax = lg[0];
#pragma unroll
        for (int o = 1; o < 4; ++o) if (lg[o] > gmax) { gmax = lg[o]; grp = o; }
        float gden = 0.f;
#pragma unroll
        for (int o = 0; o < 4; ++o) gden += __expf(lg[o] - gmax);
        const float ptg = 1.f / gden;
        float le[8];
#pragma unroll
        for (int o = 0; o < 8; ++o) {
            float a = 0.f;
            const int col = grp * 8 + o;
#pragma unroll
            for (int j = 0; j < 4; ++j)
#pragma unroll
                for (int e = 0; e < 4; ++e) a += hv[j * 4 + e] * we[(size_t)(j * 256 + lane * 4 + e) * 32 + col];
            le[o] = wave_sum(a) + p.in[I_BEXP][l * 32 + col];
        }
        int i1 = 0; float m1 = le[0];
#pragma unroll
        for (int o = 1; o < 8; ++o) if (le[o] > m1) { m1 = le[o]; i1 = o; }
        int i2 = -1; float m2 = -3.0e38f;
#pragma unroll
        for (int o = 0; o < 8; ++o) if (o != i1 && le[o] > m2) { m2 = le[o]; i2 = o; }
        const float e2 = __expf(m2 - m1);
        const float w1 = ptg / (1.f + e2), w2 = ptg * e2 / (1.f + e2);
        if (lane == 0) {
            const int ea = grp * 8 + i1, eb = grp * 8 + i2;
            const unsigned pa = atomicAdd(&cnt[ea], 1u); list[(size_t)ea * NTOK + pa] = r * 2;
            const unsigned pb = atomicAdd(&cnt[eb], 1u); list[(size_t)eb * NTOK + pb] = r * 2 + 1;
            wt[r * 2] = w1; wt[r * 2 + 1] = w2;
        }
    }
}

__device__ void ph_moe1(const Params& p, int l, float* sm) {
    float* sA = sm; float* sB = sm + 16 * 68;
    const bf16* H = (const bf16*)(p.ws + WS_H);
    bf16* ACT = (bf16*)(p.ws + WS_ACT);
    const unsigned* cnt = (const unsigned*)(p.ws + WS_CTL) + l * 32;
    const int* list = (const int*)(p.ws + WS_LIST);
    const int tid = threadIdx.x, ty = tid >> 4, tx = tid & 15;
    int tstart[33]; tstart[0] = 0;
#pragma unroll
    for (int e = 0; e < 32; ++e) tstart[e + 1] = tstart[e] + (int)((cnt[e] + 63u) >> 6);
    const int ntiles = tstart[32];
    for (int it = blockIdx.x; it < ntiles * 8; it += gridDim.x) {
        const int trow = it >> 3, tn = it & 7, c0 = tn * 64;
        int e = 0;
#pragma unroll
        for (int q = 1; q < 32; ++q) if (trow >= tstart[q]) e = q;
        int tbase = 0;
#pragma unroll
        for (int q = 0; q < 32; ++q) if (q == e) tbase = tstart[q];
        const int i0 = (trow - tbase) * 64, ce = (int)cnt[e];
        const int* le = list + (size_t)e * NTOK;
        const float* Wg = p.in[I_WGATE] + ((size_t)(l * 32 + e) * D) * 512;
        const float* Wu = p.in[I_WUP] + ((size_t)(l * 32 + e) * D) * 512;
        float ag[4][4], au[4][4]; zero_acc(ag); zero_acc(au);
        auto al = [&](int m, int k) { const int ii = min(i0 + m, ce - 1); const int tok = le[ii] >> 1; return ld_bf4(H + (size_t)tok * D + k); };
        gemm64(ag, D, al, [&](int k, int n) { return *(const float4*)(Wg + (size_t)k * 512 + c0 + n); }, sA, sB);
        gemm64(au, D, al, [&](int k, int n) { return *(const float4*)(Wu + (size_t)k * 512 + c0 + n); }, sA, sB);
#pragma unroll
        for (int i = 0; i < 4; ++i) {
            const int ii = i0 + ty * 4 + i;
            if (ii < ce) {
                const int asg = le[ii];
                st_bf4(ACT + (size_t)asg * 512 + c0 + tx * 4, silu_f(ag[i][0]) * au[i][0], silu_f(ag[i][1]) * au[i][1], silu_f(ag[i][2]) * au[i][2], silu_f(ag[i][3]) * au[i][3]);
            }
        }
    }
}

__device__ void ph_moe2(const Params& p, int l, float* sm) {
    float* sA = sm; float* sB = sm + 16 * 68;
    const bf16* ACT = (const bf16*)(p.ws + WS_ACT);
    const unsigned* cnt = (const unsigned*)(p.ws + WS_CTL) + l * 32;
    const int* list = (const int*)(p.ws + WS_LIST);
    const float* wt = (const float*)(p.ws + WS_WT);
    const int tid = threadIdx.x, ty = tid >> 4, tx = tid & 15;
    int tstart[33]; tstart[0] = 0;
#pragma unroll
    for (int e = 0; e < 32; ++e) tstart[e + 1] = tstart[e] + (int)((cnt[e] + 63u) >> 6);
    const int ntiles = tstart[32];
    for (int it = blockIdx.x; it < ntiles * 16; it += gridDim.x) {
        const int trow = it >> 4, tn = it & 15, c0 = tn * 64;
        int e = 0;
#pragma unroll
        for (int q = 1; q < 32; ++q) if (trow >= tstart[q]) e = q;
        int tbase = 0;
#pragma unroll
        for (int q = 0; q < 32; ++q) if (q == e) tbase = tstart[q];
        const int i0 = (trow - tbase) * 64, ce = (int)cnt[e];
        const int* le = list + (size_t)e * NTOK;
        const float* Wd = p.in[I_WDOWN] + ((size_t)(l * 32 + e) * 512) * D;
        float acc[4][4]; zero_acc(acc);
        gemm64(acc, 512,
               [&](int m, int k) { const int ii = min(i0 + m, ce - 1); return ld_bf4(ACT + (size_t)le[ii] * 512 + k); },
               [&](int k, int n) { return *(const float4*)(Wd + (size_t)k * D + c0 + n); }, sA, sB);
#pragma unroll
        for (int i = 0; i < 4; ++i) {
            const int ii = i0 + ty * 4 + i;
            if (ii < ce) {
                const int asg = le[ii], tok = asg >> 1, kk = asg & 1;
                const float w = wt[asg];
                bf16* Y = (bf16*)(p.ws + (kk ? WS_Y1 : WS_Y0));
                st_bf4(Y + (size_t)tok * D + c0 + tx * 4, w * acc[i][0], w * acc[i][1], w * acc[i][2], w * acc[i][3]);
            }
        }
    }
}

__device__ void ph_combine(const Params& p, int l) {
    const int lane = threadIdx.x & 63, gw = blockIdx.x * 4 + (threadIdx.x >> 6), ngw = gridDim.x * 4;
    const bf16* Y0 = (const bf16*)(p.ws + WS_Y0);
    const bf16* Y1 = (const bf16*)(p.ws + WS_Y1);
    const int nrows = (l == 0) ? NTOK : NL;
    for (int r = gw; r < nrows; r += ngw) {
        const float* x = x1row(p, r);
        float* xo = r < NL ? p.out + (size_t)r * D : (float*)(p.ws + WS_XC) + (size_t)(r - NL) * D;
        const float* g2 = modv(p, l, modrow(r), 5);
        float4 v[4]; float ss = 0.f;
#pragma unroll
        for (int j = 0; j < 4; ++j) {
            const int c = j * 256 + lane * 4;
            const float4 xv = *(const float4*)(x + c), gg = *(const float4*)(g2 + c);
            const float4 a = ld_bf4(Y0 + (size_t)r * D + c), b = ld_bf4(Y1 + (size_t)r * D + c);
            v[j] = make_float4(xv.x + gg.x * (a.x + b.x), xv.y + gg.y * (a.y + b.y), xv.z + gg.z * (a.z + b.z), xv.w + gg.w * (a.w + b.w));
            ss += v[j].x * v[j].x + v[j].y * v[j].y + v[j].z * v[j].z + v[j].w * v[j].w;
        }
        if (l == 0) {
#pragma unroll
            for (int j = 0; j < 4; ++j) *(float4*)(xo + j * 256 + lane * 4) = v[j];
        } else {
            const float inv = rsqrtf(wave_sum(ss) * (1.f / D) + EPS);
            const float* fg = p.in[I_FING];
#pragma unroll
            for (int j = 0; j < 4; ++j) {
                const int c = j * 256 + lane * 4;
                const float4 gg = *(const float4*)(fg + c);
                *(float4*)(xo + c) = make_float4(v[j].x * inv * gg.x, v[j].y * inv * gg.y, v[j].z * inv * gg.z, v[j].w * inv * gg.w);
            }
        }
    }
}

constexpr int LDS_BYTES = 96 * 1024;
__global__ void __launch_bounds__(256) mega_fwd(Params p) {
    extern __shared__ __attribute__((aligned(16))) unsigned char smem_raw[];
    float* sm = (float*)smem_raw;
    cg::grid_group grid = cg::this_grid();
    ph_init(p, sm);
    grid.sync();
    for (int l = 0; l < 2; ++l) {
        ph_norm1(p, l);        grid.sync();
        ph_gemm_in(p, l, sm);  grid.sync();
        ph_prep(p, l);         grid.sync();
        ph_attn(p, l, sm);
        ph_gla(p, l, sm);
        ph_pool(p, l, sm);     grid.sync();
        ph_ygla(p, l);         grid.sync();
        ph_merge(p, l, sm);    grid.sync();
        ph_outproj(p, l, sm);  grid.sync();
        ph_router(p, l);       grid.sync();
        ph_moe1(p, l, sm);     grid.sync();
        ph_moe2(p, l, sm);     grid.sync();
        ph_combine(p, l);      grid.sync();
    }
}

extern "C" void kernel_launch(void* const* d_in, const int* in_sizes, int n_in, void* d_out, int out_size, void* d_ws, size_t ws_size,
                              hipStream_t stream) {
    if (n_in != 28 || ws_size < WS_END) { fprintf(stderr, "kernel_launch: bad n_in %d or ws_size %zu (< %zu)\n", n_in, ws_size, (size_t)WS_END); return; }
    static int grid_blocks = 0;
    if (!grid_blocks) {
        int dev = 0, cus = 0, per_cu = 0;
        (void)hipGetDevice(&dev);
        (void)hipDeviceGetAttribute(&cus, hipDeviceAttributeMultiprocessorCount, dev);
        (void)hipFuncSetAttribute((const void*)mega_fwd, hipFuncAttributeMaxDynamicSharedMemorySize, LDS_BYTES);
        (void)hipOccupancyMaxActiveBlocksPerMultiprocessor(&per_cu, (const void*)mega_fwd, 256, LDS_BYTES);
        if (per_cu < 1) per_cu = 1;
        grid_blocks = cus * per_cu;
        fprintf(stderr, "kernel_launch: cus %d per_cu %d grid %d ws_size %zu\n", cus, per_cu, grid_blocks, ws_size);
    }
    Params p{};
    for (int i = 0; i < 28; ++i) p.in[i] = (const float*)d_in[i];
    p.out = (float*)d_out; p.ws = (unsigned char*)d_ws;
    (void)hipMemsetAsync((char*)d_ws + WS_CTL, 0, 1 * MiB, stream);
    void* args[] = {&p};
    hipError_t e = hipLaunchCooperativeKernel((const void*)mega_fwd, dim3(grid_blocks), dim3(256), args, LDS_BYTES, stream);
    if (e != hipSuccess) fprintf(stderr, "cooperative launch failed: %s (grid %d)\n", hipGetErrorString(e), grid_blocks);
}
```

```cpp
#include <hip/hip_runtime.h>
#include <hip/hip_cooperative_groups.h>
namespace cg = cooperative_groups;
#include <cstdio>
#include <cstdint>

typedef unsigned short bf16;

constexpr int D = 1024, NB = 8, T = 4096, CL = 256, NL = NB * T, NC = NB * CL, NTOK = NL + NC;
constexpr int INW = 5920;
constexpr int O_GQ = 0, O_GK = 256, O_GV = 512, O_GR = 1024, O_GLF = 1536, O_GLB = 1552, O_AQ = 1568, O_AK = 2080,
              O_AV = 2208, O_PU = 2336, O_GT = 2848;
constexpr float EPS = 1e-6f;

constexpr size_t MiB = 1u << 20;
constexpr size_t WS_CTL = 0;
constexpr size_t WS_MODV = 1 * MiB;
constexpr size_t WS_ROPE = 1 * MiB + 512 * 1024;
constexpr size_t WS_WT = 2 * MiB;
constexpr size_t WS_LIST = 3 * MiB;
constexpr size_t WS_XC = 8 * MiB;
constexpr size_t WS_H = 16 * MiB;
constexpr size_t WS_PROJ = 84 * MiB;
constexpr size_t WS_R2 = 478 * MiB;
constexpr size_t WS_WGU = WS_R2;
constexpr size_t WS_WDT = WS_R2 + 64 * MiB;
constexpr size_t WS_WSM = 580 * MiB;
constexpr size_t SZ_WINT = (size_t)6016 * 1024 * 2, SZ_WBT = (size_t)1024 * 512 * 2, SZ_WOUTT = (size_t)1024 * 1024 * 2;
constexpr size_t SZ_WSM_L = SZ_WINT + 3 * SZ_WBT + SZ_WOUTT;
constexpr size_t WS_END = 614 * MiB;
static_assert(WS_WSM + 2 * SZ_WSM_L <= WS_END, "ws map");
constexpr size_t SZ_Y512 = (size_t)NTOK * 512 * 2;
constexpr size_t WS_ACT = WS_PROJ;
constexpr size_t WS_Y0 = WS_PROJ + 68 * MiB;
constexpr size_t WS_Y1 = WS_PROJ + 136 * MiB;

struct Params {
    const float* in[28];
    float* out;
    unsigned char* ws;
};
enum { I_X = 0, I_C, I_CTX, I_CCTX, I_WMOD, I_BMOD, I_N1G, I_N2G, I_WIN, I_UPF, I_BIASF, I_UPB, I_BIASB, I_GLANG, I_QNG, I_KNG,
       I_POOLW, I_POOLS, I_WBR, I_WOUT, I_WGRP, I_BGRP, I_WEXP, I_BEXP, I_WGATE, I_WUP, I_WDOWN, I_FING };

__device__ __forceinline__ float bf2f(bf16 v) { return __uint_as_float(((unsigned)v) << 16); }
__device__ __forceinline__ bf16 f2bf(float f) { unsigned u = __float_as_uint(f); return (bf16)((u + 0x7fffu + ((u >> 16) & 1u)) >> 16); }
__device__ __forceinline__ float4 ld_bf4(const bf16* p) {
    uint2 u = *(const uint2*)p;
    return make_float4(__uint_as_float(u.x << 16), __uint_as_float(u.x & 0xffff0000u), __uint_as_float(u.y << 16), __uint_as_float(u.y & 0xffff0000u));
}
__device__ __forceinline__ void st_bf4(bf16* p, float a, float b, float c, float d) {
    uint2 u; u.x = (unsigned)f2bf(a) | ((unsigned)f2bf(b) << 16); u.y = (unsigned)f2bf(c) | ((unsigned)f2bf(d) << 16);
    *(uint2*)p = u;
}
__device__ __forceinline__ int tid_opaque() { int t = threadIdx.x; asm volatile("" : "+v"(t)); return t; }
__device__ __forceinline__ float wave_sum(float v) {
#pragma unroll
    for (int o = 1; o < 64; o <<= 1) v += __shfl_xor(v, o);
    return v;
}
__device__ __forceinline__ float silu_f(float x) { return x / (1.f + __expf(-x)); }
__device__ __forceinline__ float sigmoid_f(float x) { return 1.f / (1.f + __expf(-x)); }
__device__ __forceinline__ int modrow(int r) { return r < NL ? r / T : 8; }
__device__ __forceinline__ const float* xrow(const Params& p, int l, int r) {
    if (l == 0) return r < NL ? p.in[I_X] + (size_t)r * D : p.in[I_CTX] + (size_t)(r - NL) * D;
    return r < NL ? p.out + (size_t)r * D : (const float*)(p.ws + WS_XC) + (size_t)(r - NL) * D;
}
__device__ __forceinline__ const float* modv(const Params& p, int l, int mb, int which) {
    return (const float*)(p.ws + WS_MODV) + ((size_t)(l * 9 + mb) * 6 + which) * D;
}

template <class AF, class BF>
__device__ __forceinline__ void gemm64(float (&acc)[4][4], int K, AF aload, BF bload, float* sA, float* sB, const int tid) {
    const int ty = tid >> 4, tx = tid & 15;
    const int am = tid >> 2, ak = (tid & 3) * 4;
    const int bk = tid >> 4, bn = (tid & 15) * 4;
    for (int k0 = 0; k0 < K; k0 += 16) {
        float4 av = aload(am, k0 + ak);
        float4 bv = bload(k0 + bk, bn);
        __syncthreads();
        sA[(ak + 0) * 68 + am] = av.x; sA[(ak + 1) * 68 + am] = av.y; sA[(ak + 2) * 68 + am] = av.z; sA[(ak + 3) * 68 + am] = av.w;
        *(float4*)&sB[bk * 64 + bn] = bv;
        __syncthreads();
#pragma unroll
        for (int kk = 0; kk < 16; ++kk) {
            float4 a = *(float4*)&sA[kk * 68 + ty * 4];
            float4 b = *(float4*)&sB[kk * 64 + tx * 4];
            float aa[4] = {a.x, a.y, a.z, a.w}, bb[4] = {b.x, b.y, b.z, b.w};
#pragma unroll
            for (int i = 0; i < 4; ++i)
#pragma unroll
                for (int j = 0; j < 4; ++j) acc[i][j] += aa[i] * bb[j];
        }
    }
    __syncthreads();
}
__device__ __forceinline__ void zero_acc(float (&acc)[4][4]) {
#pragma unroll
    for (int i = 0; i < 4; ++i)
#pragma unroll
        for (int j = 0; j < 4; ++j) acc[i][j] = 0.f;
}

typedef short bf16x8 __attribute__((ext_vector_type(8)));
typedef float f32x4 __attribute__((ext_vector_type(4)));
constexpr int GT_BYTES = 16384;
__device__ __forceinline__ void zero_acc4(f32x4 (&acc)[4][4]) {
#pragma unroll
    for (int i = 0; i < 4; ++i)
#pragma unroll
        for (int j = 0; j < 4; ++j) acc[i][j] = (f32x4){0.f, 0.f, 0.f, 0.f};
}
template <class FA, class FB>
__device__ __forceinline__ void gemm_tile(f32x4 (&acc)[4][4], FA arow, FB brow, int K, unsigned char* lds, const int tid) {
    const int lane = tid & 63, wid = tid >> 6, wr = wid >> 1, wc = wid & 1, fr = lane & 15, fq = lane >> 4;
    const int srow = tid >> 3, sc = ((tid & 7) ^ ((tid >> 4) & 7)) * 8;
    const bf16* ap[4]; const bf16* bp[4];
#pragma unroll
    for (int j = 0; j < 4; ++j) { ap[j] = arow(j * 32 + srow) + sc; bp[j] = brow(j * 32 + srow) + sc; }
    const int KT = K >> 6;
#pragma unroll
    for (int j = 0; j < 4; ++j) {
        __builtin_amdgcn_global_load_lds((const unsigned*)(ap[j]), (unsigned*)(lds + j * 4096 + tid * 16), 16, 0, 0);
        __builtin_amdgcn_global_load_lds((const unsigned*)(bp[j]), (unsigned*)(lds + GT_BYTES + j * 4096 + tid * 16), 16, 0, 0);
    }
#pragma unroll 1
    for (int kt = 0; kt < KT; ++kt) {
        asm volatile("s_waitcnt vmcnt(0)" ::: "memory");
        __syncthreads();
        if (kt + 1 < KT) {
            unsigned char* sa = lds + ((kt + 1) & 1) * 2 * GT_BYTES;
#pragma unroll
            for (int j = 0; j < 4; ++j) {
                __builtin_amdgcn_global_load_lds((const unsigned*)(ap[j] + (kt + 1) * 64), (unsigned*)(sa + j * 4096 + tid * 16), 16, 0, 0);
                __builtin_amdgcn_global_load_lds((const unsigned*)(bp[j] + (kt + 1) * 64), (unsigned*)(sa + GT_BYTES + j * 4096 + tid * 16), 16, 0, 0);
            }
        }
        const unsigned char* sa = lds + (kt & 1) * 2 * GT_BYTES;
        const unsigned char* sb = sa + GT_BYTES;
#pragma unroll
        for (int ks = 0; ks < 2; ++ks) {
            const int phys = ((ks * 4 + fq) ^ (fr >> 1)) * 16;
            bf16x8 af[4], bq[4];
#pragma unroll
            for (int i = 0; i < 4; ++i) af[i] = *(const bf16x8*)(sa + (wr * 64 + i * 16 + fr) * 128 + phys);
#pragma unroll
            for (int j = 0; j < 4; ++j) bq[j] = *(const bf16x8*)(sb + (wc * 64 + j * 16 + fr) * 128 + phys);
#pragma unroll
            for (int i = 0; i < 4; ++i)
#pragma unroll
                for (int j = 0; j < 4; ++j) acc[i][j] = __builtin_amdgcn_mfma_f32_16x16x32_bf16(bq[j], af[i], acc[i][j], 0, 0, 0);
        }
    }
}
__device__ __forceinline__ void tile_coords(int it, int nM, int nN, int& tm, int& tn) {
    const int GM = 8, per = GM * nN, grp = it / per, fm = grp * GM, gsz = min(nM - fm, GM), rem = it - grp * per;
    tm = fm + rem % gsz; tn = rem / gsz;
}
__device__ __forceinline__ int vblock() { const int G = gridDim.x, b = blockIdx.x; return (G & 7) == 0 ? (b & 7) * (G >> 3) + (b >> 3) : b; }

template <class NMap>
__device__ __forceinline__ void conv_tile(const float* src, int ldsrc, int nvalid, int k0, int n0, bf16* dst, int lddst, NMap nmap, float* sm, const int tid) {
    __syncthreads();
    {
        const int k = tid >> 2, nq = (tid & 3) * 16;
#pragma unroll
        for (int q = 0; q < 4; ++q) {
            const int n = n0 + nq + q * 4;
            const float4 v = (n < nvalid) ? *(const float4*)(src + (size_t)(k0 + k) * ldsrc + n) : make_float4(0.f, 0.f, 0.f, 0.f);
            float* d = sm + k * 65 + nq + q * 4; d[0] = v.x; d[1] = v.y; d[2] = v.z; d[3] = v.w;
        }
    }
    __syncthreads();
    {
        const int n = tid >> 2, kq = (tid & 3) * 16;
        unsigned w[8];
#pragma unroll
        for (int i = 0; i < 8; ++i) w[i] = (unsigned)f2bf(sm[(kq + 2 * i) * 65 + n]) | ((unsigned)f2bf(sm[(kq + 2 * i + 1) * 65 + n]) << 16);
        bf16* d = dst + (size_t)nmap(n0 + n) * lddst + k0 + kq;
        *(uint4*)d = make_uint4(w[0], w[1], w[2], w[3]);
        *(uint4*)(d + 8) = make_uint4(w[4], w[5], w[6], w[7]);
    }
}
__device__ __forceinline__ bf16* wsm_int(const Params& p, int l) { return (bf16*)(p.ws + WS_WSM + (size_t)l * SZ_WSM_L); }
__device__ __forceinline__ bf16* wsm_bt(const Params& p, int l, int br) { return (bf16*)(p.ws + WS_WSM + (size_t)l * SZ_WSM_L + SZ_WINT + (size_t)br * SZ_WBT); }
__device__ __forceinline__ bf16* wsm_outt(const Params& p, int l) { return (bf16*)(p.ws + WS_WSM + (size_t)l * SZ_WSM_L + SZ_WINT + 3 * SZ_WBT); }

__device__ void ph_init(const Params& p, float* sm) {
    const int tid = tid_opaque();
    for (int it = blockIdx.x; it < 49 + 2 * 2144; it += gridDim.x) {
        if (it >= 49) {
            const int l = (it - 49) / 2144; int r = (it - 49) % 2144;
            if (r < 1504) { conv_tile(p.in[I_WIN] + (size_t)l * D * INW, INW, INW, (r / 94) * 64, (r % 94) * 64, wsm_int(p, l), D, [](int n) { return n; }, sm, tid); continue; }
            r -= 1504;
            if (r < 256) { const int br = r >> 7, q = r & 127;
                conv_tile(p.in[I_WBR] + ((size_t)(l * 3 + br) * 512) * D, D, D, (q >> 4) * 64, (q & 15) * 64, wsm_bt(p, l, br), 512, [](int n) { return n; }, sm, tid); continue; }
            r -= 256;
            if (r < 256) { conv_tile(p.in[I_WOUT] + (size_t)l * D * D, D, D, (r >> 4) * 64, (r & 15) * 64, wsm_outt(p, l), D, [](int n) { return n; }, sm, tid); continue; }
            r -= 256;
            {
                const int m0 = (r >> 4) * 64, n0 = (r & 15) * 64, g = m0 >> 7;
                const float* PW = p.in[I_POOLW] + ((size_t)(l * 4 + g) * 128) * 128;
                const float* PS = p.in[I_POOLS] + l * 512 + g * 128;
                const float* WB = p.in[I_WBR] + ((size_t)(l * 3 + 2) * 512 + g * 128) * D;
                float acc[4][4]; zero_acc(acc);
                gemm64(acc, 128,
                       [&](int m, int k) { const float4 a = *(const float4*)(PW + (size_t)((m0 + m) & 127) * 128 + k); const float4 sc = *(const float4*)(PS + k);
                                           return make_float4(a.x * sc.x, a.y * sc.y, a.z * sc.z, a.w * sc.w); },
                       [&](int k, int n) { return *(const float4*)(WB + (size_t)k * D + n0 + n); }, sm, sm + 16 * 68, tid);
                const int ty = tid >> 4, tx = tid & 15;
                bf16* dst = wsm_bt(p, l, 2);
#pragma unroll
                for (int j = 0; j < 4; ++j) st_bf4(dst + (size_t)(n0 + tx * 4 + j) * 512 + m0 + ty * 4, acc[0][j], acc[1][j], acc[2][j], acc[3][j]);
            }
            continue;
        }
        if (it == 48) {
            float2* rope = (float2*)(p.ws + WS_ROPE);
            for (int e = tid; e < 64 * 16; e += 256) {
                const int pos = e >> 4, i = e & 15;
                const float invf = powf(10000.0f, -(float)(2 * i) / 32.0f);
                const float angf = (float)pos * invf;
                const double ang = (double)angf;
                const double twopi = 6.283185307179586476925286766559;
                const double n = rint(ang / twopi);
                const double r = ang - n * twopi, r2 = r * r;
                double s = 1.0, c = 1.0;
                for (int q = 14; q >= 1; --q) { s = 1.0 - r2 / (double)((2 * q) * (2 * q + 1)) * s; c = 1.0 - r2 / (double)((2 * q - 1) * (2 * q)) * c; }
                s *= r;
                rope[e] = make_float2((float)c, (float)s);
            }
            continue;
        }
        const int l = it / 24, cb = it % 24;
        __syncthreads();
        for (int e = tid; e < 9 * D; e += 256) {
            const int mb = e / D, k = e % D;
            const float v = mb < 8 ? p.in[I_C][mb * D + k] : p.in[I_CCTX][k];
            sm[e] = silu_f(v);
        }
        __syncthreads();
        const int col = cb * 256 + tid;
        const float* w = p.in[I_WMOD] + (size_t)l * D * 6144 + col;
        float acc[9];
#pragma unroll
        for (int m = 0; m < 9; ++m) acc[m] = 0.f;
#pragma unroll 4
        for (int k = 0; k < D; ++k) {
            const float wv = w[(size_t)k * 6144];
#pragma unroll
            for (int m = 0; m < 9; ++m) acc[m] += sm[m * D + k] * wv;
        }
        const float bias = p.in[I_BMOD][l * 6144 + col];
        float* mv = (float*)(p.ws + WS_MODV);
#pragma unroll
        for (int m = 0; m < 9; ++m) mv[(size_t)(l * 9 + m) * 6144 + col] = acc[m] + bias;
    }
}

__device__ void ph_norm1(const Params& p, int l) {
    const int tid = tid_opaque(), lane = tid & 63, gw = blockIdx.x * 4 + (tid >> 6), ngw = gridDim.x * 4;
    bf16* H = (bf16*)(p.ws + WS_H);
    const float* g = p.in[I_N1G] + l * D;
    for (int r = gw; r < NTOK; r += ngw) {
        const float* x = xrow(p, l, r);
        const int mb = modrow(r);
        const float* sh = modv(p, l, mb, 0); const float* sc = modv(p, l, mb, 1);
        float4 v[4]; float ss = 0.f;
#pragma unroll
        for (int j = 0; j < 4; ++j) { v[j] = *(const float4*)(x + j * 256 + lane * 4); ss += v[j].x * v[j].x + v[j].y * v[j].y + v[j].z * v[j].z + v[j].w * v[j].w; }
        const float inv = rsqrtf(wave_sum(ss) * (1.f / D) + EPS);
#pragma unroll
        for (int j = 0; j < 4; ++j) {
            const int c = j * 256 + lane * 4;
            const float4 gg = *(const float4*)(g + c), s1 = *(const float4*)(sh + c), s2 = *(const float4*)(sc + c);
            st_bf4(H + (size_t)r * D + c, v[j].x * inv * gg.x * (1.f + s2.x) + s1.x, v[j].y * inv * gg.y * (1.f + s2.y) + s1.y,
                   v[j].z * inv * gg.z * (1.f + s2.z) + s1.z, v[j].w * inv * gg.w * (1.f + s2.w) + s1.w);
        }
    }
}

__device__ void ph_gemm_in(const Params& p, int l, unsigned char* lds) {
    const bf16* H = (const bf16*)(p.ws + WS_H);
    bf16* PROJ = (bf16*)(p.ws + WS_PROJ);
    const bf16* WT = wsm_int(p, l);
    const int nN = 47, nM = NTOK / 128;
    const int tid = tid_opaque(), lane = tid & 63, wid = tid >> 6, wr = wid >> 1, wc = wid & 1, fr = lane & 15, fq = lane >> 4;
    for (int it = vblock(); it < nM * nN; it += gridDim.x) {
        int tm, tn; tile_coords(it, nM, nN, tm, tn);
        f32x4 acc[4][4]; zero_acc4(acc);
        gemm_tile(acc, [&](int r) { return H + (size_t)(tm * 128 + r) * D; }, [&](int r) { return WT + (size_t)(tn * 128 + r) * D; }, D, lds, tid);
#pragma unroll
        for (int i = 0; i < 4; ++i)
#pragma unroll
            for (int j = 0; j < 4; ++j) {
                const int row = tm * 128 + wr * 64 + i * 16 + fr, col = tn * 128 + wc * 64 + j * 16 + fq * 4;
                if (col < INW) st_bf4(PROJ + (size_t)row * INW + col, acc[i][j][0], acc[i][j][1], acc[i][j][2], acc[i][j][3]);
            }
    }
}

__device__ void ph_prep(const Params& p, int l) {
    const int tid = tid_opaque();
    bf16* PROJ = (bf16*)(p.ws + WS_PROJ);
    const float2* rope = (const float2*)(p.ws + WS_ROPE);
    const long total = (long)NTOK * 10;
    for (long id = (long)blockIdx.x * 256 + tid; id < total; id += (long)gridDim.x * 256) {
        const int r = (int)(id / 10), j = (int)(id % 10);
        const bool isq = j < 8;
        if (l == 1 && r >= NL && isq) continue;
        bf16* ptr = PROJ + (size_t)r * INW + (isq ? O_AQ + j * 64 : O_AK + (j - 8) * 64);
        const float* g = p.in[isq ? I_QNG : I_KNG] + l * 64;
        float v[64]; float ss = 0.f;
#pragma unroll
        for (int q = 0; q < 16; ++q) { float4 t = ld_bf4(ptr + q * 4); v[q * 4] = t.x; v[q * 4 + 1] = t.y; v[q * 4 + 2] = t.z; v[q * 4 + 3] = t.w; }
#pragma unroll
        for (int d = 0; d < 64; ++d) ss += v[d] * v[d];
        const float inv = rsqrtf(ss * (1.f / 64.f) + EPS);
#pragma unroll
        for (int d = 0; d < 64; ++d) v[d] = v[d] * inv * g[d];
        if (r < NL) {
            const int t = r % T, row = t >> 6, col = t & 63;
#pragma unroll
            for (int i = 0; i < 16; ++i) {
                const float2 a = rope[row * 16 + i]; const float x1 = v[i], x2 = v[16 + i];
                v[i] = x1 * a.x - x2 * a.y; v[16 + i] = x1 * a.y + x2 * a.x;
                const float2 b = rope[col * 16 + i]; const float y1 = v[32 + i], y2 = v[48 + i];
                v[32 + i] = y1 * b.x - y2 * b.y; v[48 + i] = y1 * b.y + y2 * b.x;
            }
        }
        const float sc = isq ? 0.125f : 1.f;
#pragma unroll
        for (int q = 0; q < 16; ++q) st_bf4(ptr + q * 4, v[q * 4] * sc, v[q * 4 + 1] * sc, v[q * 4 + 2] * sc, v[q * 4 + 3] * sc);
    }
    bf16* DP = (bf16*)(p.ws + WS_R2 + 2 * SZ_Y512);
    const long tot2 = (long)((l == 0) ? NTOK : NL) * 128;
    for (long id = (long)blockIdx.x * 256 + tid; id < tot2; id += (long)gridDim.x * 256) {
        const int r = (int)(id >> 7), ch = (int)(id & 127) * 4, g = ch >> 7, hw = 1 << g;
        int t, base, tl;
        if (r < NL) { t = r % T; base = r - t; tl = T; } else { t = (r - NL) % CL; base = r - t; tl = CL; }
        const int lo = max(t - hw, 0), hi = min(t + hw, tl);
        float4 sacc = make_float4(0.f, 0.f, 0.f, 0.f);
        for (int u = lo; u < hi; ++u) { const float4 v = ld_bf4(PROJ + (size_t)(base + u) * INW + O_PU + ch); sacc.x += v.x; sacc.y += v.y; sacc.z += v.z; sacc.w += v.w; }
        const float inv = 1.f / (float)(hi - lo);
        const float4 c = ld_bf4(PROJ + (size_t)r * INW + O_PU + ch);
        st_bf4(DP + (size_t)r * 512 + ch, sacc.x * inv - c.x, sacc.y * inv - c.y, sacc.z * inv - c.z, sacc.w * inv - c.w);
    }
}

__device__ void ph_attn(const Params& p, int l, float* sm) {
    float* sQ = sm;
    float* sK = sQ + 64 * 65;
    float* sV = sK + 64 * 65;
    float* sP = sV + 64 * 64;
    bf16* PROJ = (bf16*)(p.ws + WS_PROJ);
    const int tid = tid_opaque(), ty = tid >> 4, tx = tid & 15;
    float mq = 0.f, mk = 0.f;
    for (int d = 0; d < 64; ++d) { mq = fmaxf(mq, fabsf(p.in[I_QNG][l * 64 + d])); mk = fmaxf(mk, fabsf(p.in[I_KNG][l * 64 + d])); }
    const float shift = 8.f * mq * mk;
    const int nlat = NB * 8 * 64, nctx = (l == 0) ? NB * 8 * 4 : 0;
    for (int it = blockIdx.x; it < nlat + nctx; it += gridDim.x) {
        int b, head, qrow0, nkt; bool lat = it < nlat;
        if (lat) { b = it / 512; head = (it / 64) % 8; qrow0 = b * T + (it % 64) * 64; nkt = 68; }
        else { const int j = it - nlat; b = j / 32; head = (j / 4) % 8; qrow0 = NL + b * CL + (j % 4) * 64; nkt = 4; }
        const int kvh = head >> 2;
        __syncthreads();
        {
            const int m = tid >> 2, d0 = (tid & 3) * 16;
            const bf16* src = PROJ + (size_t)(qrow0 + m) * INW + O_AQ + head * 64 + d0;
#pragma unroll
            for (int q = 0; q < 4; ++q) { float4 t = ld_bf4(src + q * 4); sQ[m * 65 + d0 + q * 4] = t.x; sQ[m * 65 + d0 + q * 4 + 1] = t.y; sQ[m * 65 + d0 + q * 4 + 2] = t.z; sQ[m * 65 + d0 + q * 4 + 3] = t.w; }
        }
        float o[4][4]; zero_acc(o);
        float lsum[4] = {0.f, 0.f, 0.f, 0.f};
        for (int kt = 0; kt < nkt; ++kt) {
            int krow0;
            if (lat) krow0 = (kt < 64) ? b * T + kt * 64 : NL + b * CL + (kt - 64) * 64;
            else krow0 = NL + b * CL + kt * 64;
            __syncthreads();
            {
                const int m = tid >> 2, d0 = (tid & 3) * 16;
                const bf16* ks = PROJ + (size_t)(krow0 + m) * INW + O_AK + kvh * 64 + d0;
                const bf16* vs = PROJ + (size_t)(krow0 + m) * INW + O_AV + kvh * 64 + d0;
#pragma unroll
                for (int q = 0; q < 4; ++q) {
                    float4 t = ld_bf4(ks + q * 4); sK[m * 65 + d0 + q * 4] = t.x; sK[m * 65 + d0 + q * 4 + 1] = t.y; sK[m * 65 + d0 + q * 4 + 2] = t.z; sK[m * 65 + d0 + q * 4 + 3] = t.w;
                    float4 u = ld_bf4(vs + q * 4); *(float4*)&sV[m * 64 + d0 + q * 4] = u;
                }
            }
            __syncthreads();
            float s[4][4]; zero_acc(s);
#pragma unroll 8
            for (int d = 0; d < 64; ++d) {
                float a[4], bb[4];
#pragma unroll
                for (int i = 0; i < 4; ++i) { a[i] = sQ[(ty * 4 + i) * 65 + d]; bb[i] = sK[(tx * 4 + i) * 65 + d]; }
#pragma unroll
                for (int i = 0; i < 4; ++i)
#pragma unroll
                    for (int j = 0; j < 4; ++j) s[i][j] += a[i] * bb[j];
            }
#pragma unroll
            for (int i = 0; i < 4; ++i)
#pragma unroll
                for (int j = 0; j < 4; ++j) { const float e = __expf(s[i][j] - shift); lsum[i] += e; sP[(ty * 4 + i) * 65 + tx * 4 + j] = e; }
            __syncthreads();
#pragma unroll 8
            for (int k = 0; k < 64; ++k) {
                const float4 vv = *(const float4*)&sV[k * 64 + tx * 4];
#pragma unroll
                for (int i = 0; i < 4; ++i) {
                    const float pp = sP[(ty * 4 + i) * 65 + k];
                    o[i][0] += pp * vv.x; o[i][1] += pp * vv.y; o[i][2] += pp * vv.z; o[i][3] += pp * vv.w;
                }
            }
        }
#pragma unroll
        for (int i = 0; i < 4; ++i) {
            float ls = lsum[i];
            ls += __shfl_xor(ls, 1); ls += __shfl_xor(ls, 2); ls += __shfl_xor(ls, 4); ls += __shfl_xor(ls, 8);
            const float inv = 1.f / ls;
            st_bf4(PROJ + (size_t)(qrow0 + ty * 4 + i) * INW + O_AQ + head * 64 + tx * 4, o[i][0] * inv, o[i][1] * inv, o[i][2] * inv, o[i][3] * inv);
        }
    }
}

__device__ void ph_gla(const Params& p, int l, float* sm) {
    constexpr int DVS = 32;
    float* sB = sm;
    float* sQ = sB + 4096;
    float* sK = sQ + 4096;
    float* sV = sK + 4096;
    float* sS = sV + 64 * DVS;
    float* sP = sS + 64 * DVS;
    const bf16* PROJ = (const bf16*)(p.ws + WS_PROJ);
    const int tid = tid_opaque(), ti = tid >> 2, part = tid & 3;
    for (int it = blockIdx.x; it < NB * 4 * 2 * 4; it += gridDim.x) {
        const int b = it >> 5, h = (it >> 3) & 3, dir = (it >> 2) & 1, sl = it & 3;
        bf16* OG = (bf16*)(p.ws + WS_R2 + (size_t)dir * SZ_Y512);
        const float* up = p.in[dir ? I_UPB : I_UPF] + (size_t)l * 16 * 256;
        const float* bias = p.in[dir ? I_BIASB : I_BIASF] + l * 256;
        const int ogl = dir ? O_GLB : O_GLF;
        __syncthreads();
        for (int e = tid; e < 64 * DVS; e += 256) sS[e] = 0.f;
        for (int n = 0; n < 68; ++n) {
            int base;
            if (n < 4) base = NL + b * CL + (dir ? 3 - n : n) * 64;
            else base = b * T + (dir ? 63 - (n - 4) : (n - 4)) * 64;
            const int tok = dir ? base + 63 - ti : base + ti;
            const bf16* prow = PROJ + (size_t)tok * INW;
            __syncthreads();
            {
                float g[16];
#pragma unroll
                for (int q = 0; q < 4; ++q) { float4 t = ld_bf4(prow + ogl + q * 4); g[q * 4] = t.x; g[q * 4 + 1] = t.y; g[q * 4 + 2] = t.z; g[q * 4 + 3] = t.w; }
#pragma unroll 4
                for (int dd = 0; dd < 16; ++dd) {
                    const int dk = part * 16 + dd, col = h * 64 + dk;
                    float a = bias[col];
#pragma unroll
                    for (int j = 0; j < 16; ++j) a += g[j] * up[j * 256 + col];
                    const float ls = fminf(a, 0.f) - log1pf(__expf(-fabsf(a)));
                    sB[ti * 64 + dk] = ls * (1.f / 16.f);
                }
            }
            __syncthreads();
            if (tid < 64) { float run = 0.f; for (int i = 0; i < 64; ++i) { run += sB[i * 64 + tid]; sB[i * 64 + tid] = run; } }
            __syncthreads();
            {
#pragma unroll
                for (int q = 0; q < 4; ++q) {
                    const int dk = part * 16 + q * 4;
                    float4 qq = ld_bf4(prow + O_GQ + h * 64 + dk), kk = ld_bf4(prow + O_GK + h * 64 + dk);
                    const float qa[4] = {qq.x, qq.y, qq.z, qq.w}, ka[4] = {kk.x, kk.y, kk.z, kk.w};
#pragma unroll
                    for (int e = 0; e < 4; ++e) {
                        const float bi = sB[ti * 64 + dk + e], br = sB[32 * 64 + dk + e];
                        sQ[ti * 64 + dk + e] = qa[e] * 0.125f * __expf(bi - br);
                        sK[ti * 64 + dk + e] = ka[e] * __expf(br - bi);
                    }
                }
#pragma unroll
                for (int q = 0; q < DVS / 16; ++q) {
                    const int dv = part * (DVS / 4) + q * 4;
                    float4 vv = ld_bf4(prow + O_GV + h * 128 + sl * DVS + dv);
                    *(float4*)&sV[ti * DVS + dv] = vv;
                }
            }
            __syncthreads();
            {
#pragma unroll 4
                for (int ss = 0; ss < 16; ++ss) {
                    const int s = part * 16 + ss;
                    float a = 0.f;
                    if (s <= ti) { for (int dk = 0; dk < 64; ++dk) a += sQ[ti * 64 + dk] * sK[s * 64 + dk]; }
                    sP[ti * 64 + s] = a;
                }
            }
            __syncthreads();
            {
                float o[DVS / 4];
#pragma unroll
                for (int e = 0; e < DVS / 4; ++e) o[e] = 0.f;
                for (int s = 0; s <= ti; ++s) {
                    const float pp = sP[ti * 64 + s];
#pragma unroll
                    for (int e = 0; e < DVS / 4; ++e) o[e] += pp * sV[s * DVS + part * (DVS / 4) + e];
                }
                for (int dk = 0; dk < 64; ++dk) {
                    const float qq = sQ[ti * 64 + dk] * __expf(sB[32 * 64 + dk]);
#pragma unroll
                    for (int e = 0; e < DVS / 4; ++e) o[e] += qq * sS[dk * DVS + part * (DVS / 4) + e];
                }
                bf16* dst = OG + (size_t)tok * 512 + h * 128 + sl * DVS + part * (DVS / 4);
#pragma unroll
                for (int e = 0; e < DVS / 4; e += 4) st_bf4(dst + e, o[e], o[e + 1], o[e + 2], o[e + 3]);
            }
            __syncthreads();
            {
                const int dk = ti;
                const float bl = sB[63 * 64 + dk], br = sB[32 * 64 + dk];
                const float al = __expf(bl), ar = __expf(bl - br);
                float acc[DVS / 4];
#pragma unroll
                for (int e = 0; e < DVS / 4; ++e) acc[e] = 0.f;
                for (int s = 0; s < 64; ++s) {
                    const float kk = sK[s * 64 + dk];
#pragma unroll
                    for (int e = 0; e < DVS / 4; ++e) acc[e] += kk * sV[s * DVS + part * (DVS / 4) + e];
                }
#pragma unroll
                for (int e = 0; e < DVS / 4; ++e) { const int ix = dk * DVS + part * (DVS / 4) + e; sS[ix] = al * sS[ix] + ar * acc[e]; }
            }
        }
    }
}

__device__ void ph_ygla(const Params& p, int l) {
    const int tid = tid_opaque(), lane = tid & 63, gw = blockIdx.x * 4 + (tid >> 6), ngw = gridDim.x * 4;
    bf16* O0 = (bf16*)(p.ws + WS_R2);
    const bf16* O1 = (const bf16*)(p.ws + WS_R2 + SZ_Y512);
    const bf16* PROJ = (const bf16*)(p.ws + WS_PROJ);
    const float* g = p.in[I_GLANG] + l * 128;
    const int nrows = (l == 0) ? NTOK : NL;
    for (int r = gw; r < nrows; r += ngw) {
        const int c = lane * 8;
        float v[8];
        { float4 a = ld_bf4(O0 + (size_t)r * 512 + c), b2 = ld_bf4(O0 + (size_t)r * 512 + c + 4), d = ld_bf4(O1 + (size_t)r * 512 + c), e = ld_bf4(O1 + (size_t)r * 512 + c + 4);
          v[0] = a.x + d.x; v[1] = a.y + d.y; v[2] = a.z + d.z; v[3] = a.w + d.w; v[4] = b2.x + e.x; v[5] = b2.y + e.y; v[6] = b2.z + e.z; v[7] = b2.w + e.w; }
        float ss = 0.f;
#pragma unroll
        for (int e = 0; e < 8; ++e) ss += v[e] * v[e];
        ss += __shfl_xor(ss, 1); ss += __shfl_xor(ss, 2); ss += __shfl_xor(ss, 4); ss += __shfl_xor(ss, 8);
        const float inv = rsqrtf(ss * (1.f / 128.f) + EPS);
        float4 r0 = ld_bf4(PROJ + (size_t)r * INW + O_GR + c), r1 = ld_bf4(PROJ + (size_t)r * INW + O_GR + c + 4);
        const float gr[8] = {r0.x, r0.y, r0.z, r0.w, r1.x, r1.y, r1.z, r1.w};
        float o[8];
#pragma unroll
        for (int e = 0; e < 8; ++e) o[e] = v[e] * inv * g[(c + e) & 127] * silu_f(gr[e]);
        st_bf4(O0 + (size_t)r * 512 + c, o[0], o[1], o[2], o[3]);
        st_bf4(O0 + (size_t)r * 512 + c + 4, o[4], o[5], o[6], o[7]);
    }
}

__device__ void ph_merge(const Params& p, int l, unsigned char* lds) {
    const bf16* PROJ = (const bf16*)(p.ws + WS_PROJ);
    const bf16* YG = (const bf16*)(p.ws + WS_R2);
    const bf16* DP = (const bf16*)(p.ws + WS_R2 + 2 * SZ_Y512);
    bf16* Z = (bf16*)(p.ws + WS_H);
    const int nrows = (l == 0) ? NTOK : NL, nM = nrows / 128, nN = 8;
    const int tid = tid_opaque(), lane = tid & 63, wid = tid >> 6, wr = wid >> 1, wc = wid & 1, fr = lane & 15, fq = lane >> 4;
    for (int it = vblock(); it < nM * nN; it += gridDim.x) {
        int tm, tn; tile_coords(it, nM, nN, tm, tn);
        f32x4 tot[4][4]; zero_acc4(tot);
#pragma unroll 1
        for (int br = 0; br < 3; ++br) {
            const bf16* WT = wsm_bt(p, l, br);
            const bf16* Ab = br == 0 ? YG : (br == 1 ? PROJ + O_AQ : DP);
            const size_t lda = br == 1 ? (size_t)INW : (size_t)512;
            f32x4 acc[4][4]; zero_acc4(acc);
            gemm_tile(acc, [&](int r) { return Ab + (size_t)(tm * 128 + r) * lda; }, [&](int r) { return WT + (size_t)(tn * 128 + r) * 512; }, 512, lds, tid);
#pragma unroll
            for (int i = 0; i < 4; ++i)
#pragma unroll
                for (int j = 0; j < 4; ++j) {
                    const int row = tm * 128 + wr * 64 + i * 16 + fr, col = tn * 128 + wc * 64 + j * 16 + fq * 4;
                    const float4 gt = ld_bf4(PROJ + (size_t)row * INW + O_GT + br * D + col);
                    tot[i][j][0] += sigmoid_f(gt.x) * acc[i][j][0]; tot[i][j][1] += sigmoid_f(gt.y) * acc[i][j][1];
                    tot[i][j][2] += sigmoid_f(gt.z) * acc[i][j][2]; tot[i][j][3] += sigmoid_f(gt.w) * acc[i][j][3];
                }
        }
#pragma unroll
        for (int i = 0; i < 4; ++i)
#pragma unroll
            for (int j = 0; j < 4; ++j) {
                const int row = tm * 128 + wr * 64 + i * 16 + fr, col = tn * 128 + wc * 64 + j * 16 + fq * 4;
                st_bf4(Z + (size_t)row * D + col, tot[i][j][0], tot[i][j][1], tot[i][j][2], tot[i][j][3]);
            }
    }
}

__device__ void ph_outproj(const Params& p, int l, unsigned char* lds) {
    const bf16* Z = (const bf16*)(p.ws + WS_H);
    const bf16* WT = wsm_outt(p, l);
    const int nrows = (l == 0) ? NTOK : NL, nM = nrows / 128, nN = 8;
    const int tid = tid_opaque(), lane = tid & 63, wid = tid >> 6, wr = wid >> 1, wc = wid & 1, fr = lane & 15, fq = lane >> 4;
    for (int it = vblock(); it < nM * nN; it += gridDim.x) {
        int tm, tn; tile_coords(it, nM, nN, tm, tn);
        f32x4 acc[4][4]; zero_acc4(acc);
        gemm_tile(acc, [&](int r) { return Z + (size_t)(tm * 128 + r) * D; }, [&](int r) { return WT + (size_t)(tn * 128 + r) * D; }, D, lds, tid);
#pragma unroll
        for (int i = 0; i < 4; ++i) {
            const int r = tm * 128 + wr * 64 + i * 16 + fr;
            const float* xr = xrow(p, l, r);
            const float* g1 = modv(p, l, modrow(r), 2);
            float* dr = r < NL ? p.out + (size_t)r * D : (float*)(p.ws + WS_XC) + (size_t)(r - NL) * D;
#pragma unroll
            for (int j = 0; j < 4; ++j) {
                const int c = tn * 128 + wc * 64 + j * 16 + fq * 4;
                const float4 xo = *(const float4*)(xr + c), gg = *(const float4*)(g1 + c);
                *(float4*)(dr + c) = make_float4(xo.x + gg.x * acc[i][j][0], xo.y + gg.y * acc[i][j][1], xo.z + gg.z * acc[i][j][2], xo.w + gg.w * acc[i][j][3]);
            }
        }
    }
}

__device__ __forceinline__ const float* x1row(const Params& p, int r) {
    return r < NL ? p.out + (size_t)r * D : (const float*)(p.ws + WS_XC) + (size_t)(r - NL) * D;
}
__device__ void ph_router(const Params& p, int l) {
    const int tid = tid_opaque(), lane = tid & 63, gw = blockIdx.x * 4 + (tid >> 6), ngw = gridDim.x * 4;
    bf16* H = (bf16*)(p.ws + WS_H);
    const float* g = p.in[I_N2G] + l * D;
    const float* wg = p.in[I_WGRP] + (size_t)l * D * 4;
    const float* we = p.in[I_WEXP] + (size_t)l * D * 32;
    unsigned* cnt = (unsigned*)(p.ws + WS_CTL) + l * 32;
    int* list = (int*)(p.ws + WS_LIST);
    float* wt = (float*)(p.ws + WS_WT);
    const int nrows = (l == 0) ? NTOK : NL;
    for (int r = gw; r < nrows; r += ngw) {
        const float* x = x1row(p, r);
        const int mb = modrow(r);
        const float* sh = modv(p, l, mb, 3); const float* sc = modv(p, l, mb, 4);
        float4 v[4]; float ss = 0.f;
#pragma unroll
        for (int j = 0; j < 4; ++j) { v[j] = *(const float4*)(x + j * 256 + lane * 4); ss += v[j].x * v[j].x + v[j].y * v[j].y + v[j].z * v[j].z + v[j].w * v[j].w; }
        const float inv = rsqrtf(wave_sum(ss) * (1.f / D) + EPS);
        float hv[16];
#pragma unroll
        for (int j = 0; j < 4; ++j) {
            const int c = j * 256 + lane * 4;
            const float4 gg = *(const float4*)(g + c), s1 = *(const float4*)(sh + c), s2 = *(const float4*)(sc + c);
            hv[j * 4 + 0] = v[j].x * inv * gg.x * (1.f + s2.x) + s1.x; hv[j * 4 + 1] = v[j].y * inv * gg.y * (1.f + s2.y) + s1.y;
            hv[j * 4 + 2] = v[j].z * inv * gg.z * (1.f + s2.z) + s1.z; hv[j * 4 + 3] = v[j].w * inv * gg.w * (1.f + s2.w) + s1.w;
            st_bf4(H + (size_t)r * D + c, hv[j * 4], hv[j * 4 + 1], hv[j * 4 + 2], hv[j * 4 + 3]);
        }
        float lg[4];
#pragma unroll
        for (int o = 0; o < 4; ++o) {
            float a = 0.f;
#pragma unroll
            for (int j = 0; j < 4; ++j)
#pragma unroll
                for (int e = 0; e < 4; ++e) a += hv[j * 4 + e] * wg[(size_t)(j * 256 + lane * 4 + e) * 4 + o];
            lg[o] = wave_sum(a) + p.in[I_BGRP][l * 4 + o];
        }
        int grp = 0; float gmax = lg[0];
#pragma unroll
        for (int o = 1; o < 4; ++o) if (lg[o] > gmax) { gmax = lg[o]; grp = o; }
        float gden = 0.f;
#pragma unroll
        for (int o = 0; o < 4; ++o) gden += __expf(lg[o] - gmax);
        const float ptg = 1.f / gden;
        float le[8];
#pragma unroll
        for (int o = 0; o < 8; ++o) {
            float a = 0.f;
            const int col = grp * 8 + o;
#pragma unroll
            for (int j = 0; j < 4; ++j)
#pragma unroll
                for (int e = 0; e < 4; ++e) a += hv[j * 4 + e] * we[(size_t)(j * 256 + lane * 4 + e) * 32 + col];
            le[o] = wave_sum(a) + p.in[I_BEXP][l * 32 + col];
        }
        int i1 = 0; float m1 = le[0];
#pragma unroll
        for (int o = 1; o < 8; ++o) if (le[o] > m1) { m1 = le[o]; i1 = o; }
        int i2 = -1; float m2 = -3.0e38f;
#pragma unroll
        for (int o = 0; o < 8; ++o) if (o != i1 && le[o] > m2) { m2 = le[o]; i2 = o; }
        const float e2 = __expf(m2 - m1);
        const float w1 = ptg / (1.f + e2), w2 = ptg * e2 / (1.f + e2);
        if (lane == 0) {
            const int ea = grp * 8 + i1, eb = grp * 8 + i2;
            const unsigned pa = atomicAdd(&cnt[ea], 1u); list[(size_t)ea * NTOK + pa] = r * 2;
            const unsigned pb = atomicAdd(&cnt[eb], 1u); list[(size_t)eb * NTOK + pb] = r * 2 + 1;
            wt[r * 2] = w1; wt[r * 2 + 1] = w2;
        }
    }
}

__device__ void ph_convmoe(const Params& p, int l, float* sm) {
    const int tid = tid_opaque();
    bf16* WGU = (bf16*)(p.ws + WS_WGU);
    bf16* WDT = (bf16*)(p.ws + WS_WDT);
    for (int it = blockIdx.x; it < 32 * 384; it += gridDim.x) {
        const int e = it / 384, r = it % 384, kind = r >> 7, q = r & 127;
        if (kind == 0)
            conv_tile(p.in[I_WGATE] + ((size_t)(l * 32 + e) * D) * 512, 512, 512, (q >> 3) * 64, (q & 7) * 64, WGU + (size_t)e * D * D, D,
                      [](int n) { return 32 * (n >> 4) + (n & 15); }, sm, tid);
        else if (kind == 1)
            conv_tile(p.in[I_WUP] + ((size_t)(l * 32 + e) * D) * 512, 512, 512, (q >> 3) * 64, (q & 7) * 64, WGU + (size_t)e * D * D, D,
                      [](int n) { return 32 * (n >> 4) + 16 + (n & 15); }, sm, tid);
        else
            conv_tile(p.in[I_WDOWN] + ((size_t)(l * 32 + e) * 512) * D, D, D, (q >> 4) * 64, (q & 15) * 64, WDT + (size_t)e * D * 512, 512,
                      [](int n) { return n; }, sm, tid);
    }
}

__device__ __forceinline__ void moe_tile_lookup(const unsigned* cnt, int trow, int& e, int& i0, int& ce) {
    int start = 0; e = 0; i0 = 0; ce = 0;
#pragma unroll 1
    for (int q = 0; q < 32; ++q) {
        const int c = (int)cnt[q], nt = (c + 127) >> 7;
        if (trow >= start && trow < start + nt) { e = q; i0 = (trow - start) * 128; ce = c; }
        start += nt;
    }
}
__device__ __forceinline__ int moe_ntiles(const unsigned* cnt) {
    int n = 0;
#pragma unroll 1
    for (int q = 0; q < 32; ++q) n += ((int)cnt[q] + 127) >> 7;
    return n;
}

__device__ void ph_moe1(const Params& p, int l, unsigned char* lds) {
    const bf16* H = (const bf16*)(p.ws + WS_H);
    bf16* ACT = (bf16*)(p.ws + WS_ACT);
    const bf16* WGU = (const bf16*)(p.ws + WS_WGU);
    const unsigned* cnt = (const unsigned*)(p.ws + WS_CTL) + l * 32;
    const int* list = (const int*)(p.ws + WS_LIST);
    const int tid = tid_opaque(), lane = tid & 63, wid = tid >> 6, wr = wid >> 1, wc = wid & 1, fr = lane & 15, fq = lane >> 4;
    const int ntiles = moe_ntiles(cnt);
    for (int it = vblock(); it < ntiles * 8; it += gridDim.x) {
        const int trow = it >> 3, tn = it & 7;
        int e, i0, ce; moe_tile_lookup(cnt, trow, e, i0, ce);
        const int* le = list + (size_t)e * NTOK;
        const bf16* WT = WGU + (size_t)e * D * D;
        f32x4 acc[4][4]; zero_acc4(acc);
        gemm_tile(acc, [&](int r) { const int ii = min(i0 + r, ce - 1); return H + (size_t)(le[ii] >> 1) * D; },
                  [&](int r) { return WT + (size_t)(tn * 128 + r) * D; }, D, lds, tid);
#pragma unroll
        for (int i = 0; i < 4; ++i) {
            const int ii = i0 + wr * 64 + i * 16 + fr;
            if (ii < ce) {
                const int asg = le[ii];
#pragma unroll
                for (int jp = 0; jp < 2; ++jp) {
                    const f32x4 g = acc[i][2 * jp], u = acc[i][2 * jp + 1];
                    st_bf4(ACT + (size_t)asg * 512 + tn * 64 + wc * 32 + jp * 16 + fq * 4, silu_f(g[0]) * u[0], silu_f(g[1]) * u[1], silu_f(g[2]) * u[2], silu_f(g[3]) * u[3]);
                }
            }
        }
    }
}

__device__ void ph_moe2(const Params& p, int l, unsigned char* lds) {
    const bf16* ACT = (const bf16*)(p.ws + WS_ACT);
    const bf16* WDT = (const bf16*)(p.ws + WS_WDT);
    const unsigned* cnt = (const unsigned*)(p.ws + WS_CTL) + l * 32;
    const int* list = (const int*)(p.ws + WS_LIST);
    const float* wt = (const float*)(p.ws + WS_WT);
    const int tid = tid_opaque(), lane = tid & 63, wid = tid >> 6, wr = wid >> 1, wc = wid & 1, fr = lane & 15, fq = lane >> 4;
    const int ntiles = moe_ntiles(cnt);
    for (int it = vblock(); it < ntiles * 8; it += gridDim.x) {
        const int trow = it >> 3, tn = it & 7;
        int e, i0, ce; moe_tile_lookup(cnt, trow, e, i0, ce);
        const int* le = list + (size_t)e * NTOK;
        const bf16* WT = WDT + (size_t)e * D * 512;
        f32x4 acc[4][4]; zero_acc4(acc);
        gemm_tile(acc, [&](int r) { const int ii = min(i0 + r, ce - 1); return ACT + (size_t)le[ii] * 512; },
                  [&](int r) { return WT + (size_t)(tn * 128 + r) * 512; }, 512, lds, tid);
#pragma unroll
        for (int i = 0; i < 4; ++i) {
            const int ii = i0 + wr * 64 + i * 16 + fr;
            if (ii < ce) {
                const int asg = le[ii], tok = asg >> 1;
                const float w = wt[asg];
                bf16* Y = (bf16*)(p.ws + ((asg & 1) ? WS_Y1 : WS_Y0));
#pragma unroll
                for (int j = 0; j < 4; ++j)
                    st_bf4(Y + (size_t)tok * D + tn * 128 + wc * 64 + j * 16 + fq * 4, w * acc[i][j][0], w * acc[i][j][1], w * acc[i][j][2], w * acc[i][j][3]);
            }
        }
    }
}

__device__ void ph_combine(const Params& p, int l) {
    const int tid = tid_opaque(), lane = tid & 63, gw = blockIdx.x * 4 + (tid >> 6), ngw = gridDim.x * 4;
    const bf16* Y0 = (const bf16*)(p.ws + WS_Y0);
    const bf16* Y1 = (const bf16*)(p.ws + WS_Y1);
    const int nrows = (l == 0) ? NTOK : NL;
    for (int r = gw; r < nrows; r += ngw) {
        const float* x = x1row(p, r);
        float* xo = r < NL ? p.out + (size_t)r * D : (float*)(p.ws + WS_XC) + (size_t)(r - NL) * D;
        const float* g2 = modv(p, l, modrow(r), 5);
        float4 v[4]; float ss = 0.f;
#pragma unroll
        for (int j = 0; j < 4; ++j) {
            const int c = j * 256 + lane * 4;
            const float4 xv = *(const float4*)(x + c), gg = *(const float4*)(g2 + c);
            const float4 a = ld_bf4(Y0 + (size_t)r * D + c), b = ld_bf4(Y1 + (size_t)r * D + c);
            v[j] = make_float4(xv.x + gg.x * (a.x + b.x), xv.y + gg.y * (a.y + b.y), xv.z + gg.z * (a.z + b.z), xv.w + gg.w * (a.w + b.w));
            ss += v[j].x * v[j].x + v[j].y * v[j].y + v[j].z * v[j].z + v[j].w * v[j].w;
        }
        if (l == 0) {
#pragma unroll
            for (int j = 0; j < 4; ++j) *(float4*)(xo + j * 256 + lane * 4) = v[j];
        } else {
            const float inv = rsqrtf(wave_sum(ss) * (1.f / D) + EPS);
            const float* fg = p.in[I_FING];
#pragma unroll
            for (int j = 0; j < 4; ++j) {
                const int c = j * 256 + lane * 4;
                const float4 gg = *(const float4*)(fg + c);
                *(float4*)(xo + c) = make_float4(v[j].x * inv * gg.x, v[j].y * inv * gg.y, v[j].z * inv * gg.z, v[j].w * inv * gg.w);
            }
        }
    }
}

constexpr int LDS_BYTES = 80 * 1024;
__global__ void __launch_bounds__(256, 2) mega_fwd(Params p) {
    extern __shared__ __attribute__((aligned(16))) unsigned char smem_raw[];
    float* sm = (float*)smem_raw;
    cg::grid_group grid = cg::this_grid();
    ph_init(p, sm);
    grid.sync();
#pragma unroll 1
    for (int l = 0; l < 2; ++l) {
        ph_norm1(p, l);             grid.sync();
        ph_gemm_in(p, l, smem_raw); grid.sync();
        ph_prep(p, l);              grid.sync();
        ph_attn(p, l, sm);
        ph_gla(p, l, sm);           grid.sync();
        ph_ygla(p, l);              grid.sync();
        ph_merge(p, l, smem_raw);   grid.sync();
        ph_outproj(p, l, smem_raw); grid.sync();
        ph_router(p, l);
        ph_convmoe(p, l, sm);       grid.sync();
        ph_moe1(p, l, smem_raw);    grid.sync();
        ph_moe2(p, l, smem_raw);    grid.sync();
        ph_combine(p, l);           grid.sync();
    }
}

extern "C" void kernel_launch(void* const* d_in, const int* in_sizes, int n_in, void* d_out, int out_size, void* d_ws, size_t ws_size,
                              hipStream_t stream) {
    if (n_in != 28 || ws_size < WS_END) { fprintf(stderr, "kernel_launch: bad n_in %d or ws_size %zu (< %zu)\n", n_in, ws_size, (size_t)WS_END); return; }
    static int grid_blocks = 0;
    if (!grid_blocks) {
        int dev = 0, cus = 0, per_cu = 0;
        (void)hipGetDevice(&dev);
        (void)hipDeviceGetAttribute(&cus, hipDeviceAttributeMultiprocessorCount, dev);
        (void)hipFuncSetAttribute((const void*)mega_fwd, hipFuncAttributeMaxDynamicSharedMemorySize, LDS_BYTES);
        (void)hipOccupancyMaxActiveBlocksPerMultiprocessor(&per_cu, (const void*)mega_fwd, 256, LDS_BYTES);
        if (per_cu < 1) per_cu = 1;
        grid_blocks = cus * per_cu;
        fprintf(stderr, "kernel_launch: cus %d per_cu %d grid %d ws_size %zu\n", cus, per_cu, grid_blocks, ws_size);
    }
    Params p{};
    for (int i = 0; i < 28; ++i) p.in[i] = (const float*)d_in[i];
    p.out = (float*)d_out; p.ws = (unsigned char*)d_ws;
    (void)hipMemsetAsync((char*)d_ws + WS_CTL, 0, 1 * MiB, stream);
    void* args[] = {&p};
    hipError_t e = hipLaunchCooperativeKernel((const void*)mega_fwd, dim3(grid_blocks), dim3(256), args, LDS_BYTES, stream);
    if (e != hipSuccess) fprintf(stderr, "cooperative launch failed: %s (grid %d)\n", hipGetErrorString(e), grid_blocks);
}
```

```cpp
#include <hip/hip_runtime.h>
#include <hip/hip_cooperative_groups.h>
namespace cg = cooperative_groups;
#include <cstdio>
#include <cstdint>

typedef unsigned short bf16;

constexpr int D = 1024, NB = 8, T = 4096, CL = 256, NL = NB * T, NC = NB * CL, NTOK = NL + NC;
constexpr int INW = 5920;
constexpr int O_GQ = 0, O_GK = 256, O_GV = 512, O_GR = 1024, O_GLF = 1536, O_GLB = 1552, O_AQ = 1568, O_AK = 2080,
              O_AV = 2208, O_PU = 2336, O_GT = 2848;
constexpr float EPS = 1e-6f;

constexpr size_t MiB = 1u << 20;
constexpr size_t WS_CTL = 0;
constexpr size_t WS_MODV = 1 * MiB;
constexpr size_t WS_ROPE = 1 * MiB + 512 * 1024;
constexpr size_t WS_WT = 2 * MiB;
constexpr size_t WS_LIST = 3 * MiB;
constexpr size_t WS_XC = 8 * MiB;
constexpr size_t WS_H = 16 * MiB;
constexpr size_t WS_PROJ = 84 * MiB;
constexpr size_t WS_R2 = 478 * MiB;
constexpr size_t WS_WGU = WS_R2;
constexpr size_t WS_WDT = WS_R2 + 64 * MiB;
constexpr size_t WS_WSM = 580 * MiB;
constexpr size_t SZ_WINT = (size_t)6016 * 1024 * 2, SZ_WBT = (size_t)1024 * 512 * 2, SZ_WOUTT = (size_t)1024 * 1024 * 2;
constexpr size_t SZ_WSM_L = SZ_WINT + 3 * SZ_WBT + SZ_WOUTT;
constexpr size_t WS_VT = 614 * MiB;
constexpr int NKEY = T + CL;
constexpr size_t WS_END = 623 * MiB;
static_assert(WS_WSM + 2 * SZ_WSM_L <= WS_END, "ws map");
constexpr size_t SZ_Y512 = (size_t)NTOK * 512 * 2;
constexpr size_t WS_ACT = WS_PROJ;
constexpr size_t WS_Y0 = WS_PROJ + 68 * MiB;
constexpr size_t WS_Y1 = WS_PROJ + 136 * MiB;

struct Params {
    const float* in[28];
    float* out;
    unsigned char* ws;
};
enum { I_X = 0, I_C, I_CTX, I_CCTX, I_WMOD, I_BMOD, I_N1G, I_N2G, I_WIN, I_UPF, I_BIASF, I_UPB, I_BIASB, I_GLANG, I_QNG, I_KNG,
       I_POOLW, I_POOLS, I_WBR, I_WOUT, I_WGRP, I_BGRP, I_WEXP, I_BEXP, I_WGATE, I_WUP, I_WDOWN, I_FING };

__device__ __forceinline__ float bf2f(bf16 v) { return __uint_as_float(((unsigned)v) << 16); }
__device__ __forceinline__ bf16 f2bf(float f) { unsigned u = __float_as_uint(f); return (bf16)((u + 0x7fffu + ((u >> 16) & 1u)) >> 16); }
__device__ __forceinline__ float4 ld_bf4(const bf16* p) {
    uint2 u = *(const uint2*)p;
    return make_float4(__uint_as_float(u.x << 16), __uint_as_float(u.x & 0xffff0000u), __uint_as_float(u.y << 16), __uint_as_float(u.y & 0xffff0000u));
}
typedef float f32x2_t __attribute__((ext_vector_type(2)));
typedef __bf16 bf16x2_t __attribute__((ext_vector_type(2)));
__device__ __forceinline__ unsigned pk_bf16(float a, float b) { f32x2_t v = {a, b}; return __builtin_bit_cast(unsigned, __builtin_convertvector(v, bf16x2_t)); }
__device__ __forceinline__ void st_bf4(bf16* p, float a, float b, float c, float d) {
    uint2 u; u.x = pk_bf16(a, b); u.y = pk_bf16(c, d);
    *(uint2*)p = u;
}
__device__ __forceinline__ int tid_opaque() { int t = threadIdx.x; asm volatile("" : "+v"(t)); return t; }
__device__ __forceinline__ float wave_sum(float v) {
#pragma unroll
    for (int o = 1; o < 64; o <<= 1) v += __shfl_xor(v, o);
    return v;
}
__device__ __forceinline__ float silu_f(float x) { return x / (1.f + __expf(-x)); }
__device__ __forceinline__ float sigmoid_f(float x) { return 1.f / (1.f + __expf(-x)); }
__device__ __forceinline__ int modrow(int r) { return r < NL ? r / T : 8; }
__device__ __forceinline__ const float* xrow(const Params& p, int l, int r) {
    if (l == 0) return r < NL ? p.in[I_X] + (size_t)r * D : p.in[I_CTX] + (size_t)(r - NL) * D;
    return r < NL ? p.out + (size_t)r * D : (const float*)(p.ws + WS_XC) + (size_t)(r - NL) * D;
}
__device__ __forceinline__ const float* modv(const Params& p, int l, int mb, int which) {
    return (const float*)(p.ws + WS_MODV) + ((size_t)(l * 9 + mb) * 6 + which) * D;
}

template <class AF, class BF>
__device__ __forceinline__ void gemm64(float (&acc)[4][4], int K, AF aload, BF bload, float* sA, float* sB, const int tid) {
    const int ty = tid >> 4, tx = tid & 15;
    const int am = tid >> 2, ak = (tid & 3) * 4;
    const int bk = tid >> 4, bn = (tid & 15) * 4;
    for (int k0 = 0; k0 < K; k0 += 16) {
        float4 av = aload(am, k0 + ak);
        float4 bv = bload(k0 + bk, bn);
        __syncthreads();
        sA[(ak + 0) * 68 + am] = av.x; sA[(ak + 1) * 68 + am] = av.y; sA[(ak + 2) * 68 + am] = av.z; sA[(ak + 3) * 68 + am] = av.w;
        *(float4*)&sB[bk * 64 + bn] = bv;
        __syncthreads();
#pragma unroll
        for (int kk = 0; kk < 16; ++kk) {
            float4 a = *(float4*)&sA[kk * 68 + ty * 4];
            float4 b = *(float4*)&sB[kk * 64 + tx * 4];
            float aa[4] = {a.x, a.y, a.z, a.w}, bb[4] = {b.x, b.y, b.z, b.w};
#pragma unroll
            for (int i = 0; i < 4; ++i)
#pragma unroll
                for (int j = 0; j < 4; ++j) acc[i][j] += aa[i] * bb[j];
        }
    }
    __syncthreads();
}
__device__ __forceinline__ void zero_acc(float (&acc)[4][4]) {
#pragma unroll
    for (int i = 0; i < 4; ++i)
#pragma unroll
        for (int j = 0; j < 4; ++j) acc[i][j] = 0.f;
}

typedef short bf16x8 __attribute__((ext_vector_type(8)));
typedef float f32x4 __attribute__((ext_vector_type(4)));
constexpr int GT_BYTES = 16384;
__device__ __forceinline__ void zero_acc4(f32x4 (&acc)[4][4]) {
#pragma unroll
    for (int i = 0; i < 4; ++i)
#pragma unroll
        for (int j = 0; j < 4; ++j) acc[i][j] = (f32x4){0.f, 0.f, 0.f, 0.f};
}
template <class FA, class FB>
__device__ __forceinline__ void gemm_tile(f32x4 (&acc)[4][4], FA arow, FB brow, int K, unsigned char* lds, const int tid) {
    const int lane = tid & 63, wid = tid >> 6, wr = wid >> 1, wc = wid & 1, fr = lane & 15, fq = lane >> 4;
    const int srow = tid >> 3, sc = ((tid & 7) ^ ((tid >> 4) & 7)) * 8;
    const bf16* ap[4]; const bf16* bp[4];
#pragma unroll
    for (int j = 0; j < 4; ++j) { ap[j] = arow(j * 32 + srow) + sc; bp[j] = brow(j * 32 + srow) + sc; }
    const int KT = K >> 6;
#pragma unroll
    for (int j = 0; j < 4; ++j) {
        __builtin_amdgcn_global_load_lds((const unsigned*)(ap[j]), (unsigned*)(lds + j * 4096 + tid * 16), 16, 0, 0);
        __builtin_amdgcn_global_load_lds((const unsigned*)(bp[j]), (unsigned*)(lds + GT_BYTES + j * 4096 + tid * 16), 16, 0, 0);
    }
#pragma unroll 1
    for (int kt = 0; kt < KT; ++kt) {
        asm volatile("s_waitcnt vmcnt(0)" ::: "memory");
        __syncthreads();
        if (kt + 1 < KT) {
            unsigned char* sa = lds + ((kt + 1) & 1) * 2 * GT_BYTES;
#pragma unroll
            for (int j = 0; j < 4; ++j) {
                __builtin_amdgcn_global_load_lds((const unsigned*)(ap[j] + (kt + 1) * 64), (unsigned*)(sa + j * 4096 + tid * 16), 16, 0, 0);
                __builtin_amdgcn_global_load_lds((const unsigned*)(bp[j] + (kt + 1) * 64), (unsigned*)(sa + GT_BYTES + j * 4096 + tid * 16), 16, 0, 0);
            }
        }
        const unsigned char* sa = lds + (kt & 1) * 2 * GT_BYTES;
        const unsigned char* sb = sa + GT_BYTES;
#pragma unroll
        for (int ks = 0; ks < 2; ++ks) {
            const int phys = ((ks * 4 + fq) ^ (fr >> 1)) * 16;
            bf16x8 af[4], bq[4];
#pragma unroll
            for (int i = 0; i < 4; ++i) af[i] = *(const bf16x8*)(sa + (wr * 64 + i * 16 + fr) * 128 + phys);
#pragma unroll
            for (int j = 0; j < 4; ++j) bq[j] = *(const bf16x8*)(sb + (wc * 64 + j * 16 + fr) * 128 + phys);
#pragma unroll
            for (int i = 0; i < 4; ++i)
#pragma unroll
                for (int j = 0; j < 4; ++j) acc[i][j] = __builtin_amdgcn_mfma_f32_16x16x32_bf16(bq[j], af[i], acc[i][j], 0, 0, 0);
        }
    }
}
__device__ __forceinline__ void tile_coords(int it, int nM, int nN, int& tm, int& tn) {
    const int GM = 8, per = GM * nN, grp = it / per, fm = grp * GM, gsz = min(nM - fm, GM), rem = it - grp * per;
    tm = fm + rem % gsz; tn = rem / gsz;
}
__device__ __forceinline__ int vblock() { const int G = gridDim.x, b = blockIdx.x; return (G & 7) == 0 ? (b & 7) * (G >> 3) + (b >> 3) : b; }

template <class NMap>
__device__ __forceinline__ void conv_tile(const float* src, int ldsrc, int nvalid, int k0, int n0, bf16* dst, int lddst, NMap nmap, float* sm, const int tid) {
    __syncthreads();
    {
        const int k = tid >> 2, nq = (tid & 3) * 16;
#pragma unroll
        for (int q = 0; q < 4; ++q) {
            const int n = n0 + nq + q * 4;
            const float4 v = (n < nvalid) ? *(const float4*)(src + (size_t)(k0 + k) * ldsrc + n) : make_float4(0.f, 0.f, 0.f, 0.f);
            float* d = sm + k * 65 + nq + q * 4; d[0] = v.x; d[1] = v.y; d[2] = v.z; d[3] = v.w;
        }
    }
    __syncthreads();
    {
        const int n = tid >> 2, kq = (tid & 3) * 16;
        unsigned w[8];
#pragma unroll
        for (int i = 0; i < 8; ++i) w[i] = (unsigned)f2bf(sm[(kq + 2 * i) * 65 + n]) | ((unsigned)f2bf(sm[(kq + 2 * i + 1) * 65 + n]) << 16);
        bf16* d = dst + (size_t)nmap(n0 + n) * lddst + k0 + kq;
        *(uint4*)d = make_uint4(w[0], w[1], w[2], w[3]);
        *(uint4*)(d + 8) = make_uint4(w[4], w[5], w[6], w[7]);
    }
}
__device__ __forceinline__ bf16* wsm_int(const Params& p, int l) { return (bf16*)(p.ws + WS_WSM + (size_t)l * SZ_WSM_L); }
__device__ __forceinline__ bf16* wsm_bt(const Params& p, int l, int br) { return (bf16*)(p.ws + WS_WSM + (size_t)l * SZ_WSM_L + SZ_WINT + (size_t)br * SZ_WBT); }
__device__ __forceinline__ bf16* wsm_outt(const Params& p, int l) { return (bf16*)(p.ws + WS_WSM + (size_t)l * SZ_WSM_L + SZ_WINT + 3 * SZ_WBT); }

__device__ void ph_init(const Params& p, float* sm) {
    const int tid = tid_opaque();
    for (int it = blockIdx.x; it < 49 + 2 * 2144; it += gridDim.x) {
        if (it >= 49) {
            const int l = (it - 49) / 2144; int r = (it - 49) % 2144;
            if (r < 1504) { conv_tile(p.in[I_WIN] + (size_t)l * D * INW, INW, INW, (r / 94) * 64, (r % 94) * 64, wsm_int(p, l), D, [](int n) { return n; }, sm, tid); continue; }
            r -= 1504;
            if (r < 256) { const int br = r >> 7, q = r & 127;
                conv_tile(p.in[I_WBR] + ((size_t)(l * 3 + br) * 512) * D, D, D, (q >> 4) * 64, (q & 15) * 64, wsm_bt(p, l, br), 512, [](int n) { return n; }, sm, tid); continue; }
            r -= 256;
            if (r < 256) { conv_tile(p.in[I_WOUT] + (size_t)l * D * D, D, D, (r >> 4) * 64, (r & 15) * 64, wsm_outt(p, l), D, [](int n) { return n; }, sm, tid); continue; }
            r -= 256;
            {
                const int m0 = (r >> 4) * 64, n0 = (r & 15) * 64, g = m0 >> 7;
                const float* PW = p.in[I_POOLW] + ((size_t)(l * 4 + g) * 128) * 128;
                const float* PS = p.in[I_POOLS] + l * 512 + g * 128;
                const float* WB = p.in[I_WBR] + ((size_t)(l * 3 + 2) * 512 + g * 128) * D;
                float acc[4][4]; zero_acc(acc);
                gemm64(acc, 128,
                       [&](int m, int k) { const float4 a = *(const float4*)(PW + (size_t)((m0 + m) & 127) * 128 + k); const float4 sc = *(const float4*)(PS + k);
                                           return make_float4(a.x * sc.x, a.y * sc.y, a.z * sc.z, a.w * sc.w); },
                       [&](int k, int n) { return *(const float4*)(WB + (size_t)k * D + n0 + n); }, sm, sm + 16 * 68, tid);
                const int ty = tid >> 4, tx = tid & 15;
                bf16* dst = wsm_bt(p, l, 2);
#pragma unroll
                for (int j = 0; j < 4; ++j) st_bf4(dst + (size_t)(n0 + tx * 4 + j) * 512 + m0 + ty * 4, acc[0][j], acc[1][j], acc[2][j], acc[3][j]);
            }
            continue;
        }
        if (it == 48) {
            float2* rope = (float2*)(p.ws + WS_ROPE);
            for (int e = tid; e < 64 * 16; e += 256) {
                const int pos = e >> 4, i = e & 15;
                const float invf = powf(10000.0f, -(float)(2 * i) / 32.0f);
                const float angf = (float)pos * invf;
                const double ang = (double)angf;
                const double twopi = 6.283185307179586476925286766559;
                const double n = rint(ang / twopi);
                const double r = ang - n * twopi, r2 = r * r;
                double s = 1.0, c = 1.0;
                for (int q = 14; q >= 1; --q) { s = 1.0 - r2 / (double)((2 * q) * (2 * q + 1)) * s; c = 1.0 - r2 / (double)((2 * q - 1) * (2 * q)) * c; }
                s *= r;
                rope[e] = make_float2((float)c, (float)s);
            }
            continue;
        }
        const int l = it / 24, cb = it % 24;
        __syncthreads();
        for (int e = tid; e < 9 * D; e += 256) {
            const int mb = e / D, k = e % D;
            const float v = mb < 8 ? p.in[I_C][mb * D + k] : p.in[I_CCTX][k];
            sm[e] = silu_f(v);
        }
        __syncthreads();
        const int col = cb * 256 + tid;
        const float* w = p.in[I_WMOD] + (size_t)l * D * 6144 + col;
        float acc[9];
#pragma unroll
        for (int m = 0; m < 9; ++m) acc[m] = 0.f;
#pragma unroll 4
        for (int k = 0; k < D; ++k) {
            const float wv = w[(size_t)k * 6144];
#pragma unroll
            for (int m = 0; m < 9; ++m) acc[m] += sm[m * D + k] * wv;
        }
        const float bias = p.in[I_BMOD][l * 6144 + col];
        float* mv = (float*)(p.ws + WS_MODV);
#pragma unroll
        for (int m = 0; m < 9; ++m) mv[(size_t)(l * 9 + m) * 6144 + col] = acc[m] + bias;
    }
}

__device__ void ph_norm1(const Params& p, int l) {
    const int tid = tid_opaque(), lane = tid & 63, gw = blockIdx.x * 4 + (tid >> 6), ngw = gridDim.x * 4;
    bf16* H = (bf16*)(p.ws + WS_H);
    const float* g = p.in[I_N1G] + l * D;
    for (int r = gw; r < NTOK; r += ngw) {
        const float* x = xrow(p, l, r);
        const int mb = modrow(r);
        const float* sh = modv(p, l, mb, 0); const float* sc = modv(p, l, mb, 1);
        float4 v[4]; float ss = 0.f;
#pragma unroll
        for (int j = 0; j < 4; ++j) { v[j] = *(const float4*)(x + j * 256 + lane * 4); ss += v[j].x * v[j].x + v[j].y * v[j].y + v[j].z * v[j].z + v[j].w * v[j].w; }
        const float inv = rsqrtf(wave_sum(ss) * (1.f / D) + EPS);
#pragma unroll
        for (int j = 0; j < 4; ++j) {
            const int c = j * 256 + lane * 4;
            const float4 gg = *(const float4*)(g + c), s1 = *(const float4*)(sh + c), s2 = *(const float4*)(sc + c);
            st_bf4(H + (size_t)r * D + c, v[j].x * inv * gg.x * (1.f + s2.x) + s1.x, v[j].y * inv * gg.y * (1.f + s2.y) + s1.y,
                   v[j].z * inv * gg.z * (1.f + s2.z) + s1.z, v[j].w * inv * gg.w * (1.f + s2.w) + s1.w);
        }
    }
}

__device__ void ph_gemm_in(const Params& p, int l, unsigned char* lds) {
    const bf16* H = (const bf16*)(p.ws + WS_H);
    bf16* PROJ = (bf16*)(p.ws + WS_PROJ);
    const bf16* WT = wsm_int(p, l);
    const int nN = 47, nM = NTOK / 128;
    const int tid = tid_opaque(), lane = tid & 63, wid = tid >> 6, wr = wid >> 1, wc = wid & 1, fr = lane & 15, fq = lane >> 4;
    for (int it = vblock(); it < nM * nN; it += gridDim.x) {
        int tm, tn; tile_coords(it, nM, nN, tm, tn);
        f32x4 acc[4][4]; zero_acc4(acc);
        gemm_tile(acc, [&](int r) { return H + (size_t)(tm * 128 + r) * D; }, [&](int r) { return WT + (size_t)(tn * 128 + r) * D; }, D, lds, tid);
#pragma unroll
        for (int i = 0; i < 4; ++i)
#pragma unroll
            for (int j = 0; j < 4; ++j) {
                const int row = tm * 128 + wr * 64 + i * 16 + fr, col = tn * 128 + wc * 64 + j * 16 + fq * 4;
                if (col < INW) st_bf4(PROJ + (size_t)row * INW + col, acc[i][j][0], acc[i][j][1], acc[i][j][2], acc[i][j][3]);
            }
    }
}

__device__ void ph_prep(const Params& p, int l, float* smf) {
    const int tid = tid_opaque();
    bf16* PROJ = (bf16*)(p.ws + WS_PROJ);
    const float2* rope = (const float2*)(p.ws + WS_ROPE);
    const long total = (long)NTOK * 10;
    for (long id = (long)blockIdx.x * 256 + tid; id < total; id += (long)gridDim.x * 256) {
        const int r = (int)(id / 10), j = (int)(id % 10);
        const bool isq = j < 8;
        if (l == 1 && r >= NL && isq) continue;
        bf16* ptr = PROJ + (size_t)r * INW + (isq ? O_AQ + j * 64 : O_AK + (j - 8) * 64);
        const float* g = p.in[isq ? I_QNG : I_KNG] + l * 64;
        float v[64]; float ss = 0.f;
#pragma unroll
        for (int q = 0; q < 16; ++q) { float4 t = ld_bf4(ptr + q * 4); v[q * 4] = t.x; v[q * 4 + 1] = t.y; v[q * 4 + 2] = t.z; v[q * 4 + 3] = t.w; }
#pragma unroll
        for (int d = 0; d < 64; ++d) ss += v[d] * v[d];
        const float inv = rsqrtf(ss * (1.f / 64.f) + EPS);
#pragma unroll
        for (int d = 0; d < 64; ++d) v[d] = v[d] * inv * g[d];
        if (r < NL) {
            const int t = r % T, row = t >> 6, col = t & 63;
#pragma unroll
            for (int i = 0; i < 16; ++i) {
                const float2 a = rope[row * 16 + i]; const float x1 = v[i], x2 = v[16 + i];
                v[i] = x1 * a.x - x2 * a.y; v[16 + i] = x1 * a.y + x2 * a.x;
                const float2 b = rope[col * 16 + i]; const float y1 = v[32 + i], y2 = v[48 + i];
                v[32 + i] = y1 * b.x - y2 * b.y; v[48 + i] = y1 * b.y + y2 * b.x;
            }
        }
        const float sc = isq ? 0.125f * 1.4426950408889634f : 1.f;
#pragma unroll
        for (int q = 0; q < 16; ++q) st_bf4(ptr + q * 4, v[q * 4] * sc, v[q * 4 + 1] * sc, v[q * 4 + 2] * sc, v[q * 4 + 3] * sc);
    }
    bf16* DP = (bf16*)(p.ws + WS_R2 + 2 * SZ_Y512);
    const long tot2 = (long)((l == 0) ? NTOK : NL) * 128;
    for (long id = (long)blockIdx.x * 256 + tid; id < tot2; id += (long)gridDim.x * 256) {
        const int r = (int)(id >> 7), ch = (int)(id & 127) * 4, g = ch >> 7, hw = 1 << g;
        int t, base, tl;
        if (r < NL) { t = r % T; base = r - t; tl = T; } else { t = (r - NL) % CL; base = r - t; tl = CL; }
        const int lo = max(t - hw, 0), hi = min(t + hw, tl);
        float4 sacc = make_float4(0.f, 0.f, 0.f, 0.f);
        for (int u = lo; u < hi; ++u) { const float4 v = ld_bf4(PROJ + (size_t)(base + u) * INW + O_PU + ch); sacc.x += v.x; sacc.y += v.y; sacc.z += v.z; sacc.w += v.w; }
        const float inv = 1.f / (float)(hi - lo);
        const float4 c = ld_bf4(PROJ + (size_t)r * INW + O_PU + ch);
        st_bf4(DP + (size_t)r * 512 + ch, sacc.x * inv - c.x, sacc.y * inv - c.y, sacc.z * inv - c.z, sacc.w * inv - c.w);
    }
    {
        bf16* VT = (bf16*)(p.ws + WS_VT);
        unsigned short* st = (unsigned short*)smf;
        for (int it = blockIdx.x; it < (NTOK / 64) * 2; it += gridDim.x) {
            const int rt = it >> 1, kvh = it & 1;
            int b, key0;
            if (rt < NL / 64) { b = rt / 64; key0 = (rt % 64) * 64; } else { const int j = rt - NL / 64; b = j / 4; key0 = T + (j % 4) * 64; }
            __syncthreads();
            {
                const int k = tid >> 2, dq = (tid & 3) * 16;
                const bf16* src = PROJ + (size_t)(rt * 64 + k) * INW + O_AV + kvh * 64 + dq;
                const uint4 a = *(const uint4*)src, c = *(const uint4*)(src + 8);
                unsigned* d = (unsigned*)(st + k * 66 + dq);
                d[0] = a.x; d[1] = a.y; d[2] = a.z; d[3] = a.w; d[4] = c.x; d[5] = c.y; d[6] = c.z; d[7] = c.w;
            }
            __syncthreads();
            {
                const int d = tid >> 2, kq = (tid & 3) * 16;
                unsigned w[8];
#pragma unroll
                for (int i = 0; i < 8; ++i) w[i] = (unsigned)st[(kq + 2 * i) * 66 + d] | ((unsigned)st[(kq + 2 * i + 1) * 66 + d] << 16);
                bf16* dst = VT + ((size_t)(b * 2 + kvh) * 64 + d) * NKEY + key0 + kq;
                *(uint4*)dst = make_uint4(w[0], w[1], w[2], w[3]);
                *(uint4*)(dst + 8) = make_uint4(w[4], w[5], w[6], w[7]);
            }
        }
    }
}

typedef float f32x16 __attribute__((ext_vector_type(16)));
typedef short s16x4 __attribute__((ext_vector_type(4)));
#define MFMA32(a, b, c) __builtin_amdgcn_mfma_f32_32x32x16_bf16((a), (b), (c), 0, 0, 0)
__device__ __forceinline__ bf16x8 pack8(const f32x16& x, int s) {
    typedef unsigned u32x4_t __attribute__((ext_vector_type(4)));
    u32x4_t r;
    r[0] = pk_bf16(x[8 * s + 0], x[8 * s + 1]); r[1] = pk_bf16(x[8 * s + 2], x[8 * s + 3]);
    r[2] = pk_bf16(x[8 * s + 4], x[8 * s + 5]); r[3] = pk_bf16(x[8 * s + 6], x[8 * s + 7]);
    return __builtin_bit_cast(bf16x8, r);
}
__device__ void ph_attn(const Params& p, int l, unsigned char* lds) {
    const int tid = tid_opaque(), lane = tid & 63, wid = tid >> 6, r32 = lane & 31, h = lane >> 5;
    bf16* PROJ = (bf16*)(p.ws + WS_PROJ);
    const bf16* VT = (const bf16*)(p.ws + WS_VT);
    float mq = 0.f, mk = 0.f;
    for (int d = 0; d < 64; ++d) { mq = fmaxf(mq, fabsf(p.in[I_QNG][l * 64 + d])); mk = fmaxf(mk, fabsf(p.in[I_KNG][l * 64 + d])); }
    const float shift2 = 8.f * mq * mk * 1.4426950408889634f;
    const int srow = tid >> 3, sc = ((tid & 7) ^ ((tid >> 4) & 7)) * 8, sw = (r32 >> 1) & 7;
    const int nlat = NB * 8 * 16, nctx = (l == 0) ? NB * 8 : 0;
    for (int it = blockIdx.x; it < nlat + nctx; it += gridDim.x) {
        int b, head, qrow0, nkt, vkey0;
        const bool lat = it < nlat;
        if (lat) { b = it >> 7; head = (it >> 4) & 7; qrow0 = b * T + (it & 15) * 256; nkt = 68; vkey0 = 0; }
        else { const int j = it - nlat; b = j >> 3; head = j & 7; qrow0 = NL + b * CL; nkt = 4; vkey0 = T; }
        const int kvh = head >> 2;
        bf16x8 qf[2][4];
#pragma unroll
        for (int qb = 0; qb < 2; ++qb)
#pragma unroll
            for (int ks = 0; ks < 4; ++ks)
                qf[qb][ks] = *(const bf16x8*)(PROJ + (size_t)(qrow0 + wid * 64 + qb * 32 + r32) * INW + O_AQ + head * 64 + ks * 16 + h * 8);
        const bf16* vsrc[2];
#pragma unroll
        for (int j = 0; j < 2; ++j) vsrc[j] = VT + ((size_t)(b * 2 + kvh) * 64 + j * 32 + srow) * NKEY + vkey0 + sc;
        const bf16* kbase = PROJ + O_AK + kvh * 64 + sc;
        auto krow = [&](int kt, int r) { return lat ? (kt < 64 ? b * T + kt * 64 + r : NL + b * CL + (kt - 64) * 64 + r) : NL + b * CL + kt * 64 + r; };
        auto stage = [&](int kt, int buf) {
            unsigned char* base = lds + buf * 16384;
#pragma unroll
            for (int j = 0; j < 2; ++j) {
                __builtin_amdgcn_global_load_lds((const unsigned*)(kbase + (size_t)krow(kt, j * 32 + srow) * INW), (unsigned*)(base + j * 4096 + tid * 16), 16, 0, 0);
                __builtin_amdgcn_global_load_lds((const unsigned*)(vsrc[j] + kt * 64), (unsigned*)(base + 8192 + j * 4096 + tid * 16), 16, 0, 0);
            }
        };
        f32x16 o[2][2];
#pragma unroll
        for (int a = 0; a < 2; ++a)
#pragma unroll
            for (int c = 0; c < 2; ++c)
#pragma unroll
                for (int e = 0; e < 16; ++e) o[a][c][e] = 0.f;
        float l0 = 0.f, l1 = 0.f;
        stage(0, 0);
#pragma unroll 1
        for (int kt = 0; kt < nkt; ++kt) {
            asm volatile("s_waitcnt vmcnt(0)" ::: "memory");
            __syncthreads();
            if (kt + 1 < nkt) stage(kt + 1, (kt + 1) & 1);
            const unsigned char* kb_ = lds + (kt & 1) * 16384;
            const unsigned char* vb_ = kb_ + 8192;
#pragma unroll
            for (int kb = 0; kb < 2; ++kb) {
                f32x16 s0, s1;
#pragma unroll
                for (int e = 0; e < 16; ++e) { s0[e] = 0.f; s1[e] = 0.f; }
#pragma unroll
                for (int ks = 0; ks < 4; ++ks) {
                    const bf16x8 kf = *(const bf16x8*)(kb_ + (kb * 32 + r32) * 128 + (((2 * ks + h) ^ sw) * 16));
                    s0 = MFMA32(kf, qf[0][ks], s0);
                    s1 = MFMA32(kf, qf[1][ks], s1);
                }
#pragma unroll
                for (int e = 0; e < 16; ++e) {
                    s0[e] = __builtin_amdgcn_exp2f(s0[e] - shift2); l0 += s0[e];
                    s1[e] = __builtin_amdgcn_exp2f(s1[e] - shift2); l1 += s1[e];
                }
#pragma unroll
                for (int s2 = 0; s2 < 2; ++s2) {
                    const bf16x8 p0 = pack8(s0, s2), p1 = pack8(s1, s2);
                    const int ksv = kb * 2 + s2;
#pragma unroll
                    for (int db = 0; db < 2; ++db) {
                        const unsigned char* vr = vb_ + (db * 32 + r32) * 128 + 8 * h;
                        const s16x4 lo = *(const s16x4*)(vr + (((2 * ksv) ^ sw) * 16));
                        const s16x4 hi = *(const s16x4*)(vr + (((2 * ksv + 1) ^ sw) * 16));
                        const bf16x8 vf = __builtin_shufflevector(lo, hi, 0, 1, 2, 3, 4, 5, 6, 7);
                        o[db][0] = MFMA32(vf, p0, o[db][0]);
                        o[db][1] = MFMA32(vf, p1, o[db][1]);
                    }
                }
            }
        }
        l0 += __shfl_xor(l0, 32); l1 += __shfl_xor(l1, 32);
        const float i0 = 1.f / l0, i1 = 1.f / l1;
#pragma unroll
        for (int qb = 0; qb < 2; ++qb) {
            const float inv = qb ? i1 : i0;
            bf16* orow = PROJ + (size_t)(qrow0 + wid * 64 + qb * 32 + r32) * INW + O_AQ + head * 64;
#pragma unroll
            for (int db = 0; db < 2; ++db)
#pragma unroll
                for (int g = 0; g < 4; ++g)
                    st_bf4(orow + db * 32 + 8 * g + 4 * h, o[db][qb][4 * g] * inv, o[db][qb][4 * g + 1] * inv, o[db][qb][4 * g + 2] * inv, o[db][qb][4 * g + 3] * inv);
        }
    }
}

__device__ void ph_gla(const Params& p, int l, float* sm) {
    constexpr int DVS = 32;
    float* sB = sm;
    float* sQ = sB + 4096;
    float* sK = sQ + 4096;
    float* sV = sK + 4096;
    float* sS = sV + 64 * DVS;
    float* sP = sS + 64 * DVS;
    const bf16* PROJ = (const bf16*)(p.ws + WS_PROJ);
    const int tid = tid_opaque(), ti = tid >> 2, part = tid & 3;
    for (int it = blockIdx.x; it < NB * 4 * 2 * 4; it += gridDim.x) {
        const int b = it >> 5, h = (it >> 3) & 3, dir = (it >> 2) & 1, sl = it & 3;
        bf16* OG = (bf16*)(p.ws + WS_R2 + (size_t)dir * SZ_Y512);
        const float* up = p.in[dir ? I_UPB : I_UPF] + (size_t)l * 16 * 256;
        const float* bias = p.in[dir ? I_BIASB : I_BIASF] + l * 256;
        const int ogl = dir ? O_GLB : O_GLF;
        __syncthreads();
        for (int e = tid; e < 64 * DVS; e += 256) sS[e] = 0.f;
        for (int n = 0; n < 68; ++n) {
            int base;
            if (n < 4) base = NL + b * CL + (dir ? 3 - n : n) * 64;
            else base = b * T + (dir ? 63 - (n - 4) : (n - 4)) * 64;
            const int tok = dir ? base + 63 - ti : base + ti;
            const bf16* prow = PROJ + (size_t)tok * INW;
            __syncthreads();
            {
                float g[16];
#pragma unroll
                for (int q = 0; q < 4; ++q) { float4 t = ld_bf4(prow + ogl + q * 4); g[q * 4] = t.x; g[q * 4 + 1] = t.y; g[q * 4 + 2] = t.z; g[q * 4 + 3] = t.w; }
#pragma unroll 4
                for (int dd = 0; dd < 16; ++dd) {
                    const int dk = part * 16 + dd, col = h * 64 + dk;
                    float a = bias[col];
#pragma unroll
                    for (int j = 0; j < 16; ++j) a += g[j] * up[j * 256 + col];
                    const float ls = fminf(a, 0.f) - log1pf(__expf(-fabsf(a)));
                    sB[ti * 64 + dk] = ls * (1.f / 16.f);
                }
            }
            __syncthreads();
            if (tid < 64) { float run = 0.f; for (int i = 0; i < 64; ++i) { run += sB[i * 64 + tid]; sB[i * 64 + tid] = run; } }
            __syncthreads();
            {
#pragma unroll
                for (int q = 0; q < 4; ++q) {
                    const int dk = part * 16 + q * 4;
                    float4 qq = ld_bf4(prow + O_GQ + h * 64 + dk), kk = ld_bf4(prow + O_GK + h * 64 + dk);
                    const float qa[4] = {qq.x, qq.y, qq.z, qq.w}, ka[4] = {kk.x, kk.y, kk.z, kk.w};
#pragma unroll
                    for (int e = 0; e < 4; ++e) {
                        const float bi = sB[ti * 64 + dk + e], br = sB[32 * 64 + dk + e];
                        sQ[ti * 64 + dk + e] = qa[e] * 0.125f * __expf(bi - br);
                        sK[ti * 64 + dk + e] = ka[e] * __expf(br - bi);
                    }
                }
#pragma unroll
                for (int q = 0; q < DVS / 16; ++q) {
                    const int dv = part * (DVS / 4) + q * 4;
                    float4 vv = ld_bf4(prow + O_GV + h * 128 + sl * DVS + dv);
                    *(float4*)&sV[ti * DVS + dv] = vv;
                }
            }
            __syncthreads();
            {
#pragma unroll 4
                for (int ss = 0; ss < 16; ++ss) {
                    const int s = part * 16 + ss;
                    float a = 0.f;
                    if (s <= ti) { for (int dk = 0; dk < 64; ++dk) a += sQ[ti * 64 + dk] * sK[s * 64 + dk]; }
                    sP[ti * 64 + s] = a;
                }
            }
            __syncthreads();
            {
                float o[DVS / 4];
#pragma unroll
                for (int e = 0; e < DVS / 4; ++e) o[e] = 0.f;
                for (int s = 0; s <= ti; ++s) {
                    const float pp = sP[ti * 64 + s];
#pragma unroll
                    for (int e = 0; e < DVS / 4; ++e) o[e] += pp * sV[s * DVS + part * (DVS / 4) + e];
                }
                for (int dk = 0; dk < 64; ++dk) {
                    const float qq = sQ[ti * 64 + dk] * __expf(sB[32 * 64 + dk]);
#pragma unroll
                    for (int e = 0; e < DVS / 4; ++e) o[e] += qq * sS[dk * DVS + part * (DVS / 4) + e];
                }
                bf16* dst = OG + (size_t)tok * 512 + h * 128 + sl * DVS + part * (DVS / 4);
#pragma unroll
                for (int e = 0; e < DVS / 4; e += 4) st_bf4(dst + e, o[e], o[e + 1], o[e + 2], o[e + 3]);
            }
            __syncthreads();
            {
                const int dk = ti;
                const float bl = sB[63 * 64 + dk], br = sB[32 * 64 + dk];
                const float al = __expf(bl), ar = __expf(bl - br);
                float acc[DVS / 4];
#pragma unroll
                for (int e = 0; e < DVS / 4; ++e) acc[e] = 0.f;
                for (int s = 0; s < 64; ++s) {
                    const float kk = sK[s * 64 + dk];
#pragma unroll
                    for (int e = 0; e < DVS / 4; ++e) acc[e] += kk * sV[s * DVS + part * (DVS / 4) + e];
                }
#pragma unroll
                for (int e = 0; e < DVS / 4; ++e) { const int ix = dk * DVS + part * (DVS / 4) + e; sS[ix] = al * sS[ix] + ar * acc[e]; }
            }
        }
    }
}

__device__ void ph_ygla(const Params& p, int l) {
    const int tid = tid_opaque(), lane = tid & 63, gw = blockIdx.x * 4 + (tid >> 6), ngw = gridDim.x * 4;
    bf16* O0 = (bf16*)(p.ws + WS_R2);
    const bf16* O1 = (const bf16*)(p.ws + WS_R2 + SZ_Y512);
    const bf16* PROJ = (const bf16*)(p.ws + WS_PROJ);
    const float* g = p.in[I_GLANG] + l * 128;
    const int nrows = (l == 0) ? NTOK : NL;
    for (int r = gw; r < nrows; r += ngw) {
        const int c = lane * 8;
        float v[8];
        { float4 a = ld_bf4(O0 + (size_t)r * 512 + c), b2 = ld_bf4(O0 + (size_t)r * 512 + c + 4), d = ld_bf4(O1 + (size_t)r * 512 + c), e = ld_bf4(O1 + (size_t)r * 512 + c + 4);
          v[0] = a.x + d.x; v[1] = a.y + d.y; v[2] = a.z + d.z; v[3] = a.w + d.w; v[4] = b2.x + e.x; v[5] = b2.y + e.y; v[6] = b2.z + e.z; v[7] = b2.w + e.w; }
        float ss = 0.f;
#pragma unroll
        for (int e = 0; e < 8; ++e) ss += v[e] * v[e];
        ss += __shfl_xor(ss, 1); ss += __shfl_xor(ss, 2); ss += __shfl_xor(ss, 4); ss += __shfl_xor(ss, 8);
        const float inv = rsqrtf(ss * (1.f / 128.f) + EPS);
        float4 r0 = ld_bf4(PROJ + (size_t)r * INW + O_GR + c), r1 = ld_bf4(PROJ + (size_t)r * INW + O_GR + c + 4);
        const float gr[8] = {r0.x, r0.y, r0.z, r0.w, r1.x, r1.y, r1.z, r1.w};
        float o[8];
#pragma unroll
        for (int e = 0; e < 8; ++e) o[e] = v[e] * inv * g[(c + e) & 127] * silu_f(gr[e]);
        st_bf4(O0 + (size_t)r * 512 + c, o[0], o[1], o[2], o[3]);
        st_bf4(O0 + (size_t)r * 512 + c + 4, o[4], o[5], o[6], o[7]);
    }
}

__device__ void ph_merge(const Params& p, int l, unsigned char* lds) {
    const bf16* PROJ = (const bf16*)(p.ws + WS_PROJ);
    const bf16* YG = (const bf16*)(p.ws + WS_R2);
    const bf16* DP = (const bf16*)(p.ws + WS_R2 + 2 * SZ_Y512);
    bf16* Z = (bf16*)(p.ws + WS_H);
    const int nrows = (l == 0) ? NTOK : NL, nM = nrows / 128, nN = 8;
    const int tid = tid_opaque(), lane = tid & 63, wid = tid >> 6, wr = wid >> 1, wc = wid & 1, fr = lane & 15, fq = lane >> 4;
    for (int it = vblock(); it < nM * nN; it += gridDim.x) {
        int tm, tn; tile_coords(it, nM, nN, tm, tn);
        f32x4 tot[4][4]; zero_acc4(tot);
#pragma unroll 1
        for (int br = 0; br < 3; ++br) {
            const bf16* WT = wsm_bt(p, l, br);
            const bf16* Ab = br == 0 ? YG : (br == 1 ? PROJ + O_AQ : DP);
            const size_t lda = br == 1 ? (size_t)INW : (size_t)512;
            f32x4 acc[4][4]; zero_acc4(acc);
            gemm_tile(acc, [&](int r) { return Ab + (size_t)(tm * 128 + r) * lda; }, [&](int r) { return WT + (size_t)(tn * 128 + r) * 512; }, 512, lds, tid);
#pragma unroll
            for (int i = 0; i < 4; ++i)
#pragma unroll
                for (int j = 0; j < 4; ++j) {
                    const int row = tm * 128 + wr * 64 + i * 16 + fr, col = tn * 128 + wc * 64 + j * 16 + fq * 4;
                    const float4 gt = ld_bf4(PROJ + (size_t)row * INW + O_GT + br * D + col);
                    tot[i][j][0] += sigmoid_f(gt.x) * acc[i][j][0]; tot[i][j][1] += sigmoid_f(gt.y) * acc[i][j][1];
                    tot[i][j][2] += sigmoid_f(gt.z) * acc[i][j][2]; tot[i][j][3] += sigmoid_f(gt.w) * acc[i][j][3];
                }
        }
#pragma unroll
        for (int i = 0; i < 4; ++i)
#pragma unroll
            for (int j = 0; j < 4; ++j) {
                const int row = tm * 128 + wr * 64 + i * 16 + fr, col = tn * 128 + wc * 64 + j * 16 + fq * 4;
                st_bf4(Z + (size_t)row * D + col, tot[i][j][0], tot[i][j][1], tot[i][j][2], tot[i][j][3]);
            }
    }
}

__device__ void ph_outproj(const Params& p, int l, unsigned char* lds) {
    const bf16* Z = (const bf16*)(p.ws + WS_H);
    const bf16* WT = wsm_outt(p, l);
    const int nrows = (l == 0) ? NTOK : NL, nM = nrows / 128, nN = 8;
    const int tid = tid_opaque(), lane = tid & 63, wid = tid >> 6, wr = wid >> 1, wc = wid & 1, fr = lane & 15, fq = lane >> 4;
    for (int it = vblock(); it < nM * nN; it += gridDim.x) {
        int tm, tn; tile_coords(it, nM, nN, tm, tn);
        f32x4 acc[4][4]; zero_acc4(acc);
        gemm_tile(acc, [&](int r) { return Z + (size_t)(tm * 128 + r) * D; }, [&](int r) { return WT + (size_t)(tn * 128 + r) * D; }, D, lds, tid);
#pragma unroll
        for (int i = 0; i < 4; ++i) {
            const int r = tm * 128 + wr * 64 + i * 16 + fr;
            const float* xr = xrow(p, l, r);
            const float* g1 = modv(p, l, modrow(r), 2);
            float* dr = r < NL ? p.out + (size_t)r * D : (float*)(p.ws + WS_XC) + (size_t)(r - NL) * D;
#pragma unroll
            for (int j = 0; j < 4; ++j) {
                const int c = tn * 128 + wc * 64 + j * 16 + fq * 4;
                const float4 xo = *(const float4*)(xr + c), gg = *(const float4*)(g1 + c);
                *(float4*)(dr + c) = make_float4(xo.x + gg.x * acc[i][j][0], xo.y + gg.y * acc[i][j][1], xo.z + gg.z * acc[i][j][2], xo.w + gg.w * acc[i][j][3]);
            }
        }
    }
}

__device__ __forceinline__ const float* x1row(const Params& p, int r) {
    return r < NL ? p.out + (size_t)r * D : (const float*)(p.ws + WS_XC) + (size_t)(r - NL) * D;
}
__device__ void ph_router(const Params& p, int l) {
    const int tid = tid_opaque(), lane = tid & 63, gw = blockIdx.x * 4 + (tid >> 6), ngw = gridDim.x * 4;
    bf16* H = (bf16*)(p.ws + WS_H);
    const float* g = p.in[I_N2G] + l * D;
    const float* wg = p.in[I_WGRP] + (size_t)l * D * 4;
    const float* we = p.in[I_WEXP] + (size_t)l * D * 32;
    unsigned* cnt = (unsigned*)(p.ws + WS_CTL) + l * 32;
    int* list = (int*)(p.ws + WS_LIST);
    float* wt = (float*)(p.ws + WS_WT);
    const int nrows = (l == 0) ? NTOK : NL;
    for (int r = gw; r < nrows; r += ngw) {
        const float* x = x1row(p, r);
        const int mb = modrow(r);
        const float* sh = modv(p, l, mb, 3); const float* sc = modv(p, l, mb, 4);
        float4 v[4]; float ss = 0.f;
#pragma unroll
        for (int j = 0; j < 4; ++j) { v[j] = *(const float4*)(x + j * 256 + lane * 4); ss += v[j].x * v[j].x + v[j].y * v[j].y + v[j].z * v[j].z + v[j].w * v[j].w; }
        const float inv = rsqrtf(wave_sum(ss) * (1.f / D) + EPS);
        float hv[16];
#pragma unroll
        for (int j = 0; j < 4; ++j) {
            const int c = j * 256 + lane * 4;
            const float4 gg = *(const float4*)(g + c), s1 = *(const float4*)(sh + c), s2 = *(const float4*)(sc + c);
            hv[j * 4 + 0] = v[j].x * inv * gg.x * (1.f + s2.x) + s1.x; hv[j * 4 + 1] = v[j].y * inv * gg.y * (1.f + s2.y) + s1.y;
            hv[j * 4 + 2] = v[j].z * inv * gg.z * (1.f + s2.z) + s1.z; hv[j * 4 + 3] = v[j].w * inv * gg.w * (1.f + s2.w) + s1.w;
            st_bf4(H + (size_t)r * D + c, hv[j * 4], hv[j * 4 + 1], hv[j * 4 + 2], hv[j * 4 + 3]);
        }
        float lg[4];
#pragma unroll
        for (int o = 0; o < 4; ++o) {
            float a = 0.f;
#pragma unroll
            for (int j = 0; j < 4; ++j)
#pragma unroll
                for (int e = 0; e < 4; ++e) a += hv[j * 4 + e] * wg[(size_t)(j * 256 + lane * 4 + e) * 4 + o];
            lg[o] = wave_sum(a) + p.in[I_BGRP][l * 4 + o];
        }
        int grp = 0; float gmax = lg[0];
#pragma unroll
        for (int o = 1; o < 4; ++o) if (lg[o] > gmax) { gmax = lg[o]; grp = o; }
        float gden = 0.f;
#pragma unroll
        for (int o = 0; o < 4; ++o) gden += __expf(lg[o] - gmax);
        const float ptg = 1.f / gden;
        float le[8];
#pragma unroll
        for (int o = 0; o < 8; ++o) {
            float a = 0.f;
            const int col = grp * 8 + o;
#pragma unroll
            for (int j = 0; j < 4; ++j)
#pragma unroll
                for (int e = 0; e < 4; ++e) a += hv[j * 4 + e] * we[(size_t)(j * 256 + lane * 4 + e) * 32 + col];
            le[o] = wave_sum(a) + p.in[I_BEXP][l * 32 + col];
        }
        int i1 = 0; float m1 = le[0];
#pragma unroll
        for (int o = 1; o < 8; ++o) if (le[o] > m1) { m1 = le[o]; i1 = o; }
        int i2 = -1; float m2 = -3.0e38f;
#pragma unroll
        for (int o = 0; o < 8; ++o) if (o != i1 && le[o] > m2) { m2 = le[o]; i2 = o; }
        const float e2 = __expf(m2 - m1);
        const float w1 = ptg / (1.f + e2), w2 = ptg * e2 / (1.f + e2);
        if (lane == 0) {
            const int ea = grp * 8 + i1, eb = grp * 8 + i2;
            const unsigned pa = atomicAdd(&cnt[ea], 1u); list[(size_t)ea * NTOK + pa] = r * 2;
            const unsigned pb = atomicAdd(&cnt[eb], 1u); list[(size_t)eb * NTOK + pb] = r * 2 + 1;
            wt[r * 2] = w1; wt[r * 2 + 1] = w2;
        }
    }
}

__device__ void ph_convmoe(const Params& p, int l, float* sm) {
    const int tid = tid_opaque();
    bf16* WGU = (bf16*)(p.ws + WS_WGU);
    bf16* WDT = (bf16*)(p.ws + WS_WDT);
    for (int it = blockIdx.x; it < 32 * 384; it += gridDim.x) {
        const int e = it / 384, r = it % 384, kind = r >> 7, q = r & 127;
        if (kind == 0)
            conv_tile(p.in[I_WGATE] + ((size_t)(l * 32 + e) * D) * 512, 512, 512, (q >> 3) * 64, (q & 7) * 64, WGU + (size_t)e * D * D, D,
                      [](int n) { return 32 * (n >> 4) + (n & 15); }, sm, tid);
        else if (kind == 1)
            conv_tile(p.in[I_WUP] + ((size_t)(l * 32 + e) * D) * 512, 512, 512, (q >> 3) * 64, (q & 7) * 64, WGU + (size_t)e * D * D, D,
                      [](int n) { return 32 * (n >> 4) + 16 + (n & 15); }, sm, tid);
        else
            conv_tile(p.in[I_WDOWN] + ((size_t)(l * 32 + e) * 512) * D, D, D, (q >> 4) * 64, (q & 15) * 64, WDT + (size_t)e * D * 512, 512,
                      [](int n) { return n; }, sm, tid);
    }
}

__device__ __forceinline__ void moe_tile_lookup(const unsigned* cnt, int trow, int& e, int& i0, int& ce) {
    int start = 0; e = 0; i0 = 0; ce = 0;
#pragma unroll 1
    for (int q = 0; q < 32; ++q) {
        const int c = (int)cnt[q], nt = (c + 127) >> 7;
        if (trow >= start && trow < start + nt) { e = q; i0 = (trow - start) * 128; ce = c; }
        start += nt;
    }
}
__device__ __forceinline__ int moe_ntiles(const unsigned* cnt) {
    int n = 0;
#pragma unroll 1
    for (int q = 0; q < 32; ++q) n += ((int)cnt[q] + 127) >> 7;
    return n;
}

__device__ void ph_moe1(const Params& p, int l, unsigned char* lds) {
    const bf16* H = (const bf16*)(p.ws + WS_H);
    bf16* ACT = (bf16*)(p.ws + WS_ACT);
    const bf16* WGU = (const bf16*)(p.ws + WS_WGU);
    const unsigned* cnt = (const unsigned*)(p.ws + WS_CTL) + l * 32;
    const int* list = (const int*)(p.ws + WS_LIST);
    const int tid = tid_opaque(), lane = tid & 63, wid = tid >> 6, wr = wid >> 1, wc = wid & 1, fr = lane & 15, fq = lane >> 4;
    const int ntiles = moe_ntiles(cnt);
    for (int it = vblock(); it < ntiles * 8; it += gridDim.x) {
        const int trow = it >> 3, tn = it & 7;
        int e, i0, ce; moe_tile_lookup(cnt, trow, e, i0, ce);
        const int* le = list + (size_t)e * NTOK;
        const bf16* WT = WGU + (size_t)e * D * D;
        f32x4 acc[4][4]; zero_acc4(acc);
        gemm_tile(acc, [&](int r) { const int ii = min(i0 + r, ce - 1); return H + (size_t)(le[ii] >> 1) * D; },
                  [&](int r) { return WT + (size_t)(tn * 128 + r) * D; }, D, lds, tid);
#pragma unroll
        for (int i = 0; i < 4; ++i) {
            const int ii = i0 + wr * 64 + i * 16 + fr;
            if (ii < ce) {
                const int asg = le[ii];
#pragma unroll
                for (int jp = 0; jp < 2; ++jp) {
                    const f32x4 g = acc[i][2 * jp], u = acc[i][2 * jp + 1];
                    st_bf4(ACT + (size_t)asg * 512 + tn * 64 + wc * 32 + jp * 16 + fq * 4, silu_f(g[0]) * u[0], silu_f(g[1]) * u[1], silu_f(g[2]) * u[2], silu_f(g[3]) * u[3]);
                }
            }
        }
    }
}

__device__ void ph_moe2(const Params& p, int l, unsigned char* lds) {
    const bf16* ACT = (const bf16*)(p.ws + WS_ACT);
    const bf16* WDT = (const bf16*)(p.ws + WS_WDT);
    const unsigned* cnt = (const unsigned*)(p.ws + WS_CTL) + l * 32;
    const int* list = (const int*)(p.ws + WS_LIST);
    const float* wt = (const float*)(p.ws + WS_WT);
    const int tid = tid_opaque(), lane = tid & 63, wid = tid >> 6, wr = wid >> 1, wc = wid & 1, fr = lane & 15, fq = lane >> 4;
    const int ntiles = moe_ntiles(cnt);
    for (int it = vblock(); it < ntiles * 8; it += gridDim.x) {
        const int trow = it >> 3, tn = it & 7;
        int e, i0, ce; moe_tile_lookup(cnt, trow, e, i0, ce);
        const int* le = list + (size_t)e * NTOK;
        const bf16* WT = WDT + (size_t)e * D * 512;
        f32x4 acc[4][4]; zero_acc4(acc);
        gemm_tile(acc, [&](int r) { const int ii = min(i0 + r, ce - 1); return ACT + (size_t)le[ii] * 512; },
                  [&](int r) { return WT + (size_t)(tn * 128 + r) * 512; }, 512, lds, tid);
#pragma unroll
        for (int i = 0; i < 4; ++i) {
            const int ii = i0 + wr * 64 + i * 16 + fr;
            if (ii < ce) {
                const int asg = le[ii], tok = asg >> 1;
                const float w = wt[asg];
                bf16* Y = (bf16*)(p.ws + ((asg & 1) ? WS_Y1 : WS_Y0));
#pragma unroll
                for (int j = 0; j < 4; ++j)
                    st_bf4(Y + (size_t)tok * D + tn * 128 + wc * 64 + j * 16 + fq * 4, w * acc[i][j][0], w * acc[i][j][1], w * acc[i][j][2], w * acc[i][j][3]);
            }
        }
    }
}

__device__ void ph_combine(const Params& p, int l) {
    const int tid = tid_opaque(), lane = tid & 63, gw = blockIdx.x * 4 + (tid >> 6), ngw = gridDim.x * 4;
    const bf16* Y0 = (const bf16*)(p.ws + WS_Y0);
    const bf16* Y1 = (const bf16*)(p.ws + WS_Y1);
    const int nrows = (l == 0) ? NTOK : NL;
    for (int r = gw; r < nrows; r += ngw) {
        const float* x = x1row(p, r);
        float* xo = r < NL ? p.out + (size_t)r * D : (float*)(p.ws + WS_XC) + (size_t)(r - NL) * D;
        const float* g2 = modv(p, l, modrow(r), 5);
        float4 v[4]; float ss = 0.f;
#pragma unroll
        for (int j = 0; j < 4; ++j) {
            const int c = j * 256 + lane * 4;
            const float4 xv = *(const float4*)(x + c), gg = *(const float4*)(g2 + c);
            const float4 a = ld_bf4(Y0 + (size_t)r * D + c), b = ld_bf4(Y1 + (size_t)r * D + c);
            v[j] = make_float4(xv.x + gg.x * (a.x + b.x), xv.y + gg.y * (a.y + b.y), xv.z + gg.z * (a.z + b.z), xv.w + gg.w * (a.w + b.w));
            ss += v[j].x * v[j].x + v[j].y * v[j].y + v[j].z * v[j].z + v[j].w * v[j].w;
        }
        if (l == 0) {
#pragma unroll
            for (int j = 0; j < 4; ++j) *(float4*)(xo + j * 256 + lane * 4) = v[j];
        } else {
            const float inv = rsqrtf(wave_sum(ss) * (1.f / D) + EPS);
            const float* fg = p.in[I_FING];
#pragma unroll
            for (int j = 0; j < 4; ++j) {
                const int c = j * 256 + lane * 4;
                const float4 gg = *(const float4*)(fg + c);
                *(float4*)(xo + c) = make_float4(v[j].x * inv * gg.x, v[j].y * inv * gg.y, v[j].z * inv * gg.z, v[j].w * inv * gg.w);
            }
        }
    }
}

#define XB_TMO      128
#define XB_XCNT(j)  (256  + 64 * (j))
#define XB_XSUB(j)  (1280 + 64 * (j))
#define XB_XGEN(j)  (2304 + 64 * (j))
#define XB_TOP      3328
#define XB_TOPGEN   3392
#define XB_SPIN_CAP (1u << 22)
constexpr int CW_BAR = 4096;
__device__ __forceinline__ unsigned xb_ld(unsigned* p)              { return __hip_atomic_load(p, __ATOMIC_RELAXED, __HIP_MEMORY_SCOPE_AGENT); }
__device__ __forceinline__ unsigned xb_add(unsigned* p, unsigned v) { return __hip_atomic_fetch_add(p, v, __ATOMIC_RELAXED, __HIP_MEMORY_SCOPE_AGENT); }
__device__ __forceinline__ unsigned xb_xcc_id() { return (unsigned)__builtin_amdgcn_s_getreg((3 << 11) | 20) & 0xFu; }
#define XB_SPIN(cond, bar) do { unsigned _sp = 0; while (cond) { __builtin_amdgcn_s_sleep(1); \
    if ((++_sp & 255u) == 0u) { if (xb_ld(&(bar)[XB_TMO])) break; if (_sp > XB_SPIN_CAP) { atomicAdd(&(bar)[XB_TMO], 1u); break; } } } } while (0)
struct XcdBarrier { unsigned* bar; unsigned x, nloc, nx; };
__device__ __forceinline__ void xcd_barrier_post(XcdBarrier& b, unsigned* bar) {
    b.bar = bar; b.x = xb_xcc_id(); b.nloc = 1; b.nx = 1;
    if (threadIdx.x == 0) (void)xb_add(&bar[XB_XCNT(b.x)], 1u);
}
__device__ __forceinline__ void xcd_barrier_census(XcdBarrier& b) {
    unsigned cnt = 0, mine = 0;
#pragma unroll
    for (unsigned j = 0; j < 16; ++j) { const unsigned c = xb_ld(&b.bar[XB_XCNT(j)]); cnt += (c > 0u) ? 1u : 0u; mine = (j == b.x) ? c : mine; }
    b.nloc = mine > 0u ? mine : 1u; b.nx = cnt > 0u ? cnt : 1u;
}
__device__ __forceinline__ void xcd_barrier(const XcdBarrier& b) {
    asm volatile("s_waitcnt vmcnt(0)" ::: "memory");
    __syncthreads();
    if (threadIdx.x == 0) {
        unsigned* bar = b.bar;
        __builtin_amdgcn_s_waitcnt(0);
        const unsigned nloc = b.nloc, nx = b.nx;
        const unsigned old = xb_add(&bar[XB_XSUB(b.x)], 1u);
        const unsigned gen = old / nloc;
        if (old + 1u == (gen + 1u) * nloc) {
            __builtin_amdgcn_fence(__ATOMIC_RELEASE, "agent");
            asm volatile("s_waitcnt vmcnt(0)" ::: "memory");
            const unsigned og = xb_add(&bar[XB_TOP], 1u);
            const unsigned tg = og / nx;
            if (og + 1u == (tg + 1u) * nx) xb_add(&bar[XB_TOPGEN], 1u);
            else XB_SPIN(xb_ld(&bar[XB_TOPGEN]) == tg, bar);
            __builtin_amdgcn_fence(__ATOMIC_ACQUIRE, "agent");
            xb_add(&bar[XB_XGEN(b.x)], 1u);
            asm volatile("s_waitcnt vmcnt(0)" ::: "memory");
        } else {
            XB_SPIN(xb_ld(&bar[XB_XGEN(b.x)]) == gen, bar);
            __builtin_amdgcn_fence(__ATOMIC_ACQUIRE, "agent");
            asm volatile("s_waitcnt vmcnt(0)" ::: "memory");
        }
    }
    __syncthreads();
}

constexpr int LDS_BYTES = 80 * 1024;
__global__ void __launch_bounds__(256, 2) mega_fwd(Params p) {
    extern __shared__ __attribute__((aligned(16))) unsigned char smem_raw[];
    float* sm = (float*)smem_raw;
    cg::grid_group grid = cg::this_grid();
    XcdBarrier xb; xcd_barrier_post(xb, (unsigned*)(p.ws + WS_CTL) + CW_BAR);
    ph_init(p, sm);
    grid.sync();
    xcd_barrier_census(xb);
#define GSYNC() xcd_barrier(xb)
#pragma unroll 1
    for (int l = 0; l < 2; ++l) {
        ph_norm1(p, l);             GSYNC();
        ph_gemm_in(p, l, smem_raw); GSYNC();
        ph_prep(p, l, sm);          GSYNC();
        ph_attn(p, l, smem_raw);
        ph_gla(p, l, sm);           GSYNC();
        ph_ygla(p, l);              GSYNC();
        ph_merge(p, l, smem_raw);   GSYNC();
        ph_outproj(p, l, smem_raw); GSYNC();
        ph_router(p, l);
        ph_convmoe(p, l, sm);       GSYNC();
        ph_moe1(p, l, smem_raw);    GSYNC();
        ph_moe2(p, l, smem_raw);    GSYNC();
        ph_combine(p, l);           if (l == 0) GSYNC();
    }
}

extern "C" void kernel_launch(void* const* d_in, const int* in_sizes, int n_in, void* d_out, int out_size, void* d_ws, size_t ws_size,
                              hipStream_t stream) {
    if (n_in != 28 || ws_size < WS_END) { fprintf(stderr, "kernel_launch: bad n_in %d or ws_size %zu (< %zu)\n", n_in, ws_size, (size_t)WS_END); return; }
    static int grid_blocks = 0;
    if (!grid_blocks) {
        int dev = 0, cus = 0, per_cu = 0;
        (void)hipGetDevice(&dev);
        (void)hipDeviceGetAttribute(&cus, hipDeviceAttributeMultiprocessorCount, dev);
        (void)hipFuncSetAttribute((const void*)mega_fwd, hipFuncAttributeMaxDynamicSharedMemorySize, LDS_BYTES);
        (void)hipOccupancyMaxActiveBlocksPerMultiprocessor(&per_cu, (const void*)mega_fwd, 256, LDS_BYTES);
        if (per_cu < 1) per_cu = 1;
        grid_blocks = cus * per_cu;
        fprintf(stderr, "kernel_launch: cus %d per_cu %d grid %d ws_size %zu\n", cus, per_cu, grid_blocks, ws_size);
    }
    Params p{};
    for (int i = 0; i < 28; ++i) p.in[i] = (const float*)d_in[i];
    p.out = (float*)d_out; p.ws = (unsigned char*)d_ws;
    (void)hipMemsetAsync((char*)d_ws + WS_CTL, 0, 1 * MiB, stream);
    void* args[] = {&p};
    hipError_t e = hipLaunchCooperativeKernel((const void*)mega_fwd, dim3(grid_blocks), dim3(256), args, LDS_BYTES, stream);
    if (e != hipSuccess) fprintf(stderr, "cooperative launch failed: %s (grid %d)\n", hipGetErrorString(e), grid_blocks);
}
```

```cpp
#include <hip/hip_runtime.h>
#include <hip/hip_cooperative_groups.h>
namespace cg = cooperative_groups;
#include <cstdio>
#include <cstdint>

typedef unsigned short bf16;

constexpr int D = 1024, NB = 8, T = 4096, CL = 256, NL = NB * T, NC = NB * CL, NTOK = NL + NC;
constexpr int INW = 5920;
constexpr int O_GQ = 0, O_GK = 256, O_GV = 512, O_GR = 1024, O_GLF = 1536, O_GLB = 1552, O_AQ = 1568, O_AK = 2080,
              O_AV = 2208, O_PU = 2336, O_GT = 2848;
constexpr float EPS = 1e-6f;

constexpr size_t MiB = 1u << 20;
constexpr size_t WS_CTL = 0;
constexpr size_t WS_MODV = 1 * MiB;
constexpr size_t WS_ROPE = 1 * MiB + 512 * 1024;
constexpr size_t WS_WT = 2 * MiB;
constexpr size_t WS_LIST = 3 * MiB;
constexpr size_t WS_XC = 8 * MiB;
constexpr size_t WS_H = 16 * MiB;
constexpr size_t WS_PROJ = 84 * MiB;
constexpr size_t WS_R2 = 478 * MiB;
constexpr size_t WS_WGU = WS_R2;
constexpr size_t WS_WDT = WS_R2 + 64 * MiB;
constexpr size_t WS_WSM = 580 * MiB;
constexpr size_t SZ_WINT = (size_t)6016 * 1024 * 2, SZ_WBT = (size_t)1024 * 512 * 2, SZ_WOUTT = (size_t)1024 * 1024 * 2;
constexpr size_t SZ_WSM_L = SZ_WINT + 3 * SZ_WBT + SZ_WOUTT;
constexpr size_t WS_VT = 614 * MiB;
constexpr int NKEY = T + CL;
constexpr size_t WS_END = 623 * MiB;
static_assert(WS_WSM + 2 * SZ_WSM_L <= WS_END, "ws map");
constexpr size_t SZ_Y512 = (size_t)NTOK * 512 * 2;
constexpr size_t WS_ACT = WS_PROJ;
constexpr size_t WS_Y0 = WS_PROJ + 68 * MiB;
constexpr size_t WS_Y1 = WS_PROJ + 136 * MiB;

struct Params {
    const float* in[28];
    float* out;
    unsigned char* ws;
};
typedef const __attribute__((address_space(4))) Params* KParams;
__device__ __forceinline__ KParams fresh(KParams k) { asm volatile("" : "+s"(k)); return k; }
enum { I_X = 0, I_C, I_CTX, I_CCTX, I_WMOD, I_BMOD, I_N1G, I_N2G, I_WIN, I_UPF, I_BIASF, I_UPB, I_BIASB, I_GLANG, I_QNG, I_KNG,
       I_POOLW, I_POOLS, I_WBR, I_WOUT, I_WGRP, I_BGRP, I_WEXP, I_BEXP, I_WGATE, I_WUP, I_WDOWN, I_FING };

__device__ __forceinline__ float bf2f(bf16 v) { return __uint_as_float(((unsigned)v) << 16); }
__device__ __forceinline__ bf16 f2bf(float f) { unsigned u = __float_as_uint(f); return (bf16)((u + 0x7fffu + ((u >> 16) & 1u)) >> 16); }
__device__ __forceinline__ float4 ld_bf4(const bf16* p) {
    uint2 u = *(const uint2*)p;
    return make_float4(__uint_as_float(u.x << 16), __uint_as_float(u.x & 0xffff0000u), __uint_as_float(u.y << 16), __uint_as_float(u.y & 0xffff0000u));
}
typedef float f32x2_t __attribute__((ext_vector_type(2)));
typedef __bf16 bf16x2_t __attribute__((ext_vector_type(2)));
__device__ __forceinline__ unsigned pk_bf16(float a, float b) { f32x2_t v = {a, b}; return __builtin_bit_cast(unsigned, __builtin_convertvector(v, bf16x2_t)); }
__device__ __forceinline__ void st_bf4(bf16* p, float a, float b, float c, float d) {
    uint2 u; u.x = pk_bf16(a, b); u.y = pk_bf16(c, d);
    *(uint2*)p = u;
}
__device__ __forceinline__ int tid_opaque() { int t = threadIdx.x; asm volatile("" : "+v"(t)); return t; }
#define DPP_ADD(v, ctrl) v += __builtin_bit_cast(float, __builtin_amdgcn_update_dpp(0, __builtin_bit_cast(int, v), (ctrl), 0xf, 0xf, true))
__device__ __forceinline__ float sum16(float v) {
    DPP_ADD(v, 0xB1);
    DPP_ADD(v, 0x4E);
    DPP_ADD(v, 0x141);
    DPP_ADD(v, 0x140);
    return v;
}
__device__ __forceinline__ float wave_sum(float v) {
#pragma unroll
    for (int o = 1; o < 64; o <<= 1) v += __shfl_xor(v, o);
    return v;
}
__device__ __forceinline__ float silu_f(float x) { return x / (1.f + __expf(-x)); }
__device__ __forceinline__ float sigmoid_f(float x) { return 1.f / (1.f + __expf(-x)); }
__device__ __forceinline__ int modrow(int r) { return r < NL ? r / T : 8; }
__device__ __forceinline__ const float* xrow(KParams p, int l, int r) {
    if (l == 0) return r < NL ? p->in[I_X] + (size_t)r * D : p->in[I_CTX] + (size_t)(r - NL) * D;
    return r < NL ? p->out + (size_t)r * D : (const float*)(p->ws + WS_XC) + (size_t)(r - NL) * D;
}
__device__ __forceinline__ const float* modv(KParams p, int l, int mb, int which) {
    return (const float*)(p->ws + WS_MODV) + ((size_t)(l * 9 + mb) * 6 + which) * D;
}

template <class AF, class BF>
__device__ __forceinline__ void gemm64(float (&acc)[4][4], int K, AF aload, BF bload, float* sA, float* sB, const int tid) {
    const int ty = tid >> 4, tx = tid & 15;
    const int am = tid >> 2, ak = (tid & 3) * 4;
    const int bk = tid >> 4, bn = (tid & 15) * 4;
    for (int k0 = 0; k0 < K; k0 += 16) {
        float4 av = aload(am, k0 + ak);
        float4 bv = bload(k0 + bk, bn);
        __syncthreads();
        sA[(ak + 0) * 68 + am] = av.x; sA[(ak + 1) * 68 + am] = av.y; sA[(ak + 2) * 68 + am] = av.z; sA[(ak + 3) * 68 + am] = av.w;
        *(float4*)&sB[bk * 64 + bn] = bv;
        __syncthreads();
#pragma unroll
        for (int kk = 0; kk < 16; ++kk) {
            float4 a = *(float4*)&sA[kk * 68 + ty * 4];
            float4 b = *(float4*)&sB[kk * 64 + tx * 4];
            float aa[4] = {a.x, a.y, a.z, a.w}, bb[4] = {b.x, b.y, b.z, b.w};
#pragma unroll
            for (int i = 0; i < 4; ++i)
#pragma unroll
                for (int j = 0; j < 4; ++j) acc[i][j] += aa[i] * bb[j];
        }
    }
    __syncthreads();
}
__device__ __forceinline__ void zero_acc(float (&acc)[4][4]) {
#pragma unroll
    for (int i = 0; i < 4; ++i)
#pragma unroll
        for (int j = 0; j < 4; ++j) acc[i][j] = 0.f;
}

typedef short bf16x8 __attribute__((ext_vector_type(8)));
typedef float f32x4 __attribute__((ext_vector_type(4)));
constexpr int GT_BYTES = 16384;
__device__ __forceinline__ void zero_acc4(f32x4 (&acc)[4][4]) {
#pragma unroll
    for (int i = 0; i < 4; ++i)
#pragma unroll
        for (int j = 0; j < 4; ++j) acc[i][j] = (f32x4){0.f, 0.f, 0.f, 0.f};
}
template <class FA, class FB>
__device__ __forceinline__ void gemm_tile(f32x4 (&acc)[4][4], FA arow, FB brow, int K, unsigned char* lds, const int tid) {
    const int lane = tid & 63, wid = tid >> 6, wr = wid >> 1, wc = wid & 1, fr = lane & 15, fq = lane >> 4;
    const int srow = tid >> 3, sc = ((tid & 7) ^ ((tid >> 4) & 7)) * 8;
    const bf16* ap[4]; const bf16* bp[4];
#pragma unroll
    for (int j = 0; j < 4; ++j) { ap[j] = arow(j * 32 + srow) + sc; bp[j] = brow(j * 32 + srow) + sc; }
    const int KT = K >> 6;
#pragma unroll
    for (int j = 0; j < 4; ++j) {
        __builtin_amdgcn_global_load_lds((const unsigned*)(ap[j]), (unsigned*)(lds + j * 4096 + tid * 16), 16, 0, 0);
        __builtin_amdgcn_global_load_lds((const unsigned*)(bp[j]), (unsigned*)(lds + GT_BYTES + j * 4096 + tid * 16), 16, 0, 0);
    }
#pragma unroll 1
    for (int kt = 0; kt < KT; ++kt) {
        asm volatile("s_waitcnt vmcnt(0)" ::: "memory");
        __syncthreads();
        if (kt + 1 < KT) {
            unsigned char* sa = lds + ((kt + 1) & 1) * 2 * GT_BYTES;
#pragma unroll
            for (int j = 0; j < 4; ++j) {
                __builtin_amdgcn_global_load_lds((const unsigned*)(ap[j] + (kt + 1) * 64), (unsigned*)(sa + j * 4096 + tid * 16), 16, 0, 0);
                __builtin_amdgcn_global_load_lds((const unsigned*)(bp[j] + (kt + 1) * 64), (unsigned*)(sa + GT_BYTES + j * 4096 + tid * 16), 16, 0, 0);
            }
        }
        const unsigned char* sa = lds + (kt & 1) * 2 * GT_BYTES;
        const unsigned char* sb = sa + GT_BYTES;
#pragma unroll
        for (int ks = 0; ks < 2; ++ks) {
            const int phys = ((ks * 4 + fq) ^ (fr >> 1)) * 16;
            bf16x8 af[4], bq[4];
#pragma unroll
            for (int i = 0; i < 4; ++i) af[i] = *(const bf16x8*)(sa + (wr * 64 + i * 16 + fr) * 128 + phys);
#pragma unroll
            for (int j = 0; j < 4; ++j) bq[j] = *(const bf16x8*)(sb + (wc * 64 + j * 16 + fr) * 128 + phys);
#pragma unroll
            for (int i = 0; i < 4; ++i)
#pragma unroll
                for (int j = 0; j < 4; ++j) acc[i][j] = __builtin_amdgcn_mfma_f32_16x16x32_bf16(bq[j], af[i], acc[i][j], 0, 0, 0);
        }
    }
}
__device__ __forceinline__ void tile_coords(int it, int nM, int nN, int& tm, int& tn) {
    const int GM = 8, per = GM * nN, grp = it / per, fm = grp * GM, gsz = min(nM - fm, GM), rem = it - grp * per;
    tm = fm + rem % gsz; tn = rem / gsz;
}
__device__ __forceinline__ int vblock() { const int G = gridDim.x, b = blockIdx.x; return (G & 7) == 0 ? (b & 7) * (G >> 3) + (b >> 3) : b; }

template <class NMap>
__device__ __forceinline__ void conv_tile(const float* src, int ldsrc, int nvalid, int k0, int n0, bf16* dst, int lddst, NMap nmap, float* sm, const int tid) {
    __syncthreads();
    {
        const int k = tid >> 2, nq = (tid & 3) * 16;
#pragma unroll
        for (int q = 0; q < 4; ++q) {
            const int n = n0 + nq + q * 4;
            const float4 v = (n < nvalid) ? *(const float4*)(src + (size_t)(k0 + k) * ldsrc + n) : make_float4(0.f, 0.f, 0.f, 0.f);
            float* d = sm + k * 65 + nq + q * 4; d[0] = v.x; d[1] = v.y; d[2] = v.z; d[3] = v.w;
        }
    }
    __syncthreads();
    {
        const int n = tid >> 2, kq = (tid & 3) * 16;
        unsigned w[8];
#pragma unroll
        for (int i = 0; i < 8; ++i) w[i] = (unsigned)f2bf(sm[(kq + 2 * i) * 65 + n]) | ((unsigned)f2bf(sm[(kq + 2 * i + 1) * 65 + n]) << 16);
        bf16* d = dst + (size_t)nmap(n0 + n) * lddst + k0 + kq;
        *(uint4*)d = make_uint4(w[0], w[1], w[2], w[3]);
        *(uint4*)(d + 8) = make_uint4(w[4], w[5], w[6], w[7]);
    }
}
__device__ __forceinline__ bf16* wsm_int(KParams p, int l) { return (bf16*)(p->ws + WS_WSM + (size_t)l * SZ_WSM_L); }
__device__ __forceinline__ bf16* wsm_bt(KParams p, int l, int br) { return (bf16*)(p->ws + WS_WSM + (size_t)l * SZ_WSM_L + SZ_WINT + (size_t)br * SZ_WBT); }
__device__ __forceinline__ bf16* wsm_outt(KParams p, int l) { return (bf16*)(p->ws + WS_WSM + (size_t)l * SZ_WSM_L + SZ_WINT + 3 * SZ_WBT); }

__device__ void ph_init(KParams p, float* sm) {
    const int tid = tid_opaque();
    for (int it = blockIdx.x; it < 49 + 2 * 2144; it += gridDim.x) {
        if (it >= 49) {
            const int l = (it - 49) / 2144; int r = (it - 49) % 2144;
            if (r < 1504) { conv_tile(p->in[I_WIN] + (size_t)l * D * INW, INW, INW, (r / 94) * 64, (r % 94) * 64, wsm_int(p, l), D, [](int n) { return n; }, sm, tid); continue; }
            r -= 1504;
            if (r < 256) { const int br = r >> 7, q = r & 127;
                conv_tile(p->in[I_WBR] + ((size_t)(l * 3 + br) * 512) * D, D, D, (q >> 4) * 64, (q & 15) * 64, wsm_bt(p, l, br), 512, [](int n) { return n; }, sm, tid); continue; }
            r -= 256;
            if (r < 256) { conv_tile(p->in[I_WOUT] + (size_t)l * D * D, D, D, (r >> 4) * 64, (r & 15) * 64, wsm_outt(p, l), D, [](int n) { return n; }, sm, tid); continue; }
            r -= 256;
            {
                const int m0 = (r >> 4) * 64, n0 = (r & 15) * 64, g = m0 >> 7;
                const float* PW = p->in[I_POOLW] + ((size_t)(l * 4 + g) * 128) * 128;
                const float* PS = p->in[I_POOLS] + l * 512 + g * 128;
                const float* WB = p->in[I_WBR] + ((size_t)(l * 3 + 2) * 512 + g * 128) * D;
                float acc[4][4]; zero_acc(acc);
                gemm64(acc, 128,
                       [&](int m, int k) { const float4 a = *(const float4*)(PW + (size_t)((m0 + m) & 127) * 128 + k); const float4 sc = *(const float4*)(PS + k);
                                           return make_float4(a.x * sc.x, a.y * sc.y, a.z * sc.z, a.w * sc.w); },
                       [&](int k, int n) { return *(const float4*)(WB + (size_t)k * D + n0 + n); }, sm, sm + 16 * 68, tid);
                const int ty = tid >> 4, tx = tid & 15;
                bf16* dst = wsm_bt(p, l, 2);
#pragma unroll
                for (int j = 0; j < 4; ++j) st_bf4(dst + (size_t)(n0 + tx * 4 + j) * 512 + m0 + ty * 4, acc[0][j], acc[1][j], acc[2][j], acc[3][j]);
            }
            continue;
        }
        if (it == 48) {
            float2* rope = (float2*)(p->ws + WS_ROPE);
            for (int e = tid; e < 64 * 16; e += 256) {
                const int pos = e >> 4, i = e & 15;
                const float invf = powf(10000.0f, -(float)(2 * i) / 32.0f);
                const float angf = (float)pos * invf;
                const double ang = (double)angf;
                const double twopi = 6.283185307179586476925286766559;
                const double n = rint(ang / twopi);
                const double r = ang - n * twopi, r2 = r * r;
                double s = 1.0, c = 1.0;
                for (int q = 14; q >= 1; --q) { s = 1.0 - r2 / (double)((2 * q) * (2 * q + 1)) * s; c = 1.0 - r2 / (double)((2 * q - 1) * (2 * q)) * c; }
                s *= r;
                rope[e] = make_float2((float)c, (float)s);
            }
            continue;
        }
        const int l = it / 24, cb = it % 24;
        __syncthreads();
        for (int e = tid; e < 9 * D; e += 256) {
            const int mb = e / D, k = e % D;
            const float v = mb < 8 ? p->in[I_C][mb * D + k] : p->in[I_CCTX][k];
            sm[e] = silu_f(v);
        }
        __syncthreads();
        const int col = cb * 256 + tid;
        const float* w = p->in[I_WMOD] + (size_t)l * D * 6144 + col;
        float acc[9];
#pragma unroll
        for (int m = 0; m < 9; ++m) acc[m] = 0.f;
#pragma unroll 4
        for (int k = 0; k < D; ++k) {
            const float wv = w[(size_t)k * 6144];
#pragma unroll
            for (int m = 0; m < 9; ++m) acc[m] += sm[m * D + k] * wv;
        }
        const float bias = p->in[I_BMOD][l * 6144 + col];
        float* mv = (float*)(p->ws + WS_MODV);
#pragma unroll
        for (int m = 0; m < 9; ++m) mv[(size_t)(l * 9 + m) * 6144 + col] = acc[m] + bias;
    }
}

__device__ void ph_norm1(KParams p, int l) {
    const int tid = tid_opaque(), lane = tid & 63, gw = blockIdx.x * 4 + (tid >> 6), ngw = gridDim.x * 4;
    bf16* H = (bf16*)(p->ws + WS_H);
    const float* g = p->in[I_N1G] + l * D;
    for (int r = gw; r < NTOK; r += ngw) {
        const float* x = xrow(p, l, r);
        const int mb = modrow(r);
        const float* sh = modv(p, l, mb, 0); const float* sc = modv(p, l, mb, 1);
        float4 v[4]; float ss = 0.f;
#pragma unroll
        for (int j = 0; j < 4; ++j) { v[j] = *(const float4*)(x + j * 256 + lane * 4); ss += v[j].x * v[j].x + v[j].y * v[j].y + v[j].z * v[j].z + v[j].w * v[j].w; }
        const float inv = rsqrtf(wave_sum(ss) * (1.f / D) + EPS);
#pragma unroll
        for (int j = 0; j < 4; ++j) {
            const int c = j * 256 + lane * 4;
            const float4 gg = *(const float4*)(g + c), s1 = *(const float4*)(sh + c), s2 = *(const float4*)(sc + c);
            st_bf4(H + (size_t)r * D + c, v[j].x * inv * gg.x * (1.f + s2.x) + s1.x, v[j].y * inv * gg.y * (1.f + s2.y) + s1.y,
                   v[j].z * inv * gg.z * (1.f + s2.z) + s1.z, v[j].w * inv * gg.w * (1.f + s2.w) + s1.w);
        }
    }
}

__device__ void ph_gemm_in(KParams p, int l, unsigned char* lds) {
    const bf16* H = (const bf16*)(p->ws + WS_H);
    bf16* PROJ = (bf16*)(p->ws + WS_PROJ);
    const bf16* WT = wsm_int(p, l);
    const int nN = 47, nM = NTOK / 128;
    const int tid = tid_opaque(), lane = tid & 63, wid = tid >> 6, wr = wid >> 1, wc = wid & 1, fr = lane & 15, fq = lane >> 4;
    for (int it = vblock(); it < nM * nN; it += gridDim.x) {
        int tm, tn; tile_coords(it, nM, nN, tm, tn);
        f32x4 acc[4][4]; zero_acc4(acc);
        gemm_tile(acc, [&](int r) { return H + (size_t)(tm * 128 + r) * D; }, [&](int r) { return WT + (size_t)(tn * 128 + r) * D; }, D, lds, tid);
#pragma unroll
        for (int i = 0; i < 4; ++i)
#pragma unroll
            for (int j = 0; j < 4; ++j) {
                const int row = tm * 128 + wr * 64 + i * 16 + fr, col = tn * 128 + wc * 64 + j * 16 + fq * 4;
                if (col < INW) st_bf4(PROJ + (size_t)row * INW + col, acc[i][j][0], acc[i][j][1], acc[i][j][2], acc[i][j][3]);
            }
    }
}

__device__ void ph_prep(KParams p, int l, float* smf) {
    const int tid = tid_opaque();
    bf16* PROJ = (bf16*)(p->ws + WS_PROJ);
    const float2* rope = (const float2*)(p->ws + WS_ROPE);
    const long total = (long)NTOK * 10;
    for (long id = (long)blockIdx.x * 256 + tid; id < total; id += (long)gridDim.x * 256) {
        const int r = (int)(id / 10), j = (int)(id % 10);
        const bool isq = j < 8;
        if (l == 1 && r >= NL && isq) continue;
        bf16* ptr = PROJ + (size_t)r * INW + (isq ? O_AQ + j * 64 : O_AK + (j - 8) * 64);
        const float* g = p->in[isq ? I_QNG : I_KNG] + l * 64;
        float v[64]; float ss = 0.f;
#pragma unroll
        for (int q = 0; q < 16; ++q) { float4 t = ld_bf4(ptr + q * 4); v[q * 4] = t.x; v[q * 4 + 1] = t.y; v[q * 4 + 2] = t.z; v[q * 4 + 3] = t.w; }
#pragma unroll
        for (int d = 0; d < 64; ++d) ss += v[d] * v[d];
        const float inv = rsqrtf(ss * (1.f / 64.f) + EPS);
#pragma unroll
        for (int d = 0; d < 64; ++d) v[d] = v[d] * inv * g[d];
        if (r < NL) {
            const int t = r % T, row = t >> 6, col = t & 63;
#pragma unroll
            for (int i = 0; i < 16; ++i) {
                const float2 a = rope[row * 16 + i]; const float x1 = v[i], x2 = v[16 + i];
                v[i] = x1 * a.x - x2 * a.y; v[16 + i] = x1 * a.y + x2 * a.x;
                const float2 b = rope[col * 16 + i]; const float y1 = v[32 + i], y2 = v[48 + i];
                v[32 + i] = y1 * b.x - y2 * b.y; v[48 + i] = y1 * b.y + y2 * b.x;
            }
        }
        const float sc = isq ? 0.125f * 1.4426950408889634f : 1.f;
#pragma unroll
        for (int q = 0; q < 16; ++q) st_bf4(ptr + q * 4, v[q * 4] * sc, v[q * 4 + 1] * sc, v[q * 4 + 2] * sc, v[q * 4 + 3] * sc);
    }
    bf16* DP = (bf16*)(p->ws + WS_R2 + 2 * SZ_Y512);
    const long tot2 = (long)((l == 0) ? NTOK : NL) * 128;
    for (long id = (long)blockIdx.x * 256 + tid; id < tot2; id += (long)gridDim.x * 256) {
        const int r = (int)(id >> 7), ch = (int)(id & 127) * 4, g = ch >> 7, hw = 1 << g;
        int t, base, tl;
        if (r < NL) { t = r % T; base = r - t; tl = T; } else { t = (r - NL) % CL; base = r - t; tl = CL; }
        const int lo = max(t - hw, 0), hi = min(t + hw, tl);
        float4 sacc = make_float4(0.f, 0.f, 0.f, 0.f);
        for (int u = lo; u < hi; ++u) { const float4 v = ld_bf4(PROJ + (size_t)(base + u) * INW + O_PU + ch); sacc.x += v.x; sacc.y += v.y; sacc.z += v.z; sacc.w += v.w; }
        const float inv = 1.f / (float)(hi - lo);
        const float4 c = ld_bf4(PROJ + (size_t)r * INW + O_PU + ch);
        st_bf4(DP + (size_t)r * 512 + ch, sacc.x * inv - c.x, sacc.y * inv - c.y, sacc.z * inv - c.z, sacc.w * inv - c.w);
    }
    {
        bf16* VT = (bf16*)(p->ws + WS_VT);
        unsigned short* st = (unsigned short*)smf;
        for (int it = blockIdx.x; it < (NTOK / 64) * 2; it += gridDim.x) {
            const int rt = it >> 1, kvh = it & 1;
            int b, key0;
            if (rt < NL / 64) { b = rt / 64; key0 = (rt % 64) * 64; } else { const int j = rt - NL / 64; b = j / 4; key0 = T + (j % 4) * 64; }
            __syncthreads();
            {
                const int k = tid >> 2, dq = (tid & 3) * 16;
                const bf16* src = PROJ + (size_t)(rt * 64 + k) * INW + O_AV + kvh * 64 + dq;
                const uint4 a = *(const uint4*)src, c = *(const uint4*)(src + 8);
                unsigned* d = (unsigned*)(st + k * 66 + dq);
                d[0] = a.x; d[1] = a.y; d[2] = a.z; d[3] = a.w; d[4] = c.x; d[5] = c.y; d[6] = c.z; d[7] = c.w;
            }
            __syncthreads();
            {
                const int d = tid >> 2, kq = (tid & 3) * 16;
                unsigned w[8];
#pragma unroll
                for (int i = 0; i < 8; ++i) w[i] = (unsigned)st[(kq + 2 * i) * 66 + d] | ((unsigned)st[(kq + 2 * i + 1) * 66 + d] << 16);
                bf16* dst = VT + ((size_t)(b * 2 + kvh) * 64 + d) * NKEY + key0 + kq;
                *(uint4*)dst = make_uint4(w[0], w[1], w[2], w[3]);
                *(uint4*)(dst + 8) = make_uint4(w[4], w[5], w[6], w[7]);
            }
        }
    }
}

typedef float f32x16 __attribute__((ext_vector_type(16)));
typedef short s16x4 __attribute__((ext_vector_type(4)));
#define MFMA32(a, b, c) __builtin_amdgcn_mfma_f32_32x32x16_bf16((a), (b), (c), 0, 0, 0)
__device__ __forceinline__ bf16x8 pack8(const f32x16& x, int s) {
    typedef unsigned u32x4_t __attribute__((ext_vector_type(4)));
    u32x4_t r;
    r[0] = pk_bf16(x[8 * s + 0], x[8 * s + 1]); r[1] = pk_bf16(x[8 * s + 2], x[8 * s + 3]);
    r[2] = pk_bf16(x[8 * s + 4], x[8 * s + 5]); r[3] = pk_bf16(x[8 * s + 6], x[8 * s + 7]);
    return __builtin_bit_cast(bf16x8, r);
}
__device__ __forceinline__ void attn_item(KParams p, int l, int it, unsigned char* lds, const int tid_) {
    const int tid = tid_opaque();
    const int lane = tid & 63, wid = tid >> 6, r32 = lane & 31, h = lane >> 5;
    bf16* PROJ = (bf16*)(p->ws + WS_PROJ);
    const bf16* VT = (const bf16*)(p->ws + WS_VT);
    float mq = 0.f, mk = 0.f;
    for (int d = 0; d < 64; ++d) { mq = fmaxf(mq, fabsf(p->in[I_QNG][l * 64 + d])); mk = fmaxf(mk, fabsf(p->in[I_KNG][l * 64 + d])); }
    const float shift2 = 8.f * mq * mk * 1.4426950408889634f;
    const int srow = tid >> 3, sc = ((tid & 7) ^ ((tid >> 4) & 7)) * 8, sw = (r32 >> 1) & 7;
    const int nlat = NB * 8 * 16;
    {
        int b, head, qrow0, nkt, vkey0;
        const bool lat = it < nlat;
        if (lat) { b = it >> 7; head = (it >> 4) & 7; qrow0 = b * T + (it & 15) * 256; nkt = 68; vkey0 = 0; }
        else { const int j = it - nlat; b = j >> 3; head = j & 7; qrow0 = NL + b * CL; nkt = 4; vkey0 = T; }
        const int kvh = head >> 2;
        bf16x8 qf[2][4];
#pragma unroll
        for (int qb = 0; qb < 2; ++qb)
#pragma unroll
            for (int ks = 0; ks < 4; ++ks)
                qf[qb][ks] = *(const bf16x8*)(PROJ + (size_t)(qrow0 + wid * 64 + qb * 32 + r32) * INW + O_AQ + head * 64 + ks * 16 + h * 8);
        const bf16* vsrc[2];
#pragma unroll
        for (int j = 0; j < 2; ++j) vsrc[j] = VT + ((size_t)(b * 2 + kvh) * 64 + j * 32 + srow) * NKEY + vkey0 + sc;
        const bf16* kbase = PROJ + O_AK + kvh * 64 + sc;
        auto krow = [&](int kt, int r) { return lat ? (kt < 64 ? b * T + kt * 64 + r : NL + b * CL + (kt - 64) * 64 + r) : NL + b * CL + kt * 64 + r; };
        auto stage = [&](int kt, int buf) {
            unsigned char* base = lds + buf * 16384;
#pragma unroll
            for (int j = 0; j < 2; ++j) {
                __builtin_amdgcn_global_load_lds((const unsigned*)(kbase + (size_t)krow(kt, j * 32 + srow) * INW), (unsigned*)(base + j * 4096 + tid * 16), 16, 0, 0);
                __builtin_amdgcn_global_load_lds((const unsigned*)(vsrc[j] + kt * 64), (unsigned*)(base + 8192 + j * 4096 + tid * 16), 16, 0, 0);
            }
        };
        f32x16 o[2][2];
#pragma unroll
        for (int a = 0; a < 2; ++a)
#pragma unroll
            for (int c = 0; c < 2; ++c)
#pragma unroll
                for (int e = 0; e < 16; ++e) o[a][c][e] = 0.f;
        float l0 = 0.f, l1 = 0.f;
        stage(0, 0);
#pragma unroll 1
        for (int kt = 0; kt < nkt; ++kt) {
            asm volatile("s_waitcnt vmcnt(0)" ::: "memory");
            __syncthreads();
            if (kt + 1 < nkt) stage(kt + 1, (kt + 1) & 1);
            const unsigned char* kb_ = lds + (kt & 1) * 16384;
            const unsigned char* vb_ = kb_ + 8192;
#pragma unroll
            for (int kb = 0; kb < 2; ++kb) {
                f32x16 s0, s1;
#pragma unroll
                for (int e = 0; e < 16; ++e) { s0[e] = 0.f; s1[e] = 0.f; }
#pragma unroll
                for (int ks = 0; ks < 4; ++ks) {
                    const bf16x8 kf = *(const bf16x8*)(kb_ + (kb * 32 + r32) * 128 + (((2 * ks + h) ^ sw) * 16));
                    s0 = MFMA32(kf, qf[0][ks], s0);
                    s1 = MFMA32(kf, qf[1][ks], s1);
                }
#pragma unroll
                for (int e = 0; e < 16; ++e) {
                    s0[e] = __builtin_amdgcn_exp2f(s0[e] - shift2); l0 += s0[e];
                    s1[e] = __builtin_amdgcn_exp2f(s1[e] - shift2); l1 += s1[e];
                }
#pragma unroll
                for (int s2 = 0; s2 < 2; ++s2) {
                    const bf16x8 p0 = pack8(s0, s2), p1 = pack8(s1, s2);
                    const int ksv = kb * 2 + s2;
#pragma unroll
                    for (int db = 0; db < 2; ++db) {
                        const unsigned char* vr = vb_ + (db * 32 + r32) * 128 + 8 * h;
                        const s16x4 lo = *(const s16x4*)(vr + (((2 * ksv) ^ sw) * 16));
                        const s16x4 hi = *(const s16x4*)(vr + (((2 * ksv + 1) ^ sw) * 16));
                        const bf16x8 vf = __builtin_shufflevector(lo, hi, 0, 1, 2, 3, 4, 5, 6, 7);
                        o[db][0] = MFMA32(vf, p0, o[db][0]);
                        o[db][1] = MFMA32(vf, p1, o[db][1]);
                    }
                }
            }
        }
        l0 += __shfl_xor(l0, 32); l1 += __shfl_xor(l1, 32);
        const float i0 = 1.f / l0, i1 = 1.f / l1;
#pragma unroll
        for (int qb = 0; qb < 2; ++qb) {
            const float inv = qb ? i1 : i0;
            bf16* orow = PROJ + (size_t)(qrow0 + wid * 64 + qb * 32 + r32) * INW + O_AQ + head * 64;
#pragma unroll
            for (int db = 0; db < 2; ++db)
#pragma unroll
                for (int g = 0; g < 4; ++g)
                    st_bf4(orow + db * 32 + 8 * g + 4 * h, o[db][qb][4 * g] * inv, o[db][qb][4 * g + 1] * inv, o[db][qb][4 * g + 2] * inv, o[db][qb][4 * g + 3] * inv);
        }
    }
}

constexpr int GL_QS = 0, GL_KS = 8192, GL_KDT = 16384, GL_VT = 24576, GL_GLS = 40960, GL_TOT = 45056, GL_FIRST = 47104, GL_EBREF = 47360, GL_EBLAST = 47616,
              GL_RAWQ = 47872, GL_RAWK = 56064, GL_RAWV = 64256;
__device__ __forceinline__ int swz(int row, int byte) { return row * 128 + ((((byte >> 4) ^ (row >> 1)) & 7) << 4) + (byte & 15); }
__device__ __forceinline__ void gla_task(KParams p, int l, int task, unsigned char* lds, const int tid_) {
    const int tid = tid_opaque();
    const int lane = tid & 63, w = tid >> 6, r32 = lane & 31, h = lane >> 5;
    const int b = task >> 3, hd = (task >> 1) & 3, dir = task & 1;
    const bf16* PROJ = (const bf16*)(p->ws + WS_PROJ);
    bf16* OG = (bf16*)(p->ws + WS_R2 + (size_t)dir * SZ_Y512);
    const float* up = p->in[dir ? I_UPB : I_UPF] + (size_t)l * 16 * 256 + hd * 64;
    const float* bias = p->in[dir ? I_BIASB : I_BIASF] + l * 256 + hd * 64;
    const int ogl = dir ? O_GLB : O_GLF;
    const int dk2 = (tid & 31) * 2, seg = tid >> 5;
    const int dv2 = (tid & 63) * 2, vq = tid >> 6;
    const float2 bia = *(const float2*)(bias + dk2);
    f32x16 S[2];
#pragma unroll
    for (int e = 0; e < 16; ++e) { S[0][e] = 0.f; S[1][e] = 0.f; }
    auto chunk_base = [&](int n) { return n < 4 ? NL + b * CL + (dir ? 3 - n : n) * 64 : b * T + (dir ? 63 - (n - 4) : (n - 4)) * 64; };
    auto prefetch = [&](int n) {
        const int base = chunk_base(n);
#pragma unroll
        for (int j = 0; j < 2; ++j) {
            const int i = j * 32 + (tid >> 3); const size_t tok = dir ? base + 63 - i : base + i;
            __builtin_amdgcn_global_load_lds((const unsigned*)(PROJ + tok * INW + O_GQ + hd * 64 + (tid & 7) * 8), (unsigned*)(lds + GL_RAWQ + j * 4096 + tid * 16), 16, 0, 0);
            __builtin_amdgcn_global_load_lds((const unsigned*)(PROJ + tok * INW + O_GK + hd * 64 + (tid & 7) * 8), (unsigned*)(lds + GL_RAWK + j * 4096 + tid * 16), 16, 0, 0);
        }
#pragma unroll
        for (int j = 0; j < 4; ++j) {
            const int i = j * 16 + (tid >> 4); const size_t tok = dir ? base + 63 - i : base + i;
            __builtin_amdgcn_global_load_lds((const unsigned*)(PROJ + tok * INW + O_GV + hd * 128 + (tid & 15) * 8), (unsigned*)(lds + GL_RAWV + j * 4096 + tid * 16), 16, 0, 0);
        }
        if (tid < 128) {
            const int i = tid >> 1; const size_t tok = dir ? base + 63 - i : base + i;
            __builtin_amdgcn_global_load_lds((const unsigned*)(PROJ + tok * INW + ogl + (tid & 1) * 8), (unsigned*)(lds + GL_GLS + tid * 16), 16, 0, 0);
        }
    };
    __syncthreads();
    prefetch(0);
#pragma unroll 1
    for (int n = 0; n < 68; ++n) {
        const int base = chunk_base(n);
        asm volatile("s_waitcnt vmcnt(0)" ::: "memory");
        __syncthreads();
        float la0[8], la1[8];
        {
            float up0[16], up1[16];
#pragma unroll
            for (int j = 0; j < 16; ++j) { const float2 t = *(const float2*)(up + j * 256 + dk2); up0[j] = t.x; up1[j] = t.y; }
            const unsigned char* gls = lds + GL_GLS;
#pragma unroll
            for (int u = 0; u < 8; ++u) {
                const int i = seg * 8 + u;
                const uint4 g0 = *(const uint4*)(gls + i * 32), g1 = *(const uint4*)(gls + i * 32 + 16);
                const unsigned gw[8] = {g0.x, g0.y, g0.z, g0.w, g1.x, g1.y, g1.z, g1.w};
                float a0 = bia.x, a1 = bia.y;
#pragma unroll
                for (int j = 0; j < 8; ++j) {
                    const float glo = __uint_as_float(gw[j] << 16), ghi = __uint_as_float(gw[j] & 0xffff0000u);
                    a0 += glo * up0[2 * j]; a1 += glo * up1[2 * j];
                    a0 += ghi * up0[2 * j + 1]; a1 += ghi * up1[2 * j + 1];
                }
                la0[u] = (fminf(a0, 0.f) - __logf(1.f + __expf(-fabsf(a0)))) * (1.f / 16.f);
                la1[u] = (fminf(a1, 0.f) - __logf(1.f + __expf(-fabsf(a1)))) * (1.f / 16.f);
            }
#pragma unroll
            for (int u = 1; u < 8; ++u) { la0[u] += la0[u - 1]; la1[u] += la1[u - 1]; }
            *(float2*)(lds + GL_TOT + (seg * 64 + dk2) * 4) = make_float2(la0[7], la1[7]);
            if (seg == 4) *(float2*)(lds + GL_FIRST + dk2 * 4) = make_float2(la0[0], la1[0]);
        }
        __syncthreads();
        {
            float off0 = 0.f, off1 = 0.f, pre0 = 0.f, pre1 = 0.f, all0 = 0.f, all1 = 0.f;
#pragma unroll
            for (int sg = 0; sg < 8; ++sg) {
                const float2 t = *(const float2*)(lds + GL_TOT + (sg * 64 + dk2) * 4);
                if (sg < seg) { off0 += t.x; off1 += t.y; }
                if (sg < 4) { pre0 += t.x; pre1 += t.y; }
                all0 += t.x; all1 += t.y;
            }
            const float2 f4 = *(const float2*)(lds + GL_FIRST + dk2 * 4);
            const float bref0 = pre0 + f4.x, bref1 = pre1 + f4.y;
            const float c0 = __expf(all0 - bref0), c1 = __expf(all1 - bref1);
            unsigned kd0[4], kd1[4];
#pragma unroll
            for (int u = 0; u < 8; u += 2) {
                float kdv[2][2];
#pragma unroll
                for (int uu = 0; uu < 2; ++uu) {
                    const int i = seg * 8 + u + uu;
                    const float e0 = __expf(off0 + la0[u + uu] - bref0), e1 = __expf(off1 + la1[u + uu] - bref1);
                    const float r0 = __builtin_amdgcn_rcpf(e0), r1 = __builtin_amdgcn_rcpf(e1);
                    const unsigned rqv = *(const unsigned*)(lds + GL_RAWQ + i * 128 + dk2 * 2), rkv = *(const unsigned*)(lds + GL_RAWK + i * 128 + dk2 * 2);
                    const float q0 = __uint_as_float(rqv << 16), q1 = __uint_as_float(rqv & 0xffff0000u);
                    const float k0 = __uint_as_float(rkv << 16), k1 = __uint_as_float(rkv & 0xffff0000u);
                    const float ks0 = k0 * r0, ks1 = k1 * r1;
                    *(unsigned*)(lds + GL_QS + swz(i, dk2 * 2)) = pk_bf16(q0 * 0.125f * e0, q1 * 0.125f * e1);
                    *(unsigned*)(lds + GL_KS + swz(i, dk2 * 2)) = pk_bf16(ks0, ks1);
                    kdv[uu][0] = ks0 * c0; kdv[uu][1] = ks1 * c1;
                }
                kd0[u >> 1] = pk_bf16(kdv[0][0], kdv[1][0]); kd1[u >> 1] = pk_bf16(kdv[0][1], kdv[1][1]);
            }
            *(uint4*)(lds + GL_KDT + swz(dk2, seg * 16)) = make_uint4(kd0[0], kd0[1], kd0[2], kd0[3]);
            *(uint4*)(lds + GL_KDT + swz(dk2 + 1, seg * 16)) = make_uint4(kd1[0], kd1[1], kd1[2], kd1[3]);
            unsigned va[8], vb[8], rv[16];
#pragma unroll
            for (int u = 0; u < 16; ++u) rv[u] = *(const unsigned*)(lds + GL_RAWV + (vq * 16 + u) * 256 + dv2 * 2);
#pragma unroll
            for (int m = 0; m < 8; ++m) { va[m] = (rv[2 * m] & 0xffffu) | (rv[2 * m + 1] << 16); vb[m] = (rv[2 * m] >> 16) | (rv[2 * m + 1] & 0xffff0000u); }
            *(uint4*)(lds + GL_VT + swz(dv2, vq * 32)) = make_uint4(va[0], va[1], va[2], va[3]);
            *(uint4*)(lds + GL_VT + swz(dv2, vq * 32 + 16)) = make_uint4(va[4], va[5], va[6], va[7]);
            *(uint4*)(lds + GL_VT + swz(dv2 + 1, vq * 32)) = make_uint4(vb[0], vb[1], vb[2], vb[3]);
            *(uint4*)(lds + GL_VT + swz(dv2 + 1, vq * 32 + 16)) = make_uint4(vb[4], vb[5], vb[6], vb[7]);
            if (seg == 0) {
                *(float2*)(lds + GL_EBREF + dk2 * 4) = make_float2(__expf(bref0), __expf(bref1));
                *(float2*)(lds + GL_EBLAST + dk2 * 4) = make_float2(__expf(all0), __expf(all1));
            }
        }
        __syncthreads();
        if (n + 1 < 68) prefetch(n + 1);
        {
            const unsigned char* QS = lds + GL_QS; const unsigned char* KS = lds + GL_KS; const unsigned char* KDT = lds + GL_KDT; const unsigned char* VTL = lds + GL_VT;
            f32x16 ot[2];
#pragma unroll
            for (int e = 0; e < 16; ++e) { ot[0][e] = 0.f; ot[1][e] = 0.f; }
            bf16x8 sp[2][2];
#pragma unroll
            for (int dkb = 0; dkb < 2; ++dkb) {
                f32x16 t;
#pragma unroll
                for (int g = 0; g < 4; ++g) {
                    const float4 e = *(const float4*)(lds + GL_EBREF + (32 * dkb + 8 * g + 4 * h) * 4);
                    t[4 * g] = S[dkb][4 * g] * e.x; t[4 * g + 1] = S[dkb][4 * g + 1] * e.y; t[4 * g + 2] = S[dkb][4 * g + 2] * e.z; t[4 * g + 3] = S[dkb][4 * g + 3] * e.w;
                }
                sp[dkb][0] = pack8(t, 0); sp[dkb][1] = pack8(t, 1);
            }
#pragma unroll
            for (int ib = 0; ib < 2; ++ib)
#pragma unroll
                for (int ksv = 0; ksv < 4; ++ksv) {
                    const int row = 32 * ib + r32;
                    const s16x4 lo = *(const s16x4*)(QS + swz(row, 32 * ksv + 8 * h));
                    const s16x4 hi = *(const s16x4*)(QS + swz(row, 32 * ksv + 16 + 8 * h));
                    const bf16x8 qp = __builtin_shufflevector(lo, hi, 0, 1, 2, 3, 4, 5, 6, 7);
                    ot[ib] = MFMA32(sp[ksv >> 1][ksv & 1], qp, ot[ib]);
                }
#pragma unroll
            for (int tI = 0; tI < 3; ++tI) {
                const int sb = tI == 2 ? 1 : 0, ib = tI == 0 ? 0 : 1;
                f32x16 pt;
#pragma unroll
                for (int e = 0; e < 16; ++e) pt[e] = 0.f;
#pragma unroll
                for (int ks = 0; ks < 4; ++ks) {
                    const bf16x8 kf = *(const bf16x8*)(KS + swz(32 * sb + r32, (2 * ks + h) * 16));
                    const bf16x8 qf = *(const bf16x8*)(QS + swz(32 * ib + r32, (2 * ks + h) * 16));
                    pt = MFMA32(kf, qf, pt);
                }
                if (sb == ib) {
#pragma unroll
                    for (int e = 0; e < 16; ++e) { const int sl = (e & 3) + 8 * (e >> 2) + 4 * h; if (sl > r32) pt[e] = 0.f; }
                }
#pragma unroll
                for (int s2 = 0; s2 < 2; ++s2) {
                    const int ksv = 2 * sb + s2, row = 32 * w + r32;
                    const s16x4 lo = *(const s16x4*)(VTL + swz(row, 32 * ksv + 8 * h));
                    const s16x4 hi = *(const s16x4*)(VTL + swz(row, 32 * ksv + 16 + 8 * h));
                    const bf16x8 vp = __builtin_shufflevector(lo, hi, 0, 1, 2, 3, 4, 5, 6, 7);
                    ot[ib] = MFMA32(vp, pack8(pt, s2), ot[ib]);
                }
            }
#pragma unroll
            for (int ib = 0; ib < 2; ++ib) {
                const int i = 32 * ib + r32; const size_t tok = dir ? base + 63 - i : base + i;
                bf16* dst = OG + tok * 512 + hd * 128 + 32 * w + 4 * h;
#pragma unroll
                for (int g = 0; g < 4; ++g) st_bf4(dst + 8 * g, ot[ib][4 * g], ot[ib][4 * g + 1], ot[ib][4 * g + 2], ot[ib][4 * g + 3]);
            }
#pragma unroll
            for (int dkb = 0; dkb < 2; ++dkb)
#pragma unroll
                for (int g = 0; g < 4; ++g) {
                    const float4 e = *(const float4*)(lds + GL_EBLAST + (32 * dkb + 8 * g + 4 * h) * 4);
                    S[dkb][4 * g] *= e.x; S[dkb][4 * g + 1] *= e.y; S[dkb][4 * g + 2] *= e.z; S[dkb][4 * g + 3] *= e.w;
                }
#pragma unroll
            for (int ks = 0; ks < 4; ++ks) {
                const bf16x8 vn = *(const bf16x8*)(VTL + swz(32 * w + r32, (2 * ks + h) * 16));
#pragma unroll
                for (int dkb = 0; dkb < 2; ++dkb) {
                    const bf16x8 kd = *(const bf16x8*)(KDT + swz(32 * dkb + r32, (2 * ks + h) * 16));
                    S[dkb] = MFMA32(kd, vn, S[dkb]);
                }
            }
        }
    }
}

constexpr int CW_WORK = 64;
constexpr int LDS_ITEM_OFF = 79 * 1024;
__device__ void ph_mix(KParams p, int l, unsigned char* lds) {
    const int tid = tid_opaque();
    unsigned* ctr = (unsigned*)(p->ws + WS_CTL) + CW_WORK + l;
    volatile int* slot = (volatile int*)(lds + LDS_ITEM_OFF);
    const int nitems = 64 + NB * 8 * 16 + ((l == 0) ? NB * 8 : 0);
    for (;;) {
        __syncthreads();
        if (tid == 0) *slot = (int)__hip_atomic_fetch_add(ctr, 1u, __ATOMIC_RELAXED, __HIP_MEMORY_SCOPE_AGENT);
        __syncthreads();
        const int it = *slot;
        if (it >= nitems) break;
        if (it < 64) gla_task(p, l, it, lds, tid);
        else attn_item(p, l, it - 64, lds, tid);
    }
}

__device__ void ph_ygla(KParams p, int l) {
    const int tid = tid_opaque(), lane = tid & 63, gw = blockIdx.x * 4 + (tid >> 6), ngw = gridDim.x * 4;
    bf16* O0 = (bf16*)(p->ws + WS_R2);
    const bf16* O1 = (const bf16*)(p->ws + WS_R2 + SZ_Y512);
    const bf16* PROJ = (const bf16*)(p->ws + WS_PROJ);
    const float* g = p->in[I_GLANG] + l * 128;
    const int nrows = (l == 0) ? NTOK : NL;
    for (int r = gw; r < nrows; r += ngw) {
        const int c = lane * 8;
        float v[8];
        { float4 a = ld_bf4(O0 + (size_t)r * 512 + c), b2 = ld_bf4(O0 + (size_t)r * 512 + c + 4), d = ld_bf4(O1 + (size_t)r * 512 + c), e = ld_bf4(O1 + (size_t)r * 512 + c + 4);
          v[0] = a.x + d.x; v[1] = a.y + d.y; v[2] = a.z + d.z; v[3] = a.w + d.w; v[4] = b2.x + e.x; v[5] = b2.y + e.y; v[6] = b2.z + e.z; v[7] = b2.w + e.w; }
        float ss = 0.f;
#pragma unroll
        for (int e = 0; e < 8; ++e) ss += v[e] * v[e];
        ss += __shfl_xor(ss, 1); ss += __shfl_xor(ss, 2); ss += __shfl_xor(ss, 4); ss += __shfl_xor(ss, 8);
        const float inv = rsqrtf(ss * (1.f / 128.f) + EPS);
        float4 r0 = ld_bf4(PROJ + (size_t)r * INW + O_GR + c), r1 = ld_bf4(PROJ + (size_t)r * INW + O_GR + c + 4);
        const float gr[8] = {r0.x, r0.y, r0.z, r0.w, r1.x, r1.y, r1.z, r1.w};
        float o[8];
#pragma unroll
        for (int e = 0; e < 8; ++e) o[e] = v[e] * inv * g[(c + e) & 127] * silu_f(gr[e]);
        st_bf4(O0 + (size_t)r * 512 + c, o[0], o[1], o[2], o[3]);
        st_bf4(O0 + (size_t)r * 512 + c + 4, o[4], o[5], o[6], o[7]);
    }
}

__device__ void ph_merge(KParams p, int l, unsigned char* lds) {
    const bf16* PROJ = (const bf16*)(p->ws + WS_PROJ);
    const bf16* YG = (const bf16*)(p->ws + WS_R2);
    const bf16* DP = (const bf16*)(p->ws + WS_R2 + 2 * SZ_Y512);
    bf16* Z = (bf16*)(p->ws + WS_H);
    const int nrows = (l == 0) ? NTOK : NL, nM = nrows / 128, nN = 8;
    const int tid = tid_opaque(), lane = tid & 63, wid = tid >> 6, wr = wid >> 1, wc = wid & 1, fr = lane & 15, fq = lane >> 4;
    for (int it = vblock(); it < nM * nN; it += gridDim.x) {
        int tm, tn; tile_coords(it, nM, nN, tm, tn);
        f32x4 tot[4][4]; zero_acc4(tot);
#pragma unroll 1
        for (int br = 0; br < 3; ++br) {
            const bf16* WT = wsm_bt(p, l, br);
            const bf16* Ab = br == 0 ? YG : (br == 1 ? PROJ + O_AQ : DP);
            const size_t lda = br == 1 ? (size_t)INW : (size_t)512;
            f32x4 acc[4][4]; zero_acc4(acc);
            gemm_tile(acc, [&](int r) { return Ab + (size_t)(tm * 128 + r) * lda; }, [&](int r) { return WT + (size_t)(tn * 128 + r) * 512; }, 512, lds, tid);
#pragma unroll
            for (int i = 0; i < 4; ++i)
#pragma unroll
                for (int j = 0; j < 4; ++j) {
                    const int row = tm * 128 + wr * 64 + i * 16 + fr, col = tn * 128 + wc * 64 + j * 16 + fq * 4;
                    const float4 gt = ld_bf4(PROJ + (size_t)row * INW + O_GT + br * D + col);
                    tot[i][j][0] += sigmoid_f(gt.x) * acc[i][j][0]; tot[i][j][1] += sigmoid_f(gt.y) * acc[i][j][1];
                    tot[i][j][2] += sigmoid_f(gt.z) * acc[i][j][2]; tot[i][j][3] += sigmoid_f(gt.w) * acc[i][j][3];
                }
        }
#pragma unroll
        for (int i = 0; i < 4; ++i)
#pragma unroll
            for (int j = 0; j < 4; ++j) {
                const int row = tm * 128 + wr * 64 + i * 16 + fr, col = tn * 128 + wc * 64 + j * 16 + fq * 4;
                st_bf4(Z + (size_t)row * D + col, tot[i][j][0], tot[i][j][1], tot[i][j][2], tot[i][j][3]);
            }
    }
}

__device__ void ph_outproj(KParams p, int l, unsigned char* lds) {
    const bf16* Z = (const bf16*)(p->ws + WS_H);
    const bf16* WT = wsm_outt(p, l);
    const int nrows = (l == 0) ? NTOK : NL, nM = nrows / 128, nN = 8;
    const int tid = tid_opaque(), lane = tid & 63, wid = tid >> 6, wr = wid >> 1, wc = wid & 1, fr = lane & 15, fq = lane >> 4;
    for (int it = vblock(); it < nM * nN; it += gridDim.x) {
        int tm, tn; tile_coords(it, nM, nN, tm, tn);
        f32x4 acc[4][4]; zero_acc4(acc);
        gemm_tile(acc, [&](int r) { return Z + (size_t)(tm * 128 + r) * D; }, [&](int r) { return WT + (size_t)(tn * 128 + r) * D; }, D, lds, tid);
#pragma unroll
        for (int i = 0; i < 4; ++i) {
            const int r = tm * 128 + wr * 64 + i * 16 + fr;
            const float* xr = xrow(p, l, r);
            const float* g1 = modv(p, l, modrow(r), 2);
            float* dr = r < NL ? p->out + (size_t)r * D : (float*)(p->ws + WS_XC) + (size_t)(r - NL) * D;
#pragma unroll
            for (int j = 0; j < 4; ++j) {
                const int c = tn * 128 + wc * 64 + j * 16 + fq * 4;
                const float4 xo = *(const float4*)(xr + c), gg = *(const float4*)(g1 + c);
                *(float4*)(dr + c) = make_float4(xo.x + gg.x * acc[i][j][0], xo.y + gg.y * acc[i][j][1], xo.z + gg.z * acc[i][j][2], xo.w + gg.w * acc[i][j][3]);
            }
        }
    }
}

__device__ __forceinline__ const float* x1row(KParams p, int r) {
    return r < NL ? p->out + (size_t)r * D : (const float*)(p->ws + WS_XC) + (size_t)(r - NL) * D;
}
__device__ void ph_router(KParams p, int l) {
    const int tid = tid_opaque(), lane = tid & 63, gw = blockIdx.x * 4 + (tid >> 6), ngw = gridDim.x * 4;
    bf16* H = (bf16*)(p->ws + WS_H);
    const float* g = p->in[I_N2G] + l * D;
    const float* wg = p->in[I_WGRP] + (size_t)l * D * 4;
    const float* we = p->in[I_WEXP] + (size_t)l * D * 32;
    unsigned* cnt = (unsigned*)(p->ws + WS_CTL) + l * 32;
    int* list = (int*)(p->ws + WS_LIST);
    float* wt = (float*)(p->ws + WS_WT);
    const int nrows = (l == 0) ? NTOK : NL;
    for (int r = gw; r < nrows; r += ngw) {
        const float* x = x1row(p, r);
        const int mb = modrow(r);
        const float* sh = modv(p, l, mb, 3); const float* sc = modv(p, l, mb, 4);
        float4 v[4]; float ss = 0.f;
#pragma unroll
        for (int j = 0; j < 4; ++j) { v[j] = *(const float4*)(x + j * 256 + lane * 4); ss += v[j].x * v[j].x + v[j].y * v[j].y + v[j].z * v[j].z + v[j].w * v[j].w; }
        const float inv = rsqrtf(wave_sum(ss) * (1.f / D) + EPS);
        float hv[16];
#pragma unroll
        for (int j = 0; j < 4; ++j) {
            const int c = j * 256 + lane * 4;
            const float4 gg = *(const float4*)(g + c), s1 = *(const float4*)(sh + c), s2 = *(const float4*)(sc + c);
            hv[j * 4 + 0] = v[j].x * inv * gg.x * (1.f + s2.x) + s1.x; hv[j * 4 + 1] = v[j].y * inv * gg.y * (1.f + s2.y) + s1.y;
            hv[j * 4 + 2] = v[j].z * inv * gg.z * (1.f + s2.z) + s1.z; hv[j * 4 + 3] = v[j].w * inv * gg.w * (1.f + s2.w) + s1.w;
            st_bf4(H + (size_t)r * D + c, hv[j * 4], hv[j * 4 + 1], hv[j * 4 + 2], hv[j * 4 + 3]);
        }
        float lg[4];
#pragma unroll
        for (int o = 0; o < 4; ++o) {
            float a = 0.f;
#pragma unroll
            for (int j = 0; j < 4; ++j)
#pragma unroll
                for (int e = 0; e < 4; ++e) a += hv[j * 4 + e] * wg[(size_t)(j * 256 + lane * 4 + e) * 4 + o];
            lg[o] = wave_sum(a) + p->in[I_BGRP][l * 4 + o];
        }
        int grp = 0; float gmax = lg[0];
#pragma unroll
        for (int o = 1; o < 4; ++o) if (lg[o] > gmax) { gmax = lg[o]; grp = o; }
        float gden = 0.f;
#pragma unroll
        for (int o = 0; o < 4; ++o) gden += __expf(lg[o] - gmax);
        const float ptg = 1.f / gden;
        float le[8];
#pragma unroll
        for (int o = 0; o < 8; ++o) {
            float a = 0.f;
            const int col = grp * 8 + o;
#pragma unroll
            for (int j = 0; j < 4; ++j)
#pragma unroll
                for (int e = 0; e < 4; ++e) a += hv[j * 4 + e] * we[(size_t)(j * 256 + lane * 4 + e) * 32 + col];
            le[o] = wave_sum(a) + p->in[I_BEXP][l * 32 + col];
        }
        int i1 = 0; float m1 = le[0];
#pragma unroll
        for (int o = 1; o < 8; ++o) if (le[o] > m1) { m1 = le[o]; i1 = o; }
        int i2 = -1; float m2 = -3.0e38f;
#pragma unroll
        for (int o = 0; o < 8; ++o) if (o != i1 && le[o] > m2) { m2 = le[o]; i2 = o; }
        const float e2 = __expf(m2 - m1);
        const float w1 = ptg / (1.f + e2), w2 = ptg * e2 / (1.f + e2);
        if (lane == 0) {
            const int ea = grp * 8 + i1, eb = grp * 8 + i2;
            const unsigned pa = atomicAdd(&cnt[ea], 1u); list[(size_t)ea * NTOK + pa] = r * 2;
            const unsigned pb = atomicAdd(&cnt[eb], 1u); list[(size_t)eb * NTOK + pb] = r * 2 + 1;
            wt[r * 2] = w1; wt[r * 2 + 1] = w2;
        }
    }
}

__device__ void ph_convmoe(KParams p, int l, float* sm) {
    const int tid = tid_opaque();
    bf16* WGU = (bf16*)(p->ws + WS_WGU);
    bf16* WDT = (bf16*)(p->ws + WS_WDT);
    for (int it = blockIdx.x; it < 32 * 384; it += gridDim.x) {
        const int e = it / 384, r = it % 384, kind = r >> 7, q = r & 127;
        if (kind == 0)
            conv_tile(p->in[I_WGATE] + ((size_t)(l * 32 + e) * D) * 512, 512, 512, (q >> 3) * 64, (q & 7) * 64, WGU + (size_t)e * D * D, D,
                      [](int n) { return 32 * (n >> 4) + (n & 15); }, sm, tid);
        else if (kind == 1)
            conv_tile(p->in[I_WUP] + ((size_t)(l * 32 + e) * D) * 512, 512, 512, (q >> 3) * 64, (q & 7) * 64, WGU + (size_t)e * D * D, D,
                      [](int n) { return 32 * (n >> 4) + 16 + (n & 15); }, sm, tid);
        else
            conv_tile(p->in[I_WDOWN] + ((size_t)(l * 32 + e) * 512) * D, D, D, (q >> 4) * 64, (q & 15) * 64, WDT + (size_t)e * D * 512, 512,
                      [](int n) { return n; }, sm, tid);
    }
}

__device__ __forceinline__ void moe_tile_lookup(const unsigned* cnt, int trow, int& e, int& i0, int& ce) {
    int start = 0; e = 0; i0 = 0; ce = 0;
#pragma unroll 1
    for (int q = 0; q < 32; ++q) {
        const int c = (int)cnt[q], nt = (c + 127) >> 7;
        if (trow >= start && trow < start + nt) { e = q; i0 = (trow - start) * 128; ce = c; }
        start += nt;
    }
}
__device__ __forceinline__ int moe_ntiles(const unsigned* cnt) {
    int n = 0;
#pragma unroll 1
    for (int q = 0; q < 32; ++q) n += ((int)cnt[q] + 127) >> 7;
    return n;
}

__device__ void ph_moe1(KParams p, int l, unsigned char* lds) {
    const bf16* H = (const bf16*)(p->ws + WS_H);
    bf16* ACT = (bf16*)(p->ws + WS_ACT);
    const bf16* WGU = (const bf16*)(p->ws + WS_WGU);
    const unsigned* cnt = (const unsigned*)(p->ws + WS_CTL) + l * 32;
    const int* list = (const int*)(p->ws + WS_LIST);
    const int tid = tid_opaque(), lane = tid & 63, wid = tid >> 6, wr = wid >> 1, wc = wid & 1, fr = lane & 15, fq = lane >> 4;
    const int ntiles = moe_ntiles(cnt);
    for (int it = vblock(); it < ntiles * 8; it += gridDim.x) {
        const int trow = it >> 3, tn = it & 7;
        int e, i0, ce; moe_tile_lookup(cnt, trow, e, i0, ce);
        const int* le = list + (size_t)e * NTOK;
        const bf16* WT = WGU + (size_t)e * D * D;
        f32x4 acc[4][4]; zero_acc4(acc);
        gemm_tile(acc, [&](int r) { const int ii = min(i0 + r, ce - 1); return H + (size_t)(le[ii] >> 1) * D; },
                  [&](int r) { return WT + (size_t)(tn * 128 + r) * D; }, D, lds, tid);
#pragma unroll
        for (int i = 0; i < 4; ++i) {
            const int ii = i0 + wr * 64 + i * 16 + fr;
            if (ii < ce) {
                const int asg = le[ii];
#pragma unroll
                for (int jp = 0; jp < 2; ++jp) {
                    const f32x4 g = acc[i][2 * jp], u = acc[i][2 * jp + 1];
                    st_bf4(ACT + (size_t)asg * 512 + tn * 64 + wc * 32 + jp * 16 + fq * 4, silu_f(g[0]) * u[0], silu_f(g[1]) * u[1], silu_f(g[2]) * u[2], silu_f(g[3]) * u[3]);
                }
            }
        }
    }
}

__device__ void ph_moe2(KParams p, int l, unsigned char* lds) {
    const bf16* ACT = (const bf16*)(p->ws + WS_ACT);
    const bf16* WDT = (const bf16*)(p->ws + WS_WDT);
    const unsigned* cnt = (const unsigned*)(p->ws + WS_CTL) + l * 32;
    const int* list = (const int*)(p->ws + WS_LIST);
    const float* wt = (const float*)(p->ws + WS_WT);
    const int tid = tid_opaque(), lane = tid & 63, wid = tid >> 6, wr = wid >> 1, wc = wid & 1, fr = lane & 15, fq = lane >> 4;
    const int ntiles = moe_ntiles(cnt);
    for (int it = vblock(); it < ntiles * 8; it += gridDim.x) {
        const int trow = it >> 3, tn = it & 7;
        int e, i0, ce; moe_tile_lookup(cnt, trow, e, i0, ce);
        const int* le = list + (size_t)e * NTOK;
        const bf16* WT = WDT + (size_t)e * D * 512;
        f32x4 acc[4][4]; zero_acc4(acc);
        gemm_tile(acc, [&](int r) { const int ii = min(i0 + r, ce - 1); return ACT + (size_t)le[ii] * 512; },
                  [&](int r) { return WT + (size_t)(tn * 128 + r) * 512; }, 512, lds, tid);
#pragma unroll
        for (int i = 0; i < 4; ++i) {
            const int ii = i0 + wr * 64 + i * 16 + fr;
            if (ii < ce) {
                const int asg = le[ii], tok = asg >> 1;
                const float w = wt[asg];
                bf16* Y = (bf16*)(p->ws + ((asg & 1) ? WS_Y1 : WS_Y0));
#pragma unroll
                for (int j = 0; j < 4; ++j)
                    st_bf4(Y + (size_t)tok * D + tn * 128 + wc * 64 + j * 16 + fq * 4, w * acc[i][j][0], w * acc[i][j][1], w * acc[i][j][2], w * acc[i][j][3]);
            }
        }
    }
}

__device__ void ph_combine(KParams p, int l) {
    const int tid = tid_opaque(), lane = tid & 63, gw = blockIdx.x * 4 + (tid >> 6), ngw = gridDim.x * 4;
    const bf16* Y0 = (const bf16*)(p->ws + WS_Y0);
    const bf16* Y1 = (const bf16*)(p->ws + WS_Y1);
    const int nrows = (l == 0) ? NTOK : NL;
    for (int r = gw; r < nrows; r += ngw) {
        const float* x = x1row(p, r);
        float* xo = r < NL ? p->out + (size_t)r * D : (float*)(p->ws + WS_XC) + (size_t)(r - NL) * D;
        const float* g2 = modv(p, l, modrow(r), 5);
        float4 v[4]; float ss = 0.f;
#pragma unroll
        for (int j = 0; j < 4; ++j) {
            const int c = j * 256 + lane * 4;
            const float4 xv = *(const float4*)(x + c), gg = *(const float4*)(g2 + c);
            const float4 a = ld_bf4(Y0 + (size_t)r * D + c), b = ld_bf4(Y1 + (size_t)r * D + c);
            v[j] = make_float4(xv.x + gg.x * (a.x + b.x), xv.y + gg.y * (a.y + b.y), xv.z + gg.z * (a.z + b.z), xv.w + gg.w * (a.w + b.w));
            ss += v[j].x * v[j].x + v[j].y * v[j].y + v[j].z * v[j].z + v[j].w * v[j].w;
        }
        if (l == 0) {
#pragma unroll
            for (int j = 0; j < 4; ++j) *(float4*)(xo + j * 256 + lane * 4) = v[j];
        } else {
            const float inv = rsqrtf(wave_sum(ss) * (1.f / D) + EPS);
            const float* fg = p->in[I_FING];
#pragma unroll
            for (int j = 0; j < 4; ++j) {
                const int c = j * 256 + lane * 4;
                const float4 gg = *(const float4*)(fg + c);
                *(float4*)(xo + c) = make_float4(v[j].x * inv * gg.x, v[j].y * inv * gg.y, v[j].z * inv * gg.z, v[j].w * inv * gg.w);
            }
        }
    }
}

#define XB_TMO      128
#define XB_XCNT(j)  (256  + 64 * (j))
#define XB_XSUB(j)  (1280 + 64 * (j))
#define XB_XGEN(j)  (2304 + 64 * (j))
#define XB_TOP      3328
#define XB_TOPGEN   3392
#define XB_SPIN_CAP (1u << 22)
constexpr int CW_BAR = 4096;
__device__ __forceinline__ unsigned xb_ld(unsigned* p)              { return __hip_atomic_load(p, __ATOMIC_RELAXED, __HIP_MEMORY_SCOPE_AGENT); }
__device__ __forceinline__ unsigned xb_add(unsigned* p, unsigned v) { return __hip_atomic_fetch_add(p, v, __ATOMIC_RELAXED, __HIP_MEMORY_SCOPE_AGENT); }
__device__ __forceinline__ unsigned xb_xcc_id() { return (unsigned)__builtin_amdgcn_s_getreg((3 << 11) | 20) & 0xFu; }
#define XB_SPIN(cond, bar) do { unsigned _sp = 0; while (cond) { __builtin_amdgcn_s_sleep(1); \
    if ((++_sp & 255u) == 0u) { if (xb_ld(&(bar)[XB_TMO])) break; if (_sp > XB_SPIN_CAP) { atomicAdd(&(bar)[XB_TMO], 1u); break; } } } } while (0)
constexpr int LDS_BAR_OFF = 79 * 1024 + 16;
__device__ __forceinline__ void xcd_barrier_post(unsigned* bar) {
    if (threadIdx.x == 0) (void)xb_add(&bar[XB_XCNT(xb_xcc_id())], 1u);
}
__device__ __forceinline__ void xcd_barrier_census(unsigned* bar, volatile unsigned* st) {
    if (threadIdx.x == 0) {
        const unsigned x = xb_xcc_id();
        unsigned cnt = 0, mine = 0;
#pragma unroll
        for (unsigned j = 0; j < 16; ++j) { const unsigned c = xb_ld(&bar[XB_XCNT(j)]); cnt += (c > 0u) ? 1u : 0u; mine = (j == x) ? c : mine; }
        st[0] = mine > 0u ? mine : 1u; st[1] = cnt > 0u ? cnt : 1u;
    }
    __syncthreads();
}
__device__ __forceinline__ void xcd_barrier(KParams kp, unsigned char* lds) {
    asm volatile("s_waitcnt vmcnt(0)" ::: "memory");
    __syncthreads();
    if (threadIdx.x == 0) {
        unsigned* bar = (unsigned*)(kp->ws + WS_CTL) + CW_BAR;
        volatile unsigned* st = (volatile unsigned*)(lds + LDS_BAR_OFF);
        __builtin_amdgcn_s_waitcnt(0);
        const unsigned x = xb_xcc_id();
        const unsigned nloc = st[0], nx = st[1];
        const unsigned old = xb_add(&bar[XB_XSUB(x)], 1u);
        const unsigned gen = old / nloc;
        if (old + 1u == (gen + 1u) * nloc) {
            __builtin_amdgcn_fence(__ATOMIC_RELEASE, "agent");
            asm volatile("s_waitcnt vmcnt(0)" ::: "memory");
            const unsigned og = xb_add(&bar[XB_TOP], 1u);
            const unsigned tg = og / nx;
            if (og + 1u == (tg + 1u) * nx) xb_add(&bar[XB_TOPGEN], 1u);
            else XB_SPIN(xb_ld(&bar[XB_TOPGEN]) == tg, bar);
            __builtin_amdgcn_fence(__ATOMIC_ACQUIRE, "agent");
            xb_add(&bar[XB_XGEN(x)], 1u);
            asm volatile("s_waitcnt vmcnt(0)" ::: "memory");
        } else {
            XB_SPIN(xb_ld(&bar[XB_XGEN(x)]) == gen, bar);
            __builtin_amdgcn_fence(__ATOMIC_ACQUIRE, "agent");
            asm volatile("s_waitcnt vmcnt(0)" ::: "memory");
        }
    }
    __syncthreads();
}

constexpr int LDS_BYTES = 80 * 1024;
__global__ void __launch_bounds__(256, 2) mega_fwd(Params p_unused) {
    const KParams kp = (KParams)__builtin_amdgcn_kernarg_segment_ptr();
    extern __shared__ __attribute__((aligned(16))) unsigned char smem_raw[];
    float* sm = (float*)smem_raw;
    cg::grid_group grid = cg::this_grid();
    xcd_barrier_post((unsigned*)(kp->ws + WS_CTL) + CW_BAR);
    ph_init(fresh(kp), sm);
    grid.sync();
    xcd_barrier_census((unsigned*)(kp->ws + WS_CTL) + CW_BAR, (volatile unsigned*)(smem_raw + LDS_BAR_OFF));
#define GSYNC() xcd_barrier(fresh(kp), smem_raw)
#ifndef PROBE_DOUBLE
#define PROBE_DOUBLE 0
#endif
#pragma unroll 1
    for (int l = 0; l < 2; ++l) {
        ph_norm1(fresh(kp), l);             GSYNC();
        ph_gemm_in(fresh(kp), l, smem_raw); GSYNC();
#if PROBE_DOUBLE == 2
        ph_gemm_in(fresh(kp), l, smem_raw); GSYNC();
#endif
        ph_prep(fresh(kp), l, sm);          GSYNC();
        ph_mix(fresh(kp), l, smem_raw);     GSYNC();
        ph_ygla(fresh(kp), l);              GSYNC();
        ph_merge(fresh(kp), l, smem_raw);   GSYNC();
#if PROBE_DOUBLE == 6
        ph_merge(fresh(kp), l, smem_raw);   GSYNC();
#endif
        ph_outproj(fresh(kp), l, smem_raw); GSYNC();
        ph_router(fresh(kp), l);
        ph_convmoe(fresh(kp), l, sm);       GSYNC();
        ph_moe1(fresh(kp), l, smem_raw);    GSYNC();
        ph_moe2(fresh(kp), l, smem_raw);    GSYNC();
#if PROBE_DOUBLE == 4
        ph_moe1(fresh(kp), l, smem_raw);    GSYNC();
        ph_moe2(fresh(kp), l, smem_raw);    GSYNC();
#endif
        ph_combine(fresh(kp), l);           if (l == 0) GSYNC();
    }
}

extern "C" void kernel_launch(void* const* d_in, const int* in_sizes, int n_in, void* d_out, int out_size, void* d_ws, size_t ws_size,
                              hipStream_t stream) {
    if (n_in != 28 || ws_size < WS_END) { fprintf(stderr, "kernel_launch: bad n_in %d or ws_size %zu (< %zu)\n", n_in, ws_size, (size_t)WS_END); return; }
    static int grid_blocks = 0;
    if (!grid_blocks) {
        int dev = 0, cus = 0, per_cu = 0;
        (void)hipGetDevice(&dev);
        (void)hipDeviceGetAttribute(&cus, hipDeviceAttributeMultiprocessorCount, dev);
        (void)hipFuncSetAttribute((const void*)mega_fwd, hipFuncAttributeMaxDynamicSharedMemorySize, LDS_BYTES);
        (void)hipOccupancyMaxActiveBlocksPerMultiprocessor(&per_cu, (const void*)mega_fwd, 256, LDS_BYTES);
        if (per_cu < 1) per_cu = 1;
        grid_blocks = cus * per_cu;
        fprintf(stderr, "kernel_launch: cus %d per_cu %d grid %d ws_size %zu\n", cus, per_cu, grid_blocks, ws_size);
    }
    Params p{};
    for (int i = 0; i < 28; ++i) p.in[i] = (const float*)d_in[i];
    p.out = (float*)d_out; p.ws = (unsigned char*)d_ws;
    (void)hipMemsetAsync((char*)d_ws + WS_CTL, 0, 1 * MiB, stream);
    void* args[] = {&p};
    hipError_t e = hipLaunchCooperativeKernel((const void*)mega_fwd, dim3(grid_blocks), dim3(256), args, LDS_BYTES, stream);
    if (e != hipSuccess) fprintf(stderr, "cooperative launch failed: %s (grid %d)\n", hipGetErrorString(e), grid_blocks);
}
```

```cpp
#include <hip/hip_runtime.h>
#include <hip/hip_cooperative_groups.h>
namespace cg = cooperative_groups;
#include <cstdio>
#include <cstdint>

typedef unsigned short bf16;

constexpr int D = 1024, NB = 8, T = 4096, CL = 256, NL = NB * T, NC = NB * CL, NTOK = NL + NC;
constexpr int INW = 5920;
constexpr int O_GQ = 0, O_GK = 256, O_GV = 512, O_GR = 1024, O_AQ = 1536, O_AK = 2048, O_AV = 2176, O_PU = 2304, O_GT = 2816, O_GLF = 5888, O_GLB = 5904;
__host__ __device__ constexpr int win_nmap(int n) { return n < 1536 ? n : (n < 1568 ? n + 4352 : (n < 5920 ? n - 32 : n)); }
constexpr float EPS = 1e-6f;

constexpr size_t MiB = 1u << 20;
constexpr size_t WS_CTL = 0;
constexpr size_t WS_MODV = 1 * MiB;
constexpr size_t WS_ROPE = 1 * MiB + 512 * 1024;
constexpr size_t WS_WT = 2 * MiB;
constexpr size_t WS_LIST = 3 * MiB;
constexpr size_t WS_RWT = 7 * MiB + 256 * 1024;
constexpr size_t WS_XC = 8 * MiB;
constexpr size_t WS_H = 16 * MiB;
constexpr size_t WS_PROJ = 84 * MiB;
constexpr size_t WS_R2 = 478 * MiB;
constexpr size_t WS_WGU = WS_R2;
constexpr size_t WS_WDT = WS_R2 + 64 * MiB;
constexpr size_t WS_WSM = 580 * MiB;
constexpr size_t SZ_WINT = (size_t)6016 * 1024 * 2, SZ_WBT = (size_t)1024 * 512 * 2, SZ_WOUTT = (size_t)1024 * 1024 * 2;
constexpr size_t SZ_WSM_L = SZ_WINT + 3 * SZ_WBT + SZ_WOUTT;
constexpr size_t WS_VT = 614 * MiB;
constexpr int NKEY = T + CL;
constexpr size_t WS_END = 623 * MiB;
static_assert(WS_WSM + 2 * SZ_WSM_L <= WS_END, "ws map");
constexpr size_t SZ_Y512 = (size_t)NTOK * 512 * 2;
constexpr size_t WS_ACT = WS_PROJ;
constexpr size_t WS_Y0 = WS_PROJ + 68 * MiB;
constexpr size_t WS_Y1 = WS_PROJ + 136 * MiB;

struct Params {
    const float* in[28];
    float* out;
    unsigned char* ws;
};
typedef const __attribute__((address_space(4))) Params* KParams;
__device__ __forceinline__ KParams fresh(KParams k) { asm volatile("" : "+s"(k)); return k; }
enum { I_X = 0, I_C, I_CTX, I_CCTX, I_WMOD, I_BMOD, I_N1G, I_N2G, I_WIN, I_UPF, I_BIASF, I_UPB, I_BIASB, I_GLANG, I_QNG, I_KNG,
       I_POOLW, I_POOLS, I_WBR, I_WOUT, I_WGRP, I_BGRP, I_WEXP, I_BEXP, I_WGATE, I_WUP, I_WDOWN, I_FING };

__device__ __forceinline__ float bf2f(bf16 v) { return __uint_as_float(((unsigned)v) << 16); }
__device__ __forceinline__ bf16 f2bf(float f) { unsigned u = __float_as_uint(f); return (bf16)((u + 0x7fffu + ((u >> 16) & 1u)) >> 16); }
__device__ __forceinline__ float4 ld_bf4(const bf16* p) {
    uint2 u = *(const uint2*)p;
    return make_float4(__uint_as_float(u.x << 16), __uint_as_float(u.x & 0xffff0000u), __uint_as_float(u.y << 16), __uint_as_float(u.y & 0xffff0000u));
}
typedef float f32x2_t __attribute__((ext_vector_type(2)));
typedef __bf16 bf16x2_t __attribute__((ext_vector_type(2)));
__device__ __forceinline__ unsigned pk_bf16(float a, float b) { f32x2_t v = {a, b}; return __builtin_bit_cast(unsigned, __builtin_convertvector(v, bf16x2_t)); }
__device__ __forceinline__ void st_bf4(bf16* p, float a, float b, float c, float d) {
    uint2 u; u.x = pk_bf16(a, b); u.y = pk_bf16(c, d);
    *(uint2*)p = u;
}
__device__ __forceinline__ int tid_opaque() { int t = threadIdx.x; asm volatile("" : "+v"(t)); return t; }
#define DPP_ADD(v, ctrl) v += __builtin_bit_cast(float, __builtin_amdgcn_update_dpp(0, __builtin_bit_cast(int, v), (ctrl), 0xf, 0xf, true))
__device__ __forceinline__ float sum16(float v) {
    DPP_ADD(v, 0xB1);
    DPP_ADD(v, 0x4E);
    DPP_ADD(v, 0x141);
    DPP_ADD(v, 0x140);
    return v;
}
__device__ __forceinline__ float wave_sum(float v) {
#pragma unroll
    for (int o = 1; o < 64; o <<= 1) v += __shfl_xor(v, o);
    return v;
}
__device__ __forceinline__ float silu_f(float x) { return x / (1.f + __expf(-x)); }
__device__ __forceinline__ float sigmoid_f(float x) { return 1.f / (1.f + __expf(-x)); }
__device__ __forceinline__ int modrow(int r) { return r < NL ? r / T : 8; }
__device__ __forceinline__ const float* xrow(KParams p, int l, int r) {
    if (l == 0) return r < NL ? p->in[I_X] + (size_t)r * D : p->in[I_CTX] + (size_t)(r - NL) * D;
    return r < NL ? p->out + (size_t)r * D : (const float*)(p->ws + WS_XC) + (size_t)(r - NL) * D;
}
__device__ __forceinline__ const float* modv(KParams p, int l, int mb, int which) {
    return (const float*)(p->ws + WS_MODV) + ((size_t)(l * 9 + mb) * 6 + which) * D;
}

template <class AF, class BF>
__device__ __forceinline__ void gemm64(float (&acc)[4][4], int K, AF aload, BF bload, float* sA, float* sB, const int tid) {
    const int ty = tid >> 4, tx = tid & 15;
    const int am = tid >> 2, ak = (tid & 3) * 4;
    const int bk = tid >> 4, bn = (tid & 15) * 4;
    for (int k0 = 0; k0 < K; k0 += 16) {
        float4 av = aload(am, k0 + ak);
        float4 bv = bload(k0 + bk, bn);
        __syncthreads();
        sA[(ak + 0) * 68 + am] = av.x; sA[(ak + 1) * 68 + am] = av.y; sA[(ak + 2) * 68 + am] = av.z; sA[(ak + 3) * 68 + am] = av.w;
        *(float4*)&sB[bk * 64 + bn] = bv;
        __syncthreads();
#pragma unroll
        for (int kk = 0; kk < 16; ++kk) {
            float4 a = *(float4*)&sA[kk * 68 + ty * 4];
            float4 b = *(float4*)&sB[kk * 64 + tx * 4];
            float aa[4] = {a.x, a.y, a.z, a.w}, bb[4] = {b.x, b.y, b.z, b.w};
#pragma unroll
            for (int i = 0; i < 4; ++i)
#pragma unroll
                for (int j = 0; j < 4; ++j) acc[i][j] += aa[i] * bb[j];
        }
    }
    __syncthreads();
}
__device__ __forceinline__ void zero_acc(float (&acc)[4][4]) {
#pragma unroll
    for (int i = 0; i < 4; ++i)
#pragma unroll
        for (int j = 0; j < 4; ++j) acc[i][j] = 0.f;
}

typedef short bf16x8 __attribute__((ext_vector_type(8)));
typedef float f32x4 __attribute__((ext_vector_type(4)));
constexpr int GT_BYTES = 16384;
__device__ __forceinline__ void zero_acc4(f32x4 (&acc)[4][4]) {
#pragma unroll
    for (int i = 0; i < 4; ++i)
#pragma unroll
        for (int j = 0; j < 4; ++j) acc[i][j] = (f32x4){0.f, 0.f, 0.f, 0.f};
}
template <class FA, class FB>
__device__ __forceinline__ void gemm_tile(f32x4 (&acc)[4][4], FA arow, FB brow, int K, unsigned char* lds, const int tid) {
    const int lane = tid & 63, wid = tid >> 6, wr = wid >> 1, wc = wid & 1, fr = lane & 15, fq = lane >> 4;
    const int srow = tid >> 3, sc = ((tid & 7) ^ ((tid >> 4) & 7)) * 8;
    const bf16* ap[4]; const bf16* bp[4];
#pragma unroll
    for (int j = 0; j < 4; ++j) { ap[j] = arow(j * 32 + srow) + sc; bp[j] = brow(j * 32 + srow) + sc; }
    const int KT = K >> 6;
#pragma unroll
    for (int j = 0; j < 4; ++j) {
        __builtin_amdgcn_global_load_lds((const unsigned*)(ap[j]), (unsigned*)(lds + j * 4096 + tid * 16), 16, 0, 0);
        __builtin_amdgcn_global_load_lds((const unsigned*)(bp[j]), (unsigned*)(lds + GT_BYTES + j * 4096 + tid * 16), 16, 0, 0);
    }
#pragma unroll 1
    for (int kt = 0; kt < KT; ++kt) {
        asm volatile("s_waitcnt vmcnt(0)" ::: "memory");
        __syncthreads();
        if (kt + 1 < KT) {
            unsigned char* sa = lds + ((kt + 1) & 1) * 2 * GT_BYTES;
#pragma unroll
            for (int j = 0; j < 4; ++j) {
                __builtin_amdgcn_global_load_lds((const unsigned*)(ap[j] + (kt + 1) * 64), (unsigned*)(sa + j * 4096 + tid * 16), 16, 0, 0);
                __builtin_amdgcn_global_load_lds((const unsigned*)(bp[j] + (kt + 1) * 64), (unsigned*)(sa + GT_BYTES + j * 4096 + tid * 16), 16, 0, 0);
            }
        }
        const unsigned char* sa = lds + (kt & 1) * 2 * GT_BYTES;
        const unsigned char* sb = sa + GT_BYTES;
#pragma unroll
        for (int ks = 0; ks < 2; ++ks) {
            const int phys = ((ks * 4 + fq) ^ (fr >> 1)) * 16;
            bf16x8 af[4], bq[4];
#pragma unroll
            for (int i = 0; i < 4; ++i) af[i] = *(const bf16x8*)(sa + (wr * 64 + i * 16 + fr) * 128 + phys);
#pragma unroll
            for (int j = 0; j < 4; ++j) bq[j] = *(const bf16x8*)(sb + (wc * 64 + j * 16 + fr) * 128 + phys);
#pragma unroll
            for (int i = 0; i < 4; ++i)
#pragma unroll
                for (int j = 0; j < 4; ++j) acc[i][j] = __builtin_amdgcn_mfma_f32_16x16x32_bf16(bq[j], af[i], acc[i][j], 0, 0, 0);
        }
    }
}
__device__ __forceinline__ void tile_coords(int it, int nM, int nN, int& tm, int& tn) {
    const int GM = 8, per = GM * nN, grp = it / per, fm = grp * GM, gsz = min(nM - fm, GM), rem = it - grp * per;
    tm = fm + rem % gsz; tn = rem / gsz;
}
__device__ __forceinline__ int vblock() { const int G = gridDim.x, b = blockIdx.x; return (G & 7) == 0 ? (b & 7) * (G >> 3) + (b >> 3) : b; }

template <class NMap>
__device__ __forceinline__ void conv_tile(const float* src, int ldsrc, int nvalid, int k0, int n0, bf16* dst, int lddst, NMap nmap, float* sm, const int tid) {
    __syncthreads();
    {
        const int k = tid >> 2, nq = (tid & 3) * 16;
#pragma unroll
        for (int q = 0; q < 4; ++q) {
            const int n = n0 + nq + q * 4;
            const float4 v = (n < nvalid) ? *(const float4*)(src + (size_t)(k0 + k) * ldsrc + n) : make_float4(0.f, 0.f, 0.f, 0.f);
            float* d = sm + k * 65 + nq + q * 4; d[0] = v.x; d[1] = v.y; d[2] = v.z; d[3] = v.w;
        }
    }
    __syncthreads();
    {
        const int n = tid >> 2, kq = (tid & 3) * 16;
        unsigned w[8];
#pragma unroll
        for (int i = 0; i < 8; ++i) w[i] = (unsigned)f2bf(sm[(kq + 2 * i) * 65 + n]) | ((unsigned)f2bf(sm[(kq + 2 * i + 1) * 65 + n]) << 16);
        bf16* d = dst + (size_t)nmap(n0 + n) * lddst + k0 + kq;
        *(uint4*)d = make_uint4(w[0], w[1], w[2], w[3]);
        *(uint4*)(d + 8) = make_uint4(w[4], w[5], w[6], w[7]);
    }
}
__device__ __forceinline__ bf16* wsm_int(KParams p, int l) { return (bf16*)(p->ws + WS_WSM + (size_t)l * SZ_WSM_L); }
__device__ __forceinline__ bf16* wsm_bt(KParams p, int l, int br) { return (bf16*)(p->ws + WS_WSM + (size_t)l * SZ_WSM_L + SZ_WINT + (size_t)br * SZ_WBT); }
__device__ __forceinline__ bf16* wsm_outt(KParams p, int l) { return (bf16*)(p->ws + WS_WSM + (size_t)l * SZ_WSM_L + SZ_WINT + 3 * SZ_WBT); }

__device__ void ph_init(KParams p, float* sm) {
    const int tid = tid_opaque();
    for (int it = blockIdx.x; it < 49 + 2 * 2144 + 72; it += gridDim.x) {
        if (it >= 49 + 2 * 2144) {
            const int q = it - (49 + 2 * 2144), l = q / 36, o = q % 36;
            float* dst = (float*)(p->ws + WS_RWT) + (size_t)(l * 36 + o) * D;
            for (int k = tid; k < D; k += 256) dst[k] = o < 4 ? p->in[I_WGRP][((size_t)l * D + k) * 4 + o] : p->in[I_WEXP][((size_t)l * D + k) * 32 + (o - 4)];
            continue;
        }
        if (it >= 49) {
            const int l = (it - 49) / 2144; int r = (it - 49) % 2144;
            if (r < 1504) { conv_tile(p->in[I_WIN] + (size_t)l * D * INW, INW, INW, (r / 94) * 64, (r % 94) * 64, wsm_int(p, l), D, [](int n) { return win_nmap(n); }, sm, tid); continue; }
            r -= 1504;
            if (r < 256) { const int br = r >> 7, q = r & 127;
                conv_tile(p->in[I_WBR] + ((size_t)(l * 3 + br) * 512) * D, D, D, (q >> 4) * 64, (q & 15) * 64, wsm_bt(p, l, br), 512, [](int n) { return n; }, sm, tid); continue; }
            r -= 256;
            if (r < 256) { conv_tile(p->in[I_WOUT] + (size_t)l * D * D, D, D, (r >> 4) * 64, (r & 15) * 64, wsm_outt(p, l), D, [](int n) { return n; }, sm, tid); continue; }
            r -= 256;
            {
                const int m0 = (r >> 4) * 64, n0 = (r & 15) * 64, g = m0 >> 7;
                const float* PW = p->in[I_POOLW] + ((size_t)(l * 4 + g) * 128) * 128;
                const float* PS = p->in[I_POOLS] + l * 512 + g * 128;
                const float* WB = p->in[I_WBR] + ((size_t)(l * 3 + 2) * 512 + g * 128) * D;
                float acc[4][4]; zero_acc(acc);
                gemm64(acc, 128,
                       [&](int m, int k) { const float4 a = *(const float4*)(PW + (size_t)((m0 + m) & 127) * 128 + k); const float4 sc = *(const float4*)(PS + k);
                                           return make_float4(a.x * sc.x, a.y * sc.y, a.z * sc.z, a.w * sc.w); },
                       [&](int k, int n) { return *(const float4*)(WB + (size_t)k * D + n0 + n); }, sm, sm + 16 * 68, tid);
                const int ty = tid >> 4, tx = tid & 15;
                bf16* dst = wsm_bt(p, l, 2);
#pragma unroll
                for (int j = 0; j < 4; ++j) st_bf4(dst + (size_t)(n0 + tx * 4 + j) * 512 + m0 + ty * 4, acc[0][j], acc[1][j], acc[2][j], acc[3][j]);
            }
            continue;
        }
        if (it == 48) {
            float2* rope = (float2*)(p->ws + WS_ROPE);
            for (int e = tid; e < 64 * 16; e += 256) {
                const int pos = e >> 4, i = e & 15;
                const float invf = powf(10000.0f, -(float)(2 * i) / 32.0f);
                const float angf = (float)pos * invf;
                const double ang = (double)angf;
                const double twopi = 6.283185307179586476925286766559;
                const double n = rint(ang / twopi);
                const double r = ang - n * twopi, r2 = r * r;
                double s = 1.0, c = 1.0;
                for (int q = 14; q >= 1; --q) { s = 1.0 - r2 / (double)((2 * q) * (2 * q + 1)) * s; c = 1.0 - r2 / (double)((2 * q - 1) * (2 * q)) * c; }
                s *= r;
                rope[e] = make_float2((float)c, (float)s);
            }
            continue;
        }
        const int l = it / 24, cb = it % 24;
        __syncthreads();
        for (int e = tid; e < 9 * D; e += 256) {
            const int mb = e / D, k = e % D;
            const float v = mb < 8 ? p->in[I_C][mb * D + k] : p->in[I_CCTX][k];
            sm[e] = silu_f(v);
        }
        __syncthreads();
        const int col = cb * 256 + tid;
        const float* w = p->in[I_WMOD] + (size_t)l * D * 6144 + col;
        float acc[9];
#pragma unroll
        for (int m = 0; m < 9; ++m) acc[m] = 0.f;
#pragma unroll 4
        for (int k = 0; k < D; ++k) {
            const float wv = w[(size_t)k * 6144];
#pragma unroll
            for (int m = 0; m < 9; ++m) acc[m] += sm[m * D + k] * wv;
        }
        const float bias = p->in[I_BMOD][l * 6144 + col];
        float* mv = (float*)(p->ws + WS_MODV);
#pragma unroll
        for (int m = 0; m < 9; ++m) mv[(size_t)(l * 9 + m) * 6144 + col] = acc[m] + bias;
    }
}

__device__ void ph_norm1(KParams p, int l) {
    const int tid = tid_opaque(), lane = tid & 63, gw = blockIdx.x * 4 + (tid >> 6), ngw = gridDim.x * 4;
    bf16* H = (bf16*)(p->ws + WS_H);
    const float* g = p->in[I_N1G] + l * D;
    for (int r = gw; r < NTOK; r += ngw) {
        const float* x = xrow(p, l, r);
        const int mb = modrow(r);
        const float* sh = modv(p, l, mb, 0); const float* sc = modv(p, l, mb, 1);
        float4 v[4]; float ss = 0.f;
#pragma unroll
        for (int j = 0; j < 4; ++j) { v[j] = *(const float4*)(x + j * 256 + lane * 4); ss += v[j].x * v[j].x + v[j].y * v[j].y + v[j].z * v[j].z + v[j].w * v[j].w; }
        const float inv = rsqrtf(wave_sum(ss) * (1.f / D) + EPS);
#pragma unroll
        for (int j = 0; j < 4; ++j) {
            const int c = j * 256 + lane * 4;
            const float4 gg = *(const float4*)(g + c), s1 = *(const float4*)(sh + c), s2 = *(const float4*)(sc + c);
            st_bf4(H + (size_t)r * D + c, v[j].x * inv * gg.x * (1.f + s2.x) + s1.x, v[j].y * inv * gg.y * (1.f + s2.y) + s1.y,
                   v[j].z * inv * gg.z * (1.f + s2.z) + s1.z, v[j].w * inv * gg.w * (1.f + s2.w) + s1.w);
        }
    }
}

__device__ void ph_gemm_in(KParams p, int l, unsigned char* lds) {
    const bf16* H = (const bf16*)(p->ws + WS_H);
    bf16* PROJ = (bf16*)(p->ws + WS_PROJ);
    const bf16* WT = wsm_int(p, l);
    const float2* rope = (const float2*)(p->ws + WS_ROPE);
    const int nN = 47, nM = NTOK / 128;
    const int tid = tid_opaque(), lane = tid & 63, wid = tid >> 6, wr = wid >> 1, wc = wid & 1, fr = lane & 15, fq = lane >> 4;
    for (int it = vblock(); it < nM * nN; it += gridDim.x) {
        int tm, tn; tile_coords(it, nM, nN, tm, tn);
        f32x4 acc[4][4]; zero_acc4(acc);
        gemm_tile(acc, [&](int r) { return H + (size_t)(tm * 128 + r) * D; }, [&](int r) { return WT + (size_t)(tn * 128 + r) * D; }, D, lds, tid);
        if (tn >= 12 && tn <= 16) {
            const bool isq = tn < 16;
            const float* gsrc = p->in[isq ? I_QNG : I_KNG] + l * 64 + fq * 4;
            float4 g[4];
#pragma unroll
            for (int j = 0; j < 4; ++j) g[j] = *(const float4*)(gsrc + j * 16);
            const float qs = isq ? 0.125f * 1.4426950408889634f : 1.f;
#pragma unroll
            for (int i = 0; i < 4; ++i) {
                float ss = 0.f;
#pragma unroll
                for (int j = 0; j < 4; ++j) ss += acc[i][j][0] * acc[i][j][0] + acc[i][j][1] * acc[i][j][1] + acc[i][j][2] * acc[i][j][2] + acc[i][j][3] * acc[i][j][3];
                ss += __shfl_xor(ss, 16); ss += __shfl_xor(ss, 32);
                const float inv = rsqrtf(ss * (1.f / 64.f) + EPS);
                const int row = tm * 128 + wr * 64 + i * 16 + fr;
                f32x4 v[4];
#pragma unroll
                for (int j = 0; j < 4; ++j) { v[j][0] = acc[i][j][0] * inv * g[j].x; v[j][1] = acc[i][j][1] * inv * g[j].y; v[j][2] = acc[i][j][2] * inv * g[j].z; v[j][3] = acc[i][j][3] * inv * g[j].w; }
                if (row < NL) {
                    const int t = row & (T - 1), prow = t >> 6, pcol = t & 63;
#pragma unroll
                    for (int e = 0; e < 4; ++e) {
                        const float2 a = rope[prow * 16 + fq * 4 + e], b2 = rope[pcol * 16 + fq * 4 + e];
                        const float x1 = v[0][e], x2 = v[1][e], y1 = v[2][e], y2 = v[3][e];
                        v[0][e] = x1 * a.x - x2 * a.y; v[1][e] = x1 * a.y + x2 * a.x;
                        v[2][e] = y1 * b2.x - y2 * b2.y; v[3][e] = y1 * b2.y + y2 * b2.x;
                    }
                }
#pragma unroll
                for (int j = 0; j < 4; ++j)
                    st_bf4(PROJ + (size_t)row * INW + tn * 128 + wc * 64 + j * 16 + fq * 4, v[j][0] * qs, v[j][1] * qs, v[j][2] * qs, v[j][3] * qs);
            }
        } else {
#pragma unroll
            for (int i = 0; i < 4; ++i)
#pragma unroll
                for (int j = 0; j < 4; ++j) {
                    const int row = tm * 128 + wr * 64 + i * 16 + fr, col = tn * 128 + wc * 64 + j * 16 + fq * 4;
                    if (col < INW) st_bf4(PROJ + (size_t)row * INW + col, acc[i][j][0], acc[i][j][1], acc[i][j][2], acc[i][j][3]);
                }
        }
    }
}

__device__ void ph_prep(KParams p, int l, float* smf) {
    const int tid = tid_opaque();
    bf16* PROJ = (bf16*)(p->ws + WS_PROJ);
    {
        bf16* DP = (bf16*)(p->ws + WS_R2 + 2 * SZ_Y512);
        const int lane = tid & 63, gw = blockIdx.x * 4 + (tid >> 6), ngw = gridDim.x * 4;
        const int ch = lane * 8, hw = 1 << (lane >> 4);
        const int nrows = (l == 0) ? NTOK : NL;
        for (int r = gw; r < nrows; r += ngw) {
            int t, tl;
            if (r < NL) { t = r & (T - 1); tl = T; } else { t = (r - NL) & (CL - 1); tl = CL; }
            const bf16* src = PROJ + (size_t)r * INW + O_PU + ch;
            const int lo = max(t - hw, 0), hi = min(t + hw, tl);
            uint4 nb[16];
#pragma unroll
            for (int u = 0; u < 16; ++u) {
                const int tt = t - 8 + u;
                nb[u] = (tt >= lo && tt < hi) ? *(const uint4*)(src + (long)(u - 8) * INW) : make_uint4(0u, 0u, 0u, 0u);
            }
            float sacc[8] = {0.f, 0.f, 0.f, 0.f, 0.f, 0.f, 0.f, 0.f};
#pragma unroll
            for (int u = 0; u < 16; ++u) {
                const unsigned w[4] = {nb[u].x, nb[u].y, nb[u].z, nb[u].w};
#pragma unroll
                for (int q = 0; q < 4; ++q) { sacc[2 * q] += __uint_as_float(w[q] << 16); sacc[2 * q + 1] += __uint_as_float(w[q] & 0xffff0000u); }
            }
            const float inv = 1.f / (float)(hi - lo);
            const uint4 cc = nb[8];
            const unsigned cw[4] = {cc.x, cc.y, cc.z, cc.w};
            unsigned o[4];
#pragma unroll
            for (int q = 0; q < 4; ++q) o[q] = pk_bf16(sacc[2 * q] * inv - __uint_as_float(cw[q] << 16), sacc[2 * q + 1] * inv - __uint_as_float(cw[q] & 0xffff0000u));
            *(uint4*)(DP + (size_t)r * 512 + ch) = make_uint4(o[0], o[1], o[2], o[3]);
        }
    }
    {
        bf16* VT = (bf16*)(p->ws + WS_VT);
        unsigned short* st = (unsigned short*)smf;
        for (int it = blockIdx.x; it < (NTOK / 64) * 2; it += gridDim.x) {
            const int rt = it >> 1, kvh = it & 1;
            int b, key0;
            if (rt < NL / 64) { b = rt / 64; key0 = (rt % 64) * 64; } else { const int j = rt - NL / 64; b = j / 4; key0 = T + (j % 4) * 64; }
            __syncthreads();
            {
                const int k = tid >> 2, dq = (tid & 3) * 16;
                const bf16* src = PROJ + (size_t)(rt * 64 + k) * INW + O_AV + kvh * 64 + dq;
                const uint4 a = *(const uint4*)src, c = *(const uint4*)(src + 8);
                unsigned* d = (unsigned*)(st + k * 66 + dq);
                d[0] = a.x; d[1] = a.y; d[2] = a.z; d[3] = a.w; d[4] = c.x; d[5] = c.y; d[6] = c.z; d[7] = c.w;
            }
            __syncthreads();
            {
                const int d = tid >> 2, kq = (tid & 3) * 16;
                unsigned w[8];
#pragma unroll
                for (int i = 0; i < 8; ++i) w[i] = (unsigned)st[(kq + 2 * i) * 66 + d] | ((unsigned)st[(kq + 2 * i + 1) * 66 + d] << 16);
                bf16* dst = VT + ((size_t)(b * 2 + kvh) * 64 + d) * NKEY + key0 + kq;
                *(uint4*)dst = make_uint4(w[0], w[1], w[2], w[3]);
                *(uint4*)(dst + 8) = make_uint4(w[4], w[5], w[6], w[7]);
            }
        }
    }
}

typedef float f32x16 __attribute__((ext_vector_type(16)));
typedef short s16x4 __attribute__((ext_vector_type(4)));
#define MFMA32(a, b, c) __builtin_amdgcn_mfma_f32_32x32x16_bf16((a), (b), (c), 0, 0, 0)
__device__ __forceinline__ bf16x8 pack8(const f32x16& x, int s) {
    typedef unsigned u32x4_t __attribute__((ext_vector_type(4)));
    u32x4_t r;
    r[0] = pk_bf16(x[8 * s + 0], x[8 * s + 1]); r[1] = pk_bf16(x[8 * s + 2], x[8 * s + 3]);
    r[2] = pk_bf16(x[8 * s + 4], x[8 * s + 5]); r[3] = pk_bf16(x[8 * s + 6], x[8 * s + 7]);
    return __builtin_bit_cast(bf16x8, r);
}
__device__ __forceinline__ void attn_item(KParams p, int l, int it, unsigned char* lds, const int tid_) {
    const int tid = tid_opaque();
    const int lane = tid & 63, wid = tid >> 6, r32 = lane & 31, h = lane >> 5;
    bf16* PROJ = (bf16*)(p->ws + WS_PROJ);
    const bf16* VT = (const bf16*)(p->ws + WS_VT);
    float mq = 0.f, mk = 0.f;
    for (int d = 0; d < 64; ++d) { mq = fmaxf(mq, fabsf(p->in[I_QNG][l * 64 + d])); mk = fmaxf(mk, fabsf(p->in[I_KNG][l * 64 + d])); }
    const float shift2 = 8.f * mq * mk * 1.4426950408889634f;
    const int srow = tid >> 3, sc = ((tid & 7) ^ ((tid >> 4) & 7)) * 8, sw = (r32 >> 1) & 7;
    const int nlat = NB * 8 * 16;
    {
        int b, head, qrow0, nkt, vkey0;
        const bool lat = it < nlat;
        if (lat) { b = it >> 7; head = (it >> 4) & 7; qrow0 = b * T + (it & 15) * 256; nkt = 68; vkey0 = 0; }
        else { const int j = it - nlat; b = j >> 3; head = j & 7; qrow0 = NL + b * CL; nkt = 4; vkey0 = T; }
        const int kvh = head >> 2;
        bf16x8 qf[2][4];
#pragma unroll
        for (int qb = 0; qb < 2; ++qb)
#pragma unroll
            for (int ks = 0; ks < 4; ++ks)
                qf[qb][ks] = *(const bf16x8*)(PROJ + (size_t)(qrow0 + wid * 64 + qb * 32 + r32) * INW + O_AQ + head * 64 + ks * 16 + h * 8);
        const bf16* vsrc[2];
#pragma unroll
        for (int j = 0; j < 2; ++j) vsrc[j] = VT + ((size_t)(b * 2 + kvh) * 64 + j * 32 + srow) * NKEY + vkey0 + sc;
        const bf16* kbase = PROJ + O_AK + kvh * 64 + sc;
        auto krow = [&](int kt, int r) { return lat ? (kt < 64 ? b * T + kt * 64 + r : NL + b * CL + (kt - 64) * 64 + r) : NL + b * CL + kt * 64 + r; };
        auto stage = [&](int kt, int buf) {
            unsigned char* base = lds + buf * 16384;
#pragma unroll
            for (int j = 0; j < 2; ++j) {
                __builtin_amdgcn_global_load_lds((const unsigned*)(kbase + (size_t)krow(kt, j * 32 + srow) * INW), (unsigned*)(base + j * 4096 + tid * 16), 16, 0, 0);
                __builtin_amdgcn_global_load_lds((const unsigned*)(vsrc[j] + kt * 64), (unsigned*)(base + 8192 + j * 4096 + tid * 16), 16, 0, 0);
            }
        };
        f32x16 o[2][2];
#pragma unroll
        for (int a = 0; a < 2; ++a)
#pragma unroll
            for (int c = 0; c < 2; ++c)
#pragma unroll
                for (int e = 0; e < 16; ++e) o[a][c][e] = 0.f;
        float l0 = 0.f, l1 = 0.f;
        stage(0, 0);
#pragma unroll 1
        for (int kt = 0; kt < nkt; ++kt) {
            asm volatile("s_waitcnt vmcnt(0)" ::: "memory");
            __syncthreads();
            if (kt + 1 < nkt) stage(kt + 1, (kt + 1) & 1);
            const unsigned char* kb_ = lds + (kt & 1) * 16384;
            const unsigned char* vb_ = kb_ + 8192;
#pragma unroll
            for (int kb = 0; kb < 2; ++kb) {
                f32x16 s0, s1;
#pragma unroll
                for (int e = 0; e < 16; ++e) { s0[e] = 0.f; s1[e] = 0.f; }
#pragma unroll
                for (int ks = 0; ks < 4; ++ks) {
                    const bf16x8 kf = *(const bf16x8*)(kb_ + (kb * 32 + r32) * 128 + (((2 * ks + h) ^ sw) * 16));
                    s0 = MFMA32(kf, qf[0][ks], s0);
                    s1 = MFMA32(kf, qf[1][ks], s1);
                }
#pragma unroll
                for (int e = 0; e < 16; ++e) {
                    s0[e] = __builtin_amdgcn_exp2f(s0[e] - shift2); l0 += s0[e];
                    s1[e] = __builtin_amdgcn_exp2f(s1[e] - shift2); l1 += s1[e];
                }
#pragma unroll
                for (int s2 = 0; s2 < 2; ++s2) {
                    const bf16x8 p0 = pack8(s0, s2), p1 = pack8(s1, s2);
                    const int ksv = kb * 2 + s2;
#pragma unroll
                    for (int db = 0; db < 2; ++db) {
                        const unsigned char* vr = vb_ + (db * 32 + r32) * 128 + 8 * h;
                        const s16x4 lo = *(const s16x4*)(vr + (((2 * ksv) ^ sw) * 16));
                        const s16x4 hi = *(const s16x4*)(vr + (((2 * ksv + 1) ^ sw) * 16));
                        const bf16x8 vf = __builtin_shufflevector(lo, hi, 0, 1, 2, 3, 4, 5, 6, 7);
                        o[db][0] = MFMA32(vf, p0, o[db][0]);
                        o[db][1] = MFMA32(vf, p1, o[db][1]);
                    }
                }
            }
        }
        l0 += __shfl_xor(l0, 32); l1 += __shfl_xor(l1, 32);
        const float i0 = 1.f / l0, i1 = 1.f / l1;
#pragma unroll
        for (int qb = 0; qb < 2; ++qb) {
            const float inv = qb ? i1 : i0;
            bf16* orow = PROJ + (size_t)(qrow0 + wid * 64 + qb * 32 + r32) * INW + O_AQ + head * 64;
#pragma unroll
            for (int db = 0; db < 2; ++db)
#pragma unroll
                for (int g = 0; g < 4; ++g)
                    st_bf4(orow + db * 32 + 8 * g + 4 * h, o[db][qb][4 * g] * inv, o[db][qb][4 * g + 1] * inv, o[db][qb][4 * g + 2] * inv, o[db][qb][4 * g + 3] * inv);
        }
    }
}

constexpr int GL_QS = 0, GL_KS = 8192, GL_KDT = 16384, GL_VT = 24576, GL_GLS = 40960, GL_TOT = 45056, GL_FIRST = 47104, GL_EBREF = 47360, GL_EBLAST = 47616,
              GL_RAWQ = 47872, GL_RAWK = 56064, GL_RAWV = 64256;
__device__ __forceinline__ int swz(int row, int byte) { return row * 128 + ((((byte >> 4) ^ (row >> 1)) & 7) << 4) + (byte & 15); }
__device__ __forceinline__ void gla_task(KParams p, int l, int task, unsigned char* lds, const int tid_) {
    const int tid = tid_opaque();
    const int lane = tid & 63, w = tid >> 6, r32 = lane & 31, h = lane >> 5;
    const int b = task >> 3, hd = (task >> 1) & 3, dir = task & 1;
    const bf16* PROJ = (const bf16*)(p->ws + WS_PROJ);
    bf16* OG = (bf16*)(p->ws + WS_R2 + (size_t)dir * SZ_Y512);
    const float* up = p->in[dir ? I_UPB : I_UPF] + (size_t)l * 16 * 256 + hd * 64;
    const float* bias = p->in[dir ? I_BIASB : I_BIASF] + l * 256 + hd * 64;
    const int ogl = dir ? O_GLB : O_GLF;
    const int dk2 = (tid & 31) * 2, seg = tid >> 5;
    const int dv2 = (tid & 63) * 2, vq = tid >> 6;
    const float2 bia = *(const float2*)(bias + dk2);
    f32x16 S[2];
#pragma unroll
    for (int e = 0; e < 16; ++e) { S[0][e] = 0.f; S[1][e] = 0.f; }
    auto chunk_base = [&](int n) { return n < 4 ? NL + b * CL + (dir ? 3 - n : n) * 64 : b * T + (dir ? 63 - (n - 4) : (n - 4)) * 64; };
    auto prefetch = [&](int n) {
        const int base = chunk_base(n);
#pragma unroll
        for (int j = 0; j < 2; ++j) {
            const int i = j * 32 + (tid >> 3); const size_t tok = dir ? base + 63 - i : base + i;
            __builtin_amdgcn_global_load_lds((const unsigned*)(PROJ + tok * INW + O_GQ + hd * 64 + (tid & 7) * 8), (unsigned*)(lds + GL_RAWQ + j * 4096 + tid * 16), 16, 0, 0);
            __builtin_amdgcn_global_load_lds((const unsigned*)(PROJ + tok * INW + O_GK + hd * 64 + (tid & 7) * 8), (unsigned*)(lds + GL_RAWK + j * 4096 + tid * 16), 16, 0, 0);
        }
#pragma unroll
        for (int j = 0; j < 4; ++j) {
            const int i = j * 16 + (tid >> 4); const size_t tok = dir ? base + 63 - i : base + i;
            __builtin_amdgcn_global_load_lds((const unsigned*)(PROJ + tok * INW + O_GV + hd * 128 + (tid & 15) * 8), (unsigned*)(lds + GL_RAWV + j * 4096 + tid * 16), 16, 0, 0);
        }
        if (tid < 128) {
            const int i = tid >> 1; const size_t tok = dir ? base + 63 - i : base + i;
            __builtin_amdgcn_global_load_lds((const unsigned*)(PROJ + tok * INW + ogl + (tid & 1) * 8), (unsigned*)(lds + GL_GLS + tid * 16), 16, 0, 0);
        }
    };
    __syncthreads();
    prefetch(0);
#pragma unroll 1
    for (int n = 0; n < 68; ++n) {
        const int base = chunk_base(n);
        asm volatile("s_waitcnt vmcnt(0)" ::: "memory");
        __syncthreads();
        float la0[8], la1[8];
        {
            float up0[16], up1[16];
#pragma unroll
            for (int j = 0; j < 16; ++j) { const float2 t = *(const float2*)(up + j * 256 + dk2); up0[j] = t.x; up1[j] = t.y; }
            const unsigned char* gls = lds + GL_GLS;
#pragma unroll
            for (int u = 0; u < 8; ++u) {
                const int i = seg * 8 + u;
                const uint4 g0 = *(const uint4*)(gls + i * 32), g1 = *(const uint4*)(gls + i * 32 + 16);
                const unsigned gw[8] = {g0.x, g0.y, g0.z, g0.w, g1.x, g1.y, g1.z, g1.w};
                float a0 = bia.x, a1 = bia.y;
#pragma unroll
                for (int j = 0; j < 8; ++j) {
                    const float glo = __uint_as_float(gw[j] << 16), ghi = __uint_as_float(gw[j] & 0xffff0000u);
                    a0 += glo * up0[2 * j]; a1 += glo * up1[2 * j];
                    a0 += ghi * up0[2 * j + 1]; a1 += ghi * up1[2 * j + 1];
                }
                la0[u] = (fminf(a0, 0.f) - __logf(1.f + __expf(-fabsf(a0)))) * (1.f / 16.f);
                la1[u] = (fminf(a1, 0.f) - __logf(1.f + __expf(-fabsf(a1)))) * (1.f / 16.f);
            }
#pragma unroll
            for (int u = 1; u < 8; ++u) { la0[u] += la0[u - 1]; la1[u] += la1[u - 1]; }
            *(float2*)(lds + GL_TOT + (seg * 64 + dk2) * 4) = make_float2(la0[7], la1[7]);
            if (seg == 4) *(float2*)(lds + GL_FIRST + dk2 * 4) = make_float2(la0[0], la1[0]);
        }
        __syncthreads();
        {
            float off0 = 0.f, off1 = 0.f, pre0 = 0.f, pre1 = 0.f, all0 = 0.f, all1 = 0.f;
#pragma unroll
            for (int sg = 0; sg < 8; ++sg) {
                const float2 t = *(const float2*)(lds + GL_TOT + (sg * 64 + dk2) * 4);
                if (sg < seg) { off0 += t.x; off1 += t.y; }
                if (sg < 4) { pre0 += t.x; pre1 += t.y; }
                all0 += t.x; all1 += t.y;
            }
            const float2 f4 = *(const float2*)(lds + GL_FIRST + dk2 * 4);
            const float bref0 = pre0 + f4.x, bref1 = pre1 + f4.y;
            const float c0 = __expf(all0 - bref0), c1 = __expf(all1 - bref1);
            unsigned kd0[4], kd1[4];
#pragma unroll
            for (int u = 0; u < 8; u += 2) {
                float kdv[2][2];
#pragma unroll
                for (int uu = 0; uu < 2; ++uu) {
                    const int i = seg * 8 + u + uu;
                    const float e0 = __expf(off0 + la0[u + uu] - bref0), e1 = __expf(off1 + la1[u + uu] - bref1);
                    const float r0 = __builtin_amdgcn_rcpf(e0), r1 = __builtin_amdgcn_rcpf(e1);
                    const unsigned rqv = *(const unsigned*)(lds + GL_RAWQ + i * 128 + dk2 * 2), rkv = *(const unsigned*)(lds + GL_RAWK + i * 128 + dk2 * 2);
                    const float q0 = __uint_as_float(rqv << 16), q1 = __uint_as_float(rqv & 0xffff0000u);
                    const float k0 = __uint_as_float(rkv << 16), k1 = __uint_as_float(rkv & 0xffff0000u);
                    const float ks0 = k0 * r0, ks1 = k1 * r1;
                    *(unsigned*)(lds + GL_QS + swz(i, dk2 * 2)) = pk_bf16(q0 * 0.125f * e0, q1 * 0.125f * e1);
                    *(unsigned*)(lds + GL_KS + swz(i, dk2 * 2)) = pk_bf16(ks0, ks1);
                    kdv[uu][0] = ks0 * c0; kdv[uu][1] = ks1 * c1;
                }
                kd0[u >> 1] = pk_bf16(kdv[0][0], kdv[1][0]); kd1[u >> 1] = pk_bf16(kdv[0][1], kdv[1][1]);
            }
            *(uint4*)(lds + GL_KDT + swz(dk2, seg * 16)) = make_uint4(kd0[0], kd0[1], kd0[2], kd0[3]);
            *(uint4*)(lds + GL_KDT + swz(dk2 + 1, seg * 16)) = make_uint4(kd1[0], kd1[1], kd1[2], kd1[3]);
            unsigned va[8], vb[8], rv[16];
#pragma unroll
            for (int u = 0; u < 16; ++u) rv[u] = *(const unsigned*)(lds + GL_RAWV + (vq * 16 + u) * 256 + dv2 * 2);
#pragma unroll
            for (int m = 0; m < 8; ++m) { va[m] = (rv[2 * m] & 0xffffu) | (rv[2 * m + 1] << 16); vb[m] = (rv[2 * m] >> 16) | (rv[2 * m + 1] & 0xffff0000u); }
            *(uint4*)(lds + GL_VT + swz(dv2, vq * 32)) = make_uint4(va[0], va[1], va[2], va[3]);
            *(uint4*)(lds + GL_VT + swz(dv2, vq * 32 + 16)) = make_uint4(va[4], va[5], va[6], va[7]);
            *(uint4*)(lds + GL_VT + swz(dv2 + 1, vq * 32)) = make_uint4(vb[0], vb[1], vb[2], vb[3]);
            *(uint4*)(lds + GL_VT + swz(dv2 + 1, vq * 32 + 16)) = make_uint4(vb[4], vb[5], vb[6], vb[7]);
            if (seg == 0) {
                *(float2*)(lds + GL_EBREF + dk2 * 4) = make_float2(__expf(bref0), __expf(bref1));
                *(float2*)(lds + GL_EBLAST + dk2 * 4) = make_float2(__expf(all0), __expf(all1));
            }
        }
        __syncthreads();
        if (n + 1 < 68) prefetch(n + 1);
        {
            const unsigned char* QS = lds + GL_QS; const unsigned char* KS = lds + GL_KS; const unsigned char* KDT = lds + GL_KDT; const unsigned char* VTL = lds + GL_VT;
            f32x16 ot[2];
#pragma unroll
            for (int e = 0; e < 16; ++e) { ot[0][e] = 0.f; ot[1][e] = 0.f; }
            bf16x8 sp[2][2];
#pragma unroll
            for (int dkb = 0; dkb < 2; ++dkb) {
                f32x16 t;
#pragma unroll
                for (int g = 0; g < 4; ++g) {
                    const float4 e = *(const float4*)(lds + GL_EBREF + (32 * dkb + 8 * g + 4 * h) * 4);
                    t[4 * g] = S[dkb][4 * g] * e.x; t[4 * g + 1] = S[dkb][4 * g + 1] * e.y; t[4 * g + 2] = S[dkb][4 * g + 2] * e.z; t[4 * g + 3] = S[dkb][4 * g + 3] * e.w;
                }
                sp[dkb][0] = pack8(t, 0); sp[dkb][1] = pack8(t, 1);
            }
#pragma unroll
            for (int ib = 0; ib < 2; ++ib)
#pragma unroll
                for (int ksv = 0; ksv < 4; ++ksv) {
                    const int row = 32 * ib + r32;
                    const s16x4 lo = *(const s16x4*)(QS + swz(row, 32 * ksv + 8 * h));
                    const s16x4 hi = *(const s16x4*)(QS + swz(row, 32 * ksv + 16 + 8 * h));
                    const bf16x8 qp = __builtin_shufflevector(lo, hi, 0, 1, 2, 3, 4, 5, 6, 7);
                    ot[ib] = MFMA32(sp[ksv >> 1][ksv & 1], qp, ot[ib]);
                }
#pragma unroll
            for (int tI = 0; tI < 3; ++tI) {
                const int sb = tI == 2 ? 1 : 0, ib = tI == 0 ? 0 : 1;
                f32x16 pt;
#pragma unroll
                for (int e = 0; e < 16; ++e) pt[e] = 0.f;
#pragma unroll
                for (int ks = 0; ks < 4; ++ks) {
                    const bf16x8 kf = *(const bf16x8*)(KS + swz(32 * sb + r32, (2 * ks + h) * 16));
                    const bf16x8 qf = *(const bf16x8*)(QS + swz(32 * ib + r32, (2 * ks + h) * 16));
                    pt = MFMA32(kf, qf, pt);
                }
                if (sb == ib) {
#pragma unroll
                    for (int e = 0; e < 16; ++e) { const int sl = (e & 3) + 8 * (e >> 2) + 4 * h; if (sl > r32) pt[e] = 0.f; }
                }
#pragma unroll
                for (int s2 = 0; s2 < 2; ++s2) {
                    const int ksv = 2 * sb + s2, row = 32 * w + r32;
                    const s16x4 lo = *(const s16x4*)(VTL + swz(row, 32 * ksv + 8 * h));
                    const s16x4 hi = *(const s16x4*)(VTL + swz(row, 32 * ksv + 16 + 8 * h));
                    const bf16x8 vp = __builtin_shufflevector(lo, hi, 0, 1, 2, 3, 4, 5, 6, 7);
                    ot[ib] = MFMA32(vp, pack8(pt, s2), ot[ib]);
                }
            }
#pragma unroll
            for (int ib = 0; ib < 2; ++ib) {
                const int i = 32 * ib + r32; const size_t tok = dir ? base + 63 - i : base + i;
                bf16* dst = OG + tok * 512 + hd * 128 + 32 * w + 4 * h;
#pragma unroll
                for (int g = 0; g < 4; ++g) st_bf4(dst + 8 * g, ot[ib][4 * g], ot[ib][4 * g + 1], ot[ib][4 * g + 2], ot[ib][4 * g + 3]);
            }
#pragma unroll
            for (int dkb = 0; dkb < 2; ++dkb)
#pragma unroll
                for (int g = 0; g < 4; ++g) {
                    const float4 e = *(const float4*)(lds + GL_EBLAST + (32 * dkb + 8 * g + 4 * h) * 4);
                    S[dkb][4 * g] *= e.x; S[dkb][4 * g + 1] *= e.y; S[dkb][4 * g + 2] *= e.z; S[dkb][4 * g + 3] *= e.w;
                }
#pragma unroll
            for (int ks = 0; ks < 4; ++ks) {
                const bf16x8 vn = *(const bf16x8*)(VTL + swz(32 * w + r32, (2 * ks + h) * 16));
#pragma unroll
                for (int dkb = 0; dkb < 2; ++dkb) {
                    const bf16x8 kd = *(const bf16x8*)(KDT + swz(32 * dkb + r32, (2 * ks + h) * 16));
                    S[dkb] = MFMA32(kd, vn, S[dkb]);
                }
            }
        }
    }
}

constexpr int CW_WORK = 64;
constexpr int LDS_ITEM_OFF = 79 * 1024;
__device__ void ph_mix(KParams p, int l, unsigned char* lds) {
    const int tid = tid_opaque();
    unsigned* ctr = (unsigned*)(p->ws + WS_CTL) + CW_WORK + l;
    volatile int* slot = (volatile int*)(lds + LDS_ITEM_OFF);
    const int nitems = 64 + NB * 8 * 16 + ((l == 0) ? NB * 8 : 0);
    for (;;) {
        __syncthreads();
        if (tid == 0) *slot = (int)__hip_atomic_fetch_add(ctr, 1u, __ATOMIC_RELAXED, __HIP_MEMORY_SCOPE_AGENT);
        __syncthreads();
        const int it = *slot;
        if (it >= nitems) break;
        if (it < 64) gla_task(p, l, it, lds, tid);
        else attn_item(p, l, it - 64, lds, tid);
    }
}

__device__ void ph_ygla(KParams p, int l) {
    const int tid = tid_opaque(), lane = tid & 63, gw = blockIdx.x * 4 + (tid >> 6), ngw = gridDim.x * 4;
    bf16* O0 = (bf16*)(p->ws + WS_R2);
    const bf16* O1 = (const bf16*)(p->ws + WS_R2 + SZ_Y512);
    const bf16* PROJ = (const bf16*)(p->ws + WS_PROJ);
    const float* g = p->in[I_GLANG] + l * 128;
    const int nrows = (l == 0) ? NTOK : NL;
    for (int r = gw; r < nrows; r += ngw) {
        const int c = lane * 8;
        float v[8];
        { float4 a = ld_bf4(O0 + (size_t)r * 512 + c), b2 = ld_bf4(O0 + (size_t)r * 512 + c + 4), d = ld_bf4(O1 + (size_t)r * 512 + c), e = ld_bf4(O1 + (size_t)r * 512 + c + 4);
          v[0] = a.x + d.x; v[1] = a.y + d.y; v[2] = a.z + d.z; v[3] = a.w + d.w; v[4] = b2.x + e.x; v[5] = b2.y + e.y; v[6] = b2.z + e.z; v[7] = b2.w + e.w; }
        float ss = 0.f;
#pragma unroll
        for (int e = 0; e < 8; ++e) ss += v[e] * v[e];
        ss += __shfl_xor(ss, 1); ss += __shfl_xor(ss, 2); ss += __shfl_xor(ss, 4); ss += __shfl_xor(ss, 8);
        const float inv = rsqrtf(ss * (1.f / 128.f) + EPS);
        float4 r0 = ld_bf4(PROJ + (size_t)r * INW + O_GR + c), r1 = ld_bf4(PROJ + (size_t)r * INW + O_GR + c + 4);
        const float gr[8] = {r0.x, r0.y, r0.z, r0.w, r1.x, r1.y, r1.z, r1.w};
        float o[8];
#pragma unroll
        for (int e = 0; e < 8; ++e) o[e] = v[e] * inv * g[(c + e) & 127] * silu_f(gr[e]);
        st_bf4(O0 + (size_t)r * 512 + c, o[0], o[1], o[2], o[3]);
        st_bf4(O0 + (size_t)r * 512 + c + 4, o[4], o[5], o[6], o[7]);
    }
}

__device__ void ph_merge(KParams p, int l, unsigned char* lds) {
    const bf16* PROJ = (const bf16*)(p->ws + WS_PROJ);
    const bf16* YG = (const bf16*)(p->ws + WS_R2);
    const bf16* DP = (const bf16*)(p->ws + WS_R2 + 2 * SZ_Y512);
    bf16* Z = (bf16*)(p->ws + WS_H);
    const int nrows = (l == 0) ? NTOK : NL, nM = nrows / 128, nN = 8;
    const int tid = tid_opaque(), lane = tid & 63, wid = tid >> 6, wr = wid >> 1, wc = wid & 1, fr = lane & 15, fq = lane >> 4;
    for (int it = vblock(); it < nM * nN; it += gridDim.x) {
        int tm, tn; tile_coords(it, nM, nN, tm, tn);
        f32x4 tot[4][4]; zero_acc4(tot);
#pragma unroll 1
        for (int br = 0; br < 3; ++br) {
            const bf16* WT = wsm_bt(p, l, br);
            const bf16* Ab = br == 0 ? YG : (br == 1 ? PROJ + O_AQ : DP);
            const size_t lda = br == 1 ? (size_t)INW : (size_t)512;
            f32x4 acc[4][4]; zero_acc4(acc);
            gemm_tile(acc, [&](int r) { return Ab + (size_t)(tm * 128 + r) * lda; }, [&](int r) { return WT + (size_t)(tn * 128 + r) * 512; }, 512, lds, tid);
#pragma unroll
            for (int i = 0; i < 4; ++i)
#pragma unroll
                for (int j = 0; j < 4; ++j) {
                    const int row = tm * 128 + wr * 64 + i * 16 + fr, col = tn * 128 + wc * 64 + j * 16 + fq * 4;
                    const float4 gt = ld_bf4(PROJ + (size_t)row * INW + O_GT + br * D + col);
                    tot[i][j][0] += sigmoid_f(gt.x) * acc[i][j][0]; tot[i][j][1] += sigmoid_f(gt.y) * acc[i][j][1];
                    tot[i][j][2] += sigmoid_f(gt.z) * acc[i][j][2]; tot[i][j][3] += sigmoid_f(gt.w) * acc[i][j][3];
                }
        }
#pragma unroll
        for (int i = 0; i < 4; ++i)
#pragma unroll
            for (int j = 0; j < 4; ++j) {
                const int row = tm * 128 + wr * 64 + i * 16 + fr, col = tn * 128 + wc * 64 + j * 16 + fq * 4;
                st_bf4(Z + (size_t)row * D + col, tot[i][j][0], tot[i][j][1], tot[i][j][2], tot[i][j][3]);
            }
    }
}

__device__ void ph_outproj(KParams p, int l, unsigned char* lds) {
    const bf16* Z = (const bf16*)(p->ws + WS_H);
    const bf16* WT = wsm_outt(p, l);
    const int nrows = (l == 0) ? NTOK : NL, nM = nrows / 128, nN = 8;
    const int tid = tid_opaque(), lane = tid & 63, wid = tid >> 6, wr = wid >> 1, wc = wid & 1, fr = lane & 15, fq = lane >> 4;
    for (int it = vblock(); it < nM * nN; it += gridDim.x) {
        int tm, tn; tile_coords(it, nM, nN, tm, tn);
        f32x4 acc[4][4]; zero_acc4(acc);
        gemm_tile(acc, [&](int r) { return Z + (size_t)(tm * 128 + r) * D; }, [&](int r) { return WT + (size_t)(tn * 128 + r) * D; }, D, lds, tid);
#pragma unroll
        for (int i = 0; i < 4; ++i) {
            const int r = tm * 128 + wr * 64 + i * 16 + fr;
            const float* xr = xrow(p, l, r);
            const float* g1 = modv(p, l, modrow(r), 2);
            float* dr = r < NL ? p->out + (size_t)r * D : (float*)(p->ws + WS_XC) + (size_t)(r - NL) * D;
#pragma unroll
            for (int j = 0; j < 4; ++j) {
                const int c = tn * 128 + wc * 64 + j * 16 + fq * 4;
                const float4 xo = *(const float4*)(xr + c), gg = *(const float4*)(g1 + c);
                *(float4*)(dr + c) = make_float4(xo.x + gg.x * acc[i][j][0], xo.y + gg.y * acc[i][j][1], xo.z + gg.z * acc[i][j][2], xo.w + gg.w * acc[i][j][3]);
            }
        }
    }
}

__device__ __forceinline__ const float* x1row(KParams p, int r) {
    return r < NL ? p->out + (size_t)r * D : (const float*)(p->ws + WS_XC) + (size_t)(r - NL) * D;
}
__device__ void ph_router(KParams p, int l, unsigned char* lds) {
    const int tid = tid_opaque(), lane = tid & 63, wid = tid >> 6;
    bf16* H = (bf16*)(p->ws + WS_H);
    const float* g = p->in[I_N2G] + l * D;
    const float* wt_ = (const float*)(p->ws + WS_RWT) + (size_t)l * 36 * D;
    unsigned* cnt = (unsigned*)(p->ws + WS_CTL) + l * 32;
    int* list = (int*)(p->ws + WS_LIST);
    float* wt = (float*)(p->ws + WS_WT);
    const int nrows = (l == 0) ? NTOK : NL, ngrp = nrows / 16;
    const int myq = lane & 3;
    auto issue_chunk = [&](int c, int buf) {
#pragma unroll
        for (int j = 0; j < 6; ++j)
            __builtin_amdgcn_global_load_lds((const unsigned*)(wt_ + (size_t)c * 6 * D + j * 1024 + tid * 4), (unsigned*)(lds + buf * 24576 + j * 4096 + tid * 16), 16, 0, 0);
    };
    __syncthreads();
    if ((int)blockIdx.x < ngrp) issue_chunk(0, 0);
    for (int gi = blockIdx.x; gi < ngrp; gi += gridDim.x) {
        const int r0 = gi * 16 + wid * 4;
        float hv[4][16];
#pragma unroll
        for (int q = 0; q < 4; ++q) {
            const int r = r0 + q;
            const float* x = x1row(p, r);
            const int mb = modrow(r);
            const float* sh = modv(p, l, mb, 3); const float* sc = modv(p, l, mb, 4);
            float4 v[4]; float ss = 0.f;
#pragma unroll
            for (int j = 0; j < 4; ++j) { v[j] = *(const float4*)(x + j * 256 + lane * 4); ss += v[j].x * v[j].x + v[j].y * v[j].y + v[j].z * v[j].z + v[j].w * v[j].w; }
            const float inv = rsqrtf(wave_sum(ss) * (1.f / D) + EPS);
#pragma unroll
            for (int j = 0; j < 4; ++j) {
                const int c = j * 256 + lane * 4;
                const float4 gg = *(const float4*)(g + c), s1 = *(const float4*)(sh + c), s2 = *(const float4*)(sc + c);
                hv[q][j * 4 + 0] = v[j].x * inv * gg.x * (1.f + s2.x) + s1.x; hv[q][j * 4 + 1] = v[j].y * inv * gg.y * (1.f + s2.y) + s1.y;
                hv[q][j * 4 + 2] = v[j].z * inv * gg.z * (1.f + s2.z) + s1.z; hv[q][j * 4 + 3] = v[j].w * inv * gg.w * (1.f + s2.w) + s1.w;
                st_bf4(H + (size_t)r * D + c, hv[q][j * 4], hv[q][j * 4 + 1], hv[q][j * 4 + 2], hv[q][j * 4 + 3]);
            }
        }
        float lg[4] = {0.f, 0.f, 0.f, 0.f}, le[8] = {0.f, 0.f, 0.f, 0.f, 0.f, 0.f, 0.f, 0.f};
        int grp = 0; float ptg = 0.f;
#pragma unroll 1
        for (int c = 0; c < 6; ++c) {
            asm volatile("s_waitcnt vmcnt(0)" ::: "memory");
            __syncthreads();
            issue_chunk(c == 5 ? 0 : c + 1, (c + 1) & 1);
            const unsigned char* wb = lds + (c & 1) * 24576;
#pragma unroll
            for (int oo = 0; oo < 6; ++oo) {
                const int o = c * 6 + oo;
                float a[4] = {0.f, 0.f, 0.f, 0.f};
#pragma unroll
                for (int j = 0; j < 4; ++j) {
                    const float4 w = *(const float4*)(wb + oo * 4096 + j * 1024 + lane * 16);
#pragma unroll
                    for (int q = 0; q < 4; ++q) a[q] += hv[q][j * 4] * w.x + hv[q][j * 4 + 1] * w.y + hv[q][j * 4 + 2] * w.z + hv[q][j * 4 + 3] * w.w;
                }
                const float k0 = (lane & 1) ? a[1] : a[0], s0 = (lane & 1) ? a[0] : a[1];
                const float k1 = (lane & 1) ? a[3] : a[2], s1_ = (lane & 1) ? a[2] : a[3];
                const float b0 = k0 + __shfl_xor(s0, 1), b1 = k1 + __shfl_xor(s1_, 1);
                const float kk = (lane & 2) ? b1 : b0, sk = (lane & 2) ? b0 : b1;
                float val = kk + __shfl_xor(sk, 2);
                val += __shfl_xor(val, 4); val += __shfl_xor(val, 8); val += __shfl_xor(val, 16); val += __shfl_xor(val, 32);
                if (o < 4) {
                    val += p->in[I_BGRP][l * 4 + o];
#pragma unroll
                    for (int z = 0; z < 4; ++z) if (z == o) lg[z] = val;
                    if (o == 3) {
                        float gmax = lg[0]; grp = 0;
#pragma unroll
                        for (int z = 1; z < 4; ++z) if (lg[z] > gmax) { gmax = lg[z]; grp = z; }
                        float gden = 0.f;
#pragma unroll
                        for (int z = 0; z < 4; ++z) gden += __expf(lg[z] - gmax);
                        ptg = 1.f / gden;
                    }
                } else {
                    const int e = o - 4;
                    val += p->in[I_BEXP][l * 32 + e];
                    const bool mine = grp == (e >> 3);
#pragma unroll
                    for (int z = 0; z < 8; ++z) if (mine && z == (e & 7)) le[z] = val;
                }
            }
        }
        {
            int i1 = 0; float m1 = le[0];
#pragma unroll
            for (int z = 1; z < 8; ++z) if (le[z] > m1) { m1 = le[z]; i1 = z; }
            int i2 = -1; float m2 = -3.0e38f;
#pragma unroll
            for (int z = 0; z < 8; ++z) if (z != i1 && le[z] > m2) { m2 = le[z]; i2 = z; }
            const float e2 = __expf(m2 - m1);
            const float w1 = ptg / (1.f + e2), w2 = ptg * e2 / (1.f + e2);
            if (lane < 4) {
                const int r = r0 + myq, ea = grp * 8 + i1, eb = grp * 8 + i2;
                const unsigned pa = atomicAdd(&cnt[ea], 1u); list[(size_t)ea * NTOK + pa] = r * 2;
                const unsigned pb = atomicAdd(&cnt[eb], 1u); list[(size_t)eb * NTOK + pb] = r * 2 + 1;
                wt[r * 2] = w1; wt[r * 2 + 1] = w2;
            }
        }
    }
    asm volatile("s_waitcnt vmcnt(0)" ::: "memory");
    __syncthreads();
}

__device__ void ph_convmoe(KParams p, int l, float* sm) {
    const int tid = tid_opaque();
    bf16* WGU = (bf16*)(p->ws + WS_WGU);
    bf16* WDT = (bf16*)(p->ws + WS_WDT);
    for (int it = blockIdx.x; it < 32 * 384; it += gridDim.x) {
        const int e = it / 384, r = it % 384, kind = r >> 7, q = r & 127;
        if (kind == 0)
            conv_tile(p->in[I_WGATE] + ((size_t)(l * 32 + e) * D) * 512, 512, 512, (q >> 3) * 64, (q & 7) * 64, WGU + (size_t)e * D * D, D,
                      [](int n) { return 32 * (n >> 4) + (n & 15); }, sm, tid);
        else if (kind == 1)
            conv_tile(p->in[I_WUP] + ((size_t)(l * 32 + e) * D) * 512, 512, 512, (q >> 3) * 64, (q & 7) * 64, WGU + (size_t)e * D * D, D,
                      [](int n) { return 32 * (n >> 4) + 16 + (n & 15); }, sm, tid);
        else
            conv_tile(p->in[I_WDOWN] + ((size_t)(l * 32 + e) * 512) * D, D, D, (q >> 4) * 64, (q & 15) * 64, WDT + (size_t)e * D * 512, 512,
                      [](int n) { return n; }, sm, tid);
    }
}

__device__ __forceinline__ void moe_tile_lookup(const unsigned* cnt, int trow, int& e, int& i0, int& ce) {
    int start = 0; e = 0; i0 = 0; ce = 0;
#pragma unroll 1
    for (int q = 0; q < 32; ++q) {
        const int c = (int)cnt[q], nt = (c + 127) >> 7;
        if (trow >= start && trow < start + nt) { e = q; i0 = (trow - start) * 128; ce = c; }
        start += nt;
    }
}
__device__ __forceinline__ int moe_ntiles(const unsigned* cnt) {
    int n = 0;
#pragma unroll 1
    for (int q = 0; q < 32; ++q) n += ((int)cnt[q] + 127) >> 7;
    return n;
}

__device__ void ph_moe1(KParams p, int l, unsigned char* lds) {
    const bf16* H = (const bf16*)(p->ws + WS_H);
    bf16* ACT = (bf16*)(p->ws + WS_ACT);
    const bf16* WGU = (const bf16*)(p->ws + WS_WGU);
    const unsigned* cnt = (const unsigned*)(p->ws + WS_CTL) + l * 32;
    const int* list = (const int*)(p->ws + WS_LIST);
    const int tid = tid_opaque(), lane = tid & 63, wid = tid >> 6, wr = wid >> 1, wc = wid & 1, fr = lane & 15, fq = lane >> 4;
    const int ntiles = moe_ntiles(cnt);
    for (int it = vblock(); it < ntiles * 8; it += gridDim.x) {
        const int trow = it >> 3, tn = it & 7;
        int e, i0, ce; moe_tile_lookup(cnt, trow, e, i0, ce);
        const int* le = list + (size_t)e * NTOK;
        const bf16* WT = WGU + (size_t)e * D * D;
        f32x4 acc[4][4]; zero_acc4(acc);
        gemm_tile(acc, [&](int r) { const int ii = min(i0 + r, ce - 1); return H + (size_t)(le[ii] >> 1) * D; },
                  [&](int r) { return WT + (size_t)(tn * 128 + r) * D; }, D, lds, tid);
#pragma unroll
        for (int i = 0; i < 4; ++i) {
            const int ii = i0 + wr * 64 + i * 16 + fr;
            if (ii < ce) {
                const int asg = le[ii];
#pragma unroll
                for (int jp = 0; jp < 2; ++jp) {
                    const f32x4 g = acc[i][2 * jp], u = acc[i][2 * jp + 1];
                    st_bf4(ACT + (size_t)asg * 512 + tn * 64 + wc * 32 + jp * 16 + fq * 4, silu_f(g[0]) * u[0], silu_f(g[1]) * u[1], silu_f(g[2]) * u[2], silu_f(g[3]) * u[3]);
                }
            }
        }
    }
}

__device__ void ph_moe2(KParams p, int l, unsigned char* lds) {
    const bf16* ACT = (const bf16*)(p->ws + WS_ACT);
    const bf16* WDT = (const bf16*)(p->ws + WS_WDT);
    const unsigned* cnt = (const unsigned*)(p->ws + WS_CTL) + l * 32;
    const int* list = (const int*)(p->ws + WS_LIST);
    const float* wt = (const float*)(p->ws + WS_WT);
    const int tid = tid_opaque(), lane = tid & 63, wid = tid >> 6, wr = wid >> 1, wc = wid & 1, fr = lane & 15, fq = lane >> 4;
    const int ntiles = moe_ntiles(cnt);
    for (int it = vblock(); it < ntiles * 8; it += gridDim.x) {
        const int trow = it >> 3, tn = it & 7;
        int e, i0, ce; moe_tile_lookup(cnt, trow, e, i0, ce);
        const int* le = list + (size_t)e * NTOK;
        const bf16* WT = WDT + (size_t)e * D * 512;
        f32x4 acc[4][4]; zero_acc4(acc);
        gemm_tile(acc, [&](int r) { const int ii = min(i0 + r, ce - 1); return ACT + (size_t)le[ii] * 512; },
                  [&](int r) { return WT + (size_t)(tn * 128 + r) * 512; }, 512, lds, tid);
#pragma unroll
        for (int i = 0; i < 4; ++i) {
            const int ii = i0 + wr * 64 + i * 16 + fr;
            if (ii < ce) {
                const int asg = le[ii], tok = asg >> 1;
                const float w = wt[asg];
                bf16* Y = (bf16*)(p->ws + ((asg & 1) ? WS_Y1 : WS_Y0));
#pragma unroll
                for (int j = 0; j < 4; ++j)
                    st_bf4(Y + (size_t)tok * D + tn * 128 + wc * 64 + j * 16 + fq * 4, w * acc[i][j][0], w * acc[i][j][1], w * acc[i][j][2], w * acc[i][j][3]);
            }
        }
    }
}

__device__ void ph_combine(KParams p, int l) {
    const int tid = tid_opaque(), lane = tid & 63, gw = blockIdx.x * 4 + (tid >> 6), ngw = gridDim.x * 4;
    const bf16* Y0 = (const bf16*)(p->ws + WS_Y0);
    const bf16* Y1 = (const bf16*)(p->ws + WS_Y1);
    const int nrows = (l == 0) ? NTOK : NL;
    for (int r = gw; r < nrows; r += ngw) {
        const float* x = x1row(p, r);
        float* xo = r < NL ? p->out + (size_t)r * D : (float*)(p->ws + WS_XC) + (size_t)(r - NL) * D;
        const float* g2 = modv(p, l, modrow(r), 5);
        float4 v[4]; float ss = 0.f;
#pragma unroll
        for (int j = 0; j < 4; ++j) {
            const int c = j * 256 + lane * 4;
            const float4 xv = *(const float4*)(x + c), gg = *(const float4*)(g2 + c);
            const float4 a = ld_bf4(Y0 + (size_t)r * D + c), b = ld_bf4(Y1 + (size_t)r * D + c);
            v[j] = make_float4(xv.x + gg.x * (a.x + b.x), xv.y + gg.y * (a.y + b.y), xv.z + gg.z * (a.z + b.z), xv.w + gg.w * (a.w + b.w));
            ss += v[j].x * v[j].x + v[j].y * v[j].y + v[j].z * v[j].z + v[j].w * v[j].w;
        }
        if (l == 0) {
#pragma unroll
            for (int j = 0; j < 4; ++j) *(float4*)(xo + j * 256 + lane * 4) = v[j];
        } else {
            const float inv = rsqrtf(wave_sum(ss) * (1.f / D) + EPS);
            const float* fg = p->in[I_FING];
#pragma unroll
            for (int j = 0; j < 4; ++j) {
                const int c = j * 256 + lane * 4;
                const float4 gg = *(const float4*)(fg + c);
                *(float4*)(xo + c) = make_float4(v[j].x * inv * gg.x, v[j].y * inv * gg.y, v[j].z * inv * gg.z, v[j].w * inv * gg.w);
            }
        }
    }
}

#define XB_TMO      128
#define XB_XCNT(j)  (256  + 64 * (j))
#define XB_XSUB(j)  (1280 + 64 * (j))
#define XB_XGEN(j)  (2304 + 64 * (j))
#define XB_TOP      3328
#define XB_TOPGEN   3392
#define XB_SPIN_CAP (1u << 22)
constexpr int CW_BAR = 4096;
__device__ __forceinline__ unsigned xb_ld(unsigned* p)              { return __hip_atomic_load(p, __ATOMIC_RELAXED, __HIP_MEMORY_SCOPE_AGENT); }
__device__ __forceinline__ unsigned xb_add(unsigned* p, unsigned v) { return __hip_atomic_fetch_add(p, v, __ATOMIC_RELAXED, __HIP_MEMORY_SCOPE_AGENT); }
__device__ __forceinline__ unsigned xb_xcc_id() { return (unsigned)__builtin_amdgcn_s_getreg((3 << 11) | 20) & 0xFu; }
#define XB_SPIN(cond, bar) do { unsigned _sp = 0; while (cond) { __builtin_amdgcn_s_sleep(1); \
    if ((++_sp & 255u) == 0u) { if (xb_ld(&(bar)[XB_TMO])) break; if (_sp > XB_SPIN_CAP) { atomicAdd(&(bar)[XB_TMO], 1u); break; } } } } while (0)
constexpr int LDS_BAR_OFF = 79 * 1024 + 16;
__device__ __forceinline__ void xcd_barrier_post(unsigned* bar) {
    if (threadIdx.x == 0) (void)xb_add(&bar[XB_XCNT(xb_xcc_id())], 1u);
}
__device__ __forceinline__ void xcd_barrier_census(unsigned* bar, volatile unsigned* st) {
    if (threadIdx.x == 0) {
        const unsigned x = xb_xcc_id();
        unsigned cnt = 0, mine = 0;
#pragma unroll
        for (unsigned j = 0; j < 16; ++j) { const unsigned c = xb_ld(&bar[XB_XCNT(j)]); cnt += (c > 0u) ? 1u : 0u; mine = (j == x) ? c : mine; }
        st[0] = mine > 0u ? mine : 1u; st[1] = cnt > 0u ? cnt : 1u;
    }
    __syncthreads();
}
__device__ __forceinline__ void xcd_barrier(KParams kp, unsigned char* lds) {
    asm volatile("s_waitcnt vmcnt(0)" ::: "memory");
    __syncthreads();
    if (threadIdx.x == 0) {
        unsigned* bar = (unsigned*)(kp->ws + WS_CTL) + CW_BAR;
        volatile unsigned* st = (volatile unsigned*)(lds + LDS_BAR_OFF);
        __builtin_amdgcn_s_waitcnt(0);
        const unsigned x = xb_xcc_id();
        const unsigned nloc = st[0], nx = st[1];
        const unsigned old = xb_add(&bar[XB_XSUB(x)], 1u);
        const unsigned gen = old / nloc;
        if (old + 1u == (gen + 1u) * nloc) {
            __builtin_amdgcn_fence(__ATOMIC_RELEASE, "agent");
            asm volatile("s_waitcnt vmcnt(0)" ::: "memory");
            const unsigned og = xb_add(&bar[XB_TOP], 1u);
            const unsigned tg = og / nx;
            if (og + 1u == (tg + 1u) * nx) xb_add(&bar[XB_TOPGEN], 1u);
            else XB_SPIN(xb_ld(&bar[XB_TOPGEN]) == tg, bar);
            __builtin_amdgcn_fence(__ATOMIC_ACQUIRE, "agent");
            xb_add(&bar[XB_XGEN(x)], 1u);
            asm volatile("s_waitcnt vmcnt(0)" ::: "memory");
        } else {
            XB_SPIN(xb_ld(&bar[XB_XGEN(x)]) == gen, bar);
            __builtin_amdgcn_fence(__ATOMIC_ACQUIRE, "agent");
            asm volatile("s_waitcnt vmcnt(0)" ::: "memory");
        }
    }
    __syncthreads();
}

constexpr int LDS_BYTES = 80 * 1024;
__global__ void __launch_bounds__(256, 2) mega_fwd(Params p_unused) {
    const KParams kp = (KParams)__builtin_amdgcn_kernarg_segment_ptr();
    extern __shared__ __attribute__((aligned(16))) unsigned char smem_raw[];
    float* sm = (float*)smem_raw;
    cg::grid_group grid = cg::this_grid();
#ifndef PROBE_SEL
#define PROBE_SEL 0ull
#endif
#if PROBE_SEL
    volatile unsigned long long* stamps = (volatile unsigned long long*)(smem_raw + 79 * 1024 + 64);
    int n_stamp = 0;
#define STAMP() do { if (blockIdx.x == 0 && threadIdx.x == 0) stamps[n_stamp] = __builtin_amdgcn_s_memrealtime(); ++n_stamp; } while (0)
#else
#define STAMP() do { } while (0)
#endif
    xcd_barrier_post((unsigned*)(kp->ws + WS_CTL) + CW_BAR);
    STAMP();
    ph_init(fresh(kp), sm);
    grid.sync();
    xcd_barrier_census((unsigned*)(kp->ws + WS_CTL) + CW_BAR, (volatile unsigned*)(smem_raw + LDS_BAR_OFF));
    STAMP();
#define GSYNC() do { xcd_barrier(fresh(kp), smem_raw); STAMP(); } while (0)
#pragma unroll 1
    for (int l = 0; l < 2; ++l) {
        ph_norm1(fresh(kp), l);             GSYNC();
        ph_gemm_in(fresh(kp), l, smem_raw); GSYNC();
        ph_prep(fresh(kp), l, sm);          GSYNC();
        ph_mix(fresh(kp), l, smem_raw);     GSYNC();
        ph_ygla(fresh(kp), l);              GSYNC();
        ph_merge(fresh(kp), l, smem_raw);   GSYNC();
        ph_outproj(fresh(kp), l, smem_raw); GSYNC();
        ph_router(fresh(kp), l, smem_raw);
        ph_convmoe(fresh(kp), l, sm);       GSYNC();
        ph_moe1(fresh(kp), l, smem_raw);    GSYNC();
        ph_moe2(fresh(kp), l, smem_raw);    GSYNC();
        ph_combine(fresh(kp), l);           GSYNC();
    }
#if PROBE_SEL
    if (blockIdx.x == 0 && threadIdx.x == 0) {
        unsigned long long dt = 0;
        for (int i = 0; i < 23; ++i) if ((PROBE_SEL >> i) & 1ull) dt += stamps[i + 1] - stamps[i];
        const unsigned long long t0 = __builtin_amdgcn_s_memrealtime();
        while (__builtin_amdgcn_s_memrealtime() - t0 < dt) __builtin_amdgcn_s_sleep(8);
    }
#endif
}

extern "C" void kernel_launch(void* const* d_in, const int* in_sizes, int n_in, void* d_out, int out_size, void* d_ws, size_t ws_size,
                              hipStream_t stream) {
    if (n_in != 28 || ws_size < WS_END) { fprintf(stderr, "kernel_launch: bad n_in %d or ws_size %zu (< %zu)\n", n_in, ws_size, (size_t)WS_END); return; }
    static int grid_blocks = 0;
    if (!grid_blocks) {
        int dev = 0, cus = 0, per_cu = 0;
        (void)hipGetDevice(&dev);
        (void)hipDeviceGetAttribute(&cus, hipDeviceAttributeMultiprocessorCount, dev);
        (void)hipFuncSetAttribute((const void*)mega_fwd, hipFuncAttributeMaxDynamicSharedMemorySize, LDS_BYTES);
        (void)hipOccupancyMaxActiveBlocksPerMultiprocessor(&per_cu, (const void*)mega_fwd, 256, LDS_BYTES);
        if (per_cu < 1) per_cu = 1;
        grid_blocks = cus * per_cu;
        fprintf(stderr, "kernel_launch: cus %d per_cu %d grid %d ws_size %zu\n", cus, per_cu, grid_blocks, ws_size);
    }
    Params p{};
    for (int i = 0; i < 28; ++i) p.in[i] = (const float*)d_in[i];
    p.out = (float*)d_out; p.ws = (unsigned char*)d_ws;
    (void)hipMemsetAsync((char*)d_ws + WS_CTL, 0, 1 * MiB, stream);
    void* args[] = {&p};
    hipError_t e = hipLaunchCooperativeKernel((const void*)mega_fwd, dim3(grid_blocks), dim3(256), args, LDS_BYTES, stream);
    if (e != hipSuccess) fprintf(stderr, "cooperative launch failed: %s (grid %d)\n", hipGetErrorString(e), grid_blocks);
}
```

```cpp
#include <hip/hip_runtime.h>
#include <hip/hip_cooperative_groups.h>
namespace cg = cooperative_groups;
#include <cstdio>
#include <cstdint>

typedef unsigned short bf16;

constexpr int D = 1024, NB = 8, T = 4096, CL = 256, NL = NB * T, NC = NB * CL, NTOK = NL + NC;
constexpr int INW = 5920;
constexpr int O_GQ = 0, O_GK = 256, O_GV = 512, O_GR = 1024, O_AQ = 1536, O_AK = 2048, O_AV = 2176, O_PU = 2304, O_GT = 2816, O_GLF = 5888, O_GLB = 5904;
__host__ __device__ constexpr int win_nmap(int n) { return n < 1536 ? n : (n < 1568 ? n + 4352 : (n < 5920 ? n - 32 : n)); }
constexpr float EPS = 1e-6f;
constexpr int CNT_BASE = 8192, CNT_STRIDE = 64;

constexpr size_t MiB = 1u << 20;
constexpr size_t WS_CTL = 0;
constexpr size_t WS_MODV = 1 * MiB;
constexpr size_t WS_ROPE = 1 * MiB + 512 * 1024;
constexpr size_t WS_WT = 2 * MiB;
constexpr size_t WS_LIST = 3 * MiB;
constexpr size_t WS_RWT = 7 * MiB + 256 * 1024;
constexpr size_t WS_XC = 8 * MiB;
constexpr size_t WS_H = 16 * MiB;
constexpr size_t WS_PROJ = 84 * MiB;
constexpr size_t WS_R2 = 478 * MiB;
constexpr size_t WS_WGU = WS_R2;
constexpr size_t WS_WDT = WS_R2 + 64 * MiB;
constexpr size_t WS_WSM = 580 * MiB;
constexpr size_t SZ_WINT = (size_t)6016 * 1024 * 2, SZ_WBT = (size_t)1024 * 512 * 2, SZ_WOUTT = (size_t)1024 * 1024 * 2;
constexpr size_t SZ_WSM_L = SZ_WINT + 3 * SZ_WBT + SZ_WOUTT;
constexpr size_t WS_VT = 614 * MiB;
constexpr int NKEY = T + CL;
constexpr size_t WS_END = 623 * MiB;
static_assert(WS_WSM + 2 * SZ_WSM_L <= WS_END, "ws map");
constexpr size_t SZ_Y512 = (size_t)NTOK * 512 * 2;
constexpr size_t WS_ACT = WS_PROJ;
constexpr size_t WS_Y0 = WS_PROJ + 68 * MiB;
constexpr size_t WS_Y1 = WS_PROJ + 136 * MiB;

struct Params {
    const float* in[28];
    float* out;
    unsigned char* ws;
};
typedef const __attribute__((address_space(4))) Params* KParams;
__device__ __forceinline__ KParams fresh(KParams k) { asm volatile("" : "+s"(k)); return k; }
enum { I_X = 0, I_C, I_CTX, I_CCTX, I_WMOD, I_BMOD, I_N1G, I_N2G, I_WIN, I_UPF, I_BIASF, I_UPB, I_BIASB, I_GLANG, I_QNG, I_KNG,
       I_POOLW, I_POOLS, I_WBR, I_WOUT, I_WGRP, I_BGRP, I_WEXP, I_BEXP, I_WGATE, I_WUP, I_WDOWN, I_FING };

__device__ __forceinline__ float bf2f(bf16 v) { return __uint_as_float(((unsigned)v) << 16); }
__device__ __forceinline__ bf16 f2bf(float f) { unsigned u = __float_as_uint(f); return (bf16)((u + 0x7fffu + ((u >> 16) & 1u)) >> 16); }
__device__ __forceinline__ float4 ld_bf4(const bf16* p) {
    uint2 u = *(const uint2*)p;
    return make_float4(__uint_as_float(u.x << 16), __uint_as_float(u.x & 0xffff0000u), __uint_as_float(u.y << 16), __uint_as_float(u.y & 0xffff0000u));
}
typedef float f32x2_t __attribute__((ext_vector_type(2)));
typedef __bf16 bf16x2_t __attribute__((ext_vector_type(2)));
__device__ __forceinline__ unsigned pk_bf16(float a, float b) { f32x2_t v = {a, b}; return __builtin_bit_cast(unsigned, __builtin_convertvector(v, bf16x2_t)); }
__device__ __forceinline__ void st_bf4(bf16* p, float a, float b, float c, float d) {
    uint2 u; u.x = pk_bf16(a, b); u.y = pk_bf16(c, d);
    *(uint2*)p = u;
}
__device__ __forceinline__ int tid_opaque() { int t = threadIdx.x; asm volatile("" : "+v"(t)); return t; }
#define DPP_ADD(v, ctrl) v += __builtin_bit_cast(float, __builtin_amdgcn_update_dpp(0, __builtin_bit_cast(int, v), (ctrl), 0xf, 0xf, true))
__device__ __forceinline__ float sum16(float v) {
    DPP_ADD(v, 0xB1);
    DPP_ADD(v, 0x4E);
    DPP_ADD(v, 0x141);
    DPP_ADD(v, 0x140);
    return v;
}
__device__ __forceinline__ float wave_sum(float v) {
#pragma unroll
    for (int o = 1; o < 64; o <<= 1) v += __shfl_xor(v, o);
    return v;
}
__device__ __forceinline__ float silu_f(float x) { return x / (1.f + __expf(-x)); }
__device__ __forceinline__ float sigmoid_f(float x) { return 1.f / (1.f + __expf(-x)); }
__device__ __forceinline__ int modrow(int r) { return r < NL ? r / T : 8; }
__device__ __forceinline__ const float* xrow(KParams p, int l, int r) {
    if (l == 0) return r < NL ? p->in[I_X] + (size_t)r * D : p->in[I_CTX] + (size_t)(r - NL) * D;
    return r < NL ? p->out + (size_t)r * D : (const float*)(p->ws + WS_XC) + (size_t)(r - NL) * D;
}
__device__ __forceinline__ const float* modv(KParams p, int l, int mb, int which) {
    return (const float*)(p->ws + WS_MODV) + ((size_t)(l * 9 + mb) * 6 + which) * D;
}

template <class AF, class BF>
__device__ __forceinline__ void gemm64(float (&acc)[4][4], int K, AF aload, BF bload, float* sA, float* sB, const int tid) {
    const int ty = tid >> 4, tx = tid & 15;
    const int am = tid >> 2, ak = (tid & 3) * 4;
    const int bk = tid >> 4, bn = (tid & 15) * 4;
    for (int k0 = 0; k0 < K; k0 += 16) {
        float4 av = aload(am, k0 + ak);
        float4 bv = bload(k0 + bk, bn);
        __syncthreads();
        sA[(ak + 0) * 68 + am] = av.x; sA[(ak + 1) * 68 + am] = av.y; sA[(ak + 2) * 68 + am] = av.z; sA[(ak + 3) * 68 + am] = av.w;
        *(float4*)&sB[bk * 64 + bn] = bv;
        __syncthreads();
#pragma unroll
        for (int kk = 0; kk < 16; ++kk) {
            float4 a = *(float4*)&sA[kk * 68 + ty * 4];
            float4 b = *(float4*)&sB[kk * 64 + tx * 4];
            float aa[4] = {a.x, a.y, a.z, a.w}, bb[4] = {b.x, b.y, b.z, b.w};
#pragma unroll
            for (int i = 0; i < 4; ++i)
#pragma unroll
                for (int j = 0; j < 4; ++j) acc[i][j] += aa[i] * bb[j];
        }
    }
    __syncthreads();
}
__device__ __forceinline__ void zero_acc(float (&acc)[4][4]) {
#pragma unroll
    for (int i = 0; i < 4; ++i)
#pragma unroll
        for (int j = 0; j < 4; ++j) acc[i][j] = 0.f;
}

typedef short bf16x8 __attribute__((ext_vector_type(8)));
typedef float f32x4 __attribute__((ext_vector_type(4)));
constexpr int GT_BYTES = 16384;
__device__ __forceinline__ void zero_acc4(f32x4 (&acc)[4][4]) {
#pragma unroll
    for (int i = 0; i < 4; ++i)
#pragma unroll
        for (int j = 0; j < 4; ++j) acc[i][j] = (f32x4){0.f, 0.f, 0.f, 0.f};
}
template <class FA, class FB>
__device__ __forceinline__ void gemm_tile(f32x4 (&acc)[4][4], FA arow, FB brow, int K, unsigned char* lds, const int tid) {
    const int lane = tid & 63, wid = tid >> 6, wr = wid >> 1, wc = wid & 1, fr = lane & 15, fq = lane >> 4;
    const int srow = tid >> 3, sc = ((tid & 7) ^ ((tid >> 4) & 7)) * 8;
    const bf16* ap[4]; const bf16* bp[4];
#pragma unroll
    for (int j = 0; j < 4; ++j) { ap[j] = arow(j * 32 + srow) + sc; bp[j] = brow(j * 32 + srow) + sc; }
    const int KT = K >> 6;
#pragma unroll
    for (int j = 0; j < 4; ++j) {
        __builtin_amdgcn_global_load_lds((const unsigned*)(ap[j]), (unsigned*)(lds + j * 4096 + tid * 16), 16, 0, 0);
        __builtin_amdgcn_global_load_lds((const unsigned*)(bp[j]), (unsigned*)(lds + GT_BYTES + j * 4096 + tid * 16), 16, 0, 0);
    }
#pragma unroll 1
    for (int kt = 0; kt < KT; ++kt) {
        asm volatile("s_waitcnt vmcnt(0)" ::: "memory");
        __syncthreads();
        if (kt + 1 < KT) {
            unsigned char* sa = lds + ((kt + 1) & 1) * 2 * GT_BYTES;
#pragma unroll
            for (int j = 0; j < 4; ++j) {
                __builtin_amdgcn_global_load_lds((const unsigned*)(ap[j] + (kt + 1) * 64), (unsigned*)(sa + j * 4096 + tid * 16), 16, 0, 0);
                __builtin_amdgcn_global_load_lds((const unsigned*)(bp[j] + (kt + 1) * 64), (unsigned*)(sa + GT_BYTES + j * 4096 + tid * 16), 16, 0, 0);
            }
        }
        const unsigned char* sa = lds + (kt & 1) * 2 * GT_BYTES;
        const unsigned char* sb = sa + GT_BYTES;
#pragma unroll
        for (int ks = 0; ks < 2; ++ks) {
            const int phys = ((ks * 4 + fq) ^ (fr >> 1)) * 16;
            bf16x8 af[4], bq[4];
#pragma unroll
            for (int i = 0; i < 4; ++i) af[i] = *(const bf16x8*)(sa + (wr * 64 + i * 16 + fr) * 128 + phys);
#pragma unroll
            for (int j = 0; j < 4; ++j) bq[j] = *(const bf16x8*)(sb + (wc * 64 + j * 16 + fr) * 128 + phys);
#pragma unroll
            for (int i = 0; i < 4; ++i)
#pragma unroll
                for (int j = 0; j < 4; ++j) acc[i][j] = __builtin_amdgcn_mfma_f32_16x16x32_bf16(bq[j], af[i], acc[i][j], 0, 0, 0);
        }
    }
}
__device__ __forceinline__ void tile_coords(int it, int nM, int nN, int& tm, int& tn) {
    const int GM = 8, per = GM * nN, grp = it / per, fm = grp * GM, gsz = min(nM - fm, GM), rem = it - grp * per;
    tm = fm + rem % gsz; tn = rem / gsz;
}
__device__ __forceinline__ int vblock() { const int G = gridDim.x, b = blockIdx.x; return (G & 7) == 0 ? (b & 7) * (G >> 3) + (b >> 3) : b; }

struct ConvItem { const float* src; bf16* dst; int ldsrc, nvalid, k0, n0, lddst, kind; };
__device__ __forceinline__ int conv_nmap(int kind, int n) {
    return kind == 0 ? n : (kind == 1 ? win_nmap(n) : 32 * (n >> 4) + (kind == 3 ? 16 : 0) + (n & 15));
}
template <class Dec>
__device__ __forceinline__ void conv_stream(Dec decode, int nitems, unsigned char* lds, const int tid) {
    auto issue = [&](const ConvItem& it, int buf) {
#pragma unroll
        for (int j = 0; j < 4; ++j) {
            const int k = j * 16 + (tid >> 4), pc = tid & 15, c = pc ^ ((k >> 4) & 3), n = it.n0 + c * 4;
            if (n < it.nvalid)
                __builtin_amdgcn_global_load_lds((const unsigned*)(it.src + (size_t)(it.k0 + k) * it.ldsrc + n), (unsigned*)(lds + buf * 16384 + j * 4096 + tid * 16), 16, 0, 0);
        }
    };
    int i = blockIdx.x;
    __syncthreads();
    ConvItem cur{};
    if (i < nitems) { cur = decode(i); issue(cur, 0); }
    int buf = 0;
    for (; i < nitems; i += gridDim.x) {
        asm volatile("s_waitcnt vmcnt(0)" ::: "memory");
        __syncthreads();
        ConvItem nxt{};
        const bool has_next = i + (int)gridDim.x < nitems;
        if (has_next) { nxt = decode(i + gridDim.x); issue(nxt, buf ^ 1); }
        {
            const float* sm = (const float*)(lds + buf * 16384);
            const int n = tid >> 2, kq = (tid & 3) * 16;
            const bool valid = cur.n0 + n < cur.nvalid;
            const int cidx = ((((n >> 2) ^ (kq >> 4)) & 15) << 2) + (n & 3);
            unsigned w[8];
#pragma unroll
            for (int q = 0; q < 8; ++q) {
                const float a = valid ? sm[(kq + 2 * q) * 64 + cidx] : 0.f, b = valid ? sm[(kq + 2 * q + 1) * 64 + cidx] : 0.f;
                w[q] = pk_bf16(a, b);
            }
            bf16* d = cur.dst + (size_t)conv_nmap(cur.kind, cur.n0 + n) * cur.lddst + cur.k0 + kq;
            *(uint4*)d = make_uint4(w[0], w[1], w[2], w[3]);
            *(uint4*)(d + 8) = make_uint4(w[4], w[5], w[6], w[7]);
        }
        cur = nxt; buf ^= 1;
    }
    asm volatile("s_waitcnt vmcnt(0)" ::: "memory");
    __syncthreads();
}
__device__ __forceinline__ bf16* wsm_int(KParams p, int l) { return (bf16*)(p->ws + WS_WSM + (size_t)l * SZ_WSM_L); }
__device__ __forceinline__ bf16* wsm_bt(KParams p, int l, int br) { return (bf16*)(p->ws + WS_WSM + (size_t)l * SZ_WSM_L + SZ_WINT + (size_t)br * SZ_WBT); }
__device__ __forceinline__ bf16* wsm_outt(KParams p, int l) { return (bf16*)(p->ws + WS_WSM + (size_t)l * SZ_WSM_L + SZ_WINT + 3 * SZ_WBT); }

__device__ void ph_init(KParams p, float* sm) {
    const int tid = tid_opaque();
    unsigned char* lds = (unsigned char*)sm;
    conv_stream([&](int it) {
        const int l = it / 2016; int r = it % 2016;
        ConvItem c;
        if (r < 1504) { c.src = p->in[I_WIN] + (size_t)l * D * INW; c.dst = wsm_int(p, l); c.ldsrc = INW; c.nvalid = INW; c.k0 = (r / 94) * 64; c.n0 = (r % 94) * 64; c.lddst = D; c.kind = 1; return c; }
        r -= 1504;
        if (r < 256) { const int br = r >> 7, q = r & 127;
            c.src = p->in[I_WBR] + ((size_t)(l * 3 + br) * 512) * D; c.dst = wsm_bt(p, l, br); c.ldsrc = D; c.nvalid = D; c.k0 = (q >> 4) * 64; c.n0 = (q & 15) * 64; c.lddst = 512; c.kind = 0; return c; }
        r -= 256;
        c.src = p->in[I_WOUT] + (size_t)l * D * D; c.dst = wsm_outt(p, l); c.ldsrc = D; c.nvalid = D; c.k0 = (r >> 4) * 64; c.n0 = (r & 15) * 64; c.lddst = D; c.kind = 0; return c;
    }, 2 * 2016, lds, tid);
    for (int it = blockIdx.x; it < 2 * 96; it += gridDim.x) {
        const int l = it / 96, cb = it % 96;
        __syncthreads();
        for (int e = tid; e < 9 * D; e += 256) {
            const int mb = e / D, k = e % D;
            sm[e] = silu_f(mb < 8 ? p->in[I_C][mb * D + k] : p->in[I_CCTX][k]);
        }
        __syncthreads();
        const int col = cb * 64 + (tid & 63), kq = tid >> 6;
        const float* w = p->in[I_WMOD] + (size_t)l * D * 6144 + (size_t)kq * 256 * 6144 + col;
        float acc[9];
#pragma unroll
        for (int m = 0; m < 9; ++m) acc[m] = 0.f;
#pragma unroll 8
        for (int k = 0; k < 256; ++k) {
            const float wv = w[(size_t)k * 6144];
#pragma unroll
            for (int m = 0; m < 9; ++m) acc[m] += sm[m * D + kq * 256 + k] * wv;
        }
        __syncthreads();
#pragma unroll
        for (int m = 0; m < 9; ++m) sm[9 * D + (kq * 9 + m) * 64 + (tid & 63)] = acc[m];
        __syncthreads();
        if (tid < 64) {
            const float bias = p->in[I_BMOD][l * 6144 + col];
            float* mv = (float*)(p->ws + WS_MODV);
#pragma unroll
            for (int m = 0; m < 9; ++m)
                mv[(size_t)(l * 9 + m) * 6144 + col] = sm[9 * D + (0 * 9 + m) * 64 + tid] + sm[9 * D + (1 * 9 + m) * 64 + tid] + sm[9 * D + (2 * 9 + m) * 64 + tid] + sm[9 * D + (3 * 9 + m) * 64 + tid] + bias;
        }
    }
    for (int it = blockIdx.x; it < 1 + 72 + 2 * 128; it += gridDim.x) {
        if (it == 0) {
            float2* rope = (float2*)(p->ws + WS_ROPE);
            for (int e = tid; e < 64 * 16; e += 256) {
                const int pos = e >> 4, i = e & 15;
                const float invf = powf(10000.0f, -(float)(2 * i) / 32.0f);
                const float angf = (float)pos * invf;
                const double ang = (double)angf;
                const double twopi = 6.283185307179586476925286766559;
                const double n = rint(ang / twopi);
                const double r = ang - n * twopi, r2 = r * r;
                double sn = 1.0, cs = 1.0;
                for (int q = 14; q >= 1; --q) { sn = 1.0 - r2 / (double)((2 * q) * (2 * q + 1)) * sn; cs = 1.0 - r2 / (double)((2 * q - 1) * (2 * q)) * cs; }
                sn *= r;
                rope[e] = make_float2((float)cs, (float)sn);
            }
        } else if (it < 73) {
            const int q = it - 1, l = q / 36, o = q % 36;
            float* dst = (float*)(p->ws + WS_RWT) + (size_t)(l * 36 + o) * D;
            for (int k = tid; k < D; k += 256) dst[k] = o < 4 ? p->in[I_WGRP][((size_t)l * D + k) * 4 + o] : p->in[I_WEXP][((size_t)l * D + k) * 32 + (o - 4)];
        } else {
            const int q = it - 73, l = q >> 7, r = q & 127;
            const int m0 = (r >> 4) * 64, n0 = (r & 15) * 64, g = m0 >> 7;
            const float* PW = p->in[I_POOLW] + ((size_t)(l * 4 + g) * 128) * 128;
            const float* PS = p->in[I_POOLS] + l * 512 + g * 128;
            const float* WB = p->in[I_WBR] + ((size_t)(l * 3 + 2) * 512 + g * 128) * D;
            float acc[4][4]; zero_acc(acc);
            gemm64(acc, 128,
                   [&](int m, int k) { const float4 a = *(const float4*)(PW + (size_t)((m0 + m) & 127) * 128 + k); const float4 sc = *(const float4*)(PS + k);
                                       return make_float4(a.x * sc.x, a.y * sc.y, a.z * sc.z, a.w * sc.w); },
                   [&](int k, int n) { return *(const float4*)(WB + (size_t)k * D + n0 + n); }, sm, sm + 16 * 68, tid);
            const int ty = tid >> 4, tx = tid & 15;
            bf16* dst = wsm_bt(p, l, 2);
#pragma unroll
            for (int j = 0; j < 4; ++j) st_bf4(dst + (size_t)(n0 + tx * 4 + j) * 512 + m0 + ty * 4, acc[0][j], acc[1][j], acc[2][j], acc[3][j]);
        }
    }
}

__device__ void ph_norm1(KParams p, int l) {
    const int tid = tid_opaque(), lane = tid & 63, gw = blockIdx.x * 4 + (tid >> 6), ngw = gridDim.x * 4;
    bf16* H = (bf16*)(p->ws + WS_H);
    const float* g = p->in[I_N1G] + l * D;
    for (int r0 = gw * 2; r0 < NTOK; r0 += ngw * 2) {
        float4 v[2][4];
#pragma unroll
        for (int q = 0; q < 2; ++q) {
            const float* x = xrow(p, l, r0 + q);
#pragma unroll
            for (int j = 0; j < 4; ++j) v[q][j] = *(const float4*)(x + j * 256 + lane * 4);
        }
#pragma unroll
        for (int q = 0; q < 2; ++q) {
            const int r = r0 + q, mb = modrow(r);
            const float* sh = modv(p, l, mb, 0); const float* sc = modv(p, l, mb, 1);
            float ss = 0.f;
#pragma unroll
            for (int j = 0; j < 4; ++j) ss += v[q][j].x * v[q][j].x + v[q][j].y * v[q][j].y + v[q][j].z * v[q][j].z + v[q][j].w * v[q][j].w;
            const float inv = rsqrtf(wave_sum(ss) * (1.f / D) + EPS);
#pragma unroll
            for (int j = 0; j < 4; ++j) {
                const int c = j * 256 + lane * 4;
                const float4 gg = *(const float4*)(g + c), s1 = *(const float4*)(sh + c), s2 = *(const float4*)(sc + c);
                st_bf4(H + (size_t)r * D + c, v[q][j].x * inv * gg.x * (1.f + s2.x) + s1.x, v[q][j].y * inv * gg.y * (1.f + s2.y) + s1.y,
                       v[q][j].z * inv * gg.z * (1.f + s2.z) + s1.z, v[q][j].w * inv * gg.w * (1.f + s2.w) + s1.w);
            }
        }
    }
}

__device__ void ph_gemm_in(KParams p, int l, unsigned char* lds) {
    const bf16* H = (const bf16*)(p->ws + WS_H);
    bf16* PROJ = (bf16*)(p->ws + WS_PROJ);
    const bf16* WT = wsm_int(p, l);
    const float2* rope = (const float2*)(p->ws + WS_ROPE);
    const int nN = 47, nM = NTOK / 128;
    const int tid = tid_opaque(), lane = tid & 63, wid = tid >> 6, wr = wid >> 1, wc = wid & 1, fr = lane & 15, fq = lane >> 4;
    for (int it = vblock(); it < nM * nN; it += gridDim.x) {
        int tm, tn; tile_coords(it, nM, nN, tm, tn);
        f32x4 acc[4][4]; zero_acc4(acc);
        gemm_tile(acc, [&](int r) { return H + (size_t)(tm * 128 + r) * D; }, [&](int r) { return WT + (size_t)(tn * 128 + r) * D; }, D, lds, tid);
        if (tn >= 12 && tn <= 16) {
            const bool isq = tn < 16;
            const float* gsrc = p->in[isq ? I_QNG : I_KNG] + l * 64 + fq * 4;
            float4 g[4];
#pragma unroll
            for (int j = 0; j < 4; ++j) g[j] = *(const float4*)(gsrc + j * 16);
            const float qs = isq ? 0.125f * 1.4426950408889634f : 1.f;
#pragma unroll
            for (int i = 0; i < 4; ++i) {
                float ss = 0.f;
#pragma unroll
                for (int j = 0; j < 4; ++j) ss += acc[i][j][0] * acc[i][j][0] + acc[i][j][1] * acc[i][j][1] + acc[i][j][2] * acc[i][j][2] + acc[i][j][3] * acc[i][j][3];
                ss += __shfl_xor(ss, 16); ss += __shfl_xor(ss, 32);
                const float inv = rsqrtf(ss * (1.f / 64.f) + EPS);
                const int row = tm * 128 + wr * 64 + i * 16 + fr;
                f32x4 v[4];
#pragma unroll
                for (int j = 0; j < 4; ++j) { v[j][0] = acc[i][j][0] * inv * g[j].x; v[j][1] = acc[i][j][1] * inv * g[j].y; v[j][2] = acc[i][j][2] * inv * g[j].z; v[j][3] = acc[i][j][3] * inv * g[j].w; }
                if (row < NL) {
                    const int t = row & (T - 1), prow = t >> 6, pcol = t & 63;
#pragma unroll
                    for (int e = 0; e < 4; ++e) {
                        const float2 a = rope[prow * 16 + fq * 4 + e], b2 = rope[pcol * 16 + fq * 4 + e];
                        const float x1 = v[0][e], x2 = v[1][e], y1 = v[2][e], y2 = v[3][e];
                        v[0][e] = x1 * a.x - x2 * a.y; v[1][e] = x1 * a.y + x2 * a.x;
                        v[2][e] = y1 * b2.x - y2 * b2.y; v[3][e] = y1 * b2.y + y2 * b2.x;
                    }
                }
#pragma unroll
                for (int j = 0; j < 4; ++j)
                    st_bf4(PROJ + (size_t)row * INW + tn * 128 + wc * 64 + j * 16 + fq * 4, v[j][0] * qs, v[j][1] * qs, v[j][2] * qs, v[j][3] * qs);
            }
        } else {
#pragma unroll
            for (int i = 0; i < 4; ++i)
#pragma unroll
                for (int j = 0; j < 4; ++j) {
                    const int row = tm * 128 + wr * 64 + i * 16 + fr, col = tn * 128 + wc * 64 + j * 16 + fq * 4;
                    if (col < INW) st_bf4(PROJ + (size_t)row * INW + col, acc[i][j][0], acc[i][j][1], acc[i][j][2], acc[i][j][3]);
                }
        }
    }
}

__device__ void ph_prep(KParams p, int l, float* smf) {
    const int tid = tid_opaque();
    bf16* PROJ = (bf16*)(p->ws + WS_PROJ);
    {
        bf16* DP = (bf16*)(p->ws + WS_R2 + 2 * SZ_Y512);
        const int lane = tid & 63, gw = blockIdx.x * 4 + (tid >> 6), ngw = gridDim.x * 4;
        const int ch = lane * 8, hw = 1 << (lane >> 4);
        const int nrows = (l == 0) ? NTOK : NL;
        for (int r = gw; r < nrows; r += ngw) {
            int t, tl;
            if (r < NL) { t = r & (T - 1); tl = T; } else { t = (r - NL) & (CL - 1); tl = CL; }
            const bf16* src = PROJ + (size_t)r * INW + O_PU + ch;
            const int lo = max(t - hw, 0), hi = min(t + hw, tl);
            uint4 nb[16];
#pragma unroll
            for (int u = 0; u < 16; ++u) {
                const int tt = t - 8 + u;
                nb[u] = (tt >= lo && tt < hi) ? *(const uint4*)(src + (long)(u - 8) * INW) : make_uint4(0u, 0u, 0u, 0u);
            }
            float sacc[8] = {0.f, 0.f, 0.f, 0.f, 0.f, 0.f, 0.f, 0.f};
#pragma unroll
            for (int u = 0; u < 16; ++u) {
                const unsigned w[4] = {nb[u].x, nb[u].y, nb[u].z, nb[u].w};
#pragma unroll
                for (int q = 0; q < 4; ++q) { sacc[2 * q] += __uint_as_float(w[q] << 16); sacc[2 * q + 1] += __uint_as_float(w[q] & 0xffff0000u); }
            }
            const float inv = 1.f / (float)(hi - lo);
            const uint4 cc = nb[8];
            const unsigned cw[4] = {cc.x, cc.y, cc.z, cc.w};
            unsigned o[4];
#pragma unroll
            for (int q = 0; q < 4; ++q) o[q] = pk_bf16(sacc[2 * q] * inv - __uint_as_float(cw[q] << 16), sacc[2 * q + 1] * inv - __uint_as_float(cw[q] & 0xffff0000u));
            *(uint4*)(DP + (size_t)r * 512 + ch) = make_uint4(o[0], o[1], o[2], o[3]);
        }
    }
    {
        bf16* VT = (bf16*)(p->ws + WS_VT);
        unsigned short* st = (unsigned short*)smf;
        for (int it = blockIdx.x; it < (NTOK / 64) * 2; it += gridDim.x) {
            const int rt = it >> 1, kvh = it & 1;
            int b, key0;
            if (rt < NL / 64) { b = rt / 64; key0 = (rt % 64) * 64; } else { const int j = rt - NL / 64; b = j / 4; key0 = T + (j % 4) * 64; }
            __syncthreads();
            {
                const int k = tid >> 2, dq = (tid & 3) * 16;
                const bf16* src = PROJ + (size_t)(rt * 64 + k) * INW + O_AV + kvh * 64 + dq;
                const uint4 a = *(const uint4*)src, c = *(const uint4*)(src + 8);
                unsigned* d = (unsigned*)(st + k * 66 + dq);
                d[0] = a.x; d[1] = a.y; d[2] = a.z; d[3] = a.w; d[4] = c.x; d[5] = c.y; d[6] = c.z; d[7] = c.w;
            }
            __syncthreads();
            {
                const int d = tid >> 2, kq = (tid & 3) * 16;
                unsigned w[8];
#pragma unroll
                for (int i = 0; i < 8; ++i) w[i] = (unsigned)st[(kq + 2 * i) * 66 + d] | ((unsigned)st[(kq + 2 * i + 1) * 66 + d] << 16);
                bf16* dst = VT + ((size_t)(b * 2 + kvh) * 64 + d) * NKEY + key0 + kq;
                *(uint4*)dst = make_uint4(w[0], w[1], w[2], w[3]);
                *(uint4*)(dst + 8) = make_uint4(w[4], w[5], w[6], w[7]);
            }
        }
    }
}

typedef float f32x16 __attribute__((ext_vector_type(16)));
typedef short s16x4 __attribute__((ext_vector_type(4)));
#define MFMA32(a, b, c) __builtin_amdgcn_mfma_f32_32x32x16_bf16((a), (b), (c), 0, 0, 0)
__device__ __forceinline__ bf16x8 pack8(const f32x16& x, int s) {
    typedef unsigned u32x4_t __attribute__((ext_vector_type(4)));
    u32x4_t r;
    r[0] = pk_bf16(x[8 * s + 0], x[8 * s + 1]); r[1] = pk_bf16(x[8 * s + 2], x[8 * s + 3]);
    r[2] = pk_bf16(x[8 * s + 4], x[8 * s + 5]); r[3] = pk_bf16(x[8 * s + 6], x[8 * s + 7]);
    return __builtin_bit_cast(bf16x8, r);
}
__device__ __forceinline__ void attn_item(KParams p, int l, int it, unsigned char* lds, const int tid_) {
    const int tid = tid_opaque();
    const int lane = tid & 63, wid = tid >> 6, r32 = lane & 31, h = lane >> 5;
    bf16* PROJ = (bf16*)(p->ws + WS_PROJ);
    const bf16* VT = (const bf16*)(p->ws + WS_VT);
    float mq = 0.f, mk = 0.f;
    for (int d = 0; d < 64; ++d) { mq = fmaxf(mq, fabsf(p->in[I_QNG][l * 64 + d])); mk = fmaxf(mk, fabsf(p->in[I_KNG][l * 64 + d])); }
    const float shift2 = 8.f * mq * mk * 1.4426950408889634f;
    const int srow = tid >> 3, sc = ((tid & 7) ^ ((tid >> 4) & 7)) * 8, sw = (r32 >> 1) & 7;
    const int nlat = NB * 8 * 16;
    {
        int b, head, qrow0, nkt, vkey0;
        const bool lat = it < nlat;
        if (lat) { b = it >> 7; head = (it >> 4) & 7; qrow0 = b * T + (it & 15) * 256; nkt = 68; vkey0 = 0; }
        else { const int j = it - nlat; b = j >> 3; head = j & 7; qrow0 = NL + b * CL; nkt = 4; vkey0 = T; }
        const int kvh = head >> 2;
        bf16x8 qf[2][4];
#pragma unroll
        for (int qb = 0; qb < 2; ++qb)
#pragma unroll
            for (int ks = 0; ks < 4; ++ks)
                qf[qb][ks] = *(const bf16x8*)(PROJ + (size_t)(qrow0 + wid * 64 + qb * 32 + r32) * INW + O_AQ + head * 64 + ks * 16 + h * 8);
        const bf16* vsrc[2];
#pragma unroll
        for (int j = 0; j < 2; ++j) vsrc[j] = VT + ((size_t)(b * 2 + kvh) * 64 + j * 32 + srow) * NKEY + vkey0 + sc;
        const bf16* kbase = PROJ + O_AK + kvh * 64 + sc;
        auto krow = [&](int kt, int r) { return lat ? (kt < 64 ? b * T + kt * 64 + r : NL + b * CL + (kt - 64) * 64 + r) : NL + b * CL + kt * 64 + r; };
        auto stage = [&](int kt, int buf) {
            unsigned char* base = lds + buf * 16384;
#pragma unroll
            for (int j = 0; j < 2; ++j) {
                __builtin_amdgcn_global_load_lds((const unsigned*)(kbase + (size_t)krow(kt, j * 32 + srow) * INW), (unsigned*)(base + j * 4096 + tid * 16), 16, 0, 0);
                __builtin_amdgcn_global_load_lds((const unsigned*)(vsrc[j] + kt * 64), (unsigned*)(base + 8192 + j * 4096 + tid * 16), 16, 0, 0);
            }
        };
        f32x16 o[2][2];
#pragma unroll
        for (int a = 0; a < 2; ++a)
#pragma unroll
            for (int c = 0; c < 2; ++c)
#pragma unroll
                for (int e = 0; e < 16; ++e) o[a][c][e] = 0.f;
        float l0 = 0.f, l1 = 0.f;
        stage(0, 0);
#pragma unroll 1
        for (int kt = 0; kt < nkt; ++kt) {
            asm volatile("s_waitcnt vmcnt(0)" ::: "memory");
            __syncthreads();
            if (kt + 1 < nkt) stage(kt + 1, (kt + 1) & 1);
            const unsigned char* kb_ = lds + (kt & 1) * 16384;
            const unsigned char* vb_ = kb_ + 8192;
#pragma unroll
            for (int kb = 0; kb < 2; ++kb) {
                f32x16 s0, s1;
#pragma unroll
                for (int e = 0; e < 16; ++e) { s0[e] = 0.f; s1[e] = 0.f; }
#pragma unroll
                for (int ks = 0; ks < 4; ++ks) {
                    const bf16x8 kf = *(const bf16x8*)(kb_ + (kb * 32 + r32) * 128 + (((2 * ks + h) ^ sw) * 16));
                    s0 = MFMA32(kf, qf[0][ks], s0);
                    s1 = MFMA32(kf, qf[1][ks], s1);
                }
#pragma unroll
                for (int e = 0; e < 16; ++e) {
                    s0[e] = __builtin_amdgcn_exp2f(s0[e] - shift2); l0 += s0[e];
                    s1[e] = __builtin_amdgcn_exp2f(s1[e] - shift2); l1 += s1[e];
                }
#pragma unroll
                for (int s2 = 0; s2 < 2; ++s2) {
                    const bf16x8 p0 = pack8(s0, s2), p1 = pack8(s1, s2);
                    const int ksv = kb * 2 + s2;
#pragma unroll
                    for (int db = 0; db < 2; ++db) {
                        const unsigned char* vr = vb_ + (db * 32 + r32) * 128 + 8 * h;
                        const s16x4 lo = *(const s16x4*)(vr + (((2 * ksv) ^ sw) * 16));
                        const s16x4 hi = *(const s16x4*)(vr + (((2 * ksv + 1) ^ sw) * 16));
                        const bf16x8 vf = __builtin_shufflevector(lo, hi, 0, 1, 2, 3, 4, 5, 6, 7);
                        o[db][0] = MFMA32(vf, p0, o[db][0]);
                        o[db][1] = MFMA32(vf, p1, o[db][1]);
                    }
                }
            }
        }
        l0 += __shfl_xor(l0, 32); l1 += __shfl_xor(l1, 32);
        const float i0 = 1.f / l0, i1 = 1.f / l1;
#pragma unroll
        for (int qb = 0; qb < 2; ++qb) {
            const float inv = qb ? i1 : i0;
            bf16* orow = PROJ + (size_t)(qrow0 + wid * 64 + qb * 32 + r32) * INW + O_AQ + head * 64;
#pragma unroll
            for (int db = 0; db < 2; ++db)
#pragma unroll
                for (int g = 0; g < 4; ++g)
                    st_bf4(orow + db * 32 + 8 * g + 4 * h, o[db][qb][4 * g] * inv, o[db][qb][4 * g + 1] * inv, o[db][qb][4 * g + 2] * inv, o[db][qb][4 * g + 3] * inv);
        }
    }
}

constexpr int GL_QS = 0, GL_KS = 8192, GL_KDT = 16384, GL_VT = 24576, GL_GLS = 40960, GL_TOT = 45056, GL_FIRST = 47104, GL_EBREF = 47360, GL_EBLAST = 47616,
              GL_RAWQ = 47872, GL_RAWK = 56064, GL_RAWV = 64256;
__device__ __forceinline__ int swz(int row, int byte) { return row * 128 + ((((byte >> 4) ^ (row >> 1)) & 7) << 4) + (byte & 15); }
__device__ __forceinline__ void gla_task(KParams p, int l, int task, unsigned char* lds, const int tid_) {
    const int tid = tid_opaque();
    const int lane = tid & 63, w = tid >> 6, r32 = lane & 31, h = lane >> 5;
    const int b = task >> 3, hd = (task >> 1) & 3, dir = task & 1;
    const bf16* PROJ = (const bf16*)(p->ws + WS_PROJ);
    bf16* OG = (bf16*)(p->ws + WS_R2 + (size_t)dir * SZ_Y512);
    const float* up = p->in[dir ? I_UPB : I_UPF] + (size_t)l * 16 * 256 + hd * 64;
    const float* bias = p->in[dir ? I_BIASB : I_BIASF] + l * 256 + hd * 64;
    const int ogl = dir ? O_GLB : O_GLF;
    const int dk2 = (tid & 31) * 2, seg = tid >> 5;
    const int dv2 = (tid & 63) * 2, vq = tid >> 6;
    const float2 bia = *(const float2*)(bias + dk2);
    f32x16 S[2];
#pragma unroll
    for (int e = 0; e < 16; ++e) { S[0][e] = 0.f; S[1][e] = 0.f; }
    auto chunk_base = [&](int n) { return n < 4 ? NL + b * CL + (dir ? 3 - n : n) * 64 : b * T + (dir ? 63 - (n - 4) : (n - 4)) * 64; };
    auto prefetch = [&](int n) {
        const int base = chunk_base(n);
#pragma unroll
        for (int j = 0; j < 2; ++j) {
            const int i = j * 32 + (tid >> 3); const size_t tok = dir ? base + 63 - i : base + i;
            __builtin_amdgcn_global_load_lds((const unsigned*)(PROJ + tok * INW + O_GQ + hd * 64 + (tid & 7) * 8), (unsigned*)(lds + GL_RAWQ + j * 4096 + tid * 16), 16, 0, 0);
            __builtin_amdgcn_global_load_lds((const unsigned*)(PROJ + tok * INW + O_GK + hd * 64 + (tid & 7) * 8), (unsigned*)(lds + GL_RAWK + j * 4096 + tid * 16), 16, 0, 0);
        }
#pragma unroll
        for (int j = 0; j < 4; ++j) {
            const int i = j * 16 + (tid >> 4); const size_t tok = dir ? base + 63 - i : base + i;
            __builtin_amdgcn_global_load_lds((const unsigned*)(PROJ + tok * INW + O_GV + hd * 128 + (tid & 15) * 8), (unsigned*)(lds + GL_RAWV + j * 4096 + tid * 16), 16, 0, 0);
        }
        if (tid < 128) {
            const int i = tid >> 1; const size_t tok = dir ? base + 63 - i : base + i;
            __builtin_amdgcn_global_load_lds((const unsigned*)(PROJ + tok * INW + ogl + (tid & 1) * 8), (unsigned*)(lds + GL_GLS + tid * 16), 16, 0, 0);
        }
    };
    __syncthreads();
    prefetch(0);
#pragma unroll 1
    for (int n = 0; n < 68; ++n) {
        const int base = chunk_base(n);
        asm volatile("s_waitcnt vmcnt(0)" ::: "memory");
        __syncthreads();
        float la0[8], la1[8];
        {
            float up0[16], up1[16];
#pragma unroll
            for (int j = 0; j < 16; ++j) { const float2 t = *(const float2*)(up + j * 256 + dk2); up0[j] = t.x; up1[j] = t.y; }
            const unsigned char* gls = lds + GL_GLS;
#pragma unroll
            for (int u = 0; u < 8; ++u) {
                const int i = seg * 8 + u;
                const uint4 g0 = *(const uint4*)(gls + i * 32), g1 = *(const uint4*)(gls + i * 32 + 16);
                const unsigned gw[8] = {g0.x, g0.y, g0.z, g0.w, g1.x, g1.y, g1.z, g1.w};
                float a0 = bia.x, a1 = bia.y;
#pragma unroll
                for (int j = 0; j < 8; ++j) {
                    const float glo = __uint_as_float(gw[j] << 16), ghi = __uint_as_float(gw[j] & 0xffff0000u);
                    a0 += glo * up0[2 * j]; a1 += glo * up1[2 * j];
                    a0 += ghi * up0[2 * j + 1]; a1 += ghi * up1[2 * j + 1];
                }
                la0[u] = (fminf(a0, 0.f) - __logf(1.f + __expf(-fabsf(a0)))) * (1.f / 16.f);
                la1[u] = (fminf(a1, 0.f) - __logf(1.f + __expf(-fabsf(a1)))) * (1.f / 16.f);
            }
#pragma unroll
            for (int u = 1; u < 8; ++u) { la0[u] += la0[u - 1]; la1[u] += la1[u - 1]; }
            *(float2*)(lds + GL_TOT + (seg * 64 + dk2) * 4) = make_float2(la0[7], la1[7]);
            if (seg == 4) *(float2*)(lds + GL_FIRST + dk2 * 4) = make_float2(la0[0], la1[0]);
        }
        __syncthreads();
        {
            float off0 = 0.f, off1 = 0.f, pre0 = 0.f, pre1 = 0.f, all0 = 0.f, all1 = 0.f;
#pragma unroll
            for (int sg = 0; sg < 8; ++sg) {
                const float2 t = *(const float2*)(lds + GL_TOT + (sg * 64 + dk2) * 4);
                if (sg < seg) { off0 += t.x; off1 += t.y; }
                if (sg < 4) { pre0 += t.x; pre1 += t.y; }
                all0 += t.x; all1 += t.y;
            }
            const float2 f4 = *(const float2*)(lds + GL_FIRST + dk2 * 4);
            const float bref0 = pre0 + f4.x, bref1 = pre1 + f4.y;
            const float c0 = __expf(all0 - bref0), c1 = __expf(all1 - bref1);
            unsigned kd0[4], kd1[4];
#pragma unroll
            for (int u = 0; u < 8; u += 2) {
                float kdv[2][2];
#pragma unroll
                for (int uu = 0; uu < 2; ++uu) {
                    const int i = seg * 8 + u + uu;
                    const float e0 = __expf(off0 + la0[u + uu] - bref0), e1 = __expf(off1 + la1[u + uu] - bref1);
                    const float r0 = __builtin_amdgcn_rcpf(e0), r1 = __builtin_amdgcn_rcpf(e1);
                    const unsigned rqv = *(const unsigned*)(lds + GL_RAWQ + i * 128 + dk2 * 2), rkv = *(const unsigned*)(lds + GL_RAWK + i * 128 + dk2 * 2);
                    const float q0 = __uint_as_float(rqv << 16), q1 = __uint_as_float(rqv & 0xffff0000u);
                    const float k0 = __uint_as_float(rkv << 16), k1 = __uint_as_float(rkv & 0xffff0000u);
                    const float ks0 = k0 * r0, ks1 = k1 * r1;
                    *(unsigned*)(lds + GL_QS + swz(i, dk2 * 2)) = pk_bf16(q0 * 0.125f * e0, q1 * 0.125f * e1);
                    *(unsigned*)(lds + GL_KS + swz(i, dk2 * 2)) = pk_bf16(ks0, ks1);
                    kdv[uu][0] = ks0 * c0; kdv[uu][1] = ks1 * c1;
                }
                kd0[u >> 1] = pk_bf16(kdv[0][0], kdv[1][0]); kd1[u >> 1] = pk_bf16(kdv[0][1], kdv[1][1]);
            }
            *(uint4*)(lds + GL_KDT + swz(dk2, seg * 16)) = make_uint4(kd0[0], kd0[1], kd0[2], kd0[3]);
            *(uint4*)(lds + GL_KDT + swz(dk2 + 1, seg * 16)) = make_uint4(kd1[0], kd1[1], kd1[2], kd1[3]);
            unsigned va[8], vb[8], rv[16];
#pragma unroll
            for (int u = 0; u < 16; ++u) rv[u] = *(const unsigned*)(lds + GL_RAWV + (vq * 16 + u) * 256 + dv2 * 2);
#pragma unroll
            for (int m = 0; m < 8; ++m) { va[m] = (rv[2 * m] & 0xffffu) | (rv[2 * m + 1] << 16); vb[m] = (rv[2 * m] >> 16) | (rv[2 * m + 1] & 0xffff0000u); }
            *(uint4*)(lds + GL_VT + swz(dv2, vq * 32)) = make_uint4(va[0], va[1], va[2], va[3]);
            *(uint4*)(lds + GL_VT + swz(dv2, vq * 32 + 16)) = make_uint4(va[4], va[5], va[6], va[7]);
            *(uint4*)(lds + GL_VT + swz(dv2 + 1, vq * 32)) = make_uint4(vb[0], vb[1], vb[2], vb[3]);
            *(uint4*)(lds + GL_VT + swz(dv2 + 1, vq * 32 + 16)) = make_uint4(vb[4], vb[5], vb[6], vb[7]);
            if (seg == 0) {
                *(float2*)(lds + GL_EBREF + dk2 * 4) = make_float2(__expf(bref0), __expf(bref1));
                *(float2*)(lds + GL_EBLAST + dk2 * 4) = make_float2(__expf(all0), __expf(all1));
            }
        }
        __syncthreads();
        if (n + 1 < 68) prefetch(n + 1);
        {
            const unsigned char* QS = lds + GL_QS; const unsigned char* KS = lds + GL_KS; const unsigned char* KDT = lds + GL_KDT; const unsigned char* VTL = lds + GL_VT;
            f32x16 ot[2];
#pragma unroll
            for (int e = 0; e < 16; ++e) { ot[0][e] = 0.f; ot[1][e] = 0.f; }
            bf16x8 sp[2][2];
#pragma unroll
            for (int dkb = 0; dkb < 2; ++dkb) {
                f32x16 t;
#pragma unroll
                for (int g = 0; g < 4; ++g) {
                    const float4 e = *(const float4*)(lds + GL_EBREF + (32 * dkb + 8 * g + 4 * h) * 4);
                    t[4 * g] = S[dkb][4 * g] * e.x; t[4 * g + 1] = S[dkb][4 * g + 1] * e.y; t[4 * g + 2] = S[dkb][4 * g + 2] * e.z; t[4 * g + 3] = S[dkb][4 * g + 3] * e.w;
                }
                sp[dkb][0] = pack8(t, 0); sp[dkb][1] = pack8(t, 1);
            }
#pragma unroll
            for (int ib = 0; ib < 2; ++ib)
#pragma unroll
                for (int ksv = 0; ksv < 4; ++ksv) {
                    const int row = 32 * ib + r32;
                    const s16x4 lo = *(const s16x4*)(QS + swz(row, 32 * ksv + 8 * h));
                    const s16x4 hi = *(const s16x4*)(QS + swz(row, 32 * ksv + 16 + 8 * h));
                    const bf16x8 qp = __builtin_shufflevector(lo, hi, 0, 1, 2, 3, 4, 5, 6, 7);
                    ot[ib] = MFMA32(sp[ksv >> 1][ksv & 1], qp, ot[ib]);
                }
#pragma unroll
            for (int tI = 0; tI < 3; ++tI) {
                const int sb = tI == 2 ? 1 : 0, ib = tI == 0 ? 0 : 1;
                f32x16 pt;
#pragma unroll
                for (int e = 0; e < 16; ++e) pt[e] = 0.f;
#pragma unroll
                for (int ks = 0; ks < 4; ++ks) {
                    const bf16x8 kf = *(const bf16x8*)(KS + swz(32 * sb + r32, (2 * ks + h) * 16));
                    const bf16x8 qf = *(const bf16x8*)(QS + swz(32 * ib + r32, (2 * ks + h) * 16));
                    pt = MFMA32(kf, qf, pt);
                }
                if (sb == ib) {
#pragma unroll
                    for (int e = 0; e < 16; ++e) { const int sl = (e & 3) + 8 * (e >> 2) + 4 * h; if (sl > r32) pt[e] = 0.f; }
                }
#pragma unroll
                for (int s2 = 0; s2 < 2; ++s2) {
                    const int ksv = 2 * sb + s2, row = 32 * w + r32;
                    const s16x4 lo = *(const s16x4*)(VTL + swz(row, 32 * ksv + 8 * h));
                    const s16x4 hi = *(const s16x4*)(VTL + swz(row, 32 * ksv + 16 + 8 * h));
                    const bf16x8 vp = __builtin_shufflevector(lo, hi, 0, 1, 2, 3, 4, 5, 6, 7);
                    ot[ib] = MFMA32(vp, pack8(pt, s2), ot[ib]);
                }
            }
#pragma unroll
            for (int ib = 0; ib < 2; ++ib) {
                const int i = 32 * ib + r32; const size_t tok = dir ? base + 63 - i : base + i;
                bf16* dst = OG + tok * 512 + hd * 128 + 32 * w + 4 * h;
#pragma unroll
                for (int g = 0; g < 4; ++g) st_bf4(dst + 8 * g, ot[ib][4 * g], ot[ib][4 * g + 1], ot[ib][4 * g + 2], ot[ib][4 * g + 3]);
            }
#pragma unroll
            for (int dkb = 0; dkb < 2; ++dkb)
#pragma unroll
                for (int g = 0; g < 4; ++g) {
                    const float4 e = *(const float4*)(lds + GL_EBLAST + (32 * dkb + 8 * g + 4 * h) * 4);
                    S[dkb][4 * g] *= e.x; S[dkb][4 * g + 1] *= e.y; S[dkb][4 * g + 2] *= e.z; S[dkb][4 * g + 3] *= e.w;
                }
#pragma unroll
            for (int ks = 0; ks < 4; ++ks) {
                const bf16x8 vn = *(const bf16x8*)(VTL + swz(32 * w + r32, (2 * ks + h) * 16));
#pragma unroll
                for (int dkb = 0; dkb < 2; ++dkb) {
                    const bf16x8 kd = *(const bf16x8*)(KDT + swz(32 * dkb + r32, (2 * ks + h) * 16));
                    S[dkb] = MFMA32(kd, vn, S[dkb]);
                }
            }
        }
    }
}

constexpr int CW_WORK = 64;
constexpr int LDS_ITEM_OFF = 79 * 1024;
__device__ void ph_mix(KParams p, int l, unsigned char* lds) {
    const int tid = tid_opaque();
    unsigned* ctr = (unsigned*)(p->ws + WS_CTL) + CW_WORK + l;
    volatile int* slot = (volatile int*)(lds + LDS_ITEM_OFF);
    const int nitems = 64 + NB * 8 * 16 + ((l == 0) ? NB * 8 : 0);
    for (;;) {
        __syncthreads();
        if (tid == 0) *slot = (int)__hip_atomic_fetch_add(ctr, 1u, __ATOMIC_RELAXED, __HIP_MEMORY_SCOPE_AGENT);
        __syncthreads();
        const int it = *slot;
        if (it >= nitems) break;
        if (it < 64) gla_task(p, l, it, lds, tid);
        else attn_item(p, l, it - 64, lds, tid);
    }
}

__device__ void ph_ygla(KParams p, int l) {
    const int tid = tid_opaque(), lane = tid & 63, gw = blockIdx.x * 4 + (tid >> 6), ngw = gridDim.x * 4;
    bf16* O0 = (bf16*)(p->ws + WS_R2);
    const bf16* O1 = (const bf16*)(p->ws + WS_R2 + SZ_Y512);
    const bf16* PROJ = (const bf16*)(p->ws + WS_PROJ);
    const int nrows = (l == 0) ? NTOK : NL;
    const int c = lane * 8;
    const float4 g0 = *(const float4*)(p->in[I_GLANG] + l * 128 + (c & 127)), g1 = *(const float4*)(p->in[I_GLANG] + l * 128 + (c & 127) + 4);
    const float g[8] = {g0.x, g0.y, g0.z, g0.w, g1.x, g1.y, g1.z, g1.w};
    for (int r0 = gw * 4; r0 < nrows; r0 += ngw * 4) {
        uint4 a[4], b[4], gr[4];
#pragma unroll
        for (int q = 0; q < 4; ++q) {
            a[q] = *(const uint4*)(O0 + (size_t)(r0 + q) * 512 + c); b[q] = *(const uint4*)(O1 + (size_t)(r0 + q) * 512 + c);
            gr[q] = *(const uint4*)(PROJ + (size_t)(r0 + q) * INW + O_GR + c);
        }
#pragma unroll
        for (int q = 0; q < 4; ++q) {
            const unsigned aw[4] = {a[q].x, a[q].y, a[q].z, a[q].w}, bw[4] = {b[q].x, b[q].y, b[q].z, b[q].w}, gw_[4] = {gr[q].x, gr[q].y, gr[q].z, gr[q].w};
            float v[8], grf[8];
#pragma unroll
            for (int e = 0; e < 4; ++e) {
                v[2 * e] = __uint_as_float(aw[e] << 16) + __uint_as_float(bw[e] << 16);
                v[2 * e + 1] = __uint_as_float(aw[e] & 0xffff0000u) + __uint_as_float(bw[e] & 0xffff0000u);
                grf[2 * e] = __uint_as_float(gw_[e] << 16); grf[2 * e + 1] = __uint_as_float(gw_[e] & 0xffff0000u);
            }
            float ss = 0.f;
#pragma unroll
            for (int e = 0; e < 8; ++e) ss += v[e] * v[e];
            ss += __shfl_xor(ss, 1); ss += __shfl_xor(ss, 2); ss += __shfl_xor(ss, 4); ss += __shfl_xor(ss, 8);
            const float inv = rsqrtf(ss * (1.f / 128.f) + EPS);
            unsigned o[4];
#pragma unroll
            for (int e = 0; e < 4; ++e) o[e] = pk_bf16(v[2 * e] * inv * g[2 * e] * silu_f(grf[2 * e]), v[2 * e + 1] * inv * g[2 * e + 1] * silu_f(grf[2 * e + 1]));
            *(uint4*)(O0 + (size_t)(r0 + q) * 512 + c) = make_uint4(o[0], o[1], o[2], o[3]);
        }
    }
}

__device__ void ph_merge(KParams p, int l, unsigned char* lds) {
    const bf16* PROJ = (const bf16*)(p->ws + WS_PROJ);
    const bf16* YG = (const bf16*)(p->ws + WS_R2);
    const bf16* DP = (const bf16*)(p->ws + WS_R2 + 2 * SZ_Y512);
    bf16* Z = (bf16*)(p->ws + WS_H);
    const int nrows = (l == 0) ? NTOK : NL, nM = nrows / 128, nN = 8;
    const int tid = tid_opaque(), lane = tid & 63, wid = tid >> 6, wr = wid >> 1, wc = wid & 1, fr = lane & 15, fq = lane >> 4;
    for (int it = vblock(); it < nM * nN; it += gridDim.x) {
        int tm, tn; tile_coords(it, nM, nN, tm, tn);
        f32x4 tot[4][4]; zero_acc4(tot);
#pragma unroll 1
        for (int br = 0; br < 3; ++br) {
            const bf16* WT = wsm_bt(p, l, br);
            const bf16* Ab = br == 0 ? YG : (br == 1 ? PROJ + O_AQ : DP);
            const size_t lda = br == 1 ? (size_t)INW : (size_t)512;
            f32x4 acc[4][4]; zero_acc4(acc);
            gemm_tile(acc, [&](int r) { return Ab + (size_t)(tm * 128 + r) * lda; }, [&](int r) { return WT + (size_t)(tn * 128 + r) * 512; }, 512, lds, tid);
#pragma unroll
            for (int i = 0; i < 4; ++i)
#pragma unroll
                for (int j = 0; j < 4; ++j) {
                    const int row = tm * 128 + wr * 64 + i * 16 + fr, col = tn * 128 + wc * 64 + j * 16 + fq * 4;
                    const float4 gt = ld_bf4(PROJ + (size_t)row * INW + O_GT + br * D + col);
                    tot[i][j][0] += sigmoid_f(gt.x) * acc[i][j][0]; tot[i][j][1] += sigmoid_f(gt.y) * acc[i][j][1];
                    tot[i][j][2] += sigmoid_f(gt.z) * acc[i][j][2]; tot[i][j][3] += sigmoid_f(gt.w) * acc[i][j][3];
                }
        }
#pragma unroll
        for (int i = 0; i < 4; ++i)
#pragma unroll
            for (int j = 0; j < 4; ++j) {
                const int row = tm * 128 + wr * 64 + i * 16 + fr, col = tn * 128 + wc * 64 + j * 16 + fq * 4;
                st_bf4(Z + (size_t)row * D + col, tot[i][j][0], tot[i][j][1], tot[i][j][2], tot[i][j][3]);
            }
    }
}

__device__ void ph_outproj(KParams p, int l, unsigned char* lds) {
    const bf16* Z = (const bf16*)(p->ws + WS_H);
    const bf16* WT = wsm_outt(p, l);
    const int nrows = (l == 0) ? NTOK : NL, nM = nrows / 128, nN = 8;
    const int tid = tid_opaque(), lane = tid & 63, wid = tid >> 6, wr = wid >> 1, wc = wid & 1, fr = lane & 15, fq = lane >> 4;
    for (int it = vblock(); it < nM * nN; it += gridDim.x) {
        int tm, tn; tile_coords(it, nM, nN, tm, tn);
        f32x4 acc[4][4]; zero_acc4(acc);
        gemm_tile(acc, [&](int r) { return Z + (size_t)(tm * 128 + r) * D; }, [&](int r) { return WT + (size_t)(tn * 128 + r) * D; }, D, lds, tid);
#pragma unroll
        for (int i = 0; i < 4; ++i) {
            const int r = tm * 128 + wr * 64 + i * 16 + fr;
            const float* xr = xrow(p, l, r);
            const float* g1 = modv(p, l, modrow(r), 2);
            float* dr = r < NL ? p->out + (size_t)r * D : (float*)(p->ws + WS_XC) + (size_t)(r - NL) * D;
#pragma unroll
            for (int j = 0; j < 4; ++j) {
                const int c = tn * 128 + wc * 64 + j * 16 + fq * 4;
                const float4 xo = *(const float4*)(xr + c), gg = *(const float4*)(g1 + c);
                *(float4*)(dr + c) = make_float4(xo.x + gg.x * acc[i][j][0], xo.y + gg.y * acc[i][j][1], xo.z + gg.z * acc[i][j][2], xo.w + gg.w * acc[i][j][3]);
            }
        }
    }
}

__device__ __forceinline__ const float* x1row(KParams p, int r) {
    return r < NL ? p->out + (size_t)r * D : (const float*)(p->ws + WS_XC) + (size_t)(r - NL) * D;
}
__device__ void ph_router(KParams p, int l, unsigned char* lds) {
    const int tid = tid_opaque(), lane = tid & 63, wid = tid >> 6;
    bf16* H = (bf16*)(p->ws + WS_H);
    const float* g = p->in[I_N2G] + l * D;
    const float* wt_ = (const float*)(p->ws + WS_RWT) + (size_t)l * 36 * D;
    unsigned* cnt = (unsigned*)(p->ws + WS_CTL) + CNT_BASE + l * 32 * CNT_STRIDE;
    int* list = (int*)(p->ws + WS_LIST);
    float* wt = (float*)(p->ws + WS_WT);
    const int nrows = (l == 0) ? NTOK : NL, ngrp = nrows / 16;
    const int myq = lane & 3;
    auto issue_chunk = [&](int c, int buf) {
#pragma unroll
        for (int j = 0; j < 6; ++j)
            __builtin_amdgcn_global_load_lds((const unsigned*)(wt_ + (size_t)c * 6 * D + j * 1024 + tid * 4), (unsigned*)(lds + buf * 24576 + j * 4096 + tid * 16), 16, 0, 0);
    };
    __syncthreads();
    if ((int)blockIdx.x < ngrp) issue_chunk(0, 0);
    for (int gi = blockIdx.x; gi < ngrp; gi += gridDim.x) {
        const int r0 = gi * 16 + wid * 4;
        float hv[4][16];
#pragma unroll
        for (int q = 0; q < 4; ++q) {
            const int r = r0 + q;
            const float* x = x1row(p, r);
            const int mb = modrow(r);
            const float* sh = modv(p, l, mb, 3); const float* sc = modv(p, l, mb, 4);
            float4 v[4]; float ss = 0.f;
#pragma unroll
            for (int j = 0; j < 4; ++j) { v[j] = *(const float4*)(x + j * 256 + lane * 4); ss += v[j].x * v[j].x + v[j].y * v[j].y + v[j].z * v[j].z + v[j].w * v[j].w; }
            const float inv = rsqrtf(wave_sum(ss) * (1.f / D) + EPS);
#pragma unroll
            for (int j = 0; j < 4; ++j) {
                const int c = j * 256 + lane * 4;
                const float4 gg = *(const float4*)(g + c), s1 = *(const float4*)(sh + c), s2 = *(const float4*)(sc + c);
                hv[q][j * 4 + 0] = v[j].x * inv * gg.x * (1.f + s2.x) + s1.x; hv[q][j * 4 + 1] = v[j].y * inv * gg.y * (1.f + s2.y) + s1.y;
                hv[q][j * 4 + 2] = v[j].z * inv * gg.z * (1.f + s2.z) + s1.z; hv[q][j * 4 + 3] = v[j].w * inv * gg.w * (1.f + s2.w) + s1.w;
                st_bf4(H + (size_t)r * D + c, hv[q][j * 4], hv[q][j * 4 + 1], hv[q][j * 4 + 2], hv[q][j * 4 + 3]);
            }
        }
        float lg[4] = {0.f, 0.f, 0.f, 0.f}, le[8] = {0.f, 0.f, 0.f, 0.f, 0.f, 0.f, 0.f, 0.f};
        int grp = 0; float ptg = 0.f;
#pragma unroll 1
        for (int c = 0; c < 6; ++c) {
            asm volatile("s_waitcnt vmcnt(0)" ::: "memory");
            __syncthreads();
            issue_chunk(c == 5 ? 0 : c + 1, (c + 1) & 1);
            const unsigned char* wb = lds + (c & 1) * 24576;
#pragma unroll
            for (int oo = 0; oo < 6; ++oo) {
                const int o = c * 6 + oo;
                float a[4] = {0.f, 0.f, 0.f, 0.f};
#pragma unroll
                for (int j = 0; j < 4; ++j) {
                    const float4 w = *(const float4*)(wb + oo * 4096 + j * 1024 + lane * 16);
#pragma unroll
                    for (int q = 0; q < 4; ++q) a[q] += hv[q][j * 4] * w.x + hv[q][j * 4 + 1] * w.y + hv[q][j * 4 + 2] * w.z + hv[q][j * 4 + 3] * w.w;
                }
                const float k0 = (lane & 1) ? a[1] : a[0], s0 = (lane & 1) ? a[0] : a[1];
                const float k1 = (lane & 1) ? a[3] : a[2], s1_ = (lane & 1) ? a[2] : a[3];
                const float b0 = k0 + __shfl_xor(s0, 1), b1 = k1 + __shfl_xor(s1_, 1);
                const float kk = (lane & 2) ? b1 : b0, sk = (lane & 2) ? b0 : b1;
                float val = kk + __shfl_xor(sk, 2);
                val += __shfl_xor(val, 4); val += __shfl_xor(val, 8); val += __shfl_xor(val, 16); val += __shfl_xor(val, 32);
                if (o < 4) {
                    val += p->in[I_BGRP][l * 4 + o];
#pragma unroll
                    for (int z = 0; z < 4; ++z) if (z == o) lg[z] = val;
                    if (o == 3) {
                        float gmax = lg[0]; grp = 0;
#pragma unroll
                        for (int z = 1; z < 4; ++z) if (lg[z] > gmax) { gmax = lg[z]; grp = z; }
                        float gden = 0.f;
#pragma unroll
                        for (int z = 0; z < 4; ++z) gden += __expf(lg[z] - gmax);
                        ptg = 1.f / gden;
                    }
                } else {
                    const int e = o - 4;
                    val += p->in[I_BEXP][l * 32 + e];
                    const bool mine = grp == (e >> 3);
#pragma unroll
                    for (int z = 0; z < 8; ++z) if (mine && z == (e & 7)) le[z] = val;
                }
            }
        }
        {
            int i1 = 0; float m1 = le[0];
#pragma unroll
            for (int z = 1; z < 8; ++z) if (le[z] > m1) { m1 = le[z]; i1 = z; }
            int i2 = -1; float m2 = -3.0e38f;
#pragma unroll
            for (int z = 0; z < 8; ++z) if (z != i1 && le[z] > m2) { m2 = le[z]; i2 = z; }
            const float e2 = __expf(m2 - m1);
            const float w1 = ptg / (1.f + e2), w2 = ptg * e2 / (1.f + e2);
            if (lane < 4) {
                const int r = r0 + myq, ea = grp * 8 + i1, eb = grp * 8 + i2;
                const unsigned pa = atomicAdd(&cnt[ea * CNT_STRIDE], 1u); list[(size_t)ea * NTOK + pa] = r * 2;
                const unsigned pb = atomicAdd(&cnt[eb * CNT_STRIDE], 1u); list[(size_t)eb * NTOK + pb] = r * 2 + 1;
                wt[r * 2] = w1; wt[r * 2 + 1] = w2;
            }
        }
    }
    asm volatile("s_waitcnt vmcnt(0)" ::: "memory");
    __syncthreads();
}

__device__ void ph_convmoe(KParams p, int l, float* sm) {
    const int tid = tid_opaque();
    bf16* WGU = (bf16*)(p->ws + WS_WGU);
    bf16* WDT = (bf16*)(p->ws + WS_WDT);
    conv_stream([&](int it) {
        const int e = it / 384, r = it % 384, kind = r >> 7, q = r & 127;
        ConvItem c;
        if (kind < 2) {
            c.src = p->in[kind == 0 ? I_WGATE : I_WUP] + ((size_t)(l * 32 + e) * D) * 512; c.dst = WGU + (size_t)e * D * D; c.ldsrc = 512; c.nvalid = 512;
            c.k0 = (q >> 3) * 64; c.n0 = (q & 7) * 64; c.lddst = D; c.kind = 2 + kind;
        } else {
            c.src = p->in[I_WDOWN] + ((size_t)(l * 32 + e) * 512) * D; c.dst = WDT + (size_t)e * D * 512; c.ldsrc = D; c.nvalid = D;
            c.k0 = (q >> 4) * 64; c.n0 = (q & 15) * 64; c.lddst = 512; c.kind = 0;
        }
        return c;
    }, 32 * 384, (unsigned char*)sm, tid);
}

constexpr int LDS_MOE_TAB = 65536;
__device__ __forceinline__ int moe_build_table(const unsigned* cnt, unsigned char* lds, const int tid) {
    int* TS = (int*)(lds + LDS_MOE_TAB); int* CN = TS + 40;
    __syncthreads();
    if (tid < 32) CN[tid] = (int)cnt[tid * CNT_STRIDE];
    __syncthreads();
    if (tid == 0) { int acc = 0; for (int q = 0; q < 32; ++q) { TS[q] = acc; acc += (CN[q] + 127) >> 7; } TS[32] = acc; }
    __syncthreads();
    return TS[32];
}
__device__ __forceinline__ void moe_tile_lookup(const unsigned char* lds, int trow, int& e, int& i0, int& ce) {
    const int* TS = (const int*)(lds + LDS_MOE_TAB); const int* CN = TS + 40;
    int lo = 0;
#pragma unroll
    for (int step = 16; step >= 1; step >>= 1) if (TS[lo + step] <= trow) lo += step;
    e = lo; i0 = (trow - TS[lo]) * 128; ce = CN[lo];
}

__device__ void ph_moe1(KParams p, int l, unsigned char* lds) {
    const bf16* H = (const bf16*)(p->ws + WS_H);
    bf16* ACT = (bf16*)(p->ws + WS_ACT);
    const bf16* WGU = (const bf16*)(p->ws + WS_WGU);
    const unsigned* cnt = (const unsigned*)(p->ws + WS_CTL) + CNT_BASE + l * 32 * CNT_STRIDE;
    const int* list = (const int*)(p->ws + WS_LIST);
    const int tid = tid_opaque(), lane = tid & 63, wid = tid >> 6, wr = wid >> 1, wc = wid & 1, fr = lane & 15, fq = lane >> 4;
    const int ntiles = moe_build_table(cnt, lds, tid);
    for (int it = vblock(); it < ntiles * 8; it += gridDim.x) {
        const int trow = it >> 3, tn = it & 7;
        int e, i0, ce; moe_tile_lookup(lds, trow, e, i0, ce);
        const int* le = list + (size_t)e * NTOK;
        const bf16* WT = WGU + (size_t)e * D * D;
        f32x4 acc[4][4]; zero_acc4(acc);
        gemm_tile(acc, [&](int r) { const int ii = min(i0 + r, ce - 1); return H + (size_t)(le[ii] >> 1) * D; },
                  [&](int r) { return WT + (size_t)(tn * 128 + r) * D; }, D, lds, tid);
#pragma unroll
        for (int i = 0; i < 4; ++i) {
            const int ii = i0 + wr * 64 + i * 16 + fr;
            if (ii < ce) {
                const int asg = le[ii];
#pragma unroll
                for (int jp = 0; jp < 2; ++jp) {
                    const f32x4 g = acc[i][2 * jp], u = acc[i][2 * jp + 1];
                    st_bf4(ACT + (size_t)asg * 512 + tn * 64 + wc * 32 + jp * 16 + fq * 4, silu_f(g[0]) * u[0], silu_f(g[1]) * u[1], silu_f(g[2]) * u[2], silu_f(g[3]) * u[3]);
                }
            }
        }
    }
}

__device__ void ph_moe2(KParams p, int l, unsigned char* lds) {
    const bf16* ACT = (const bf16*)(p->ws + WS_ACT);
    const bf16* WDT = (const bf16*)(p->ws + WS_WDT);
    const unsigned* cnt = (const unsigned*)(p->ws + WS_CTL) + CNT_BASE + l * 32 * CNT_STRIDE;
    const int* list = (const int*)(p->ws + WS_LIST);
    const float* wt = (const float*)(p->ws + WS_WT);
    const int tid = tid_opaque(), lane = tid & 63, wid = tid >> 6, wr = wid >> 1, wc = wid & 1, fr = lane & 15, fq = lane >> 4;
    const int ntiles = moe_build_table(cnt, lds, tid);
    for (int it = vblock(); it < ntiles * 8; it += gridDim.x) {
        const int trow = it >> 3, tn = it & 7;
        int e, i0, ce; moe_tile_lookup(lds, trow, e, i0, ce);
        const int* le = list + (size_t)e * NTOK;
        const bf16* WT = WDT + (size_t)e * D * 512;
        f32x4 acc[4][4]; zero_acc4(acc);
        gemm_tile(acc, [&](int r) { const int ii = min(i0 + r, ce - 1); return ACT + (size_t)le[ii] * 512; },
                  [&](int r) { return WT + (size_t)(tn * 128 + r) * 512; }, 512, lds, tid);
#pragma unroll
        for (int i = 0; i < 4; ++i) {
            const int ii = i0 + wr * 64 + i * 16 + fr;
            if (ii < ce) {
                const int asg = le[ii], tok = asg >> 1;
                const float w = wt[asg];
                bf16* Y = (bf16*)(p->ws + ((asg & 1) ? WS_Y1 : WS_Y0));
#pragma unroll
                for (int j = 0; j < 4; ++j)
                    st_bf4(Y + (size_t)tok * D + tn * 128 + wc * 64 + j * 16 + fq * 4, w * acc[i][j][0], w * acc[i][j][1], w * acc[i][j][2], w * acc[i][j][3]);
            }
        }
    }
}

__device__ void ph_combine(KParams p, int l) {
    const int tid = tid_opaque(), lane = tid & 63, gw = blockIdx.x * 4 + (tid >> 6), ngw = gridDim.x * 4;
    const bf16* Y0 = (const bf16*)(p->ws + WS_Y0);
    const bf16* Y1 = (const bf16*)(p->ws + WS_Y1);
    bf16* H = (bf16*)(p->ws + WS_H);
    const int nrows = (l == 0) ? NTOK : NL;
    const float* ng = (l == 0) ? p->in[I_N1G] + D : p->in[I_FING];
    for (int r0 = gw * 2; r0 < nrows; r0 += ngw * 2) {
        float4 xv[2][4]; uint2 ya[2][4], yb[2][4];
#pragma unroll
        for (int q = 0; q < 2; ++q) {
            const int r = r0 + q;
            const float* x = x1row(p, r);
#pragma unroll
            for (int j = 0; j < 4; ++j) {
                const int c = j * 256 + lane * 4;
                xv[q][j] = *(const float4*)(x + c); ya[q][j] = *(const uint2*)(Y0 + (size_t)r * D + c); yb[q][j] = *(const uint2*)(Y1 + (size_t)r * D + c);
            }
        }
#pragma unroll
        for (int q = 0; q < 2; ++q) {
            const int r = r0 + q, mb = modrow(r);
            float* xo = r < NL ? p->out + (size_t)r * D : (float*)(p->ws + WS_XC) + (size_t)(r - NL) * D;
            const float* g2 = modv(p, l, mb, 5);
            float4 v[4]; float ss = 0.f;
#pragma unroll
            for (int j = 0; j < 4; ++j) {
                const int c = j * 256 + lane * 4;
                const float4 gg = *(const float4*)(g2 + c);
                const float a0 = __uint_as_float(ya[q][j].x << 16) + __uint_as_float(yb[q][j].x << 16), a1 = __uint_as_float(ya[q][j].x & 0xffff0000u) + __uint_as_float(yb[q][j].x & 0xffff0000u);
                const float a2 = __uint_as_float(ya[q][j].y << 16) + __uint_as_float(yb[q][j].y << 16), a3 = __uint_as_float(ya[q][j].y & 0xffff0000u) + __uint_as_float(yb[q][j].y & 0xffff0000u);
                v[j] = make_float4(xv[q][j].x + gg.x * a0, xv[q][j].y + gg.y * a1, xv[q][j].z + gg.z * a2, xv[q][j].w + gg.w * a3);
                ss += v[j].x * v[j].x + v[j].y * v[j].y + v[j].z * v[j].z + v[j].w * v[j].w;
            }
            const float inv = rsqrtf(wave_sum(ss) * (1.f / D) + EPS);
            if (l == 0) {
                const float* sh = modv(p, 1, mb, 0); const float* sc = modv(p, 1, mb, 1);
#pragma unroll
                for (int j = 0; j < 4; ++j) {
                    const int c = j * 256 + lane * 4;
                    *(float4*)(xo + c) = v[j];
                    const float4 gg = *(const float4*)(ng + c), s1 = *(const float4*)(sh + c), s2 = *(const float4*)(sc + c);
                    st_bf4(H + (size_t)r * D + c, v[j].x * inv * gg.x * (1.f + s2.x) + s1.x, v[j].y * inv * gg.y * (1.f + s2.y) + s1.y,
                           v[j].z * inv * gg.z * (1.f + s2.z) + s1.z, v[j].w * inv * gg.w * (1.f + s2.w) + s1.w);
                }
            } else {
#pragma unroll
                for (int j = 0; j < 4; ++j) {
                    const int c = j * 256 + lane * 4;
                    const float4 gg = *(const float4*)(ng + c);
                    *(float4*)(xo + c) = make_float4(v[j].x * inv * gg.x, v[j].y * inv * gg.y, v[j].z * inv * gg.z, v[j].w * inv * gg.w);
                }
            }
        }
    }
}

#define XB_TMO      128
#define XB_XCNT(j)  (256  + 64 * (j))
#define XB_XSUB(j)  (1280 + 64 * (j))
#define XB_XGEN(j)  (2304 + 64 * (j))
#define XB_TOP      3328
#define XB_TOPGEN   3392
#define XB_SPIN_CAP (1u << 22)
constexpr int CW_BAR = 4096;
__device__ __forceinline__ unsigned xb_ld(unsigned* p)              { return __hip_atomic_load(p, __ATOMIC_RELAXED, __HIP_MEMORY_SCOPE_AGENT); }
__device__ __forceinline__ unsigned xb_add(unsigned* p, unsigned v) { return __hip_atomic_fetch_add(p, v, __ATOMIC_RELAXED, __HIP_MEMORY_SCOPE_AGENT); }
__device__ __forceinline__ unsigned xb_xcc_id() { return (unsigned)__builtin_amdgcn_s_getreg((3 << 11) | 20) & 0xFu; }
#define XB_SPIN(cond, bar) do { unsigned _sp = 0; while (cond) { __builtin_amdgcn_s_sleep(1); \
    if ((++_sp & 255u) == 0u) { if (xb_ld(&(bar)[XB_TMO])) break; if (_sp > XB_SPIN_CAP) { atomicAdd(&(bar)[XB_TMO], 1u); break; } } } } while (0)
constexpr int LDS_BAR_OFF = 79 * 1024 + 16;
__device__ __forceinline__ void xcd_barrier_post(unsigned* bar) {
    if (threadIdx.x == 0) (void)xb_add(&bar[XB_XCNT(xb_xcc_id())], 1u);
}
__device__ __forceinline__ void xcd_barrier_census(unsigned* bar, volatile unsigned* st) {
    if (threadIdx.x == 0) {
        const unsigned x = xb_xcc_id();
        unsigned cnt = 0, mine = 0;
#pragma unroll
        for (unsigned j = 0; j < 16; ++j) { const unsigned c = xb_ld(&bar[XB_XCNT(j)]); cnt += (c > 0u) ? 1u : 0u; mine = (j == x) ? c : mine; }
        st[0] = mine > 0u ? mine : 1u; st[1] = cnt > 0u ? cnt : 1u;
    }
    __syncthreads();
}
__device__ __forceinline__ void xcd_barrier(KParams kp, unsigned char* lds) {
    asm volatile("s_waitcnt vmcnt(0)" ::: "memory");
    __syncthreads();
    if (threadIdx.x == 0) {
        unsigned* bar = (unsigned*)(kp->ws + WS_CTL) + CW_BAR;
        volatile unsigned* st = (volatile unsigned*)(lds + LDS_BAR_OFF);
        __builtin_amdgcn_s_waitcnt(0);
        const unsigned x = xb_xcc_id();
        const unsigned nloc = st[0], nx = st[1];
        const unsigned old = xb_add(&bar[XB_XSUB(x)], 1u);
        const unsigned gen = old / nloc;
        if (old + 1u == (gen + 1u) * nloc) {
            __builtin_amdgcn_fence(__ATOMIC_RELEASE, "agent");
            asm volatile("s_waitcnt vmcnt(0)" ::: "memory");
            const unsigned og = xb_add(&bar[XB_TOP], 1u);
            const unsigned tg = og / nx;
            if (og + 1u == (tg + 1u) * nx) xb_add(&bar[XB_TOPGEN], 1u);
            else XB_SPIN(xb_ld(&bar[XB_TOPGEN]) == tg, bar);
            __builtin_amdgcn_fence(__ATOMIC_ACQUIRE, "agent");
            xb_add(&bar[XB_XGEN(x)], 1u);
            asm volatile("s_waitcnt vmcnt(0)" ::: "memory");
        } else {
            XB_SPIN(xb_ld(&bar[XB_XGEN(x)]) == gen, bar);
            __builtin_amdgcn_fence(__ATOMIC_ACQUIRE, "agent");
            asm volatile("s_waitcnt vmcnt(0)" ::: "memory");
        }
    }
    __syncthreads();
}

constexpr int LDS_BYTES = 80 * 1024;
__global__ void __launch_bounds__(256, 2) mega_fwd(Params p_unused) {
    const KParams kp = (KParams)__builtin_amdgcn_kernarg_segment_ptr();
    extern __shared__ __attribute__((aligned(16))) unsigned char smem_raw[];
    float* sm = (float*)smem_raw;
    cg::grid_group grid = cg::this_grid();
#ifndef PROBE_SEL
#define PROBE_SEL 0ull
#endif
#if PROBE_SEL
    volatile unsigned long long* stamps = (volatile unsigned long long*)(smem_raw + 79 * 1024 + 64);
    int n_stamp = 0;
#define STAMP() do { if (blockIdx.x == 0 && threadIdx.x == 0) stamps[n_stamp] = __builtin_amdgcn_s_memrealtime(); ++n_stamp; } while (0)
#else
#define STAMP() do { } while (0)
#endif
    xcd_barrier_post((unsigned*)(kp->ws + WS_CTL) + CW_BAR);
    STAMP();
    ph_init(fresh(kp), sm);
    grid.sync();
    xcd_barrier_census((unsigned*)(kp->ws + WS_CTL) + CW_BAR, (volatile unsigned*)(smem_raw + LDS_BAR_OFF));
    STAMP();
#define GSYNC() do { xcd_barrier(fresh(kp), smem_raw); STAMP(); } while (0)
#pragma unroll 1
    for (int l = 0; l < 2; ++l) {
        if (l == 0) { ph_norm1(fresh(kp), l); GSYNC(); }
        ph_gemm_in(fresh(kp), l, smem_raw); GSYNC();
        ph_prep(fresh(kp), l, sm);          GSYNC();
        ph_mix(fresh(kp), l, smem_raw);     GSYNC();
        ph_ygla(fresh(kp), l);              GSYNC();
        ph_merge(fresh(kp), l, smem_raw);   GSYNC();
        ph_outproj(fresh(kp), l, smem_raw); GSYNC();
        ph_router(fresh(kp), l, smem_raw);
        ph_convmoe(fresh(kp), l, sm);       GSYNC();
        ph_moe1(fresh(kp), l, smem_raw);    GSYNC();
        ph_moe2(fresh(kp), l, smem_raw);    GSYNC();
        ph_combine(fresh(kp), l);           GSYNC();
    }
#if PROBE_SEL
    if (blockIdx.x == 0 && threadIdx.x == 0) {
        unsigned long long dt = 0;
        for (int i = 0; i < 23; ++i) if ((PROBE_SEL >> i) & 1ull) dt += stamps[i + 1] - stamps[i];
        const unsigned long long t0 = __builtin_amdgcn_s_memrealtime();
        while (__builtin_amdgcn_s_memrealtime() - t0 < dt) __builtin_amdgcn_s_sleep(8);
    }
#endif
}

extern "C" void kernel_launch(void* const* d_in, const int* in_sizes, int n_in, void* d_out, int out_size, void* d_ws, size_t ws_size,
                              hipStream_t stream) {
    if (n_in != 28 || ws_size < WS_END) { fprintf(stderr, "kernel_launch: bad n_in %d or ws_size %zu (< %zu)\n", n_in, ws_size, (size_t)WS_END); return; }
    static int grid_blocks = 0;
    if (!grid_blocks) {
        int dev = 0, cus = 0, per_cu = 0;
        (void)hipGetDevice(&dev);
        (void)hipDeviceGetAttribute(&cus, hipDeviceAttributeMultiprocessorCount, dev);
        (void)hipFuncSetAttribute((const void*)mega_fwd, hipFuncAttributeMaxDynamicSharedMemorySize, LDS_BYTES);
        (void)hipOccupancyMaxActiveBlocksPerMultiprocessor(&per_cu, (const void*)mega_fwd, 256, LDS_BYTES);
        if (per_cu < 1) per_cu = 1;
        grid_blocks = cus * per_cu;
        fprintf(stderr, "kernel_launch: cus %d per_cu %d grid %d ws_size %zu\n", cus, per_cu, grid_blocks, ws_size);
    }
    Params p{};
    for (int i = 0; i < 28; ++i) p.in[i] = (const float*)d_in[i];
    p.out = (float*)d_out; p.ws = (unsigned char*)d_ws;
    (void)hipMemsetAsync((char*)d_ws + WS_CTL, 0, 1 * MiB, stream);
    void* args[] = {&p};
    hipError_t e = hipLaunchCooperativeKernel((const void*)mega_fwd, dim3(grid_blocks), dim3(256), args, LDS_BYTES, stream);
    if (e != hipSuccess) fprintf(stderr, "cooperative launch failed: %s (grid %d)\n", hipGetErrorString(e), grid_blocks);
}
```

```cpp
#include <hip/hip_runtime.h>
#include <hip/hip_cooperative_groups.h>
namespace cg = cooperative_groups;
#include <cstdio>
#include <cstdint>

typedef unsigned short bf16;

constexpr int D = 1024, NB = 8, T = 4096, CL = 256, NL = NB * T, NC = NB * CL, NTOK = NL + NC;
constexpr int INW = 5920;
constexpr int O_GQ = 0, O_GK = 256, O_GV = 512, O_GR = 1024, O_AQ = 1536, O_AK = 2048, O_AV = 2176, O_PU = 2304, O_GT = 2816, O_GLF = 5888, O_GLB = 5904;
__host__ __device__ constexpr int win_nmap(int n) { return n < 1536 ? n : (n < 1568 ? n + 4352 : (n < 5920 ? n - 32 : n)); }
constexpr float EPS = 1e-6f;
constexpr int CNT_BASE = 8192, CNT_STRIDE = 64;

constexpr size_t MiB = 1u << 20;
constexpr size_t WS_CTL = 0;
constexpr size_t WS_MODV = 1 * MiB;
constexpr size_t WS_ROPE = 1 * MiB + 512 * 1024;
constexpr size_t WS_WT = 2 * MiB;
constexpr size_t WS_LIST = 3 * MiB;
constexpr size_t WS_RWT = 7 * MiB + 256 * 1024;
constexpr size_t WS_XC = 8 * MiB;
constexpr size_t WS_H = 16 * MiB;
constexpr size_t WS_PROJ = 84 * MiB;
constexpr size_t WS_R2 = 478 * MiB;
constexpr size_t WS_WGU = WS_R2;
constexpr size_t WS_WDT = WS_R2 + 64 * MiB;
constexpr size_t WS_WSM = 580 * MiB;
constexpr size_t SZ_WINT = (size_t)6016 * 1024 * 2, SZ_WBT = (size_t)1024 * 512 * 2, SZ_WOUTT = (size_t)1024 * 1024 * 2;
constexpr size_t SZ_WSM_L = SZ_WINT + 3 * SZ_WBT + SZ_WOUTT;
constexpr size_t WS_VT = 614 * MiB;
constexpr int NKEY = T + CL;
constexpr size_t WS_END = 623 * MiB;
static_assert(WS_WSM + 2 * SZ_WSM_L <= WS_END, "ws map");
constexpr size_t SZ_Y512 = (size_t)NTOK * 512 * 2;
constexpr size_t WS_ACT = WS_PROJ;
constexpr size_t WS_Y0 = WS_PROJ + 68 * MiB;
constexpr size_t WS_Y1 = WS_PROJ + 136 * MiB;

struct Params {
    const float* in[28];
    float* out;
    unsigned char* ws;
};
typedef const __attribute__((address_space(4))) Params* KParams;
__device__ __forceinline__ KParams fresh(KParams k) { asm volatile("" : "+s"(k)); return k; }
enum { I_X = 0, I_C, I_CTX, I_CCTX, I_WMOD, I_BMOD, I_N1G, I_N2G, I_WIN, I_UPF, I_BIASF, I_UPB, I_BIASB, I_GLANG, I_QNG, I_KNG,
       I_POOLW, I_POOLS, I_WBR, I_WOUT, I_WGRP, I_BGRP, I_WEXP, I_BEXP, I_WGATE, I_WUP, I_WDOWN, I_FING };

__device__ __forceinline__ float bf2f(bf16 v) { return __uint_as_float(((unsigned)v) << 16); }
__device__ __forceinline__ bf16 f2bf(float f) { unsigned u = __float_as_uint(f); return (bf16)((u + 0x7fffu + ((u >> 16) & 1u)) >> 16); }
__device__ __forceinline__ float4 ld_bf4(const bf16* p) {
    uint2 u = *(const uint2*)p;
    return make_float4(__uint_as_float(u.x << 16), __uint_as_float(u.x & 0xffff0000u), __uint_as_float(u.y << 16), __uint_as_float(u.y & 0xffff0000u));
}
typedef float f32x2_t __attribute__((ext_vector_type(2)));
typedef __bf16 bf16x2_t __attribute__((ext_vector_type(2)));
__device__ __forceinline__ unsigned pk_bf16(float a, float b) { f32x2_t v = {a, b}; return __builtin_bit_cast(unsigned, __builtin_convertvector(v, bf16x2_t)); }
__device__ __forceinline__ void st_bf4(bf16* p, float a, float b, float c, float d) {
    uint2 u; u.x = pk_bf16(a, b); u.y = pk_bf16(c, d);
    *(uint2*)p = u;
}
__device__ __forceinline__ int tid_opaque() { int t = threadIdx.x; asm volatile("" : "+v"(t)); return t; }
#define DPP_ADD(v, ctrl) v += __builtin_bit_cast(float, __builtin_amdgcn_update_dpp(0, __builtin_bit_cast(int, v), (ctrl), 0xf, 0xf, true))
__device__ __forceinline__ float sum16(float v) {
    DPP_ADD(v, 0xB1);
    DPP_ADD(v, 0x4E);
    DPP_ADD(v, 0x141);
    DPP_ADD(v, 0x140);
    return v;
}
__device__ __forceinline__ float wave_sum(float v) {
#pragma unroll
    for (int o = 1; o < 64; o <<= 1) v += __shfl_xor(v, o);
    return v;
}
__device__ __forceinline__ float silu_f(float x) { return x * __builtin_amdgcn_rcpf(1.f + __expf(-x)); }
__device__ __forceinline__ float sigmoid_f(float x) { return __builtin_amdgcn_rcpf(1.f + __expf(-x)); }
__device__ __forceinline__ int modrow(int r) { return r < NL ? r / T : 8; }
__device__ __forceinline__ const float* xrow(KParams p, int l, int r) {
    if (l == 0) return r < NL ? p->in[I_X] + (size_t)r * D : p->in[I_CTX] + (size_t)(r - NL) * D;
    return r < NL ? p->out + (size_t)r * D : (const float*)(p->ws + WS_XC) + (size_t)(r - NL) * D;
}
__device__ __forceinline__ const float* modv(KParams p, int l, int mb, int which) {
    return (const float*)(p->ws + WS_MODV) + ((size_t)(l * 9 + mb) * 6 + which) * D;
}

template <class AF, class BF>
__device__ __forceinline__ void gemm64(float (&acc)[4][4], int K, AF aload, BF bload, float* sA, float* sB, const int tid) {
    const int ty = tid >> 4, tx = tid & 15;
    const int am = tid >> 2, ak = (tid & 3) * 4;
    const int bk = tid >> 4, bn = (tid & 15) * 4;
    for (int k0 = 0; k0 < K; k0 += 16) {
        float4 av = aload(am, k0 + ak);
        float4 bv = bload(k0 + bk, bn);
        __syncthreads();
        sA[(ak + 0) * 68 + am] = av.x; sA[(ak + 1) * 68 + am] = av.y; sA[(ak + 2) * 68 + am] = av.z; sA[(ak + 3) * 68 + am] = av.w;
        *(float4*)&sB[bk * 64 + bn] = bv;
        __syncthreads();
#pragma unroll
        for (int kk = 0; kk < 16; ++kk) {
            float4 a = *(float4*)&sA[kk * 68 + ty * 4];
            float4 b = *(float4*)&sB[kk * 64 + tx * 4];
            float aa[4] = {a.x, a.y, a.z, a.w}, bb[4] = {b.x, b.y, b.z, b.w};
#pragma unroll
            for (int i = 0; i < 4; ++i)
#pragma unroll
                for (int j = 0; j < 4; ++j) acc[i][j] += aa[i] * bb[j];
        }
    }
    __syncthreads();
}
__device__ __forceinline__ void zero_acc(float (&acc)[4][4]) {
#pragma unroll
    for (int i = 0; i < 4; ++i)
#pragma unroll
        for (int j = 0; j < 4; ++j) acc[i][j] = 0.f;
}

typedef short bf16x8 __attribute__((ext_vector_type(8)));
typedef float f32x4 __attribute__((ext_vector_type(4)));
constexpr int GT_BYTES = 16384;
__device__ __forceinline__ void zero_acc4(f32x4 (&acc)[4][4]) {
#pragma unroll
    for (int i = 0; i < 4; ++i)
#pragma unroll
        for (int j = 0; j < 4; ++j) acc[i][j] = (f32x4){0.f, 0.f, 0.f, 0.f};
}
template <class FA, class FB>
__device__ __forceinline__ void gemm_issue0(FA arow, FB brow, unsigned char* lds, const int tid) {
    const int srow = tid >> 3, sc = ((tid & 7) ^ ((tid >> 4) & 7)) * 8;
#pragma unroll
    for (int j = 0; j < 4; ++j) {
        __builtin_amdgcn_global_load_lds((const unsigned*)(arow(j * 32 + srow) + sc), (unsigned*)(lds + j * 4096 + tid * 16), 16, 0, 0);
        __builtin_amdgcn_global_load_lds((const unsigned*)(brow(j * 32 + srow) + sc), (unsigned*)(lds + GT_BYTES + j * 4096 + tid * 16), 16, 0, 0);
    }
}
template <bool AFF, class FA, class FB, class NF>
__device__ __forceinline__ void gemm_tile(f32x4 (&acc)[4][4], FA arow, FB brow, int K, unsigned char* lds, const int tid, NF next) {
    const int lane = tid & 63, wid = tid >> 6, wr = wid >> 1, wc = wid & 1, fr = lane & 15, fq = lane >> 4;
    const int srow = tid >> 3, sc = ((tid & 7) ^ ((tid >> 4) & 7)) * 8;
    const bf16* ap[4]; const bf16* bp[4];
    if (AFF) {
        const bf16* a0 = arow(srow) + sc; const long astep = (long)(arow(32) - arow(0));
#pragma unroll
        for (int j = 0; j < 4; ++j) ap[j] = a0 + j * astep;
    } else {
#pragma unroll
        for (int j = 0; j < 4; ++j) ap[j] = arow(j * 32 + srow) + sc;
    }
    {
        const bf16* b0 = brow(srow) + sc; const long bstep = (long)(brow(32) - brow(0));
#pragma unroll
        for (int j = 0; j < 4; ++j) bp[j] = b0 + j * bstep;
    }
    const int KT = K >> 6;
#pragma unroll 1
    for (int kt = 0; kt < KT; ++kt) {
        asm volatile("s_waitcnt vmcnt(0)" ::: "memory");
        __syncthreads();
        if (kt + 1 < KT) {
            unsigned char* sa = lds + ((kt + 1) & 1) * 2 * GT_BYTES;
#pragma unroll
            for (int j = 0; j < 4; ++j) {
                __builtin_amdgcn_global_load_lds((const unsigned*)(ap[j] + (kt + 1) * 64), (unsigned*)(sa + j * 4096 + tid * 16), 16, 0, 0);
                __builtin_amdgcn_global_load_lds((const unsigned*)(bp[j] + (kt + 1) * 64), (unsigned*)(sa + GT_BYTES + j * 4096 + tid * 16), 16, 0, 0);
            }
        } else {
            next();
        }
        const unsigned char* sa = lds + (kt & 1) * 2 * GT_BYTES;
        const unsigned char* sb = sa + GT_BYTES;
#pragma unroll
        for (int ks = 0; ks < 2; ++ks) {
            const int phys = ((ks * 4 + fq) ^ (fr >> 1)) * 16;
            bf16x8 bq[4];
#pragma unroll
            for (int j = 0; j < 4; ++j) bq[j] = *(const bf16x8*)(sb + (wc * 64 + j * 16 + fr) * 128 + phys);
#pragma unroll
            for (int i = 0; i < 4; ++i) {
                const bf16x8 af = *(const bf16x8*)(sa + (wr * 64 + i * 16 + fr) * 128 + phys);
#pragma unroll
                for (int j = 0; j < 4; ++j) acc[i][j] = __builtin_amdgcn_mfma_f32_16x16x32_bf16(bq[j], af, acc[i][j], 0, 0, 0);
            }
        }
    }
}
__device__ __forceinline__ void tile_coords(int it, int nM, int nN, int& tm, int& tn) {
    const int GM = 8, per = GM * nN, grp = it / per, fm = grp * GM, gsz = min(nM - fm, GM), rem = it - grp * per;
    tm = fm + rem % gsz; tn = rem / gsz;
}
constexpr int CW_TQ = 32768;
constexpr int LDS_TQ_OFF = 79 * 1024 + 32;
struct TileQ { unsigned* ctr; int ntiles; };
__device__ __forceinline__ int tq_next(const TileQ& q) {
    const int x = (int)(__builtin_amdgcn_s_getreg((3 << 11) | 20) & 7u);
    for (int s = 0; s < 8; ++s) {
        const int c = (x + s) & 7;
        const int b = (int)(((long)q.ntiles * c) >> 3), e = (int)(((long)q.ntiles * (c + 1)) >> 3);
        if (b >= e) continue;
        if ((int)__hip_atomic_load(q.ctr + c * 64, __ATOMIC_RELAXED, __HIP_MEMORY_SCOPE_AGENT) >= e - b) continue;
        const int t = (int)__hip_atomic_fetch_add(q.ctr + c * 64, 1u, __ATOMIC_RELAXED, __HIP_MEMORY_SCOPE_AGENT);
        if (b + t < e) return b + t;
    }
    return -1;
}
__device__ __forceinline__ int vblock() { const int G = gridDim.x, b = blockIdx.x; return (G & 7) == 0 ? (b & 7) * (G >> 3) + (b >> 3) : b; }

struct ConvItem { const float* src; bf16* dst; int ldsrc, nvalid, k0, n0, lddst, kind; };
__device__ __forceinline__ int conv_nmap(int kind, int n) {
    return kind == 0 ? n : (kind == 1 ? win_nmap(n) : 32 * (n >> 4) + (kind == 3 ? 16 : 0) + (n & 15));
}
template <class Dec>
__device__ __forceinline__ void conv_stream(Dec decode, int nitems, unsigned char* lds, const int tid) {
    auto issue = [&](const ConvItem& it, int buf) {
#pragma unroll
        for (int j = 0; j < 4; ++j) {
            const int k = j * 16 + (tid >> 4), pc = tid & 15, c = pc ^ ((k >> 4) & 3), n = it.n0 + c * 4;
            if (n < it.nvalid)
                __builtin_amdgcn_global_load_lds((const unsigned*)(it.src + (size_t)(it.k0 + k) * it.ldsrc + n), (unsigned*)(lds + buf * 16384 + j * 4096 + tid * 16), 16, 0, 0);
        }
    };
    int i = blockIdx.x;
    __syncthreads();
    ConvItem cur{};
    if (i < nitems) { cur = decode(i); issue(cur, 0); }
    int buf = 0;
    for (; i < nitems; i += gridDim.x) {
        asm volatile("s_waitcnt vmcnt(0)" ::: "memory");
        __syncthreads();
        ConvItem nxt{};
        const bool has_next = i + (int)gridDim.x < nitems;
        if (has_next) { nxt = decode(i + gridDim.x); issue(nxt, buf ^ 1); }
        {
            const float* sm = (const float*)(lds + buf * 16384);
            const int n = tid >> 2, kq = (tid & 3) * 16;
            const bool valid = cur.n0 + n < cur.nvalid;
            const int cidx = ((((n >> 2) ^ (kq >> 4)) & 15) << 2) + (n & 3);
            unsigned w[8];
#pragma unroll
            for (int q = 0; q < 8; ++q) {
                const float a = valid ? sm[(kq + 2 * q) * 64 + cidx] : 0.f, b = valid ? sm[(kq + 2 * q + 1) * 64 + cidx] : 0.f;
                w[q] = pk_bf16(a, b);
            }
            bf16* d = cur.dst + (size_t)conv_nmap(cur.kind, cur.n0 + n) * cur.lddst + cur.k0 + kq;
            *(uint4*)d = make_uint4(w[0], w[1], w[2], w[3]);
            *(uint4*)(d + 8) = make_uint4(w[4], w[5], w[6], w[7]);
        }
        cur = nxt; buf ^= 1;
    }
    asm volatile("s_waitcnt vmcnt(0)" ::: "memory");
    __syncthreads();
}
__device__ __forceinline__ bf16* wsm_int(KParams p, int l) { return (bf16*)(p->ws + WS_WSM + (size_t)l * SZ_WSM_L); }
__device__ __forceinline__ bf16* wsm_bt(KParams p, int l, int br) { return (bf16*)(p->ws + WS_WSM + (size_t)l * SZ_WSM_L + SZ_WINT + (size_t)br * SZ_WBT); }
__device__ __forceinline__ bf16* wsm_outt(KParams p, int l) { return (bf16*)(p->ws + WS_WSM + (size_t)l * SZ_WSM_L + SZ_WINT + 3 * SZ_WBT); }

__device__ void ph_init(KParams p, float* sm) {
    const int tid = tid_opaque();
    unsigned char* lds = (unsigned char*)sm;
    conv_stream([&](int it) {
        const int l = it / 2016; int r = it % 2016;
        ConvItem c;
        if (r < 1504) { c.src = p->in[I_WIN] + (size_t)l * D * INW; c.dst = wsm_int(p, l); c.ldsrc = INW; c.nvalid = INW; c.k0 = (r / 94) * 64; c.n0 = (r % 94) * 64; c.lddst = D; c.kind = 1; return c; }
        r -= 1504;
        if (r < 256) { const int br = r >> 7, q = r & 127;
            c.src = p->in[I_WBR] + ((size_t)(l * 3 + br) * 512) * D; c.dst = wsm_bt(p, l, br); c.ldsrc = D; c.nvalid = D; c.k0 = (q >> 4) * 64; c.n0 = (q & 15) * 64; c.lddst = 512; c.kind = 0; return c; }
        r -= 256;
        c.src = p->in[I_WOUT] + (size_t)l * D * D; c.dst = wsm_outt(p, l); c.ldsrc = D; c.nvalid = D; c.k0 = (r >> 4) * 64; c.n0 = (r & 15) * 64; c.lddst = D; c.kind = 0; return c;
    }, 2 * 2016, lds, tid);
    for (int it = blockIdx.x; it < 2 * 96; it += gridDim.x) {
        const int l = it / 96, cb = it % 96;
        __syncthreads();
        for (int e = tid; e < 9 * D; e += 256) {
            const int mb = e / D, k = e % D;
            sm[e] = silu_f(mb < 8 ? p->in[I_C][mb * D + k] : p->in[I_CCTX][k]);
        }
        __syncthreads();
        const int col = cb * 64 + (tid & 63), kq = tid >> 6;
        const float* w = p->in[I_WMOD] + (size_t)l * D * 6144 + (size_t)kq * 256 * 6144 + col;
        float acc[9];
#pragma unroll
        for (int m = 0; m < 9; ++m) acc[m] = 0.f;
#pragma unroll 8
        for (int k = 0; k < 256; ++k) {
            const float wv = w[(size_t)k * 6144];
#pragma unroll
            for (int m = 0; m < 9; ++m) acc[m] += sm[m * D + kq * 256 + k] * wv;
        }
        __syncthreads();
#pragma unroll
        for (int m = 0; m < 9; ++m) sm[9 * D + (kq * 9 + m) * 64 + (tid & 63)] = acc[m];
        __syncthreads();
        if (tid < 64) {
            const float bias = p->in[I_BMOD][l * 6144 + col];
            float* mv = (float*)(p->ws + WS_MODV);
#pragma unroll
            for (int m = 0; m < 9; ++m)
                mv[(size_t)(l * 9 + m) * 6144 + col] = sm[9 * D + (0 * 9 + m) * 64 + tid] + sm[9 * D + (1 * 9 + m) * 64 + tid] + sm[9 * D + (2 * 9 + m) * 64 + tid] + sm[9 * D + (3 * 9 + m) * 64 + tid] + bias;
        }
    }
    for (int it = blockIdx.x; it < 1 + 72 + 2 * 128; it += gridDim.x) {
        if (it == 0) {
            float2* rope = (float2*)(p->ws + WS_ROPE);
            for (int e = tid; e < 64 * 16; e += 256) {
                const int pos = e >> 4, i = e & 15;
                const float invf = powf(10000.0f, -(float)(2 * i) / 32.0f);
                const float angf = (float)pos * invf;
                const double ang = (double)angf;
                const double twopi = 6.283185307179586476925286766559;
                const double n = rint(ang / twopi);
                const double r = ang - n * twopi, r2 = r * r;
                double sn = 1.0, cs = 1.0;
                for (int q = 14; q >= 1; --q) { sn = 1.0 - r2 / (double)((2 * q) * (2 * q + 1)) * sn; cs = 1.0 - r2 / (double)((2 * q - 1) * (2 * q)) * cs; }
                sn *= r;
                rope[e] = make_float2((float)cs, (float)sn);
            }
        } else if (it < 73) {
            const int q = it - 1, l = q / 36, o = q % 36;
            float* dst = (float*)(p->ws + WS_RWT) + (size_t)(l * 36 + o) * D;
            for (int k = tid; k < D; k += 256) dst[k] = o < 4 ? p->in[I_WGRP][((size_t)l * D + k) * 4 + o] : p->in[I_WEXP][((size_t)l * D + k) * 32 + (o - 4)];
        } else {
            const int q = it - 73, l = q >> 7, r = q & 127;
            const int m0 = (r >> 4) * 64, n0 = (r & 15) * 64, g = m0 >> 7;
            const float* PW = p->in[I_POOLW] + ((size_t)(l * 4 + g) * 128) * 128;
            const float* PS = p->in[I_POOLS] + l * 512 + g * 128;
            const float* WB = p->in[I_WBR] + ((size_t)(l * 3 + 2) * 512 + g * 128) * D;
            float acc[4][4]; zero_acc(acc);
            gemm64(acc, 128,
                   [&](int m, int k) { const float4 a = *(const float4*)(PW + (size_t)((m0 + m) & 127) * 128 + k); const float4 sc = *(const float4*)(PS + k);
                                       return make_float4(a.x * sc.x, a.y * sc.y, a.z * sc.z, a.w * sc.w); },
                   [&](int k, int n) { return *(const float4*)(WB + (size_t)k * D + n0 + n); }, sm, sm + 16 * 68, tid);
            const int ty = tid >> 4, tx = tid & 15;
            bf16* dst = wsm_bt(p, l, 2);
#pragma unroll
            for (int j = 0; j < 4; ++j) st_bf4(dst + (size_t)(n0 + tx * 4 + j) * 512 + m0 + ty * 4, acc[0][j], acc[1][j], acc[2][j], acc[3][j]);
        }
    }
}

__device__ void ph_norm1(KParams p, int l) {
    const int tid = tid_opaque(), lane = tid & 63, gw = blockIdx.x * 4 + (tid >> 6), ngw = gridDim.x * 4;
    bf16* H = (bf16*)(p->ws + WS_H);
    const float* g = p->in[I_N1G] + l * D;
    for (int r0 = gw * 2; r0 < NTOK; r0 += ngw * 2) {
        float4 v[2][4];
#pragma unroll
        for (int q = 0; q < 2; ++q) {
            const float* x = xrow(p, l, r0 + q);
#pragma unroll
            for (int j = 0; j < 4; ++j) v[q][j] = *(const float4*)(x + j * 256 + lane * 4);
        }
#pragma unroll
        for (int q = 0; q < 2; ++q) {
            const int r = r0 + q, mb = modrow(r);
            const float* sh = modv(p, l, mb, 0); const float* sc = modv(p, l, mb, 1);
            float ss = 0.f;
#pragma unroll
            for (int j = 0; j < 4; ++j) ss += v[q][j].x * v[q][j].x + v[q][j].y * v[q][j].y + v[q][j].z * v[q][j].z + v[q][j].w * v[q][j].w;
            const float inv = rsqrtf(wave_sum(ss) * (1.f / D) + EPS);
#pragma unroll
            for (int j = 0; j < 4; ++j) {
                const int c = j * 256 + lane * 4;
                const float4 gg = *(const float4*)(g + c), s1 = *(const float4*)(sh + c), s2 = *(const float4*)(sc + c);
                st_bf4(H + (size_t)r * D + c, v[q][j].x * inv * gg.x * (1.f + s2.x) + s1.x, v[q][j].y * inv * gg.y * (1.f + s2.y) + s1.y,
                       v[q][j].z * inv * gg.z * (1.f + s2.z) + s1.z, v[q][j].w * inv * gg.w * (1.f + s2.w) + s1.w);
            }
        }
    }
}

__device__ void ph_gemm_in(KParams p, int l, unsigned char* lds) {
    const bf16* H = (const bf16*)(p->ws + WS_H);
    bf16* PROJ = (bf16*)(p->ws + WS_PROJ);
    const bf16* WT = wsm_int(p, l);
    const float2* rope = (const float2*)(p->ws + WS_ROPE);
    const int nN = 47, nM = NTOK / 128;
    const int tid = tid_opaque(), lane = tid & 63, wid = tid >> 6, wr = wid >> 1, wc = wid & 1, fr = lane & 15, fq = lane >> 4;
    const TileQ tq{(unsigned*)(p->ws + WS_CTL) + CW_TQ + (l * 5 + 0) * 512, nM * nN};
    volatile int* slot = (volatile int*)(lds + LDS_TQ_OFF);
    auto issue = [&](int it_) { int tm_, tn_; tile_coords(it_, nM, nN, tm_, tn_);
        gemm_issue0([&](int r) { return H + (size_t)(tm_ * 128 + r) * D; }, [&](int r) { return WT + (size_t)(tn_ * 128 + r) * D; }, lds, tid); };
    __syncthreads();
    if (tid == 0) slot[0] = tq_next(tq);
    __syncthreads();
    int it = slot[0];
    if (it >= 0) issue(it);
    for (int n_ = 0; it >= 0; ++n_) {
        if (tid == 0) slot[(n_ + 1) & 1] = tq_next(tq);
        int tm, tn; tile_coords(it, nM, nN, tm, tn);
        f32x4 acc[4][4]; zero_acc4(acc);
        gemm_tile<true>(acc, [&](int r) { return H + (size_t)(tm * 128 + r) * D; }, [&](int r) { return WT + (size_t)(tn * 128 + r) * D; }, D, lds, tid,
                  [&]() { const int nx = slot[(n_ + 1) & 1]; if (nx >= 0) issue(nx); });
        it = slot[(n_ + 1) & 1];
        if (tn >= 12 && tn <= 16) {
            const bool isq = tn < 16;
            const float* gsrc = p->in[isq ? I_QNG : I_KNG] + l * 64 + fq * 4;
            float4 g[4];
#pragma unroll
            for (int j = 0; j < 4; ++j) g[j] = *(const float4*)(gsrc + j * 16);
            const float qs = isq ? 0.125f * 1.4426950408889634f : 1.f;
#pragma unroll
            for (int i = 0; i < 4; ++i) {
                float ss = 0.f;
#pragma unroll
                for (int j = 0; j < 4; ++j) ss += acc[i][j][0] * acc[i][j][0] + acc[i][j][1] * acc[i][j][1] + acc[i][j][2] * acc[i][j][2] + acc[i][j][3] * acc[i][j][3];
                ss += __shfl_xor(ss, 16); ss += __shfl_xor(ss, 32);
                const float inv = rsqrtf(ss * (1.f / 64.f) + EPS);
                const int row = tm * 128 + wr * 64 + i * 16 + fr;
                f32x4 v[4];
#pragma unroll
                for (int j = 0; j < 4; ++j) { v[j][0] = acc[i][j][0] * inv * g[j].x; v[j][1] = acc[i][j][1] * inv * g[j].y; v[j][2] = acc[i][j][2] * inv * g[j].z; v[j][3] = acc[i][j][3] * inv * g[j].w; }
                if (row < NL) {
                    const int t = row & (T - 1), prow = t >> 6, pcol = t & 63;
#pragma unroll
                    for (int e = 0; e < 4; ++e) {
                        const float2 a = rope[prow * 16 + fq * 4 + e], b2 = rope[pcol * 16 + fq * 4 + e];
                        const float x1 = v[0][e], x2 = v[1][e], y1 = v[2][e], y2 = v[3][e];
                        v[0][e] = x1 * a.x - x2 * a.y; v[1][e] = x1 * a.y + x2 * a.x;
                        v[2][e] = y1 * b2.x - y2 * b2.y; v[3][e] = y1 * b2.y + y2 * b2.x;
                    }
                }
#pragma unroll
                for (int j = 0; j < 4; ++j)
                    st_bf4(PROJ + (size_t)row * INW + tn * 128 + wc * 64 + j * 16 + fq * 4, v[j][0] * qs, v[j][1] * qs, v[j][2] * qs, v[j][3] * qs);
            }
        } else {
#pragma unroll
            for (int i = 0; i < 4; ++i)
#pragma unroll
                for (int j = 0; j < 4; ++j) {
                    const int row = tm * 128 + wr * 64 + i * 16 + fr, col = tn * 128 + wc * 64 + j * 16 + fq * 4;
                    if (col < INW) st_bf4(PROJ + (size_t)row * INW + col, acc[i][j][0], acc[i][j][1], acc[i][j][2], acc[i][j][3]);
                }
        }
    }
}

__device__ void ph_prep(KParams p, int l, float* smf) {
    const int tid = tid_opaque();
    bf16* PROJ = (bf16*)(p->ws + WS_PROJ);
    {
        bf16* DP = (bf16*)(p->ws + WS_R2 + 2 * SZ_Y512);
        const int lane = tid & 63, gw = blockIdx.x * 4 + (tid >> 6), ngw = gridDim.x * 4;
        const int ch = lane * 8, hw = 1 << (lane >> 4);
        const int nrows = (l == 0) ? NTOK : NL;
        for (int r = gw; r < nrows; r += ngw) {
            int t, tl;
            if (r < NL) { t = r & (T - 1); tl = T; } else { t = (r - NL) & (CL - 1); tl = CL; }
            const bf16* src = PROJ + (size_t)r * INW + O_PU + ch;
            const int lo = max(t - hw, 0), hi = min(t + hw, tl);
            uint4 nb[16];
#pragma unroll
            for (int u = 0; u < 16; ++u) {
                const int tt = t - 8 + u;
                nb[u] = (tt >= lo && tt < hi) ? *(const uint4*)(src + (long)(u - 8) * INW) : make_uint4(0u, 0u, 0u, 0u);
            }
            float sacc[8] = {0.f, 0.f, 0.f, 0.f, 0.f, 0.f, 0.f, 0.f};
#pragma unroll
            for (int u = 0; u < 16; ++u) {
                const unsigned w[4] = {nb[u].x, nb[u].y, nb[u].z, nb[u].w};
#pragma unroll
                for (int q = 0; q < 4; ++q) { sacc[2 * q] += __uint_as_float(w[q] << 16); sacc[2 * q + 1] += __uint_as_float(w[q] & 0xffff0000u); }
            }
            const float inv = 1.f / (float)(hi - lo);
            const uint4 cc = nb[8];
            const unsigned cw[4] = {cc.x, cc.y, cc.z, cc.w};
            unsigned o[4];
#pragma unroll
            for (int q = 0; q < 4; ++q) o[q] = pk_bf16(sacc[2 * q] * inv - __uint_as_float(cw[q] << 16), sacc[2 * q + 1] * inv - __uint_as_float(cw[q] & 0xffff0000u));
            *(uint4*)(DP + (size_t)r * 512 + ch) = make_uint4(o[0], o[1], o[2], o[3]);
        }
    }
    {
        bf16* VT = (bf16*)(p->ws + WS_VT);
        unsigned short* st = (unsigned short*)smf;
        for (int it = blockIdx.x; it < (NTOK / 64) * 2; it += gridDim.x) {
            const int rt = it >> 1, kvh = it & 1;
            int b, key0;
            if (rt < NL / 64) { b = rt / 64; key0 = (rt % 64) * 64; } else { const int j = rt - NL / 64; b = j / 4; key0 = T + (j % 4) * 64; }
            __syncthreads();
            {
                const int k = tid >> 2, dq = (tid & 3) * 16;
                const bf16* src = PROJ + (size_t)(rt * 64 + k) * INW + O_AV + kvh * 64 + dq;
                const uint4 a = *(const uint4*)src, c = *(const uint4*)(src + 8);
                unsigned* d = (unsigned*)(st + k * 66 + dq);
                d[0] = a.x; d[1] = a.y; d[2] = a.z; d[3] = a.w; d[4] = c.x; d[5] = c.y; d[6] = c.z; d[7] = c.w;
            }
            __syncthreads();
            {
                const int d = tid >> 2, kq = (tid & 3) * 16;
                unsigned w[8];
#pragma unroll
                for (int i = 0; i < 8; ++i) w[i] = (unsigned)st[(kq + 2 * i) * 66 + d] | ((unsigned)st[(kq + 2 * i + 1) * 66 + d] << 16);
                bf16* dst = VT + ((size_t)(b * 2 + kvh) * 64 + d) * NKEY + key0 + kq;
                *(uint4*)dst = make_uint4(w[0], w[1], w[2], w[3]);
                *(uint4*)(dst + 8) = make_uint4(w[4], w[5], w[6], w[7]);
            }
        }
    }
}

typedef float f32x16 __attribute__((ext_vector_type(16)));
typedef short s16x4 __attribute__((ext_vector_type(4)));
#define MFMA32(a, b, c) __builtin_amdgcn_mfma_f32_32x32x16_bf16((a), (b), (c), 0, 0, 0)
__device__ __forceinline__ bf16x8 pack8(const f32x16& x, int s) {
    typedef unsigned u32x4_t __attribute__((ext_vector_type(4)));
    u32x4_t r;
    r[0] = pk_bf16(x[8 * s + 0], x[8 * s + 1]); r[1] = pk_bf16(x[8 * s + 2], x[8 * s + 3]);
    r[2] = pk_bf16(x[8 * s + 4], x[8 * s + 5]); r[3] = pk_bf16(x[8 * s + 6], x[8 * s + 7]);
    return __builtin_bit_cast(bf16x8, r);
}
__device__ __forceinline__ void attn_item(KParams p, int l, int it, unsigned char* lds, const int tid_) {
    const int tid = tid_opaque();
    const int lane = tid & 63, wid = tid >> 6, r32 = lane & 31, h = lane >> 5;
    bf16* PROJ = (bf16*)(p->ws + WS_PROJ);
    const bf16* VT = (const bf16*)(p->ws + WS_VT);
    float mq = 0.f, mk = 0.f;
    for (int d = 0; d < 64; ++d) { mq = fmaxf(mq, fabsf(p->in[I_QNG][l * 64 + d])); mk = fmaxf(mk, fabsf(p->in[I_KNG][l * 64 + d])); }
    const float shift2 = 8.f * mq * mk * 1.4426950408889634f;
    const int srow = tid >> 3, sc = ((tid & 7) ^ ((tid >> 4) & 7)) * 8, sw = (r32 >> 1) & 7;
    const int nlat = NB * 8 * 16;
    {
        int b, head, qrow0, nkt, vkey0;
        const bool lat = it < nlat;
        if (lat) { b = it >> 7; head = (it >> 4) & 7; qrow0 = b * T + (it & 15) * 256; nkt = 68; vkey0 = 0; }
        else { const int j = it - nlat; b = j >> 3; head = j & 7; qrow0 = NL + b * CL; nkt = 4; vkey0 = T; }
        const int kvh = head >> 2;
        bf16x8 qf[2][4];
#pragma unroll
        for (int qb = 0; qb < 2; ++qb)
#pragma unroll
            for (int ks = 0; ks < 4; ++ks)
                qf[qb][ks] = *(const bf16x8*)(PROJ + (size_t)(qrow0 + wid * 64 + qb * 32 + r32) * INW + O_AQ + head * 64 + ks * 16 + h * 8);
        const bf16* vsrc[2];
#pragma unroll
        for (int j = 0; j < 2; ++j) vsrc[j] = VT + ((size_t)(b * 2 + kvh) * 64 + j * 32 + srow) * NKEY + vkey0 + sc;
        const bf16* kbase = PROJ + O_AK + kvh * 64 + sc;
        auto krow = [&](int kt, int r) { return lat ? (kt < 64 ? b * T + kt * 64 + r : NL + b * CL + (kt - 64) * 64 + r) : NL + b * CL + kt * 64 + r; };
        auto stage = [&](int kt, int buf) {
            unsigned char* base = lds + buf * 16384;
#pragma unroll
            for (int j = 0; j < 2; ++j) {
                __builtin_amdgcn_global_load_lds((const unsigned*)(kbase + (size_t)krow(kt, j * 32 + srow) * INW), (unsigned*)(base + j * 4096 + tid * 16), 16, 0, 0);
                __builtin_amdgcn_global_load_lds((const unsigned*)(vsrc[j] + kt * 64), (unsigned*)(base + 8192 + j * 4096 + tid * 16), 16, 0, 0);
            }
        };
        f32x16 o[2][2];
#pragma unroll
        for (int a = 0; a < 2; ++a)
#pragma unroll
            for (int c = 0; c < 2; ++c)
#pragma unroll
                for (int e = 0; e < 16; ++e) o[a][c][e] = 0.f;
        float l0 = 0.f, l1 = 0.f;
        stage(0, 0);
#pragma unroll 1
        for (int kt = 0; kt < nkt; ++kt) {
            asm volatile("s_waitcnt vmcnt(0)" ::: "memory");
            __syncthreads();
            if (kt + 1 < nkt) stage(kt + 1, (kt + 1) & 1);
            const unsigned char* kb_ = lds + (kt & 1) * 16384;
            const unsigned char* vb_ = kb_ + 8192;
#pragma unroll
            for (int kb = 0; kb < 2; ++kb) {
                f32x16 s0, s1;
#pragma unroll
                for (int e = 0; e < 16; ++e) { s0[e] = 0.f; s1[e] = 0.f; }
#pragma unroll
                for (int ks = 0; ks < 4; ++ks) {
                    const bf16x8 kf = *(const bf16x8*)(kb_ + (kb * 32 + r32) * 128 + (((2 * ks + h) ^ sw) * 16));
                    s0 = MFMA32(kf, qf[0][ks], s0);
                    s1 = MFMA32(kf, qf[1][ks], s1);
                }
#pragma unroll
                for (int e = 0; e < 16; ++e) {
                    s0[e] = __builtin_amdgcn_exp2f(s0[e] - shift2); l0 += s0[e];
                    s1[e] = __builtin_amdgcn_exp2f(s1[e] - shift2); l1 += s1[e];
                }
#pragma unroll
                for (int s2 = 0; s2 < 2; ++s2) {
                    const bf16x8 p0 = pack8(s0, s2), p1 = pack8(s1, s2);
                    const int ksv = kb * 2 + s2;
#pragma unroll
                    for (int db = 0; db < 2; ++db) {
                        const unsigned char* vr = vb_ + (db * 32 + r32) * 128 + 8 * h;
                        const s16x4 lo = *(const s16x4*)(vr + (((2 * ksv) ^ sw) * 16));
                        const s16x4 hi = *(const s16x4*)(vr + (((2 * ksv + 1) ^ sw) * 16));
                        const bf16x8 vf = __builtin_shufflevector(lo, hi, 0, 1, 2, 3, 4, 5, 6, 7);
                        o[db][0] = MFMA32(vf, p0, o[db][0]);
                        o[db][1] = MFMA32(vf, p1, o[db][1]);
                    }
                }
            }
        }
        l0 += __shfl_xor(l0, 32); l1 += __shfl_xor(l1, 32);
        const float i0 = 1.f / l0, i1 = 1.f / l1;
#pragma unroll
        for (int qb = 0; qb < 2; ++qb) {
            const float inv = qb ? i1 : i0;
            bf16* orow = PROJ + (size_t)(qrow0 + wid * 64 + qb * 32 + r32) * INW + O_AQ + head * 64;
#pragma unroll
            for (int db = 0; db < 2; ++db)
#pragma unroll
                for (int g = 0; g < 4; ++g)
                    st_bf4(orow + db * 32 + 8 * g + 4 * h, o[db][qb][4 * g] * inv, o[db][qb][4 * g + 1] * inv, o[db][qb][4 * g + 2] * inv, o[db][qb][4 * g + 3] * inv);
        }
    }
}

constexpr int GL_QS = 0, GL_KS = 8192, GL_KDT = 16384, GL_VT = 24576, GL_GLS = 40960, GL_TOT = 45056, GL_FIRST = 47104,
              GL_RAWQ = 47872, GL_RAWK = 56064, GL_RAWV = 64256;
constexpr size_t WS_DST = WS_H;
constexpr size_t WS_EBL = WS_LIST;
__device__ __forceinline__ int swz(int row, int byte) { return row * 128 + ((((byte >> 4) ^ (row >> 1)) & 7) << 4) + (byte & 15); }
__device__ __forceinline__ int gla_chunk_base(int b, int c) { return c < 4 ? NL + b * CL + c * 64 : b * T + (c - 4) * 64; }

__device__ __forceinline__ void gla_local_item(KParams p, int l, int item, unsigned char* lds, const int tid_) {
    const int tid = tid_opaque();
    const int lane = tid & 63, w = tid >> 6, r32 = lane & 31, h = lane >> 5;
    const int hd = item & 3, c = (item >> 2) % 68, b = (item >> 2) / 68;
    bf16* PROJ = (bf16*)(p->ws + WS_PROJ);
    const int base = gla_chunk_base(b, c);
    const int dk2 = (tid & 31) * 2, seg = tid >> 5;
    const int dv2 = (tid & 63) * 2, vq = tid >> 6;
    __syncthreads();
    {
#pragma unroll
        for (int j = 0; j < 2; ++j) {
            const size_t tok = base + j * 32 + (tid >> 3);
            __builtin_amdgcn_global_load_lds((const unsigned*)(PROJ + tok * INW + O_GQ + hd * 64 + (tid & 7) * 8), (unsigned*)(lds + GL_RAWQ + j * 4096 + tid * 16), 16, 0, 0);
            __builtin_amdgcn_global_load_lds((const unsigned*)(PROJ + tok * INW + O_GK + hd * 64 + (tid & 7) * 8), (unsigned*)(lds + GL_RAWK + j * 4096 + tid * 16), 16, 0, 0);
        }
#pragma unroll
        for (int j = 0; j < 4; ++j) {
            const size_t tok = base + j * 16 + (tid >> 4);
            __builtin_amdgcn_global_load_lds((const unsigned*)(PROJ + tok * INW + O_GV + hd * 128 + (tid & 15) * 8), (unsigned*)(lds + GL_RAWV + j * 4096 + tid * 16), 16, 0, 0);
        }
        {
            const int t2 = tid & 127; const size_t tok = base + (t2 >> 1);
            __builtin_amdgcn_global_load_lds((const unsigned*)(PROJ + tok * INW + (tid < 128 ? O_GLF : O_GLB) + (t2 & 1) * 8), (unsigned*)(lds + GL_GLS + tid * 16), 16, 0, 0);
        }
    }
#pragma unroll 1
    for (int dir = 0; dir < 2; ++dir) {
        const float* up = p->in[dir ? I_UPB : I_UPF] + (size_t)l * 16 * 256 + hd * 64;
        const float2 bia = *(const float2*)(p->in[dir ? I_BIASB : I_BIASF] + l * 256 + hd * 64 + dk2);
        const int id2 = (((b * 68 + c) * 4 + hd) << 1) + dir;
        asm volatile("s_waitcnt vmcnt(0)" ::: "memory");
        __syncthreads();
        float la0[8], la1[8];
        {
            float up0[16], up1[16];
#pragma unroll
            for (int j = 0; j < 16; ++j) { const float2 t = *(const float2*)(up + j * 256 + dk2); up0[j] = t.x; up1[j] = t.y; }
            const unsigned char* gls = lds + GL_GLS + dir * 2048;
#pragma unroll
            for (int u = 0; u < 8; ++u) {
                const int i = seg * 8 + u, ti = dir ? 63 - i : i;
                const uint4 g0 = *(const uint4*)(gls + ti * 32), g1 = *(const uint4*)(gls + ti * 32 + 16);
                const unsigned gw[8] = {g0.x, g0.y, g0.z, g0.w, g1.x, g1.y, g1.z, g1.w};
                float a0 = bia.x, a1 = bia.y;
#pragma unroll
                for (int j = 0; j < 8; ++j) {
                    const float glo = __uint_as_float(gw[j] << 16), ghi = __uint_as_float(gw[j] & 0xffff0000u);
                    a0 += glo * up0[2 * j]; a1 += glo * up1[2 * j];
                    a0 += ghi * up0[2 * j + 1]; a1 += ghi * up1[2 * j + 1];
                }
                la0[u] = (fminf(a0, 0.f) - __logf(1.f + __expf(-fabsf(a0)))) * (1.f / 16.f);
                la1[u] = (fminf(a1, 0.f) - __logf(1.f + __expf(-fabsf(a1)))) * (1.f / 16.f);
            }
#pragma unroll
            for (int u = 1; u < 8; ++u) { la0[u] += la0[u - 1]; la1[u] += la1[u - 1]; }
            *(float2*)(lds + GL_TOT + (seg * 64 + dk2) * 4) = make_float2(la0[7], la1[7]);
            if (seg == 4) *(float2*)(lds + GL_FIRST + dk2 * 4) = make_float2(la0[0], la1[0]);
        }
        __syncthreads();
        {
            float off0 = 0.f, off1 = 0.f, pre0 = 0.f, pre1 = 0.f, all0 = 0.f, all1 = 0.f;
#pragma unroll
            for (int sg = 0; sg < 8; ++sg) {
                const float2 t = *(const float2*)(lds + GL_TOT + (sg * 64 + dk2) * 4);
                if (sg < seg) { off0 += t.x; off1 += t.y; }
                if (sg < 4) { pre0 += t.x; pre1 += t.y; }
                all0 += t.x; all1 += t.y;
            }
            const float2 f4 = *(const float2*)(lds + GL_FIRST + dk2 * 4);
            const float bref0 = pre0 + f4.x, bref1 = pre1 + f4.y;
            const float c0 = __expf(all0 - bref0), c1 = __expf(all1 - bref1);
            const float er0 = __expf(bref0), er1 = __expf(bref1);
            bf16* qdst = PROJ + (size_t)base * INW + (dir ? O_GK : O_GQ) + hd * 64 + dk2;
            unsigned kd0[4], kd1[4];
#pragma unroll
            for (int u = 0; u < 8; u += 2) {
                float kdv[2][2];
#pragma unroll
                for (int uu = 0; uu < 2; ++uu) {
                    const int i = seg * 8 + u + uu, ti = dir ? 63 - i : i;
                    const float e0 = __expf(off0 + la0[u + uu] - bref0), e1 = __expf(off1 + la1[u + uu] - bref1);
                    const float r0 = __builtin_amdgcn_rcpf(e0), r1 = __builtin_amdgcn_rcpf(e1);
                    const unsigned rqv = *(const unsigned*)(lds + GL_RAWQ + ti * 128 + dk2 * 2), rkv = *(const unsigned*)(lds + GL_RAWK + ti * 128 + dk2 * 2);
                    const float q0 = __uint_as_float(rqv << 16) * 0.125f * e0, q1 = __uint_as_float(rqv & 0xffff0000u) * 0.125f * e1;
                    const float k0 = __uint_as_float(rkv << 16), k1 = __uint_as_float(rkv & 0xffff0000u);
                    const float ks0 = k0 * r0, ks1 = k1 * r1;
                    *(unsigned*)(lds + GL_QS + swz(i, dk2 * 2)) = pk_bf16(q0, q1);
                    *(unsigned*)(lds + GL_KS + swz(i, dk2 * 2)) = pk_bf16(ks0, ks1);
                    *(unsigned*)(qdst + (size_t)ti * INW) = pk_bf16(q0 * er0, q1 * er1);
                    kdv[uu][0] = ks0 * c0; kdv[uu][1] = ks1 * c1;
                }
                kd0[u >> 1] = pk_bf16(kdv[0][0], kdv[1][0]); kd1[u >> 1] = pk_bf16(kdv[0][1], kdv[1][1]);
            }
            *(uint4*)(lds + GL_KDT + swz(dk2, seg * 16)) = make_uint4(kd0[0], kd0[1], kd0[2], kd0[3]);
            *(uint4*)(lds + GL_KDT + swz(dk2 + 1, seg * 16)) = make_uint4(kd1[0], kd1[1], kd1[2], kd1[3]);
            unsigned va[8], vb[8], rv[16];
#pragma unroll
            for (int u = 0; u < 16; ++u) { const int i = vq * 16 + u, ti = dir ? 63 - i : i; rv[u] = *(const unsigned*)(lds + GL_RAWV + ti * 256 + dv2 * 2); }
#pragma unroll
            for (int m = 0; m < 8; ++m) { va[m] = (rv[2 * m] & 0xffffu) | (rv[2 * m + 1] << 16); vb[m] = (rv[2 * m] >> 16) | (rv[2 * m + 1] & 0xffff0000u); }
            *(uint4*)(lds + GL_VT + swz(dv2, vq * 32)) = make_uint4(va[0], va[1], va[2], va[3]);
            *(uint4*)(lds + GL_VT + swz(dv2, vq * 32 + 16)) = make_uint4(va[4], va[5], va[6], va[7]);
            *(uint4*)(lds + GL_VT + swz(dv2 + 1, vq * 32)) = make_uint4(vb[0], vb[1], vb[2], vb[3]);
            *(uint4*)(lds + GL_VT + swz(dv2 + 1, vq * 32 + 16)) = make_uint4(vb[4], vb[5], vb[6], vb[7]);
            if (seg == 0) *(float2*)((float*)(p->ws + WS_EBL) + (size_t)id2 * 64 + dk2) = make_float2(__expf(all0), __expf(all1));
        }
        __syncthreads();
        {
            const unsigned char* QS = lds + GL_QS; const unsigned char* KS = lds + GL_KS; const unsigned char* KDT = lds + GL_KDT; const unsigned char* VTL = lds + GL_VT;
            f32x16 ot[2];
#pragma unroll
            for (int e = 0; e < 16; ++e) { ot[0][e] = 0.f; ot[1][e] = 0.f; }
#pragma unroll
            for (int tI = 0; tI < 3; ++tI) {
                const int sb = tI == 2 ? 1 : 0, ib = tI == 0 ? 0 : 1;
                f32x16 pt;
#pragma unroll
                for (int e = 0; e < 16; ++e) pt[e] = 0.f;
#pragma unroll
                for (int ks = 0; ks < 4; ++ks) {
                    const bf16x8 kf = *(const bf16x8*)(KS + swz(32 * sb + r32, (2 * ks + h) * 16));
                    const bf16x8 qf = *(const bf16x8*)(QS + swz(32 * ib + r32, (2 * ks + h) * 16));
                    pt = MFMA32(kf, qf, pt);
                }
                if (sb == ib) {
#pragma unroll
                    for (int e = 0; e < 16; ++e) { const int sl = (e & 3) + 8 * (e >> 2) + 4 * h; if (sl > r32) pt[e] = 0.f; }
                }
#pragma unroll
                for (int s2 = 0; s2 < 2; ++s2) {
                    const int ksv = 2 * sb + s2, row = 32 * w + r32;
                    const s16x4 lo = *(const s16x4*)(VTL + swz(row, 32 * ksv + 8 * h));
                    const s16x4 hi = *(const s16x4*)(VTL + swz(row, 32 * ksv + 16 + 8 * h));
                    const bf16x8 vp = __builtin_shufflevector(lo, hi, 0, 1, 2, 3, 4, 5, 6, 7);
                    ot[ib] = MFMA32(vp, pack8(pt, s2), ot[ib]);
                }
            }
            bf16* OG = (bf16*)(p->ws + WS_R2 + (size_t)dir * SZ_Y512);
#pragma unroll
            for (int ib = 0; ib < 2; ++ib) {
                const int i = 32 * ib + r32; const size_t tok = base + (dir ? 63 - i : i);
                bf16* dst = OG + tok * 512 + hd * 128 + 32 * w + 4 * h;
#pragma unroll
                for (int g = 0; g < 4; ++g) st_bf4(dst + 8 * g, ot[ib][4 * g], ot[ib][4 * g + 1], ot[ib][4 * g + 2], ot[ib][4 * g + 3]);
            }
            f32x16 dS[2];
#pragma unroll
            for (int e = 0; e < 16; ++e) { dS[0][e] = 0.f; dS[1][e] = 0.f; }
#pragma unroll
            for (int ks = 0; ks < 4; ++ks) {
                const bf16x8 vn = *(const bf16x8*)(VTL + swz(32 * w + r32, (2 * ks + h) * 16));
#pragma unroll
                for (int dkb = 0; dkb < 2; ++dkb) {
                    const bf16x8 kd = *(const bf16x8*)(KDT + swz(32 * dkb + r32, (2 * ks + h) * 16));
                    dS[dkb] = MFMA32(kd, vn, dS[dkb]);
                }
            }
            bf16* dd = (bf16*)(p->ws + WS_DST) + (((size_t)id2 * 4 + w) * 64 + lane) * 32;
#pragma unroll
            for (int dkb = 0; dkb < 2; ++dkb)
#pragma unroll
                for (int g = 0; g < 2; ++g)
                    *(uint4*)(dd + dkb * 16 + g * 8) = make_uint4(pk_bf16(dS[dkb][8 * g], dS[dkb][8 * g + 1]), pk_bf16(dS[dkb][8 * g + 2], dS[dkb][8 * g + 3]),
                                                                  pk_bf16(dS[dkb][8 * g + 4], dS[dkb][8 * g + 5]), pk_bf16(dS[dkb][8 * g + 6], dS[dkb][8 * g + 7]));
        }
    }
}

__device__ __forceinline__ void gla_chain(KParams p, int l, int task, const int tid_) {
    const int tid = tid_opaque();
    const int lane = tid & 63, w = tid >> 6, h = lane >> 5;
    const int b = task >> 3, hd = (task >> 1) & 3, dir = task & 1;
    bf16* DST = (bf16*)(p->ws + WS_DST);
    const float* EBL = (const float*)(p->ws + WS_EBL);
    f32x16 S[2];
#pragma unroll
    for (int e = 0; e < 16; ++e) { S[0][e] = 0.f; S[1][e] = 0.f; }
    auto id2_of = [&](int n) { const int c = n < 4 ? (dir ? 3 - n : n) : 4 + (dir ? 63 - (n - 4) : (n - 4)); return (size_t)((((b * 68 + c) * 4 + hd) << 1) + dir); };
    typedef unsigned u32x4_t __attribute__((ext_vector_type(4)));
    u32x4_t d0[4], d1[4], d2[4], d3[4];
    auto load_ds = [&](u32x4_t (&d)[4], int n) {
        const bf16* dd = DST + ((id2_of(n) * 4 + w) * 64 + lane) * 32;
#pragma unroll
        for (int q = 0; q < 4; ++q) d[q] = *(const u32x4_t*)(dd + q * 8);
    };
    load_ds(d0, 0); load_ds(d1, 1); load_ds(d2, 2); load_ds(d3, 3);
    auto step = [&](u32x4_t (&d)[4], int n) {
        const size_t id2 = id2_of(n);
        float4 eb[2][4];
        const float* ee = EBL + id2 * 64;
#pragma unroll
        for (int dkb = 0; dkb < 2; ++dkb)
#pragma unroll
            for (int g = 0; g < 4; ++g) eb[dkb][g] = *(const float4*)(ee + 32 * dkb + 8 * g + 4 * h);
        bf16* dd = DST + ((id2 * 4 + w) * 64 + lane) * 32;
#pragma unroll
        for (int dkb = 0; dkb < 2; ++dkb)
#pragma unroll
            for (int s2 = 0; s2 < 2; ++s2) *(bf16x8*)(dd + (dkb * 2 + s2) * 8) = pack8(S[dkb], s2);
        const unsigned dw[16] = {d[0][0], d[0][1], d[0][2], d[0][3], d[1][0], d[1][1], d[1][2], d[1][3], d[2][0], d[2][1], d[2][2], d[2][3], d[3][0], d[3][1], d[3][2], d[3][3]};
#pragma unroll
        for (int dkb = 0; dkb < 2; ++dkb)
#pragma unroll
            for (int g = 0; g < 4; ++g) {
                const float4 e = eb[dkb][g];
                const unsigned w0 = dw[dkb * 8 + g * 2], w1 = dw[dkb * 8 + g * 2 + 1];
                S[dkb][4 * g]     = S[dkb][4 * g] * e.x     + __uint_as_float(w0 << 16);
                S[dkb][4 * g + 1] = S[dkb][4 * g + 1] * e.y + __uint_as_float(w0 & 0xffff0000u);
                S[dkb][4 * g + 2] = S[dkb][4 * g + 2] * e.z + __uint_as_float(w1 << 16);
                S[dkb][4 * g + 3] = S[dkb][4 * g + 3] * e.w + __uint_as_float(w1 & 0xffff0000u);
            }
        if (n + 4 < 68) load_ds(d, n + 4);
    };
#pragma unroll 1
    for (int n = 0; n < 68; n += 4) { step(d0, n); step(d1, n + 1); step(d2, n + 2); step(d3, n + 3); }
}

__device__ __forceinline__ void gla_out_item(KParams p, int l, int item, unsigned char* lds, const int tid_) {
    const int tid = tid_opaque();
    const int lane = tid & 63, w = tid >> 6, r32 = lane & 31, h = lane >> 5;
    const int hd = item & 3, c = (item >> 2) % 68, b = (item >> 2) / 68;
    const bf16* PROJ = (const bf16*)(p->ws + WS_PROJ);
    const bf16* DST = (const bf16*)(p->ws + WS_DST);
    const int base = gla_chunk_base(b, c);
    f32x16 ot[2];
#pragma unroll
    for (int e = 0; e < 16; ++e) { ot[0][e] = 0.f; ot[1][e] = 0.f; }
    uint2 og[2][2][4];
#pragma unroll
    for (int dir = 0; dir < 2; ++dir) {
        const bf16* OG = (const bf16*)(p->ws + WS_R2 + (size_t)dir * SZ_Y512);
#pragma unroll
        for (int ib = 0; ib < 2; ++ib)
#pragma unroll
            for (int g = 0; g < 4; ++g) og[dir][ib][g] = *(const uint2*)(OG + (size_t)(base + 32 * ib + r32) * 512 + hd * 128 + 32 * w + 4 * h + 8 * g);
    }
    uint2 grv[2][4];
#pragma unroll
    for (int ib = 0; ib < 2; ++ib)
#pragma unroll
        for (int g = 0; g < 4; ++g) grv[ib][g] = *(const uint2*)(PROJ + (size_t)(base + 32 * ib + r32) * INW + O_GR + hd * 128 + 32 * w + 4 * h + 8 * g);
#pragma unroll
    for (int dir = 0; dir < 2; ++dir) {
        const size_t id2 = (size_t)((((b * 68 + c) * 4 + hd) << 1) + dir);
        const bf16* dd = DST + ((id2 * 4 + w) * 64 + lane) * 32;
        bf16x8 sp[4];
#pragma unroll
        for (int q = 0; q < 4; ++q) sp[q] = *(const bf16x8*)(dd + q * 8);
        const int qcol = (dir ? O_GK : O_GQ) + hd * 64 + 4 * h;
#pragma unroll
        for (int ib = 0; ib < 2; ++ib) {
            const bf16* row = PROJ + (size_t)(base + 32 * ib + r32) * INW + qcol;
#pragma unroll
            for (int ksv = 0; ksv < 4; ++ksv) {
                const s16x4 lo = *(const s16x4*)(row + 16 * ksv), hi = *(const s16x4*)(row + 16 * ksv + 8);
                const bf16x8 qp = __builtin_shufflevector(lo, hi, 0, 1, 2, 3, 4, 5, 6, 7);
                ot[ib] = MFMA32(sp[ksv], qp, ot[ib]);
            }
        }
    }
    float ssq[2];
#pragma unroll
    for (int ib = 0; ib < 2; ++ib) {
        float a = 0.f;
#pragma unroll
        for (int g = 0; g < 4; ++g) {
            const uint2 x0 = og[0][ib][g], x1 = og[1][ib][g];
            ot[ib][4 * g]     += __uint_as_float(x0.x << 16) + __uint_as_float(x1.x << 16);
            ot[ib][4 * g + 1] += __uint_as_float(x0.x & 0xffff0000u) + __uint_as_float(x1.x & 0xffff0000u);
            ot[ib][4 * g + 2] += __uint_as_float(x0.y << 16) + __uint_as_float(x1.y << 16);
            ot[ib][4 * g + 3] += __uint_as_float(x0.y & 0xffff0000u) + __uint_as_float(x1.y & 0xffff0000u);
            a += ot[ib][4 * g] * ot[ib][4 * g] + ot[ib][4 * g + 1] * ot[ib][4 * g + 1] + ot[ib][4 * g + 2] * ot[ib][4 * g + 2] + ot[ib][4 * g + 3] * ot[ib][4 * g + 3];
        }
        a += __shfl_xor(a, 32);
        ssq[ib] = a;
    }
    float* red = (float*)lds;
    __syncthreads();
    if (h == 0) { red[w * 64 + r32] = ssq[0]; red[w * 64 + 32 + r32] = ssq[1]; }
    __syncthreads();
    const float* gn = p->in[I_GLANG] + l * 128 + 32 * w + 4 * h;
    bf16* YG = (bf16*)(p->ws + WS_R2);
#pragma unroll
    for (int ib = 0; ib < 2; ++ib) {
        const int t = 32 * ib + r32;
        const float inv = rsqrtf((red[t] + red[64 + t] + red[128 + t] + red[192 + t]) * (1.f / 128.f) + EPS);
        bf16* dst = YG + (size_t)(base + t) * 512 + hd * 128 + 32 * w + 4 * h;
#pragma unroll
        for (int g = 0; g < 4; ++g) {
            const float4 gg = *(const float4*)(gn + 8 * g);
            const float r0 = __uint_as_float(grv[ib][g].x << 16), r1 = __uint_as_float(grv[ib][g].x & 0xffff0000u), r2 = __uint_as_float(grv[ib][g].y << 16), r3 = __uint_as_float(grv[ib][g].y & 0xffff0000u);
            st_bf4(dst + 8 * g, ot[ib][4 * g] * inv * gg.x * silu_f(r0), ot[ib][4 * g + 1] * inv * gg.y * silu_f(r1), ot[ib][4 * g + 2] * inv * gg.z * silu_f(r2), ot[ib][4 * g + 3] * inv * gg.w * silu_f(r3));
        }
    }
}
__device__ void ph_gla_out(KParams p, int l, unsigned char* lds) {
    const int tid = tid_opaque();
    const int nchunk = (l == 0) ? 68 : 64;
    for (int it = blockIdx.x; it < NB * nchunk * 4; it += gridDim.x) {
        const int hd = it & 3, q = it >> 2, bb = q / nchunk, cc = q % nchunk + (68 - nchunk);
        gla_out_item(p, l, ((bb * 68 + cc) << 2) + hd, lds, tid);
    }
}

__device__ void ph_gla_local(KParams p, int l, unsigned char* lds) {
    const int tid = tid_opaque();
    for (int it = blockIdx.x; it < NB * 68 * 4; it += gridDim.x) gla_local_item(p, l, it, lds, tid);
    __syncthreads();
}

constexpr int CW_WORK = 64;
constexpr int LDS_ITEM_OFF = 79 * 1024;
__device__ void ph_mix(KParams p, int l, unsigned char* lds) {
    const int tid = tid_opaque();
    unsigned* ctr = (unsigned*)(p->ws + WS_CTL) + CW_WORK + l;
    volatile int* slot = (volatile int*)(lds + LDS_ITEM_OFF);
    const int nitems = 64 + NB * 8 * 16 + ((l == 0) ? NB * 8 : 0);
    for (;;) {
        __syncthreads();
        if (tid == 0) *slot = (int)__hip_atomic_fetch_add(ctr, 1u, __ATOMIC_RELAXED, __HIP_MEMORY_SCOPE_AGENT);
        __syncthreads();
        const int it = *slot;
        if (it >= nitems) break;
        if (it < 64) gla_chain(p, l, it, tid);
        else attn_item(p, l, it - 64, lds, tid);
    }
}

__device__ void ph_ygla(KParams p, int l) {
    const int tid = tid_opaque(), lane = tid & 63, gw = blockIdx.x * 4 + (tid >> 6), ngw = gridDim.x * 4;
    bf16* O0 = (bf16*)(p->ws + WS_R2);
    const bf16* O1 = (const bf16*)(p->ws + WS_R2 + SZ_Y512);
    const bf16* PROJ = (const bf16*)(p->ws + WS_PROJ);
    const int nrows = (l == 0) ? NTOK : NL;
    const int c = lane * 8;
    const float4 g0 = *(const float4*)(p->in[I_GLANG] + l * 128 + (c & 127)), g1 = *(const float4*)(p->in[I_GLANG] + l * 128 + (c & 127) + 4);
    const float g[8] = {g0.x, g0.y, g0.z, g0.w, g1.x, g1.y, g1.z, g1.w};
    for (int r0 = gw * 4; r0 < nrows; r0 += ngw * 4) {
        uint4 a[4], b[4], gr[4];
#pragma unroll
        for (int q = 0; q < 4; ++q) {
            a[q] = *(const uint4*)(O0 + (size_t)(r0 + q) * 512 + c); b[q] = *(const uint4*)(O1 + (size_t)(r0 + q) * 512 + c);
            gr[q] = *(const uint4*)(PROJ + (size_t)(r0 + q) * INW + O_GR + c);
        }
#pragma unroll
        for (int q = 0; q < 4; ++q) {
            const unsigned aw[4] = {a[q].x, a[q].y, a[q].z, a[q].w}, bw[4] = {b[q].x, b[q].y, b[q].z, b[q].w}, gw_[4] = {gr[q].x, gr[q].y, gr[q].z, gr[q].w};
            float v[8], grf[8];
#pragma unroll
            for (int e = 0; e < 4; ++e) {
                v[2 * e] = __uint_as_float(aw[e] << 16) + __uint_as_float(bw[e] << 16);
                v[2 * e + 1] = __uint_as_float(aw[e] & 0xffff0000u) + __uint_as_float(bw[e] & 0xffff0000u);
                grf[2 * e] = __uint_as_float(gw_[e] << 16); grf[2 * e + 1] = __uint_as_float(gw_[e] & 0xffff0000u);
            }
            float ss = 0.f;
#pragma unroll
            for (int e = 0; e < 8; ++e) ss += v[e] * v[e];
            ss += __shfl_xor(ss, 1); ss += __shfl_xor(ss, 2); ss += __shfl_xor(ss, 4); ss += __shfl_xor(ss, 8);
            const float inv = rsqrtf(ss * (1.f / 128.f) + EPS);
            unsigned o[4];
#pragma unroll
            for (int e = 0; e < 4; ++e) o[e] = pk_bf16(v[2 * e] * inv * g[2 * e] * silu_f(grf[2 * e]), v[2 * e + 1] * inv * g[2 * e + 1] * silu_f(grf[2 * e + 1]));
            *(uint4*)(O0 + (size_t)(r0 + q) * 512 + c) = make_uint4(o[0], o[1], o[2], o[3]);
        }
    }
}

__device__ void ph_merge(KParams p, int l, unsigned char* lds) {
    const bf16* PROJ = (const bf16*)(p->ws + WS_PROJ);
    const bf16* YG = (const bf16*)(p->ws + WS_R2);
    const bf16* DP = (const bf16*)(p->ws + WS_R2 + 2 * SZ_Y512);
    bf16* Z = (bf16*)(p->ws + WS_H);
    const int nrows = (l == 0) ? NTOK : NL, nM = nrows / 128, nN = 8, G = gridDim.x;
    const int tid = tid_opaque(), lane = tid & 63, wid = tid >> 6, wr = wid >> 1, wc = wid & 1, fr = lane & 15, fq = lane >> 4;
    const bf16* WT0 = wsm_bt(p, l, 0);
    auto issue = [&](int it_, int br_) {
        int tm_, tn_; tile_coords(it_, nM, nN, tm_, tn_);
        const bf16* Ab_ = br_ == 0 ? YG : (br_ == 1 ? PROJ + O_AQ : DP);
        const size_t lda_ = br_ == 1 ? (size_t)INW : (size_t)512;
        const bf16* W_ = WT0 + (size_t)br_ * (SZ_WBT / 2);
        gemm_issue0([&](int r) { return Ab_ + (size_t)(tm_ * 128 + r) * lda_; }, [&](int r) { return W_ + (size_t)(tn_ * 128 + r) * 512; }, lds, tid);
    };
    const TileQ tq{(unsigned*)(p->ws + WS_CTL) + CW_TQ + (l * 5 + 1) * 512, nM * nN};
    volatile int* slot = (volatile int*)(lds + LDS_TQ_OFF);
    __syncthreads();
    if (tid == 0) slot[0] = tq_next(tq);
    __syncthreads();
    int it = slot[0];
    if (it >= 0) issue(it, 0);
    for (int n_ = 0; it >= 0; ++n_) {
        if (tid == 0) slot[(n_ + 1) & 1] = tq_next(tq);
        int tm, tn; tile_coords(it, nM, nN, tm, tn);
        f32x4 acc[4][4]; zero_acc4(acc);
        uint2 ga[4][4], gb[4][4];
        const bf16* gbase = PROJ + (size_t)(tm * 128 + wr * 64 + fr) * INW + O_GT + tn * 128 + wc * 64 + fq * 4;
#pragma unroll
        for (int i = 0; i < 4; ++i)
#pragma unroll
            for (int j = 0; j < 4; ++j) ga[i][j] = *(const uint2*)(gbase + (size_t)i * 16 * INW + j * 16);
#pragma unroll 1
        for (int br = 0; br < 3; ++br) {
            const bf16* WT = WT0 + (size_t)br * (SZ_WBT / 2);
            const bf16* Ab = br == 0 ? YG : (br == 1 ? PROJ + O_AQ : DP);
            const size_t lda = br == 1 ? (size_t)INW : (size_t)512;
            if (br < 2) {
#pragma unroll
                for (int i = 0; i < 4; ++i)
#pragma unroll
                    for (int j = 0; j < 4; ++j) gb[i][j] = *(const uint2*)(gbase + (size_t)i * 16 * INW + (br + 1) * D + j * 16);
            }
            gemm_tile<true>(acc, [&](int r) { return Ab + (size_t)(tm * 128 + r) * lda; }, [&](int r) { return WT + (size_t)(tn * 128 + r) * 512; }, 512, lds, tid,
                      [&]() { if (br < 2) issue(it, br + 1); else { const int nx = slot[(n_ + 1) & 1]; if (nx >= 0) issue(nx, 0); } });
#pragma unroll
            for (int i = 0; i < 4; ++i)
#pragma unroll
                for (int j = 0; j < 4; ++j) {
                    const float a0 = __uint_as_float(ga[i][j].x << 16), a1 = __uint_as_float(ga[i][j].x & 0xffff0000u), a2 = __uint_as_float(ga[i][j].y << 16), a3 = __uint_as_float(ga[i][j].y & 0xffff0000u);
                    float r0 = sigmoid_f(a0), r1 = sigmoid_f(a1), r2 = sigmoid_f(a2), r3 = sigmoid_f(a3);
                    if (br < 2) {
                        const float b0 = __uint_as_float(gb[i][j].x << 16), b1 = __uint_as_float(gb[i][j].x & 0xffff0000u), b2 = __uint_as_float(gb[i][j].y << 16), b3 = __uint_as_float(gb[i][j].y & 0xffff0000u);
                        r0 *= 1.f + __expf(-b0); r1 *= 1.f + __expf(-b1); r2 *= 1.f + __expf(-b2); r3 *= 1.f + __expf(-b3);
                    }
                    acc[i][j][0] *= r0; acc[i][j][1] *= r1; acc[i][j][2] *= r2; acc[i][j][3] *= r3;
                    ga[i][j] = gb[i][j];
                }
        }
#pragma unroll
        for (int i = 0; i < 4; ++i)
#pragma unroll
            for (int j = 0; j < 4; ++j) {
                const int row = tm * 128 + wr * 64 + i * 16 + fr, col = tn * 128 + wc * 64 + j * 16 + fq * 4;
                st_bf4(Z + (size_t)row * D + col, acc[i][j][0], acc[i][j][1], acc[i][j][2], acc[i][j][3]);
            }
        it = slot[(n_ + 1) & 1];
    }
}

__device__ void ph_outproj(KParams p, int l, unsigned char* lds) {
    const bf16* Z = (const bf16*)(p->ws + WS_H);
    const bf16* WT = wsm_outt(p, l);
    const int nrows = (l == 0) ? NTOK : NL, nM = nrows / 128, nN = 8, G = gridDim.x;
    const int tid = tid_opaque(), lane = tid & 63, wid = tid >> 6, wr = wid >> 1, wc = wid & 1, fr = lane & 15, fq = lane >> 4;
    auto issue = [&](int it_) { int tm_, tn_; tile_coords(it_, nM, nN, tm_, tn_);
        gemm_issue0([&](int r) { return Z + (size_t)(tm_ * 128 + r) * D; }, [&](int r) { return WT + (size_t)(tn_ * 128 + r) * D; }, lds, tid); };
    const TileQ tq{(unsigned*)(p->ws + WS_CTL) + CW_TQ + (l * 5 + 2) * 512, nM * nN};
    volatile int* slot = (volatile int*)(lds + LDS_TQ_OFF);
    __syncthreads();
    if (tid == 0) slot[0] = tq_next(tq);
    __syncthreads();
    int it = slot[0];
    if (it >= 0) issue(it);
    for (int n_ = 0; it >= 0; ++n_) {
        if (tid == 0) slot[(n_ + 1) & 1] = tq_next(tq);
        int tm, tn; tile_coords(it, nM, nN, tm, tn);
        float4 xo[4][4];
#pragma unroll
        for (int i = 0; i < 4; ++i) {
            const float* xr = xrow(p, l, tm * 128 + wr * 64 + i * 16 + fr);
#pragma unroll
            for (int j = 0; j < 4; ++j) xo[i][j] = *(const float4*)(xr + tn * 128 + wc * 64 + j * 16 + fq * 4);
        }
        f32x4 acc[4][4]; zero_acc4(acc);
        gemm_tile<true>(acc, [&](int r) { return Z + (size_t)(tm * 128 + r) * D; }, [&](int r) { return WT + (size_t)(tn * 128 + r) * D; }, D, lds, tid,
                  [&]() { const int nx = slot[(n_ + 1) & 1]; if (nx >= 0) issue(nx); });
#pragma unroll
        for (int i = 0; i < 4; ++i) {
            const int r = tm * 128 + wr * 64 + i * 16 + fr;
            const float* g1 = modv(p, l, modrow(r), 2);
            float* dr = r < NL ? p->out + (size_t)r * D : (float*)(p->ws + WS_XC) + (size_t)(r - NL) * D;
#pragma unroll
            for (int j = 0; j < 4; ++j) {
                const int c = tn * 128 + wc * 64 + j * 16 + fq * 4;
                const float4 gg = *(const float4*)(g1 + c);
                *(float4*)(dr + c) = make_float4(xo[i][j].x + gg.x * acc[i][j][0], xo[i][j].y + gg.y * acc[i][j][1], xo[i][j].z + gg.z * acc[i][j][2], xo[i][j].w + gg.w * acc[i][j][3]);
            }
        }
        it = slot[(n_ + 1) & 1];
    }
}

__device__ __forceinline__ const float* x1row(KParams p, int r) {
    return r < NL ? p->out + (size_t)r * D : (const float*)(p->ws + WS_XC) + (size_t)(r - NL) * D;
}
__device__ void ph_router(KParams p, int l, unsigned char* lds) {
    const int tid = tid_opaque(), lane = tid & 63, wid = tid >> 6;
    bf16* H = (bf16*)(p->ws + WS_H);
    const float* g = p->in[I_N2G] + l * D;
    const float* wt_ = (const float*)(p->ws + WS_RWT) + (size_t)l * 36 * D;
    unsigned* cnt = (unsigned*)(p->ws + WS_CTL) + CNT_BASE + l * 32 * CNT_STRIDE;
    int* list = (int*)(p->ws + WS_LIST);
    float* wt = (float*)(p->ws + WS_WT);
    const int nrows = (l == 0) ? NTOK : NL, ngrp = nrows / 16;
    float* LG = (float*)(lds + 65536) + wid * 4 * 40;
    const int myidx = (int)(__builtin_bitreverse32((unsigned)(lane & 31)) >> 27);
    auto issue_chunk = [&](int c, int buf) {
#pragma unroll
        for (int j = 0; j < 8; ++j)
            __builtin_amdgcn_global_load_lds((const unsigned*)(wt_ + (size_t)c * 8 * D + j * 1024 + tid * 4), (unsigned*)(lds + buf * 32768 + j * 4096 + tid * 16), 16, 0, 0);
    };
    __syncthreads();
    if ((int)blockIdx.x < ngrp) issue_chunk(0, 0);
    int kk = 0;
    for (int gi = blockIdx.x; gi < ngrp; gi += gridDim.x) {
        const int r0 = gi * 16 + wid * 4;
        float hv[4][16];
        {
            float4 xv[4][4];
#pragma unroll
            for (int q = 0; q < 4; ++q) {
                const float* x = x1row(p, r0 + q);
#pragma unroll
                for (int j = 0; j < 4; ++j) xv[q][j] = *(const float4*)(x + j * 256 + lane * 4);
            }
            float inv[4];
#pragma unroll
            for (int q = 0; q < 4; ++q) {
                float ss = 0.f;
#pragma unroll
                for (int j = 0; j < 4; ++j) ss += xv[q][j].x * xv[q][j].x + xv[q][j].y * xv[q][j].y + xv[q][j].z * xv[q][j].z + xv[q][j].w * xv[q][j].w;
                inv[q] = ss;
            }
#pragma unroll
            for (int o = 1; o < 64; o <<= 1) {
#pragma unroll
                for (int q = 0; q < 4; ++q) inv[q] += __shfl_xor(inv[q], o);
            }
#pragma unroll
            for (int q = 0; q < 4; ++q) {
                const int r = r0 + q, mb = modrow(r);
                const float iv = rsqrtf(inv[q] * (1.f / D) + EPS);
                const float* sh = modv(p, l, mb, 3); const float* sc = modv(p, l, mb, 4);
#pragma unroll
                for (int j = 0; j < 4; ++j) {
                    const int c = j * 256 + lane * 4;
                    const float4 gg = *(const float4*)(g + c), s1 = *(const float4*)(sh + c), s2 = *(const float4*)(sc + c);
                    hv[q][j * 4 + 0] = xv[q][j].x * iv * gg.x * (1.f + s2.x) + s1.x; hv[q][j * 4 + 1] = xv[q][j].y * iv * gg.y * (1.f + s2.y) + s1.y;
                    hv[q][j * 4 + 2] = xv[q][j].z * iv * gg.z * (1.f + s2.z) + s1.z; hv[q][j * 4 + 3] = xv[q][j].w * iv * gg.w * (1.f + s2.w) + s1.w;
                }
            }
#pragma unroll
            for (int q = 0; q < 4; ++q)
#pragma unroll
                for (int j = 0; j < 4; ++j)
                    st_bf4(H + (size_t)(r0 + q) * D + j * 256 + lane * 4, hv[q][j * 4], hv[q][j * 4 + 1], hv[q][j * 4 + 2], hv[q][j * 4 + 3]);
        }
#pragma unroll 1
        for (int c = 0; c < 5; ++c) {
            asm volatile("s_waitcnt vmcnt(0)" ::: "memory");
            __syncthreads();
            issue_chunk(c == 4 ? 0 : c + 1, (kk + 1) & 1);
            const unsigned char* wb = lds + (kk & 1) * 32768;
            ++kk;
            float v[32];
#pragma unroll
            for (int e = 0; e < 32; ++e) v[e] = 0.f;
#pragma unroll
            for (int oo = 0; oo < 8; ++oo)
#pragma unroll
                for (int j = 0; j < 4; ++j) {
                    const float4 w = *(const float4*)(wb + oo * 4096 + j * 1024 + lane * 16);
#pragma unroll
                    for (int q = 0; q < 4; ++q) v[oo * 4 + q] += hv[q][j * 4] * w.x + hv[q][j * 4 + 1] * w.y + hv[q][j * 4 + 2] * w.z + hv[q][j * 4 + 3] * w.w;
                }
#pragma unroll
            for (int st = 0; st < 5; ++st) {
                const int n = 16 >> st;
                const bool up = (lane >> st) & 1;
#pragma unroll
                for (int i = 0; i < n; ++i) {
                    const float keep = up ? v[i + n] : v[i], send = up ? v[i] : v[i + n];
                    v[i] = keep + __shfl_xor(send, 1 << st);
                }
            }
            const float val = v[0] + __shfl_xor(v[0], 32);
            const int o = c * 8 + (myidx >> 2);
            if (lane < 32 && o < 36) LG[(myidx & 3) * 40 + o] = val;
        }
        __syncthreads();
        if (lane < 4) {
            const float* lgq = LG + lane * 40;
            float lg[4];
#pragma unroll
            for (int z = 0; z < 4; ++z) lg[z] = lgq[z] + p->in[I_BGRP][l * 4 + z];
            float gmax = lg[0]; int grp = 0;
#pragma unroll
            for (int z = 1; z < 4; ++z) if (lg[z] > gmax) { gmax = lg[z]; grp = z; }
            float gden = 0.f;
#pragma unroll
            for (int z = 0; z < 4; ++z) gden += __expf(lg[z] - gmax);
            const float ptg = 1.f / gden;
            float le[8];
#pragma unroll
            for (int z = 0; z < 8; ++z) le[z] = lgq[4 + grp * 8 + z] + p->in[I_BEXP][l * 32 + grp * 8 + z];
            int i1 = 0; float m1 = le[0];
#pragma unroll
            for (int z = 1; z < 8; ++z) if (le[z] > m1) { m1 = le[z]; i1 = z; }
            int i2 = -1; float m2 = -3.0e38f;
#pragma unroll
            for (int z = 0; z < 8; ++z) if (z != i1 && le[z] > m2) { m2 = le[z]; i2 = z; }
            const float e2 = __expf(m2 - m1);
            const float w1 = ptg / (1.f + e2), w2 = ptg * e2 / (1.f + e2);
            const int r = r0 + lane, ea = grp * 8 + i1, eb = grp * 8 + i2;
            const unsigned pa = atomicAdd(&cnt[ea * CNT_STRIDE], 1u); list[(size_t)ea * NTOK + pa] = r * 2;
            const unsigned pb = atomicAdd(&cnt[eb * CNT_STRIDE], 1u); list[(size_t)eb * NTOK + pb] = r * 2 + 1;
            wt[r * 2] = w1; wt[r * 2 + 1] = w2;
        }
    }
    asm volatile("s_waitcnt vmcnt(0)" ::: "memory");
    __syncthreads();
}

__device__ void ph_convmoe(KParams p, int l, float* sm) {
    const int tid = tid_opaque();
    bf16* WGU = (bf16*)(p->ws + WS_WGU);
    bf16* WDT = (bf16*)(p->ws + WS_WDT);
    conv_stream([&](int it) {
        const int e = it / 384, r = it % 384, kind = r >> 7, q = r & 127;
        ConvItem c;
        if (kind < 2) {
            c.src = p->in[kind == 0 ? I_WGATE : I_WUP] + ((size_t)(l * 32 + e) * D) * 512; c.dst = WGU + (size_t)e * D * D; c.ldsrc = 512; c.nvalid = 512;
            c.k0 = (q >> 3) * 64; c.n0 = (q & 7) * 64; c.lddst = D; c.kind = 2 + kind;
        } else {
            c.src = p->in[I_WDOWN] + ((size_t)(l * 32 + e) * 512) * D; c.dst = WDT + (size_t)e * D * 512; c.ldsrc = D; c.nvalid = D;
            c.k0 = (q >> 4) * 64; c.n0 = (q & 15) * 64; c.lddst = 512; c.kind = 0;
        }
        return c;
    }, 32 * 384, (unsigned char*)sm, tid);
}

constexpr int LDS_MOE_TAB = 65536;
__device__ __forceinline__ int moe_build_table(const unsigned* cnt, unsigned char* lds, const int tid) {
    int* TS = (int*)(lds + LDS_MOE_TAB); int* CN = TS + 40;
    __syncthreads();
    if (tid < 32) CN[tid] = (int)cnt[tid * CNT_STRIDE];
    __syncthreads();
    if (tid == 0) { int acc = 0; for (int q = 0; q < 32; ++q) { TS[q] = acc; acc += (CN[q] + 127) >> 7; } TS[32] = acc; }
    __syncthreads();
    return TS[32];
}
__device__ __forceinline__ void moe_tile_lookup(const unsigned char* lds, int trow, int& e, int& i0, int& ce) {
    const int* TS = (const int*)(lds + LDS_MOE_TAB); const int* CN = TS + 40;
    int lo = 0;
#pragma unroll
    for (int step = 16; step >= 1; step >>= 1) if (TS[lo + step] <= trow) lo += step;
    e = lo; i0 = (trow - TS[lo]) * 128; ce = CN[lo];
}

__device__ void ph_moe1(KParams p, int l, unsigned char* lds) {
    const bf16* H = (const bf16*)(p->ws + WS_H);
    bf16* ACT = (bf16*)(p->ws + WS_ACT);
    const bf16* WGU = (const bf16*)(p->ws + WS_WGU);
    const unsigned* cnt = (const unsigned*)(p->ws + WS_CTL) + CNT_BASE + l * 32 * CNT_STRIDE;
    const int* list = (const int*)(p->ws + WS_LIST);
    const int tid = tid_opaque(), lane = tid & 63, wid = tid >> 6, wr = wid >> 1, wc = wid & 1, fr = lane & 15, fq = lane >> 4;
    const int ntiles = moe_build_table(cnt, lds, tid), G = gridDim.x;
    auto issue = [&](int it_) {
        int e_, i0_, ce_; moe_tile_lookup(lds, it_ >> 3, e_, i0_, ce_);
        const int* le_ = list + (size_t)e_ * NTOK; const bf16* W_ = WGU + (size_t)e_ * D * D + (size_t)(it_ & 7) * 128 * D;
        gemm_issue0([&](int r) { const int ii = min(i0_ + r, ce_ - 1); return H + (size_t)(le_[ii] >> 1) * D; }, [&](int r) { return W_ + (size_t)r * D; }, lds, tid);
    };
    const TileQ tq{(unsigned*)(p->ws + WS_CTL) + CW_TQ + (l * 5 + 3) * 512, ntiles * 8};
    volatile int* slot = (volatile int*)(lds + LDS_TQ_OFF);
    __syncthreads();
    if (tid == 0) slot[0] = tq_next(tq);
    __syncthreads();
    int it = slot[0];
    if (it >= 0) issue(it);
    for (int n_ = 0; it >= 0; ++n_) {
        if (tid == 0) slot[(n_ + 1) & 1] = tq_next(tq);
        const int trow = it >> 3, tn = it & 7;
        int e, i0, ce; moe_tile_lookup(lds, trow, e, i0, ce);
        const int* le = list + (size_t)e * NTOK;
        const bf16* WT = WGU + (size_t)e * D * D;
        int asg[4];
#pragma unroll
        for (int i = 0; i < 4; ++i) asg[i] = le[min(i0 + wr * 64 + i * 16 + fr, ce - 1)];
        f32x4 acc[4][4]; zero_acc4(acc);
        gemm_tile<false>(acc, [&](int r) { const int ii = min(i0 + r, ce - 1); return H + (size_t)(le[ii] >> 1) * D; },
                  [&](int r) { return WT + (size_t)(tn * 128 + r) * D; }, D, lds, tid, [&]() { const int nx = slot[(n_ + 1) & 1]; if (nx >= 0) issue(nx); });
#pragma unroll
        for (int i = 0; i < 4; ++i) {
            const int ii = i0 + wr * 64 + i * 16 + fr;
            if (ii < ce) {
#pragma unroll
                for (int jp = 0; jp < 2; ++jp) {
                    const f32x4 g = acc[i][2 * jp], u = acc[i][2 * jp + 1];
                    st_bf4(ACT + (size_t)asg[i] * 512 + tn * 64 + wc * 32 + jp * 16 + fq * 4, silu_f(g[0]) * u[0], silu_f(g[1]) * u[1], silu_f(g[2]) * u[2], silu_f(g[3]) * u[3]);
                }
            }
        }
        it = slot[(n_ + 1) & 1];
    }
}

__device__ void ph_moe2(KParams p, int l, unsigned char* lds) {
    const bf16* ACT = (const bf16*)(p->ws + WS_ACT);
    const bf16* WDT = (const bf16*)(p->ws + WS_WDT);
    const unsigned* cnt = (const unsigned*)(p->ws + WS_CTL) + CNT_BASE + l * 32 * CNT_STRIDE;
    const int* list = (const int*)(p->ws + WS_LIST);
    const float* wt = (const float*)(p->ws + WS_WT);
    const int tid = tid_opaque(), lane = tid & 63, wid = tid >> 6, wr = wid >> 1, wc = wid & 1, fr = lane & 15, fq = lane >> 4;
    const int ntiles = moe_build_table(cnt, lds, tid), G = gridDim.x;
    auto issue = [&](int it_) {
        int e_, i0_, ce_; moe_tile_lookup(lds, it_ >> 3, e_, i0_, ce_);
        const int* le_ = list + (size_t)e_ * NTOK; const bf16* W_ = WDT + (size_t)e_ * D * 512 + (size_t)(it_ & 7) * 128 * 512;
        gemm_issue0([&](int r) { const int ii = min(i0_ + r, ce_ - 1); return ACT + (size_t)le_[ii] * 512; }, [&](int r) { return W_ + (size_t)r * 512; }, lds, tid);
    };
    const TileQ tq{(unsigned*)(p->ws + WS_CTL) + CW_TQ + (l * 5 + 4) * 512, ntiles * 8};
    volatile int* slot = (volatile int*)(lds + LDS_TQ_OFF);
    __syncthreads();
    if (tid == 0) slot[0] = tq_next(tq);
    __syncthreads();
    int it = slot[0];
    if (it >= 0) issue(it);
    for (int n_ = 0; it >= 0; ++n_) {
        if (tid == 0) slot[(n_ + 1) & 1] = tq_next(tq);
        const int trow = it >> 3, tn = it & 7;
        int e, i0, ce; moe_tile_lookup(lds, trow, e, i0, ce);
        const int* le = list + (size_t)e * NTOK;
        const bf16* WT = WDT + (size_t)e * D * 512;
        int asg[4]; float wv[4];
#pragma unroll
        for (int i = 0; i < 4; ++i) { asg[i] = le[min(i0 + wr * 64 + i * 16 + fr, ce - 1)]; wv[i] = wt[asg[i]]; }
        f32x4 acc[4][4]; zero_acc4(acc);
        gemm_tile<false>(acc, [&](int r) { const int ii = min(i0 + r, ce - 1); return ACT + (size_t)le[ii] * 512; },
                  [&](int r) { return WT + (size_t)(tn * 128 + r) * 512; }, 512, lds, tid, [&]() { const int nx = slot[(n_ + 1) & 1]; if (nx >= 0) issue(nx); });
#pragma unroll
        for (int i = 0; i < 4; ++i) {
            const int ii = i0 + wr * 64 + i * 16 + fr;
            if (ii < ce) {
                const int tok = asg[i] >> 1;
                const float w = wv[i];
                bf16* Y = (bf16*)(p->ws + ((asg[i] & 1) ? WS_Y1 : WS_Y0));
#pragma unroll
                for (int j = 0; j < 4; ++j)
                    st_bf4(Y + (size_t)tok * D + tn * 128 + wc * 64 + j * 16 + fq * 4, w * acc[i][j][0], w * acc[i][j][1], w * acc[i][j][2], w * acc[i][j][3]);
            }
        }
        it = slot[(n_ + 1) & 1];
    }
}

__device__ void ph_combine(KParams p, int l) {
    const int tid = tid_opaque(), lane = tid & 63, gw = blockIdx.x * 4 + (tid >> 6), ngw = gridDim.x * 4;
    const bf16* Y0 = (const bf16*)(p->ws + WS_Y0);
    const bf16* Y1 = (const bf16*)(p->ws + WS_Y1);
    bf16* H = (bf16*)(p->ws + WS_H);
    const int nrows = (l == 0) ? NTOK : NL;
    const float* ng = (l == 0) ? p->in[I_N1G] + D : p->in[I_FING];
    for (int r0 = gw * 2; r0 < nrows; r0 += ngw * 2) {
        float4 xv[2][4]; uint2 ya[2][4], yb[2][4];
#pragma unroll
        for (int q = 0; q < 2; ++q) {
            const int r = r0 + q;
            const float* x = x1row(p, r);
#pragma unroll
            for (int j = 0; j < 4; ++j) {
                const int c = j * 256 + lane * 4;
                xv[q][j] = *(const float4*)(x + c); ya[q][j] = *(const uint2*)(Y0 + (size_t)r * D + c); yb[q][j] = *(const uint2*)(Y1 + (size_t)r * D + c);
            }
        }
#pragma unroll
        for (int q = 0; q < 2; ++q) {
            const int r = r0 + q, mb = modrow(r);
            float* xo = r < NL ? p->out + (size_t)r * D : (float*)(p->ws + WS_XC) + (size_t)(r - NL) * D;
            const float* g2 = modv(p, l, mb, 5);
            float4 v[4]; float ss = 0.f;
#pragma unroll
            for (int j = 0; j < 4; ++j) {
                const int c = j * 256 + lane * 4;
                const float4 gg = *(const float4*)(g2 + c);
                const float a0 = __uint_as_float(ya[q][j].x << 16) + __uint_as_float(yb[q][j].x << 16), a1 = __uint_as_float(ya[q][j].x & 0xffff0000u) + __uint_as_float(yb[q][j].x & 0xffff0000u);
                const float a2 = __uint_as_float(ya[q][j].y << 16) + __uint_as_float(yb[q][j].y << 16), a3 = __uint_as_float(ya[q][j].y & 0xffff0000u) + __uint_as_float(yb[q][j].y & 0xffff0000u);
                v[j] = make_float4(xv[q][j].x + gg.x * a0, xv[q][j].y + gg.y * a1, xv[q][j].z + gg.z * a2, xv[q][j].w + gg.w * a3);
                ss += v[j].x * v[j].x + v[j].y * v[j].y + v[j].z * v[j].z + v[j].w * v[j].w;
            }
            const float inv = rsqrtf(wave_sum(ss) * (1.f / D) + EPS);
            if (l == 0) {
                const float* sh = modv(p, 1, mb, 0); const float* sc = modv(p, 1, mb, 1);
#pragma unroll
                for (int j = 0; j < 4; ++j) {
                    const int c = j * 256 + lane * 4;
                    *(float4*)(xo + c) = v[j];
                    const float4 gg = *(const float4*)(ng + c), s1 = *(const float4*)(sh + c), s2 = *(const float4*)(sc + c);
                    st_bf4(H + (size_t)r * D + c, v[j].x * inv * gg.x * (1.f + s2.x) + s1.x, v[j].y * inv * gg.y * (1.f + s2.y) + s1.y,
                           v[j].z * inv * gg.z * (1.f + s2.z) + s1.z, v[j].w * inv * gg.w * (1.f + s2.w) + s1.w);
                }
            } else {
#pragma unroll
                for (int j = 0; j < 4; ++j) {
                    const int c = j * 256 + lane * 4;
                    const float4 gg = *(const float4*)(ng + c);
                    *(float4*)(xo + c) = make_float4(v[j].x * inv * gg.x, v[j].y * inv * gg.y, v[j].z * inv * gg.z, v[j].w * inv * gg.w);
                }
            }
        }
    }
}

#define XB_TMO      128
#define XB_XCNT(j)  (256  + 64 * (j))
#define XB_XSUB(j)  (1280 + 64 * (j))
#define XB_XGEN(j)  (2304 + 64 * (j))
#define XB_TOP      3328
#define XB_TOPGEN   3392
#define XB_SPIN_CAP (1u << 22)
constexpr int CW_BAR = 4096;
__device__ __forceinline__ unsigned xb_ld(unsigned* p)              { return __hip_atomic_load(p, __ATOMIC_RELAXED, __HIP_MEMORY_SCOPE_AGENT); }
__device__ __forceinline__ unsigned xb_add(unsigned* p, unsigned v) { return __hip_atomic_fetch_add(p, v, __ATOMIC_RELAXED, __HIP_MEMORY_SCOPE_AGENT); }
__device__ __forceinline__ unsigned xb_xcc_id() { return (unsigned)__builtin_amdgcn_s_getreg((3 << 11) | 20) & 0xFu; }
#define XB_SPIN(cond, bar) do { unsigned _sp = 0; while (cond) { __builtin_amdgcn_s_sleep(1); \
    if ((++_sp & 255u) == 0u) { if (xb_ld(&(bar)[XB_TMO])) break; if (_sp > XB_SPIN_CAP) { atomicAdd(&(bar)[XB_TMO], 1u); break; } } } } while (0)
constexpr int LDS_BAR_OFF = 79 * 1024 + 16;
__device__ __forceinline__ void xcd_barrier_post(unsigned* bar) {
    if (threadIdx.x == 0) (void)xb_add(&bar[XB_XCNT(xb_xcc_id())], 1u);
}
__device__ __forceinline__ void xcd_barrier_census(unsigned* bar, volatile unsigned* st) {
    if (threadIdx.x == 0) {
        const unsigned x = xb_xcc_id();
        unsigned cnt = 0, mine = 0;
#pragma unroll
        for (unsigned j = 0; j < 16; ++j) { const unsigned c = xb_ld(&bar[XB_XCNT(j)]); cnt += (c > 0u) ? 1u : 0u; mine = (j == x) ? c : mine; }
        st[0] = mine > 0u ? mine : 1u; st[1] = cnt > 0u ? cnt : 1u;
    }
    __syncthreads();
}
__device__ __forceinline__ void xcd_barrier(KParams kp, unsigned char* lds) {
    asm volatile("s_waitcnt vmcnt(0)" ::: "memory");
    __syncthreads();
    if (threadIdx.x == 0) {
        unsigned* bar = (unsigned*)(kp->ws + WS_CTL) + CW_BAR;
        volatile unsigned* st = (volatile unsigned*)(lds + LDS_BAR_OFF);
        __builtin_amdgcn_s_waitcnt(0);
        const unsigned x = xb_xcc_id();
        const unsigned nloc = st[0], nx = st[1];
        const unsigned old = xb_add(&bar[XB_XSUB(x)], 1u);
        const unsigned gen = old / nloc;
        if (old + 1u == (gen + 1u) * nloc) {
            __builtin_amdgcn_fence(__ATOMIC_RELEASE, "agent");
            asm volatile("s_waitcnt vmcnt(0)" ::: "memory");
            const unsigned og = xb_add(&bar[XB_TOP], 1u);
            const unsigned tg = og / nx;
            if (og + 1u == (tg + 1u) * nx) xb_add(&bar[XB_TOPGEN], 1u);
            else XB_SPIN(xb_ld(&bar[XB_TOPGEN]) == tg, bar);
            __builtin_amdgcn_fence(__ATOMIC_ACQUIRE, "agent");
            xb_add(&bar[XB_XGEN(x)], 1u);
            asm volatile("s_waitcnt vmcnt(0)" ::: "memory");
        } else {
            XB_SPIN(xb_ld(&bar[XB_XGEN(x)]) == gen, bar);
            __builtin_amdgcn_fence(__ATOMIC_ACQUIRE, "agent");
            asm volatile("s_waitcnt vmcnt(0)" ::: "memory");
        }
    }
    __syncthreads();
}

constexpr int LDS_BYTES = 80 * 1024;
__global__ void __launch_bounds__(256, 2) mega_fwd(Params p_unused) {
    const KParams kp = (KParams)__builtin_amdgcn_kernarg_segment_ptr();
    extern __shared__ __attribute__((aligned(16))) unsigned char smem_raw[];
    float* sm = (float*)smem_raw;
    cg::grid_group grid = cg::this_grid();
#ifndef PROBE_SEL
#define PROBE_SEL 0ull
#endif
#if PROBE_SEL
    volatile unsigned long long* stamps = (volatile unsigned long long*)(smem_raw + 79 * 1024 + 64);
    int n_stamp = 0;
#define STAMP() do { if (blockIdx.x == 0 && threadIdx.x == 0) stamps[n_stamp] = __builtin_amdgcn_s_memrealtime(); ++n_stamp; } while (0)
#else
#define STAMP() do { } while (0)
#endif
    xcd_barrier_post((unsigned*)(kp->ws + WS_CTL) + CW_BAR);
    STAMP();
    ph_init(fresh(kp), sm);
    grid.sync();
    xcd_barrier_census((unsigned*)(kp->ws + WS_CTL) + CW_BAR, (volatile unsigned*)(smem_raw + LDS_BAR_OFF));
    STAMP();
#define GSYNC() do { xcd_barrier(fresh(kp), smem_raw); STAMP(); } while (0)
#pragma unroll 1
    for (int l = 0; l < 2; ++l) {
        if (l == 0) { ph_norm1(fresh(kp), l); GSYNC(); }
        ph_gemm_in(fresh(kp), l, smem_raw); GSYNC();
        ph_prep(fresh(kp), l, sm);
        ph_gla_local(fresh(kp), l, smem_raw); GSYNC();
        ph_mix(fresh(kp), l, smem_raw);     GSYNC();
        ph_gla_out(fresh(kp), l, smem_raw); GSYNC();
        ph_merge(fresh(kp), l, smem_raw);   GSYNC();
        ph_outproj(fresh(kp), l, smem_raw); GSYNC();
        ph_router(fresh(kp), l, smem_raw);
        ph_convmoe(fresh(kp), l, sm);       GSYNC();
        ph_moe1(fresh(kp), l, smem_raw);    GSYNC();
        ph_moe2(fresh(kp), l, smem_raw);    GSYNC();
        ph_combine(fresh(kp), l);           GSYNC();
    }
#if PROBE_SEL
    if (blockIdx.x == 0 && threadIdx.x == 0) {
        unsigned long long dt = 0;
        for (int i = 0; i < 23; ++i) if ((PROBE_SEL >> i) & 1ull) dt += stamps[i + 1] - stamps[i];
        const unsigned long long t0 = __builtin_amdgcn_s_memrealtime();
        while (__builtin_amdgcn_s_memrealtime() - t0 < dt) __builtin_amdgcn_s_sleep(8);
    }
#endif
}

extern "C" void kernel_launch(void* const* d_in, const int* in_sizes, int n_in, void* d_out, int out_size, void* d_ws, size_t ws_size,
                              hipStream_t stream) {
    if (n_in != 28 || ws_size < WS_END) { fprintf(stderr, "kernel_launch: bad n_in %d or ws_size %zu (< %zu)\n", n_in, ws_size, (size_t)WS_END); return; }
    static int grid_blocks = 0;
    if (!grid_blocks) {
        int dev = 0, cus = 0, per_cu = 0;
        (void)hipGetDevice(&dev);
        (void)hipDeviceGetAttribute(&cus, hipDeviceAttributeMultiprocessorCount, dev);
        (void)hipFuncSetAttribute((const void*)mega_fwd, hipFuncAttributeMaxDynamicSharedMemorySize, LDS_BYTES);
        (void)hipOccupancyMaxActiveBlocksPerMultiprocessor(&per_cu, (const void*)mega_fwd, 256, LDS_BYTES);
        if (per_cu < 1) per_cu = 1;
        grid_blocks = cus * per_cu;
        fprintf(stderr, "kernel_launch: cus %d per_cu %d grid %d ws_size %zu\n", cus, per_cu, grid_blocks, ws_size);
    }
    Params p{};
    for (int i = 0; i < 28; ++i) p.in[i] = (const float*)d_in[i];
    p.out = (float*)d_out; p.ws = (unsigned char*)d_ws;
    (void)hipMemsetAsync((char*)d_ws + WS_CTL, 0, 1 * MiB, stream);
    void* args[] = {&p};
    hipError_t e = hipLaunchCooperativeKernel((const void*)mega_fwd, dim3(grid_blocks), dim3(256), args, LDS_BYTES, stream);
    if (e != hipSuccess) fprintf(stderr, "cooperative launch failed: %s (grid %d)\n", hipGetErrorString(e), grid_blocks);
}
```

```cpp
#include <hip/hip_runtime.h>
#include <hip/hip_cooperative_groups.h>
namespace cg = cooperative_groups;
#include <cstdio>
#include <cstdint>

typedef unsigned short bf16;

constexpr int D = 1024, NB = 8, T = 4096, CL = 256, NL = NB * T, NC = NB * CL, NTOK = NL + NC;
constexpr int INW = 5920;
constexpr int O_GQ = 0, O_GK = 256, O_GV = 512, O_GR = 1024, O_AQ = 1536, O_AK = 2048, O_AV = 2176, O_PU = 2304, O_GT = 2816, O_GLF = 5888, O_GLB = 5904;
__host__ __device__ constexpr int win_nmap(int n) { return n < 1536 ? n : (n < 1568 ? n + 4352 : (n < 5920 ? n - 32 : n)); }
constexpr float EPS = 1e-6f;
constexpr int CNT_BASE = 8192, CNT_STRIDE = 64;

constexpr size_t MiB = 1u << 20;
constexpr size_t WS_CTL = 0;
constexpr size_t WS_MODV = 1 * MiB;
constexpr size_t WS_ROPE = 1 * MiB + 512 * 1024;
constexpr size_t WS_WT = 2 * MiB;
constexpr size_t WS_LIST = 3 * MiB;
constexpr size_t WS_RWT = 7 * MiB + 256 * 1024;
constexpr size_t WS_XC = 8 * MiB;
constexpr size_t WS_H = 16 * MiB;
constexpr size_t WS_PROJ = 84 * MiB;
constexpr size_t WS_R2 = 478 * MiB;
constexpr size_t WS_WGU = WS_R2;
constexpr size_t WS_WDT = WS_R2 + 64 * MiB;
constexpr size_t WS_WSM = 580 * MiB;
constexpr size_t SZ_WINT = (size_t)6016 * 1024 * 2, SZ_WBT = (size_t)1024 * 512 * 2, SZ_WOUTT = (size_t)1024 * 1024 * 2;
constexpr size_t SZ_WSM_L = SZ_WINT + 3 * SZ_WBT + SZ_WOUTT;
constexpr size_t WS_VT = 614 * MiB;
constexpr int NKEY = T + CL;
constexpr size_t WS_END = 623 * MiB;
static_assert(WS_WSM + 2 * SZ_WSM_L <= WS_END, "ws map");
constexpr size_t SZ_Y512 = (size_t)NTOK * 512 * 2;
constexpr size_t WS_ACT = WS_PROJ;
constexpr size_t WS_Y0 = WS_PROJ + 68 * MiB;
constexpr size_t WS_Y1 = WS_PROJ + 136 * MiB;

struct Params {
    const float* in[28];
    float* out;
    unsigned char* ws;
};
typedef const __attribute__((address_space(4))) Params* KParams;
__device__ __forceinline__ KParams fresh(KParams k) { asm volatile("" : "+s"(k)); return k; }
enum { I_X = 0, I_C, I_CTX, I_CCTX, I_WMOD, I_BMOD, I_N1G, I_N2G, I_WIN, I_UPF, I_BIASF, I_UPB, I_BIASB, I_GLANG, I_QNG, I_KNG,
       I_POOLW, I_POOLS, I_WBR, I_WOUT, I_WGRP, I_BGRP, I_WEXP, I_BEXP, I_WGATE, I_WUP, I_WDOWN, I_FING };

__device__ __forceinline__ float bf2f(bf16 v) { return __uint_as_float(((unsigned)v) << 16); }
__device__ __forceinline__ bf16 f2bf(float f) { unsigned u = __float_as_uint(f); return (bf16)((u + 0x7fffu + ((u >> 16) & 1u)) >> 16); }
__device__ __forceinline__ float4 ld_bf4(const bf16* p) {
    uint2 u = *(const uint2*)p;
    return make_float4(__uint_as_float(u.x << 16), __uint_as_float(u.x & 0xffff0000u), __uint_as_float(u.y << 16), __uint_as_float(u.y & 0xffff0000u));
}
typedef float f32x2_t __attribute__((ext_vector_type(2)));
typedef __bf16 bf16x2_t __attribute__((ext_vector_type(2)));
__device__ __forceinline__ unsigned pk_bf16(float a, float b) { f32x2_t v = {a, b}; return __builtin_bit_cast(unsigned, __builtin_convertvector(v, bf16x2_t)); }
__device__ __forceinline__ void st_bf4(bf16* p, float a, float b, float c, float d) {
    uint2 u; u.x = pk_bf16(a, b); u.y = pk_bf16(c, d);
    *(uint2*)p = u;
}
__device__ __forceinline__ int tid_opaque() { int t = threadIdx.x; asm volatile("" : "+v"(t)); return t; }
#define DPP_ADD(v, ctrl) v += __builtin_bit_cast(float, __builtin_amdgcn_update_dpp(0, __builtin_bit_cast(int, v), (ctrl), 0xf, 0xf, true))
__device__ __forceinline__ float sum16(float v) {
    DPP_ADD(v, 0xB1);
    DPP_ADD(v, 0x4E);
    DPP_ADD(v, 0x141);
    DPP_ADD(v, 0x140);
    return v;
}
__device__ __forceinline__ float wave_sum(float v) {
#pragma unroll
    for (int o = 1; o < 64; o <<= 1) v += __shfl_xor(v, o);
    return v;
}
__device__ __forceinline__ float silu_f(float x) { return x * __builtin_amdgcn_rcpf(1.f + __expf(-x)); }
__device__ __forceinline__ float sigmoid_f(float x) { return __builtin_amdgcn_rcpf(1.f + __expf(-x)); }
__device__ __forceinline__ int modrow(int r) { return r < NL ? r / T : 8; }
__device__ __forceinline__ const float* xrow(KParams p, int l, int r) {
    if (l == 0) return r < NL ? p->in[I_X] + (size_t)r * D : p->in[I_CTX] + (size_t)(r - NL) * D;
    return r < NL ? p->out + (size_t)r * D : (const float*)(p->ws + WS_XC) + (size_t)(r - NL) * D;
}
__device__ __forceinline__ const float* modv(KParams p, int l, int mb, int which) {
    return (const float*)(p->ws + WS_MODV) + ((size_t)(l * 9 + mb) * 6 + which) * D;
}

template <class AF, class BF>
__device__ __forceinline__ void gemm64(float (&acc)[4][4], int K, AF aload, BF bload, float* sA, float* sB, const int tid) {
    const int ty = tid >> 4, tx = tid & 15;
    const int am = tid >> 2, ak = (tid & 3) * 4;
    const int bk = tid >> 4, bn = (tid & 15) * 4;
    for (int k0 = 0; k0 < K; k0 += 16) {
        float4 av = aload(am, k0 + ak);
        float4 bv = bload(k0 + bk, bn);
        __syncthreads();
        sA[(ak + 0) * 68 + am] = av.x; sA[(ak + 1) * 68 + am] = av.y; sA[(ak + 2) * 68 + am] = av.z; sA[(ak + 3) * 68 + am] = av.w;
        *(float4*)&sB[bk * 64 + bn] = bv;
        __syncthreads();
#pragma unroll
        for (int kk = 0; kk < 16; ++kk) {
            float4 a = *(float4*)&sA[kk * 68 + ty * 4];
            float4 b = *(float4*)&sB[kk * 64 + tx * 4];
            float aa[4] = {a.x, a.y, a.z, a.w}, bb[4] = {b.x, b.y, b.z, b.w};
#pragma unroll
            for (int i = 0; i < 4; ++i)
#pragma unroll
                for (int j = 0; j < 4; ++j) acc[i][j] += aa[i] * bb[j];
        }
    }
    __syncthreads();
}
__device__ __forceinline__ void zero_acc(float (&acc)[4][4]) {
#pragma unroll
    for (int i = 0; i < 4; ++i)
#pragma unroll
        for (int j = 0; j < 4; ++j) acc[i][j] = 0.f;
}

typedef short bf16x8 __attribute__((ext_vector_type(8)));
typedef float f32x4 __attribute__((ext_vector_type(4)));
constexpr int GT_BYTES = 16384;
__device__ __forceinline__ void zero_acc4(f32x4 (&acc)[4][4]) {
#pragma unroll
    for (int i = 0; i < 4; ++i)
#pragma unroll
        for (int j = 0; j < 4; ++j) acc[i][j] = (f32x4){0.f, 0.f, 0.f, 0.f};
}
template <class FA, class FB>
__device__ __forceinline__ void gemm_issue0(FA arow, FB brow, unsigned char* lds, const int tid) {
    const int srow = tid >> 3, sc = ((tid & 7) ^ ((tid >> 4) & 7)) * 8;
#pragma unroll
    for (int j = 0; j < 4; ++j) {
        __builtin_amdgcn_global_load_lds((const unsigned*)(arow(j * 32 + srow) + sc), (unsigned*)(lds + j * 4096 + tid * 16), 16, 0, 0);
        __builtin_amdgcn_global_load_lds((const unsigned*)(brow(j * 32 + srow) + sc), (unsigned*)(lds + GT_BYTES + j * 4096 + tid * 16), 16, 0, 0);
    }
}
template <bool AFF, class FA, class FB, class NF>
__device__ __forceinline__ void gemm_tile(f32x4 (&acc)[4][4], FA arow, FB brow, int K, unsigned char* lds, const int tid, NF next) {
    const int lane = tid & 63, wid = tid >> 6, wr = wid >> 1, wc = wid & 1, fr = lane & 15, fq = lane >> 4;
    const int srow = tid >> 3, sc = ((tid & 7) ^ ((tid >> 4) & 7)) * 8;
    const bf16* ap[4]; const bf16* bp[4];
    if (AFF) {
        const bf16* a0 = arow(srow) + sc; const long astep = (long)(arow(32) - arow(0));
#pragma unroll
        for (int j = 0; j < 4; ++j) ap[j] = a0 + j * astep;
    } else {
#pragma unroll
        for (int j = 0; j < 4; ++j) ap[j] = arow(j * 32 + srow) + sc;
    }
    {
        const bf16* b0 = brow(srow) + sc; const long bstep = (long)(brow(32) - brow(0));
#pragma unroll
        for (int j = 0; j < 4; ++j) bp[j] = b0 + j * bstep;
    }
    const int KT = K >> 6;
#pragma unroll 1
    for (int kt = 0; kt < KT; ++kt) {
        asm volatile("s_waitcnt vmcnt(0)" ::: "memory");
        __syncthreads();
        if (kt + 1 < KT) {
            unsigned char* sa = lds + ((kt + 1) & 1) * 2 * GT_BYTES;
#pragma unroll
            for (int j = 0; j < 4; ++j) {
                __builtin_amdgcn_global_load_lds((const unsigned*)(ap[j] + (kt + 1) * 64), (unsigned*)(sa + j * 4096 + tid * 16), 16, 0, 0);
                __builtin_amdgcn_global_load_lds((const unsigned*)(bp[j] + (kt + 1) * 64), (unsigned*)(sa + GT_BYTES + j * 4096 + tid * 16), 16, 0, 0);
            }
        } else {
            next();
        }
        const unsigned char* sa = lds + (kt & 1) * 2 * GT_BYTES;
        const unsigned char* sb = sa + GT_BYTES;
#pragma unroll
        for (int ks = 0; ks < 2; ++ks) {
            const int phys = ((ks * 4 + fq) ^ (fr >> 1)) * 16;
            bf16x8 bq[4];
#pragma unroll
            for (int j = 0; j < 4; ++j) bq[j] = *(const bf16x8*)(sb + (wc * 64 + j * 16 + fr) * 128 + phys);
#pragma unroll
            for (int i = 0; i < 4; ++i) {
                const bf16x8 af = *(const bf16x8*)(sa + (wr * 64 + i * 16 + fr) * 128 + phys);
#pragma unroll
                for (int j = 0; j < 4; ++j) acc[i][j] = __builtin_amdgcn_mfma_f32_16x16x32_bf16(bq[j], af, acc[i][j], 0, 0, 0);
            }
        }
    }
}
__device__ __forceinline__ void tile_coords(int it, int nM, int nN, int& tm, int& tn) {
    const int GM = 8, per = GM * nN, grp = it / per, fm = grp * GM, gsz = min(nM - fm, GM), rem = it - grp * per;
    tm = fm + rem % gsz; tn = rem / gsz;
}
constexpr int CW_TQ = 32768;
constexpr int LDS_TQ_OFF = 79 * 1024 + 32;
struct TileQ { unsigned* ctr; int ntiles; };
__device__ __forceinline__ int tq_next(const TileQ& q) {
    const int x = (int)(__builtin_amdgcn_s_getreg((3 << 11) | 20) & 7u);
    for (int s = 0; s < 8; ++s) {
        const int c = (x + s) & 7;
        const int b = (int)(((long)q.ntiles * c) >> 3), e = (int)(((long)q.ntiles * (c + 1)) >> 3);
        if (b >= e) continue;
        if ((int)__hip_atomic_load(q.ctr + c * 64, __ATOMIC_RELAXED, __HIP_MEMORY_SCOPE_AGENT) >= e - b) continue;
        const int t = (int)__hip_atomic_fetch_add(q.ctr + c * 64, 1u, __ATOMIC_RELAXED, __HIP_MEMORY_SCOPE_AGENT);
        if (b + t < e) return b + t;
    }
    return -1;
}
constexpr int STG_OFF = 32768;
template <int NCH>
__device__ __forceinline__ void stg_put(unsigned char* lds, int row, int colbyte, unsigned lo, unsigned hi) {
    *(uint2*)(lds + STG_OFF + row * (NCH * 16) + ((((colbyte >> 4) ^ row) & (NCH - 1)) << 4) + (colbyte & 15)) = make_uint2(lo, hi);
}
template <int NCH, class RP>
__device__ __forceinline__ void stg_flush(unsigned char* lds, const int tid, RP rowptr) {
#pragma unroll
    for (int k = 0; k < NCH / 2; ++k) {
        const int idx = k * 256 + tid, row = idx / NCH, ch = idx % NCH;
        bf16* dst = rowptr(row, ch);
        if (dst) *(uint4*)dst = *(const uint4*)(lds + STG_OFF + row * (NCH * 16) + (((ch ^ row) & (NCH - 1)) << 4));
    }
}
__device__ __forceinline__ int vblock() { const int G = gridDim.x, b = blockIdx.x; return (G & 7) == 0 ? (b & 7) * (G >> 3) + (b >> 3) : b; }

struct ConvItem { const float* src; bf16* dst; int ldsrc, nvalid, k0, n0, lddst, kind; };
__device__ __forceinline__ int conv_nmap(int kind, int n) {
    return kind == 0 ? n : (kind == 1 ? win_nmap(n) : 32 * (n >> 4) + (kind == 3 ? 16 : 0) + (n & 15));
}
template <class Dec>
__device__ __forceinline__ void conv_stream(Dec decode, int nitems, unsigned char* lds, const int tid) {
    auto issue = [&](const ConvItem& it, int buf) {
#pragma unroll
        for (int j = 0; j < 4; ++j) {
            const int k = j * 16 + (tid >> 4), pc = tid & 15, c = pc ^ ((k >> 4) & 3), n = it.n0 + c * 4;
            if (n < it.nvalid)
                __builtin_amdgcn_global_load_lds((const unsigned*)(it.src + (size_t)(it.k0 + k) * it.ldsrc + n), (unsigned*)(lds + buf * 16384 + j * 4096 + tid * 16), 16, 0, 0);
        }
    };
    int i = blockIdx.x;
    __syncthreads();
    ConvItem cur{};
    if (i < nitems) { cur = decode(i); issue(cur, 0); }
    int buf = 0;
    for (; i < nitems; i += gridDim.x) {
        asm volatile("s_waitcnt vmcnt(0)" ::: "memory");
        __syncthreads();
        ConvItem nxt{};
        const bool has_next = i + (int)gridDim.x < nitems;
        if (has_next) { nxt = decode(i + gridDim.x); issue(nxt, buf ^ 1); }
        {
            const float* sm = (const float*)(lds + buf * 16384);
            const int n = tid >> 2, kq = (tid & 3) * 16;
            const bool valid = cur.n0 + n < cur.nvalid;
            const int cidx = ((((n >> 2) ^ (kq >> 4)) & 15) << 2) + (n & 3);
            unsigned w[8];
#pragma unroll
            for (int q = 0; q < 8; ++q) {
                const float a = valid ? sm[(kq + 2 * q) * 64 + cidx] : 0.f, b = valid ? sm[(kq + 2 * q + 1) * 64 + cidx] : 0.f;
                w[q] = pk_bf16(a, b);
            }
            bf16* d = cur.dst + (size_t)conv_nmap(cur.kind, cur.n0 + n) * cur.lddst + cur.k0 + kq;
            *(uint4*)d = make_uint4(w[0], w[1], w[2], w[3]);
            *(uint4*)(d + 8) = make_uint4(w[4], w[5], w[6], w[7]);
        }
        cur = nxt; buf ^= 1;
    }
    asm volatile("s_waitcnt vmcnt(0)" ::: "memory");
    __syncthreads();
}
__device__ __forceinline__ bf16* wsm_int(KParams p, int l) { return (bf16*)(p->ws + WS_WSM + (size_t)l * SZ_WSM_L); }
__device__ __forceinline__ bf16* wsm_bt(KParams p, int l, int br) { return (bf16*)(p->ws + WS_WSM + (size_t)l * SZ_WSM_L + SZ_WINT + (size_t)br * SZ_WBT); }
__device__ __forceinline__ bf16* wsm_outt(KParams p, int l) { return (bf16*)(p->ws + WS_WSM + (size_t)l * SZ_WSM_L + SZ_WINT + 3 * SZ_WBT); }

__device__ void ph_init(KParams p, float* sm) {
    const int tid = tid_opaque();
    unsigned char* lds = (unsigned char*)sm;
    conv_stream([&](int it) {
        const int l = it / 2016; int r = it % 2016;
        ConvItem c;
        if (r < 1504) { c.src = p->in[I_WIN] + (size_t)l * D * INW; c.dst = wsm_int(p, l); c.ldsrc = INW; c.nvalid = INW; c.k0 = (r / 94) * 64; c.n0 = (r % 94) * 64; c.lddst = D; c.kind = 1; return c; }
        r -= 1504;
        if (r < 256) { const int br = r >> 7, q = r & 127;
            c.src = p->in[I_WBR] + ((size_t)(l * 3 + br) * 512) * D; c.dst = wsm_bt(p, l, br); c.ldsrc = D; c.nvalid = D; c.k0 = (q >> 4) * 64; c.n0 = (q & 15) * 64; c.lddst = 512; c.kind = 0; return c; }
        r -= 256;
        c.src = p->in[I_WOUT] + (size_t)l * D * D; c.dst = wsm_outt(p, l); c.ldsrc = D; c.nvalid = D; c.k0 = (r >> 4) * 64; c.n0 = (r & 15) * 64; c.lddst = D; c.kind = 0; return c;
    }, 2 * 2016, lds, tid);
    for (int it = blockIdx.x; it < 2 * 96; it += gridDim.x) {
        const int l = it / 96, cb = it % 96;
        __syncthreads();
        for (int e = tid; e < 9 * D; e += 256) {
            const int mb = e / D, k = e % D;
            sm[e] = silu_f(mb < 8 ? p->in[I_C][mb * D + k] : p->in[I_CCTX][k]);
        }
        __syncthreads();
        const int col = cb * 64 + (tid & 63), kq = tid >> 6;
        const float* w = p->in[I_WMOD] + (size_t)l * D * 6144 + (size_t)kq * 256 * 6144 + col;
        float acc[9];
#pragma unroll
        for (int m = 0; m < 9; ++m) acc[m] = 0.f;
#pragma unroll 8
        for (int k = 0; k < 256; ++k) {
            const float wv = w[(size_t)k * 6144];
#pragma unroll
            for (int m = 0; m < 9; ++m) acc[m] += sm[m * D + kq * 256 + k] * wv;
        }
        __syncthreads();
#pragma unroll
        for (int m = 0; m < 9; ++m) sm[9 * D + (kq * 9 + m) * 64 + (tid & 63)] = acc[m];
        __syncthreads();
        if (tid < 64) {
            const float bias = p->in[I_BMOD][l * 6144 + col];
            float* mv = (float*)(p->ws + WS_MODV);
#pragma unroll
            for (int m = 0; m < 9; ++m)
                mv[(size_t)(l * 9 + m) * 6144 + col] = sm[9 * D + (0 * 9 + m) * 64 + tid] + sm[9 * D + (1 * 9 + m) * 64 + tid] + sm[9 * D + (2 * 9 + m) * 64 + tid] + sm[9 * D + (3 * 9 + m) * 64 + tid] + bias;
        }
    }
    for (int it = blockIdx.x; it < 1 + 72 + 2 * 128; it += gridDim.x) {
        if (it == 0) {
            float2* rope = (float2*)(p->ws + WS_ROPE);
            for (int e = tid; e < 64 * 16; e += 256) {
                const int pos = e >> 4, i = e & 15;
                const float invf = powf(10000.0f, -(float)(2 * i) / 32.0f);
                const float angf = (float)pos * invf;
                const double ang = (double)angf;
                const double twopi = 6.283185307179586476925286766559;
                const double n = rint(ang / twopi);
                const double r = ang - n * twopi, r2 = r * r;
                double sn = 1.0, cs = 1.0;
                for (int q = 14; q >= 1; --q) { sn = 1.0 - r2 / (double)((2 * q) * (2 * q + 1)) * sn; cs = 1.0 - r2 / (double)((2 * q - 1) * (2 * q)) * cs; }
                sn *= r;
                rope[e] = make_float2((float)cs, (float)sn);
            }
        } else if (it < 73) {
            const int q = it - 1, l = q / 36, o = q % 36;
            float* dst = (float*)(p->ws + WS_RWT) + (size_t)(l * 36 + o) * D;
            for (int k = tid; k < D; k += 256) dst[k] = o < 4 ? p->in[I_WGRP][((size_t)l * D + k) * 4 + o] : p->in[I_WEXP][((size_t)l * D + k) * 32 + (o - 4)];
        } else {
            const int q = it - 73, l = q >> 7, r = q & 127;
            const int m0 = (r >> 4) * 64, n0 = (r & 15) * 64, g = m0 >> 7;
            const float* PW = p->in[I_POOLW] + ((size_t)(l * 4 + g) * 128) * 128;
            const float* PS = p->in[I_POOLS] + l * 512 + g * 128;
            const float* WB = p->in[I_WBR] + ((size_t)(l * 3 + 2) * 512 + g * 128) * D;
            float acc[4][4]; zero_acc(acc);
            gemm64(acc, 128,
                   [&](int m, int k) { const float4 a = *(const float4*)(PW + (size_t)((m0 + m) & 127) * 128 + k); const float4 sc = *(const float4*)(PS + k);
                                       return make_float4(a.x * sc.x, a.y * sc.y, a.z * sc.z, a.w * sc.w); },
                   [&](int k, int n) { return *(const float4*)(WB + (size_t)k * D + n0 + n); }, sm, sm + 16 * 68, tid);
            const int ty = tid >> 4, tx = tid & 15;
            bf16* dst = wsm_bt(p, l, 2);
#pragma unroll
            for (int j = 0; j < 4; ++j) st_bf4(dst + (size_t)(n0 + tx * 4 + j) * 512 + m0 + ty * 4, acc[0][j], acc[1][j], acc[2][j], acc[3][j]);
        }
    }
}

__device__ void ph_norm1(KParams p, int l) {
    const int tid = tid_opaque(), lane = tid & 63, gw = blockIdx.x * 4 + (tid >> 6), ngw = gridDim.x * 4;
    bf16* H = (bf16*)(p->ws + WS_H);
    const float* g = p->in[I_N1G] + l * D;
    for (int r0 = gw * 2; r0 < NTOK; r0 += ngw * 2) {
        float4 v[2][4];
#pragma unroll
        for (int q = 0; q < 2; ++q) {
            const float* x = xrow(p, l, r0 + q);
#pragma unroll
            for (int j = 0; j < 4; ++j) v[q][j] = *(const float4*)(x + j * 256 + lane * 4);
        }
#pragma unroll
        for (int q = 0; q < 2; ++q) {
            const int r = r0 + q, mb = modrow(r);
            const float* sh = modv(p, l, mb, 0); const float* sc = modv(p, l, mb, 1);
            float ss = 0.f;
#pragma unroll
            for (int j = 0; j < 4; ++j) ss += v[q][j].x * v[q][j].x + v[q][j].y * v[q][j].y + v[q][j].z * v[q][j].z + v[q][j].w * v[q][j].w;
            const float inv = rsqrtf(wave_sum(ss) * (1.f / D) + EPS);
#pragma unroll
            for (int j = 0; j < 4; ++j) {
                const int c = j * 256 + lane * 4;
                const float4 gg = *(const float4*)(g + c), s1 = *(const float4*)(sh + c), s2 = *(const float4*)(sc + c);
                st_bf4(H + (size_t)r * D + c, v[q][j].x * inv * gg.x * (1.f + s2.x) + s1.x, v[q][j].y * inv * gg.y * (1.f + s2.y) + s1.y,
                       v[q][j].z * inv * gg.z * (1.f + s2.z) + s1.z, v[q][j].w * inv * gg.w * (1.f + s2.w) + s1.w);
            }
        }
    }
}

__device__ void ph_gemm_in(KParams p, int l, unsigned char* lds) {
    const bf16* H = (const bf16*)(p->ws + WS_H);
    bf16* PROJ = (bf16*)(p->ws + WS_PROJ);
    const bf16* WT = wsm_int(p, l);
    const float2* rope = (const float2*)(p->ws + WS_ROPE);
    const int nN = 47, nM = NTOK / 128;
    const int tid = tid_opaque(), lane = tid & 63, wid = tid >> 6, wr = wid >> 1, wc = wid & 1, fr = lane & 15, fq = lane >> 4;
    const TileQ tq{(unsigned*)(p->ws + WS_CTL) + CW_TQ + (l * 5 + 0) * 512, nM * nN};
    volatile int* slot = (volatile int*)(lds + LDS_TQ_OFF);
    auto issue = [&](int it_) { int tm_, tn_; tile_coords(it_, nM, nN, tm_, tn_);
        gemm_issue0([&](int r) { return H + (size_t)(tm_ * 128 + r) * D; }, [&](int r) { return WT + (size_t)(tn_ * 128 + r) * D; }, lds, tid); };
    __syncthreads();
    if (tid == 0) slot[0] = tq_next(tq);
    __syncthreads();
    int it = slot[0];
    if (it >= 0) issue(it);
    for (int n_ = 0; it >= 0; ++n_) {
        if (tid == 0) slot[(n_ + 1) & 1] = tq_next(tq);
        int tm, tn; tile_coords(it, nM, nN, tm, tn);
        f32x4 acc[4][4]; zero_acc4(acc);
        gemm_tile<true>(acc, [&](int r) { return H + (size_t)(tm * 128 + r) * D; }, [&](int r) { return WT + (size_t)(tn * 128 + r) * D; }, D, lds, tid,
                  [&]() { const int nx = slot[(n_ + 1) & 1]; if (nx >= 0) issue(nx); });
        it = slot[(n_ + 1) & 1];
        __syncthreads();
        if (tn >= 12 && tn <= 16) {
            const bool isq = tn < 16;
            const float* gsrc = p->in[isq ? I_QNG : I_KNG] + l * 64 + fq * 4;
            float4 g[4];
#pragma unroll
            for (int j = 0; j < 4; ++j) g[j] = *(const float4*)(gsrc + j * 16);
            const float qs = isq ? 0.125f * 1.4426950408889634f : 1.f;
#pragma unroll
            for (int i = 0; i < 4; ++i) {
                float ss = 0.f;
#pragma unroll
                for (int j = 0; j < 4; ++j) ss += acc[i][j][0] * acc[i][j][0] + acc[i][j][1] * acc[i][j][1] + acc[i][j][2] * acc[i][j][2] + acc[i][j][3] * acc[i][j][3];
                ss += __shfl_xor(ss, 16); ss += __shfl_xor(ss, 32);
                const float inv = rsqrtf(ss * (1.f / 64.f) + EPS);
                const int row = tm * 128 + wr * 64 + i * 16 + fr;
                f32x4 v[4];
#pragma unroll
                for (int j = 0; j < 4; ++j) { v[j][0] = acc[i][j][0] * inv * g[j].x; v[j][1] = acc[i][j][1] * inv * g[j].y; v[j][2] = acc[i][j][2] * inv * g[j].z; v[j][3] = acc[i][j][3] * inv * g[j].w; }
                if (row < NL) {
                    const int t = row & (T - 1), prow = t >> 6, pcol = t & 63;
#pragma unroll
                    for (int e = 0; e < 4; ++e) {
                        const float2 a = rope[prow * 16 + fq * 4 + e], b2 = rope[pcol * 16 + fq * 4 + e];
                        const float x1 = v[0][e], x2 = v[1][e], y1 = v[2][e], y2 = v[3][e];
                        v[0][e] = x1 * a.x - x2 * a.y; v[1][e] = x1 * a.y + x2 * a.x;
                        v[2][e] = y1 * b2.x - y2 * b2.y; v[3][e] = y1 * b2.y + y2 * b2.x;
                    }
                }
#pragma unroll
                for (int j = 0; j < 4; ++j)
                    stg_put<16>(lds, wr * 64 + i * 16 + fr, (wc * 64 + j * 16 + fq * 4) * 2, pk_bf16(v[j][0] * qs, v[j][1] * qs), pk_bf16(v[j][2] * qs, v[j][3] * qs));
            }
        } else {
#pragma unroll
            for (int i = 0; i < 4; ++i)
#pragma unroll
                for (int j = 0; j < 4; ++j)
                    stg_put<16>(lds, wr * 64 + i * 16 + fr, (wc * 64 + j * 16 + fq * 4) * 2, pk_bf16(acc[i][j][0], acc[i][j][1]), pk_bf16(acc[i][j][2], acc[i][j][3]));
        }
        __syncthreads();
        stg_flush<16>(lds, tid, [&](int row, int ch) -> bf16* { return (tn * 128 + ch * 8 < INW) ? PROJ + (size_t)(tm * 128 + row) * INW + tn * 128 + ch * 8 : nullptr; });
    }
}

__device__ void ph_prep(KParams p, int l, float* smf) {
    const int tid = tid_opaque();
    bf16* PROJ = (bf16*)(p->ws + WS_PROJ);
    {
        bf16* DP = (bf16*)(p->ws + WS_R2 + 2 * SZ_Y512);
        const int lane = tid & 63, gw = blockIdx.x * 4 + (tid >> 6), ngw = gridDim.x * 4;
        const int ch = lane * 8, hw = 1 << (lane >> 4);
        const int nrows = (l == 0) ? NTOK : NL;
        for (int r = gw; r < nrows; r += ngw) {
            int t, tl;
            if (r < NL) { t = r & (T - 1); tl = T; } else { t = (r - NL) & (CL - 1); tl = CL; }
            const bf16* src = PROJ + (size_t)r * INW + O_PU + ch;
            const int lo = max(t - hw, 0), hi = min(t + hw, tl);
            uint4 nb[16];
#pragma unroll
            for (int u = 0; u < 16; ++u) {
                const int tt = t - 8 + u;
                nb[u] = (tt >= lo && tt < hi) ? *(const uint4*)(src + (long)(u - 8) * INW) : make_uint4(0u, 0u, 0u, 0u);
            }
            float sacc[8] = {0.f, 0.f, 0.f, 0.f, 0.f, 0.f, 0.f, 0.f};
#pragma unroll
            for (int u = 0; u < 16; ++u) {
                const unsigned w[4] = {nb[u].x, nb[u].y, nb[u].z, nb[u].w};
#pragma unroll
                for (int q = 0; q < 4; ++q) { sacc[2 * q] += __uint_as_float(w[q] << 16); sacc[2 * q + 1] += __uint_as_float(w[q] & 0xffff0000u); }
            }
            const float inv = 1.f / (float)(hi - lo);
            const uint4 cc = nb[8];
            const unsigned cw[4] = {cc.x, cc.y, cc.z, cc.w};
            unsigned o[4];
#pragma unroll
            for (int q = 0; q < 4; ++q) o[q] = pk_bf16(sacc[2 * q] * inv - __uint_as_float(cw[q] << 16), sacc[2 * q + 1] * inv - __uint_as_float(cw[q] & 0xffff0000u));
            *(uint4*)(DP + (size_t)r * 512 + ch) = make_uint4(o[0], o[1], o[2], o[3]);
        }
    }
    {
        bf16* VT = (bf16*)(p->ws + WS_VT);
        unsigned short* st = (unsigned short*)smf;
        for (int it = blockIdx.x; it < (NTOK / 64) * 2; it += gridDim.x) {
            const int rt = it >> 1, kvh = it & 1;
            int b, key0;
            if (rt < NL / 64) { b = rt / 64; key0 = (rt % 64) * 64; } else { const int j = rt - NL / 64; b = j / 4; key0 = T + (j % 4) * 64; }
            __syncthreads();
            {
                const int k = tid >> 2, dq = (tid & 3) * 16;
                const bf16* src = PROJ + (size_t)(rt * 64 + k) * INW + O_AV + kvh * 64 + dq;
                const uint4 a = *(const uint4*)src, c = *(const uint4*)(src + 8);
                unsigned* d = (unsigned*)(st + k * 66 + dq);
                d[0] = a.x; d[1] = a.y; d[2] = a.z; d[3] = a.w; d[4] = c.x; d[5] = c.y; d[6] = c.z; d[7] = c.w;
            }
            __syncthreads();
            {
                const int d = tid >> 2, kq = (tid & 3) * 16;
                unsigned w[8];
#pragma unroll
                for (int i = 0; i < 8; ++i) w[i] = (unsigned)st[(kq + 2 * i) * 66 + d] | ((unsigned)st[(kq + 2 * i + 1) * 66 + d] << 16);
                bf16* dst = VT + ((size_t)(b * 2 + kvh) * 64 + d) * NKEY + key0 + kq;
                *(uint4*)dst = make_uint4(w[0], w[1], w[2], w[3]);
                *(uint4*)(dst + 8) = make_uint4(w[4], w[5], w[6], w[7]);
            }
        }
    }
}

typedef float f32x16 __attribute__((ext_vector_type(16)));
typedef short s16x4 __attribute__((ext_vector_type(4)));
#define MFMA32(a, b, c) __builtin_amdgcn_mfma_f32_32x32x16_bf16((a), (b), (c), 0, 0, 0)
__device__ __forceinline__ bf16x8 pack8(const f32x16& x, int s) {
    typedef unsigned u32x4_t __attribute__((ext_vector_type(4)));
    u32x4_t r;
    r[0] = pk_bf16(x[8 * s + 0], x[8 * s + 1]); r[1] = pk_bf16(x[8 * s + 2], x[8 * s + 3]);
    r[2] = pk_bf16(x[8 * s + 4], x[8 * s + 5]); r[3] = pk_bf16(x[8 * s + 6], x[8 * s + 7]);
    return __builtin_bit_cast(bf16x8, r);
}
__device__ __forceinline__ void attn_item(KParams p, int l, int it, unsigned char* lds, const int tid_) {
    const int tid = tid_opaque();
    const int lane = tid & 63, wid = tid >> 6, r32 = lane & 31, h = lane >> 5;
    bf16* PROJ = (bf16*)(p->ws + WS_PROJ);
    const bf16* VT = (const bf16*)(p->ws + WS_VT);
    float mq = 0.f, mk = 0.f;
    for (int d = 0; d < 64; ++d) { mq = fmaxf(mq, fabsf(p->in[I_QNG][l * 64 + d])); mk = fmaxf(mk, fabsf(p->in[I_KNG][l * 64 + d])); }
    const float shift2 = 8.f * mq * mk * 1.4426950408889634f;
    const int srow = tid >> 3, sc = ((tid & 7) ^ ((tid >> 4) & 7)) * 8, sw = (r32 >> 1) & 7;
    const int nlat = NB * 8 * 16;
    {
        int b, head, qrow0, nkt, vkey0;
        const bool lat = it < nlat;
        if (lat) { b = it >> 7; head = (it >> 4) & 7; qrow0 = b * T + (it & 15) * 256; nkt = 68; vkey0 = 0; }
        else { const int j = it - nlat; b = j >> 3; head = j & 7; qrow0 = NL + b * CL; nkt = 4; vkey0 = T; }
        const int kvh = head >> 2;
        bf16x8 qf[2][4];
#pragma unroll
        for (int qb = 0; qb < 2; ++qb)
#pragma unroll
            for (int ks = 0; ks < 4; ++ks)
                qf[qb][ks] = *(const bf16x8*)(PROJ + (size_t)(qrow0 + wid * 64 + qb * 32 + r32) * INW + O_AQ + head * 64 + ks * 16 + h * 8);
        const bf16* vsrc[2];
#pragma unroll
        for (int j = 0; j < 2; ++j) vsrc[j] = VT + ((size_t)(b * 2 + kvh) * 64 + j * 32 + srow) * NKEY + vkey0 + sc;
        const bf16* kbase = PROJ + O_AK + kvh * 64 + sc;
        auto krow = [&](int kt, int r) { return lat ? (kt < 64 ? b * T + kt * 64 + r : NL + b * CL + (kt - 64) * 64 + r) : NL + b * CL + kt * 64 + r; };
        auto stage = [&](int kt, int buf) {
            unsigned char* base = lds + buf * 16384;
#pragma unroll
            for (int j = 0; j < 2; ++j) {
                __builtin_amdgcn_global_load_lds((const unsigned*)(kbase + (size_t)krow(kt, j * 32 + srow) * INW), (unsigned*)(base + j * 4096 + tid * 16), 16, 0, 0);
                __builtin_amdgcn_global_load_lds((const unsigned*)(vsrc[j] + kt * 64), (unsigned*)(base + 8192 + j * 4096 + tid * 16), 16, 0, 0);
            }
        };
        f32x16 o[2][2];
#pragma unroll
        for (int a = 0; a < 2; ++a)
#pragma unroll
            for (int c = 0; c < 2; ++c)
#pragma unroll
                for (int e = 0; e < 16; ++e) o[a][c][e] = 0.f;
        f32x16 lacc0, lacc1;
#pragma unroll
        for (int e = 0; e < 16; ++e) { lacc0[e] = 0.f; lacc1[e] = 0.f; }
        bf16x8 ones;
#pragma unroll
        for (int e = 0; e < 8; ++e) ones[e] = (r32 == 0) ? (short)0x3f80 : (short)0;
        stage(0, 0);
#pragma unroll 1
        for (int kt = 0; kt < nkt; ++kt) {
            asm volatile("s_waitcnt vmcnt(0)" ::: "memory");
            __syncthreads();
            if (kt + 1 < nkt) stage(kt + 1, (kt + 1) & 1);
            const unsigned char* kb_ = lds + (kt & 1) * 16384;
            const unsigned char* vb_ = kb_ + 8192;
            bf16x8 kf[2][4];
#pragma unroll
            for (int kb = 0; kb < 2; ++kb)
#pragma unroll
                for (int ks = 0; ks < 4; ++ks) kf[kb][ks] = *(const bf16x8*)(kb_ + (kb * 32 + r32) * 128 + (((2 * ks + h) ^ sw) * 16));
            __builtin_amdgcn_sched_barrier(0);
#pragma unroll
            for (int kb = 0; kb < 2; ++kb) {
                f32x16 s0, s1;
#pragma unroll
                for (int e = 0; e < 16; ++e) { s0[e] = -shift2; s1[e] = -shift2; }
#pragma unroll
                for (int ks = 0; ks < 4; ++ks) {
                    s0 = MFMA32(kf[kb][ks], qf[0][ks], s0);
                    s1 = MFMA32(kf[kb][ks], qf[1][ks], s1);
                }
                bf16x8 vf[2][2];
#pragma unroll
                for (int s2 = 0; s2 < 2; ++s2)
#pragma unroll
                    for (int db = 0; db < 2; ++db) {
                        const int ksv = kb * 2 + s2;
                        const unsigned char* vr = vb_ + (db * 32 + r32) * 128 + 8 * h;
                        const s16x4 lo = *(const s16x4*)(vr + (((2 * ksv) ^ sw) * 16));
                        const s16x4 hi = *(const s16x4*)(vr + (((2 * ksv + 1) ^ sw) * 16));
                        vf[s2][db] = __builtin_shufflevector(lo, hi, 0, 1, 2, 3, 4, 5, 6, 7);
                    }
                __builtin_amdgcn_sched_barrier(0);
#pragma unroll
                for (int e = 0; e < 16; ++e) { s0[e] = __builtin_amdgcn_exp2f(s0[e]); s1[e] = __builtin_amdgcn_exp2f(s1[e]); }
#pragma unroll
                for (int s2 = 0; s2 < 2; ++s2) {
                    const bf16x8 p0 = pack8(s0, s2), p1 = pack8(s1, s2);
                    lacc0 = MFMA32(ones, p0, lacc0);
                    lacc1 = MFMA32(ones, p1, lacc1);
#pragma unroll
                    for (int db = 0; db < 2; ++db) {
                        o[db][0] = MFMA32(vf[s2][db], p0, o[db][0]);
                        o[db][1] = MFMA32(vf[s2][db], p1, o[db][1]);
                    }
                }
            }
        }
        float l0 = lacc0[0], l1 = lacc1[0];
        l0 = __shfl(l0, r32); l1 = __shfl(l1, r32);
        const float i0 = 1.f / l0, i1 = 1.f / l1;
#pragma unroll
        for (int qb = 0; qb < 2; ++qb) {
            const float inv = qb ? i1 : i0;
            bf16* orow = PROJ + (size_t)(qrow0 + wid * 64 + qb * 32 + r32) * INW + O_AQ + head * 64;
#pragma unroll
            for (int db = 0; db < 2; ++db)
#pragma unroll
                for (int g = 0; g < 4; ++g)
                    st_bf4(orow + db * 32 + 8 * g + 4 * h, o[db][qb][4 * g] * inv, o[db][qb][4 * g + 1] * inv, o[db][qb][4 * g + 2] * inv, o[db][qb][4 * g + 3] * inv);
        }
    }
}

constexpr int GL_QS = 0, GL_KS = 8192, GL_KDT = 16384, GL_VT = 24576, GL_GLS = 40960, GL_TOT = 45056, GL_FIRST = 47104,
              GL_RAWQ = 47872, GL_RAWK = 56064, GL_RAWV = 64256;
constexpr size_t WS_DST = WS_H;
constexpr size_t WS_EBL = WS_LIST;
__device__ __forceinline__ int swz(int row, int byte) { return row * 128 + ((((byte >> 4) ^ (row >> 1)) & 7) << 4) + (byte & 15); }
__device__ __forceinline__ int gla_chunk_base(int b, int c) { return c < 4 ? NL + b * CL + c * 64 : b * T + (c - 4) * 64; }

__device__ __forceinline__ void gla_local_item(KParams p, int l, int item, unsigned char* lds, const int tid_) {
    const int tid = tid_opaque();
    const int lane = tid & 63, w = tid >> 6, r32 = lane & 31, h = lane >> 5;
    const int hd = item & 3, c = (item >> 2) % 68, b = (item >> 2) / 68;
    bf16* PROJ = (bf16*)(p->ws + WS_PROJ);
    const int base = gla_chunk_base(b, c);
    const int dk2 = (tid & 31) * 2, seg = tid >> 5;
    const int dv2 = (tid & 63) * 2, vq = tid >> 6;
    __syncthreads();
    {
#pragma unroll
        for (int j = 0; j < 2; ++j) {
            const size_t tok = base + j * 32 + (tid >> 3);
            __builtin_amdgcn_global_load_lds((const unsigned*)(PROJ + tok * INW + O_GQ + hd * 64 + (tid & 7) * 8), (unsigned*)(lds + GL_RAWQ + j * 4096 + tid * 16), 16, 0, 0);
            __builtin_amdgcn_global_load_lds((const unsigned*)(PROJ + tok * INW + O_GK + hd * 64 + (tid & 7) * 8), (unsigned*)(lds + GL_RAWK + j * 4096 + tid * 16), 16, 0, 0);
        }
#pragma unroll
        for (int j = 0; j < 4; ++j) {
            const size_t tok = base + j * 16 + (tid >> 4);
            __builtin_amdgcn_global_load_lds((const unsigned*)(PROJ + tok * INW + O_GV + hd * 128 + (tid & 15) * 8), (unsigned*)(lds + GL_RAWV + j * 4096 + tid * 16), 16, 0, 0);
        }
        {
            const int t2 = tid & 127; const size_t tok = base + (t2 >> 1);
            __builtin_amdgcn_global_load_lds((const unsigned*)(PROJ + tok * INW + (tid < 128 ? O_GLF : O_GLB) + (t2 & 1) * 8), (unsigned*)(lds + GL_GLS + tid * 16), 16, 0, 0);
        }
    }
#pragma unroll 1
    for (int dir = 0; dir < 2; ++dir) {
        const float* up = p->in[dir ? I_UPB : I_UPF] + (size_t)l * 16 * 256 + hd * 64;
        const float2 bia = *(const float2*)(p->in[dir ? I_BIASB : I_BIASF] + l * 256 + hd * 64 + dk2);
        const int id2 = (((b * 68 + c) * 4 + hd) << 1) + dir;
        asm volatile("s_waitcnt vmcnt(0)" ::: "memory");
        __syncthreads();
        float la0[8], la1[8];
        {
            float up0[16], up1[16];
#pragma unroll
            for (int j = 0; j < 16; ++j) { const float2 t = *(const float2*)(up + j * 256 + dk2); up0[j] = t.x; up1[j] = t.y; }
            const unsigned char* gls = lds + GL_GLS + dir * 2048;
#pragma unroll
            for (int u = 0; u < 8; ++u) {
                const int i = seg * 8 + u, ti = dir ? 63 - i : i;
                const uint4 g0 = *(const uint4*)(gls + ti * 32), g1 = *(const uint4*)(gls + ti * 32 + 16);
                const unsigned gw[8] = {g0.x, g0.y, g0.z, g0.w, g1.x, g1.y, g1.z, g1.w};
                float a0 = bia.x, a1 = bia.y;
#pragma unroll
                for (int j = 0; j < 8; ++j) {
                    const float glo = __uint_as_float(gw[j] << 16), ghi = __uint_as_float(gw[j] & 0xffff0000u);
                    a0 += glo * up0[2 * j]; a1 += glo * up1[2 * j];
                    a0 += ghi * up0[2 * j + 1]; a1 += ghi * up1[2 * j + 1];
                }
                la0[u] = (fminf(a0, 0.f) - __logf(1.f + __expf(-fabsf(a0)))) * (1.f / 16.f);
                la1[u] = (fminf(a1, 0.f) - __logf(1.f + __expf(-fabsf(a1)))) * (1.f / 16.f);
            }
#pragma unroll
            for (int u = 1; u < 8; ++u) { la0[u] += la0[u - 1]; la1[u] += la1[u - 1]; }
            *(float2*)(lds + GL_TOT + (seg * 64 + dk2) * 4) = make_float2(la0[7], la1[7]);
            if (seg == 4) *(float2*)(lds + GL_FIRST + dk2 * 4) = make_float2(la0[0], la1[0]);
        }
        __syncthreads();
        {
            float off0 = 0.f, off1 = 0.f, pre0 = 0.f, pre1 = 0.f, all0 = 0.f, all1 = 0.f;
#pragma unroll
            for (int sg = 0; sg < 8; ++sg) {
                const float2 t = *(const float2*)(lds + GL_TOT + (sg * 64 + dk2) * 4);
                if (sg < seg) { off0 += t.x; off1 += t.y; }
                if (sg < 4) { pre0 += t.x; pre1 += t.y; }
                all0 += t.x; all1 += t.y;
            }
            const float2 f4 = *(const float2*)(lds + GL_FIRST + dk2 * 4);
            const float bref0 = pre0 + f4.x, bref1 = pre1 + f4.y;
            const float c0 = __expf(all0 - bref0), c1 = __expf(all1 - bref1);
            const float er0 = __expf(bref0), er1 = __expf(bref1);
            bf16* qdst = PROJ + (size_t)base * INW + (dir ? O_GK : O_GQ) + hd * 64 + dk2;
            unsigned kd0[4], kd1[4];
#pragma unroll
            for (int u = 0; u < 8; u += 2) {
                float kdv[2][2];
#pragma unroll
                for (int uu = 0; uu < 2; ++uu) {
                    const int i = seg * 8 + u + uu, ti = dir ? 63 - i : i;
                    const float e0 = __expf(off0 + la0[u + uu] - bref0), e1 = __expf(off1 + la1[u + uu] - bref1);
                    const float r0 = __builtin_amdgcn_rcpf(e0), r1 = __builtin_amdgcn_rcpf(e1);
                    const unsigned rqv = *(const unsigned*)(lds + GL_RAWQ + ti * 128 + dk2 * 2), rkv = *(const unsigned*)(lds + GL_RAWK + ti * 128 + dk2 * 2);
                    const float q0 = __uint_as_float(rqv << 16) * 0.125f * e0, q1 = __uint_as_float(rqv & 0xffff0000u) * 0.125f * e1;
                    const float k0 = __uint_as_float(rkv << 16), k1 = __uint_as_float(rkv & 0xffff0000u);
                    const float ks0 = k0 * r0, ks1 = k1 * r1;
                    *(unsigned*)(lds + GL_QS + swz(i, dk2 * 2)) = pk_bf16(q0, q1);
                    *(unsigned*)(lds + GL_KS + swz(i, dk2 * 2)) = pk_bf16(ks0, ks1);
                    *(unsigned*)(qdst + (size_t)ti * INW) = pk_bf16(q0 * er0, q1 * er1);
                    kdv[uu][0] = ks0 * c0; kdv[uu][1] = ks1 * c1;
                }
                kd0[u >> 1] = pk_bf16(kdv[0][0], kdv[1][0]); kd1[u >> 1] = pk_bf16(kdv[0][1], kdv[1][1]);
            }
            *(uint4*)(lds + GL_KDT + swz(dk2, seg * 16)) = make_uint4(kd0[0], kd0[1], kd0[2], kd0[3]);
            *(uint4*)(lds + GL_KDT + swz(dk2 + 1, seg * 16)) = make_uint4(kd1[0], kd1[1], kd1[2], kd1[3]);
            unsigned va[8], vb[8], rv[16];
#pragma unroll
            for (int u = 0; u < 16; ++u) { const int i = vq * 16 + u, ti = dir ? 63 - i : i; rv[u] = *(const unsigned*)(lds + GL_RAWV + ti * 256 + dv2 * 2); }
#pragma unroll
            for (int m = 0; m < 8; ++m) { va[m] = (rv[2 * m] & 0xffffu) | (rv[2 * m + 1] << 16); vb[m] = (rv[2 * m] >> 16) | (rv[2 * m + 1] & 0xffff0000u); }
            *(uint4*)(lds + GL_VT + swz(dv2, vq * 32)) = make_uint4(va[0], va[1], va[2], va[3]);
            *(uint4*)(lds + GL_VT + swz(dv2, vq * 32 + 16)) = make_uint4(va[4], va[5], va[6], va[7]);
            *(uint4*)(lds + GL_VT + swz(dv2 + 1, vq * 32)) = make_uint4(vb[0], vb[1], vb[2], vb[3]);
            *(uint4*)(lds + GL_VT + swz(dv2 + 1, vq * 32 + 16)) = make_uint4(vb[4], vb[5], vb[6], vb[7]);
            if (seg == 0) *(float2*)((float*)(p->ws + WS_EBL) + (size_t)id2 * 64 + dk2) = make_float2(__expf(all0), __expf(all1));
        }
        __syncthreads();
        {
            const unsigned char* QS = lds + GL_QS; const unsigned char* KS = lds + GL_KS; const unsigned char* KDT = lds + GL_KDT; const unsigned char* VTL = lds + GL_VT;
            f32x16 ot[2];
#pragma unroll
            for (int e = 0; e < 16; ++e) { ot[0][e] = 0.f; ot[1][e] = 0.f; }
#pragma unroll
            for (int tI = 0; tI < 3; ++tI) {
                const int sb = tI == 2 ? 1 : 0, ib = tI == 0 ? 0 : 1;
                f32x16 pt;
#pragma unroll
                for (int e = 0; e < 16; ++e) pt[e] = 0.f;
#pragma unroll
                for (int ks = 0; ks < 4; ++ks) {
                    const bf16x8 kf = *(const bf16x8*)(KS + swz(32 * sb + r32, (2 * ks + h) * 16));
                    const bf16x8 qf = *(const bf16x8*)(QS + swz(32 * ib + r32, (2 * ks + h) * 16));
                    pt = MFMA32(kf, qf, pt);
                }
                if (sb == ib) {
#pragma unroll
                    for (int e = 0; e < 16; ++e) { const int sl = (e & 3) + 8 * (e >> 2) + 4 * h; if (sl > r32) pt[e] = 0.f; }
                }
#pragma unroll
                for (int s2 = 0; s2 < 2; ++s2) {
                    const int ksv = 2 * sb + s2, row = 32 * w + r32;
                    const s16x4 lo = *(const s16x4*)(VTL + swz(row, 32 * ksv + 8 * h));
                    const s16x4 hi = *(const s16x4*)(VTL + swz(row, 32 * ksv + 16 + 8 * h));
                    const bf16x8 vp = __builtin_shufflevector(lo, hi, 0, 1, 2, 3, 4, 5, 6, 7);
                    ot[ib] = MFMA32(vp, pack8(pt, s2), ot[ib]);
                }
            }
            bf16* OG = (bf16*)(p->ws + WS_R2 + (size_t)dir * SZ_Y512);
#pragma unroll
            for (int ib = 0; ib < 2; ++ib) {
                const int i = 32 * ib + r32; const size_t tok = base + (dir ? 63 - i : i);
                bf16* dst = OG + tok * 512 + hd * 128 + 32 * w + 4 * h;
#pragma unroll
                for (int g = 0; g < 4; ++g) st_bf4(dst + 8 * g, ot[ib][4 * g], ot[ib][4 * g + 1], ot[ib][4 * g + 2], ot[ib][4 * g + 3]);
            }
            f32x16 dS[2];
#pragma unroll
            for (int e = 0; e < 16; ++e) { dS[0][e] = 0.f; dS[1][e] = 0.f; }
#pragma unroll
            for (int ks = 0; ks < 4; ++ks) {
                const bf16x8 vn = *(const bf16x8*)(VTL + swz(32 * w + r32, (2 * ks + h) * 16));
#pragma unroll
                for (int dkb = 0; dkb < 2; ++dkb) {
                    const bf16x8 kd = *(const bf16x8*)(KDT + swz(32 * dkb + r32, (2 * ks + h) * 16));
                    dS[dkb] = MFMA32(kd, vn, dS[dkb]);
                }
            }
            bf16* dd = (bf16*)(p->ws + WS_DST) + (((size_t)id2 * 4 + w) * 64 + lane) * 32;
#pragma unroll
            for (int dkb = 0; dkb < 2; ++dkb)
#pragma unroll
                for (int g = 0; g < 2; ++g)
                    *(uint4*)(dd + dkb * 16 + g * 8) = make_uint4(pk_bf16(dS[dkb][8 * g], dS[dkb][8 * g + 1]), pk_bf16(dS[dkb][8 * g + 2], dS[dkb][8 * g + 3]),
                                                                  pk_bf16(dS[dkb][8 * g + 4], dS[dkb][8 * g + 5]), pk_bf16(dS[dkb][8 * g + 6], dS[dkb][8 * g + 7]));
        }
    }
}

__device__ __forceinline__ void gla_chain(KParams p, int l, int task, unsigned char* lds, const int tid_) {
    const int tid = tid_opaque();
    const int lane = tid & 63, w = tid >> 6, h = lane >> 5;
    const int b = task >> 3, hd = (task >> 1) & 3, dir = task & 1;
    bf16* DST = (bf16*)(p->ws + WS_DST);
    const float* EBL = (const float*)(p->ws + WS_EBL);
    f32x16 S[2];
#pragma unroll
    for (int e = 0; e < 16; ++e) { S[0][e] = 0.f; S[1][e] = 0.f; }
    auto id2_of = [&](int n) { const int c = n < 4 ? (dir ? 3 - n : n) : 4 + (dir ? 63 - (n - 4) : (n - 4)); return (size_t)((((b * 68 + c) * 4 + hd) << 1) + dir); };
    typedef unsigned u32x4_t __attribute__((ext_vector_type(4)));
    u32x4_t d0[4], d1[4], d2[4], d3[4];
    auto load_ds = [&](u32x4_t (&d)[4], int n) {
        const bf16* dd = DST + ((id2_of(n) * 4 + w) * 64 + lane) * 32;
#pragma unroll
        for (int q = 0; q < 4; ++q) d[q] = *(const u32x4_t*)(dd + q * 8);
    };
    load_ds(d0, 0); load_ds(d1, 1); load_ds(d2, 2); load_ds(d3, 3);
    __syncthreads();
    for (int n = w; n < 68; n += 4)
        __builtin_amdgcn_global_load_lds((const unsigned*)(EBL + id2_of(n) * 64 + lane), (unsigned*)(lds + n * 256 + lane * 4), 4, 0, 0);
    asm volatile("s_waitcnt vmcnt(0)" ::: "memory");
    __syncthreads();
    auto step = [&](u32x4_t (&d)[4], int n) {
        const size_t id2 = id2_of(n);
        float4 eb[2][4];
#pragma unroll
        for (int dkb = 0; dkb < 2; ++dkb)
#pragma unroll
            for (int g = 0; g < 4; ++g) eb[dkb][g] = *(const float4*)(lds + n * 256 + (32 * dkb + 8 * g + 4 * h) * 4);
        bf16* dd = DST + ((id2 * 4 + w) * 64 + lane) * 32;
#pragma unroll
        for (int dkb = 0; dkb < 2; ++dkb)
#pragma unroll
            for (int s2 = 0; s2 < 2; ++s2) *(bf16x8*)(dd + (dkb * 2 + s2) * 8) = pack8(S[dkb], s2);
        const unsigned dw[16] = {d[0][0], d[0][1], d[0][2], d[0][3], d[1][0], d[1][1], d[1][2], d[1][3], d[2][0], d[2][1], d[2][2], d[2][3], d[3][0], d[3][1], d[3][2], d[3][3]};
#pragma unroll
        for (int dkb = 0; dkb < 2; ++dkb)
#pragma unroll
            for (int g = 0; g < 4; ++g) {
                const float4 e = eb[dkb][g];
                const unsigned w0 = dw[dkb * 8 + g * 2], w1 = dw[dkb * 8 + g * 2 + 1];
                S[dkb][4 * g]     = S[dkb][4 * g] * e.x     + __uint_as_float(w0 << 16);
                S[dkb][4 * g + 1] = S[dkb][4 * g + 1] * e.y + __uint_as_float(w0 & 0xffff0000u);
                S[dkb][4 * g + 2] = S[dkb][4 * g + 2] * e.z + __uint_as_float(w1 << 16);
                S[dkb][4 * g + 3] = S[dkb][4 * g + 3] * e.w + __uint_as_float(w1 & 0xffff0000u);
            }
        if (n + 4 < 68) load_ds(d, n + 4);
    };
#pragma unroll 1
    for (int n = 0; n < 68; n += 4) { step(d0, n); step(d1, n + 1); step(d2, n + 2); step(d3, n + 3); }
}

__device__ __forceinline__ void gla_out_item(KParams p, int l, int item, unsigned char* lds, const int tid_) {
    const int tid = tid_opaque();
    const int lane = tid & 63, w = tid >> 6, r32 = lane & 31, h = lane >> 5;
    const int hd = item & 3, c = (item >> 2) % 68, b = (item >> 2) / 68;
    const bf16* PROJ = (const bf16*)(p->ws + WS_PROJ);
    const bf16* DST = (const bf16*)(p->ws + WS_DST);
    const int base = gla_chunk_base(b, c);
    f32x16 ot[2];
#pragma unroll
    for (int e = 0; e < 16; ++e) { ot[0][e] = 0.f; ot[1][e] = 0.f; }
    uint2 og[2][2][4];
#pragma unroll
    for (int dir = 0; dir < 2; ++dir) {
        const bf16* OG = (const bf16*)(p->ws + WS_R2 + (size_t)dir * SZ_Y512);
#pragma unroll
        for (int ib = 0; ib < 2; ++ib)
#pragma unroll
            for (int g = 0; g < 4; ++g) og[dir][ib][g] = *(const uint2*)(OG + (size_t)(base + 32 * ib + r32) * 512 + hd * 128 + 32 * w + 4 * h + 8 * g);
    }
    uint2 grv[2][4];
#pragma unroll
    for (int ib = 0; ib < 2; ++ib)
#pragma unroll
        for (int g = 0; g < 4; ++g) grv[ib][g] = *(const uint2*)(PROJ + (size_t)(base + 32 * ib + r32) * INW + O_GR + hd * 128 + 32 * w + 4 * h + 8 * g);
#pragma unroll
    for (int dir = 0; dir < 2; ++dir) {
        const size_t id2 = (size_t)((((b * 68 + c) * 4 + hd) << 1) + dir);
        const bf16* dd = DST + ((id2 * 4 + w) * 64 + lane) * 32;
        bf16x8 sp[4];
#pragma unroll
        for (int q = 0; q < 4; ++q) sp[q] = *(const bf16x8*)(dd + q * 8);
        const int qcol = (dir ? O_GK : O_GQ) + hd * 64 + 4 * h;
#pragma unroll
        for (int ib = 0; ib < 2; ++ib) {
            const bf16* row = PROJ + (size_t)(base + 32 * ib + r32) * INW + qcol;
#pragma unroll
            for (int ksv = 0; ksv < 4; ++ksv) {
                const s16x4 lo = *(const s16x4*)(row + 16 * ksv), hi = *(const s16x4*)(row + 16 * ksv + 8);
                const bf16x8 qp = __builtin_shufflevector(lo, hi, 0, 1, 2, 3, 4, 5, 6, 7);
                ot[ib] = MFMA32(sp[ksv], qp, ot[ib]);
            }
        }
    }
    float ssq[2];
#pragma unroll
    for (int ib = 0; ib < 2; ++ib) {
        float a = 0.f;
#pragma unroll
        for (int g = 0; g < 4; ++g) {
            const uint2 x0 = og[0][ib][g], x1 = og[1][ib][g];
            ot[ib][4 * g]     += __uint_as_float(x0.x << 16) + __uint_as_float(x1.x << 16);
            ot[ib][4 * g + 1] += __uint_as_float(x0.x & 0xffff0000u) + __uint_as_float(x1.x & 0xffff0000u);
            ot[ib][4 * g + 2] += __uint_as_float(x0.y << 16) + __uint_as_float(x1.y << 16);
            ot[ib][4 * g + 3] += __uint_as_float(x0.y & 0xffff0000u) + __uint_as_float(x1.y & 0xffff0000u);
            a += ot[ib][4 * g] * ot[ib][4 * g] + ot[ib][4 * g + 1] * ot[ib][4 * g + 1] + ot[ib][4 * g + 2] * ot[ib][4 * g + 2] + ot[ib][4 * g + 3] * ot[ib][4 * g + 3];
        }
        a += __shfl_xor(a, 32);
        ssq[ib] = a;
    }
    float* red = (float*)lds;
    __syncthreads();
    if (h == 0) { red[w * 64 + r32] = ssq[0]; red[w * 64 + 32 + r32] = ssq[1]; }
    __syncthreads();
    const float* gn = p->in[I_GLANG] + l * 128 + 32 * w + 4 * h;
    bf16* YG = (bf16*)(p->ws + WS_R2);
#pragma unroll
    for (int ib = 0; ib < 2; ++ib) {
        const int t = 32 * ib + r32;
        const float inv = rsqrtf((red[t] + red[64 + t] + red[128 + t] + red[192 + t]) * (1.f / 128.f) + EPS);
        bf16* dst = YG + (size_t)(base + t) * 512 + hd * 128 + 32 * w + 4 * h;
#pragma unroll
        for (int g = 0; g < 4; ++g) {
            const float4 gg = *(const float4*)(gn + 8 * g);
            const float r0 = __uint_as_float(grv[ib][g].x << 16), r1 = __uint_as_float(grv[ib][g].x & 0xffff0000u), r2 = __uint_as_float(grv[ib][g].y << 16), r3 = __uint_as_float(grv[ib][g].y & 0xffff0000u);
            st_bf4(dst + 8 * g, ot[ib][4 * g] * inv * gg.x * silu_f(r0), ot[ib][4 * g + 1] * inv * gg.y * silu_f(r1), ot[ib][4 * g + 2] * inv * gg.z * silu_f(r2), ot[ib][4 * g + 3] * inv * gg.w * silu_f(r3));
        }
    }
}
__device__ void ph_gla_out(KParams p, int l, unsigned char* lds) {
    const int tid = tid_opaque();
    const int nchunk = (l == 0) ? 68 : 64;
    for (int it = blockIdx.x; it < NB * nchunk * 4; it += gridDim.x) {
        const int hd = it & 3, q = it >> 2, bb = q / nchunk, cc = q % nchunk + (68 - nchunk);
        gla_out_item(p, l, ((bb * 68 + cc) << 2) + hd, lds, tid);
    }
}

__device__ void ph_gla_local(KParams p, int l, unsigned char* lds) {
    const int tid = tid_opaque();
    for (int it = blockIdx.x; it < NB * 68 * 4; it += gridDim.x) gla_local_item(p, l, it, lds, tid);
    __syncthreads();
}

constexpr int CW_WORK = 64;
constexpr int LDS_ITEM_OFF = 79 * 1024;
__device__ void ph_mix(KParams p, int l, unsigned char* lds) {
    const int tid = tid_opaque();
    unsigned* ctr = (unsigned*)(p->ws + WS_CTL) + CW_WORK + l;
    volatile int* slot = (volatile int*)(lds + LDS_ITEM_OFF);
    const int nitems = 64 + NB * 8 * 16 + ((l == 0) ? NB * 8 : 0);
    for (;;) {
        __syncthreads();
        if (tid == 0) *slot = (int)__hip_atomic_fetch_add(ctr, 1u, __ATOMIC_RELAXED, __HIP_MEMORY_SCOPE_AGENT);
        __syncthreads();
        const int it = *slot;
        if (it >= nitems) break;
        if (it < 64) gla_chain(p, l, it, lds, tid);
        else attn_item(p, l, it - 64, lds, tid);
    }
}

__device__ void ph_ygla(KParams p, int l) {
    const int tid = tid_opaque(), lane = tid & 63, gw = blockIdx.x * 4 + (tid >> 6), ngw = gridDim.x * 4;
    bf16* O0 = (bf16*)(p->ws + WS_R2);
    const bf16* O1 = (const bf16*)(p->ws + WS_R2 + SZ_Y512);
    const bf16* PROJ = (const bf16*)(p->ws + WS_PROJ);
    const int nrows = (l == 0) ? NTOK : NL;
    const int c = lane * 8;
    const float4 g0 = *(const float4*)(p->in[I_GLANG] + l * 128 + (c & 127)), g1 = *(const float4*)(p->in[I_GLANG] + l * 128 + (c & 127) + 4);
    const float g[8] = {g0.x, g0.y, g0.z, g0.w, g1.x, g1.y, g1.z, g1.w};
    for (int r0 = gw * 4; r0 < nrows; r0 += ngw * 4) {
        uint4 a[4], b[4], gr[4];
#pragma unroll
        for (int q = 0; q < 4; ++q) {
            a[q] = *(const uint4*)(O0 + (size_t)(r0 + q) * 512 + c); b[q] = *(const uint4*)(O1 + (size_t)(r0 + q) * 512 + c);
            gr[q] = *(const uint4*)(PROJ + (size_t)(r0 + q) * INW + O_GR + c);
        }
#pragma unroll
        for (int q = 0; q < 4; ++q) {
            const unsigned aw[4] = {a[q].x, a[q].y, a[q].z, a[q].w}, bw[4] = {b[q].x, b[q].y, b[q].z, b[q].w}, gw_[4] = {gr[q].x, gr[q].y, gr[q].z, gr[q].w};
            float v[8], grf[8];
#pragma unroll
            for (int e = 0; e < 4; ++e) {
                v[2 * e] = __uint_as_float(aw[e] << 16) + __uint_as_float(bw[e] << 16);
                v[2 * e + 1] = __uint_as_float(aw[e] & 0xffff0000u) + __uint_as_float(bw[e] & 0xffff0000u);
                grf[2 * e] = __uint_as_float(gw_[e] << 16); grf[2 * e + 1] = __uint_as_float(gw_[e] & 0xffff0000u);
            }
            float ss = 0.f;
#pragma unroll
            for (int e = 0; e < 8; ++e) ss += v[e] * v[e];
            ss += __shfl_xor(ss, 1); ss += __shfl_xor(ss, 2); ss += __shfl_xor(ss, 4); ss += __shfl_xor(ss, 8);
            const float inv = rsqrtf(ss * (1.f / 128.f) + EPS);
            unsigned o[4];
#pragma unroll
            for (int e = 0; e < 4; ++e) o[e] = pk_bf16(v[2 * e] * inv * g[2 * e] * silu_f(grf[2 * e]), v[2 * e + 1] * inv * g[2 * e + 1] * silu_f(grf[2 * e + 1]));
            *(uint4*)(O0 + (size_t)(r0 + q) * 512 + c) = make_uint4(o[0], o[1], o[2], o[3]);
        }
    }
}

__device__ void ph_merge(KParams p, int l, unsigned char* lds) {
    const bf16* PROJ = (const bf16*)(p->ws + WS_PROJ);
    const bf16* YG = (const bf16*)(p->ws + WS_R2);
    const bf16* DP = (const bf16*)(p->ws + WS_R2 + 2 * SZ_Y512);
    bf16* Z = (bf16*)(p->ws + WS_H);
    const int nrows = (l == 0) ? NTOK : NL, nM = nrows / 128, nN = 8, G = gridDim.x;
    const int tid = tid_opaque(), lane = tid & 63, wid = tid >> 6, wr = wid >> 1, wc = wid & 1, fr = lane & 15, fq = lane >> 4;
    const bf16* WT0 = wsm_bt(p, l, 0);
    auto issue = [&](int it_, int br_) {
        int tm_, tn_; tile_coords(it_, nM, nN, tm_, tn_);
        const bf16* Ab_ = br_ == 0 ? YG : (br_ == 1 ? PROJ + O_AQ : DP);
        const size_t lda_ = br_ == 1 ? (size_t)INW : (size_t)512;
        const bf16* W_ = WT0 + (size_t)br_ * (SZ_WBT / 2);
        gemm_issue0([&](int r) { return Ab_ + (size_t)(tm_ * 128 + r) * lda_; }, [&](int r) { return W_ + (size_t)(tn_ * 128 + r) * 512; }, lds, tid);
    };
    const TileQ tq{(unsigned*)(p->ws + WS_CTL) + CW_TQ + (l * 5 + 1) * 512, nM * nN};
    volatile int* slot = (volatile int*)(lds + LDS_TQ_OFF);
    __syncthreads();
    if (tid == 0) slot[0] = tq_next(tq);
    __syncthreads();
    int it = slot[0];
    if (it >= 0) issue(it, 0);
    for (int n_ = 0; it >= 0; ++n_) {
        if (tid == 0) slot[(n_ + 1) & 1] = tq_next(tq);
        int tm, tn; tile_coords(it, nM, nN, tm, tn);
        f32x4 acc[4][4]; zero_acc4(acc);
        uint2 ga[4][4], gb[4][4];
        const bf16* gbase = PROJ + (size_t)(tm * 128 + wr * 64 + fr) * INW + O_GT + tn * 128 + wc * 64 + fq * 4;
#pragma unroll
        for (int i = 0; i < 4; ++i)
#pragma unroll
            for (int j = 0; j < 4; ++j) ga[i][j] = *(const uint2*)(gbase + (size_t)i * 16 * INW + j * 16);
#pragma unroll 1
        for (int br = 0; br < 3; ++br) {
            const bf16* WT = WT0 + (size_t)br * (SZ_WBT / 2);
            const bf16* Ab = br == 0 ? YG : (br == 1 ? PROJ + O_AQ : DP);
            const size_t lda = br == 1 ? (size_t)INW : (size_t)512;
            if (br < 2) {
#pragma unroll
                for (int i = 0; i < 4; ++i)
#pragma unroll
                    for (int j = 0; j < 4; ++j) gb[i][j] = *(const uint2*)(gbase + (size_t)i * 16 * INW + (br + 1) * D + j * 16);
            }
            gemm_tile<true>(acc, [&](int r) { return Ab + (size_t)(tm * 128 + r) * lda; }, [&](int r) { return WT + (size_t)(tn * 128 + r) * 512; }, 512, lds, tid,
                      [&]() { if (br < 2) issue(it, br + 1); else { const int nx = slot[(n_ + 1) & 1]; if (nx >= 0) issue(nx, 0); } });
#pragma unroll
            for (int i = 0; i < 4; ++i)
#pragma unroll
                for (int j = 0; j < 4; ++j) {
                    const float a0 = __uint_as_float(ga[i][j].x << 16), a1 = __uint_as_float(ga[i][j].x & 0xffff0000u), a2 = __uint_as_float(ga[i][j].y << 16), a3 = __uint_as_float(ga[i][j].y & 0xffff0000u);
                    float r0 = sigmoid_f(a0), r1 = sigmoid_f(a1), r2 = sigmoid_f(a2), r3 = sigmoid_f(a3);
                    if (br < 2) {
                        const float b0 = __uint_as_float(gb[i][j].x << 16), b1 = __uint_as_float(gb[i][j].x & 0xffff0000u), b2 = __uint_as_float(gb[i][j].y << 16), b3 = __uint_as_float(gb[i][j].y & 0xffff0000u);
                        r0 *= 1.f + __expf(-b0); r1 *= 1.f + __expf(-b1); r2 *= 1.f + __expf(-b2); r3 *= 1.f + __expf(-b3);
                    }
                    acc[i][j][0] *= r0; acc[i][j][1] *= r1; acc[i][j][2] *= r2; acc[i][j][3] *= r3;
                    ga[i][j] = gb[i][j];
                }
        }
#pragma unroll
        for (int i = 0; i < 4; ++i)
#pragma unroll
            for (int j = 0; j < 4; ++j) {
                const int row = tm * 128 + wr * 64 + i * 16 + fr, col = tn * 128 + wc * 64 + j * 16 + fq * 4;
                st_bf4(Z + (size_t)row * D + col, acc[i][j][0], acc[i][j][1], acc[i][j][2], acc[i][j][3]);
            }
        it = slot[(n_ + 1) & 1];
    }
}

__device__ void ph_outproj(KParams p, int l, unsigned char* lds) {
    const bf16* Z = (const bf16*)(p->ws + WS_H);
    const bf16* WT = wsm_outt(p, l);
    const int nrows = (l == 0) ? NTOK : NL, nM = nrows / 128, nN = 8, G = gridDim.x;
    const int tid = tid_opaque(), lane = tid & 63, wid = tid >> 6, wr = wid >> 1, wc = wid & 1, fr = lane & 15, fq = lane >> 4;
    auto issue = [&](int it_) { int tm_, tn_; tile_coords(it_, nM, nN, tm_, tn_);
        gemm_issue0([&](int r) { return Z + (size_t)(tm_ * 128 + r) * D; }, [&](int r) { return WT + (size_t)(tn_ * 128 + r) * D; }, lds, tid); };
    const TileQ tq{(unsigned*)(p->ws + WS_CTL) + CW_TQ + (l * 5 + 2) * 512, nM * nN};
    volatile int* slot = (volatile int*)(lds + LDS_TQ_OFF);
    __syncthreads();
    if (tid == 0) slot[0] = tq_next(tq);
    __syncthreads();
    int it = slot[0];
    if (it >= 0) issue(it);
    for (int n_ = 0; it >= 0; ++n_) {
        if (tid == 0) slot[(n_ + 1) & 1] = tq_next(tq);
        int tm, tn; tile_coords(it, nM, nN, tm, tn);
        float4 xo[4][4];
#pragma unroll
        for (int i = 0; i < 4; ++i) {
            const float* xr = xrow(p, l, tm * 128 + wr * 64 + i * 16 + fr);
#pragma unroll
            for (int j = 0; j < 4; ++j) xo[i][j] = *(const float4*)(xr + tn * 128 + wc * 64 + j * 16 + fq * 4);
        }
        f32x4 acc[4][4]; zero_acc4(acc);
        gemm_tile<true>(acc, [&](int r) { return Z + (size_t)(tm * 128 + r) * D; }, [&](int r) { return WT + (size_t)(tn * 128 + r) * D; }, D, lds, tid,
                  [&]() { const int nx = slot[(n_ + 1) & 1]; if (nx >= 0) issue(nx); });
#pragma unroll
        for (int i = 0; i < 4; ++i) {
            const int r = tm * 128 + wr * 64 + i * 16 + fr;
            const float* g1 = modv(p, l, modrow(r), 2);
            float* dr = r < NL ? p->out + (size_t)r * D : (float*)(p->ws + WS_XC) + (size_t)(r - NL) * D;
#pragma unroll
            for (int j = 0; j < 4; ++j) {
                const int c = tn * 128 + wc * 64 + j * 16 + fq * 4;
                const float4 gg = *(const float4*)(g1 + c);
                *(float4*)(dr + c) = make_float4(xo[i][j].x + gg.x * acc[i][j][0], xo[i][j].y + gg.y * acc[i][j][1], xo[i][j].z + gg.z * acc[i][j][2], xo[i][j].w + gg.w * acc[i][j][3]);
            }
        }
        it = slot[(n_ + 1) & 1];
    }
}

__device__ __forceinline__ const float* x1row(KParams p, int r) {
    return r < NL ? p->out + (size_t)r * D : (const float*)(p->ws + WS_XC) + (size_t)(r - NL) * D;
}
__device__ void ph_router(KParams p, int l, unsigned char* lds) {
    const int tid = tid_opaque(), lane = tid & 63, wid = tid >> 6;
    bf16* H = (bf16*)(p->ws + WS_H);
    const float* g = p->in[I_N2G] + l * D;
    const float* wt_ = (const float*)(p->ws + WS_RWT) + (size_t)l * 36 * D;
    unsigned* cnt = (unsigned*)(p->ws + WS_CTL) + CNT_BASE + l * 32 * CNT_STRIDE;
    int* list = (int*)(p->ws + WS_LIST);
    float* wt = (float*)(p->ws + WS_WT);
    const int nrows = (l == 0) ? NTOK : NL, ngrp = nrows / 16;
    float* LG = (float*)(lds + 65536) + wid * 4 * 40;
    const int myidx = (int)(__builtin_bitreverse32((unsigned)(lane & 31)) >> 27);
    auto issue_chunk = [&](int c, int buf) {
#pragma unroll
        for (int j = 0; j < 8; ++j)
            __builtin_amdgcn_global_load_lds((const unsigned*)(wt_ + (size_t)c * 8 * D + j * 1024 + tid * 4), (unsigned*)(lds + buf * 32768 + j * 4096 + tid * 16), 16, 0, 0);
    };
    __syncthreads();
    if ((int)blockIdx.x < ngrp) issue_chunk(0, 0);
    int kk = 0;
    for (int gi = blockIdx.x; gi < ngrp; gi += gridDim.x) {
        const int r0 = gi * 16 + wid * 4;
        float hv[4][16];
        {
            float4 xv[4][4];
#pragma unroll
            for (int q = 0; q < 4; ++q) {
                const float* x = x1row(p, r0 + q);
#pragma unroll
                for (int j = 0; j < 4; ++j) xv[q][j] = *(const float4*)(x + j * 256 + lane * 4);
            }
            float inv[4];
#pragma unroll
            for (int q = 0; q < 4; ++q) {
                float ss = 0.f;
#pragma unroll
                for (int j = 0; j < 4; ++j) ss += xv[q][j].x * xv[q][j].x + xv[q][j].y * xv[q][j].y + xv[q][j].z * xv[q][j].z + xv[q][j].w * xv[q][j].w;
                inv[q] = ss;
            }
#pragma unroll
            for (int o = 1; o < 64; o <<= 1) {
#pragma unroll
                for (int q = 0; q < 4; ++q) inv[q] += __shfl_xor(inv[q], o);
            }
#pragma unroll
            for (int q = 0; q < 4; ++q) {
                const int r = r0 + q, mb = modrow(r);
                const float iv = rsqrtf(inv[q] * (1.f / D) + EPS);
                const float* sh = modv(p, l, mb, 3); const float* sc = modv(p, l, mb, 4);
#pragma unroll
                for (int j = 0; j < 4; ++j) {
                    const int c = j * 256 + lane * 4;
                    const float4 gg = *(const float4*)(g + c), s1 = *(const float4*)(sh + c), s2 = *(const float4*)(sc + c);
                    hv[q][j * 4 + 0] = xv[q][j].x * iv * gg.x * (1.f + s2.x) + s1.x; hv[q][j * 4 + 1] = xv[q][j].y * iv * gg.y * (1.f + s2.y) + s1.y;
                    hv[q][j * 4 + 2] = xv[q][j].z * iv * gg.z * (1.f + s2.z) + s1.z; hv[q][j * 4 + 3] = xv[q][j].w * iv * gg.w * (1.f + s2.w) + s1.w;
                }
            }
#pragma unroll
            for (int q = 0; q < 4; ++q)
#pragma unroll
                for (int j = 0; j < 4; ++j)
                    st_bf4(H + (size_t)(r0 + q) * D + j * 256 + lane * 4, hv[q][j * 4], hv[q][j * 4 + 1], hv[q][j * 4 + 2], hv[q][j * 4 + 3]);
        }
#pragma unroll 1
        for (int c = 0; c < 5; ++c) {
            asm volatile("s_waitcnt vmcnt(0)" ::: "memory");
            __syncthreads();
            issue_chunk(c == 4 ? 0 : c + 1, (kk + 1) & 1);
            const unsigned char* wb = lds + (kk & 1) * 32768;
            ++kk;
            float v[32];
#pragma unroll
            for (int e = 0; e < 32; ++e) v[e] = 0.f;
#pragma unroll
            for (int oo = 0; oo < 8; ++oo)
#pragma unroll
                for (int j = 0; j < 4; ++j) {
                    const float4 w = *(const float4*)(wb + oo * 4096 + j * 1024 + lane * 16);
#pragma unroll
                    for (int q = 0; q < 4; ++q) v[oo * 4 + q] += hv[q][j * 4] * w.x + hv[q][j * 4 + 1] * w.y + hv[q][j * 4 + 2] * w.z + hv[q][j * 4 + 3] * w.w;
                }
#pragma unroll
            for (int st = 0; st < 5; ++st) {
                const int n = 16 >> st;
                const bool up = (lane >> st) & 1;
#pragma unroll
                for (int i = 0; i < n; ++i) {
                    const float keep = up ? v[i + n] : v[i], send = up ? v[i] : v[i + n];
                    v[i] = keep + __shfl_xor(send, 1 << st);
                }
            }
            const float val = v[0] + __shfl_xor(v[0], 32);
            const int o = c * 8 + (myidx >> 2);
            if (lane < 32 && o < 36) LG[(myidx & 3) * 40 + o] = val;
        }
        __syncthreads();
        if (lane < 4) {
            const float* lgq = LG + lane * 40;
            float lg[4];
#pragma unroll
            for (int z = 0; z < 4; ++z) lg[z] = lgq[z] + p->in[I_BGRP][l * 4 + z];
            float gmax = lg[0]; int grp = 0;
#pragma unroll
            for (int z = 1; z < 4; ++z) if (lg[z] > gmax) { gmax = lg[z]; grp = z; }
            float gden = 0.f;
#pragma unroll
            for (int z = 0; z < 4; ++z) gden += __expf(lg[z] - gmax);
            const float ptg = 1.f / gden;
            float le[8];
#pragma unroll
            for (int z = 0; z < 8; ++z) le[z] = lgq[4 + grp * 8 + z] + p->in[I_BEXP][l * 32 + grp * 8 + z];
            int i1 = 0; float m1 = le[0];
#pragma unroll
            for (int z = 1; z < 8; ++z) if (le[z] > m1) { m1 = le[z]; i1 = z; }
            int i2 = -1; float m2 = -3.0e38f;
#pragma unroll
            for (int z = 0; z < 8; ++z) if (z != i1 && le[z] > m2) { m2 = le[z]; i2 = z; }
            const float e2 = __expf(m2 - m1);
            const float w1 = ptg / (1.f + e2), w2 = ptg * e2 / (1.f + e2);
            const int r = r0 + lane, ea = grp * 8 + i1, eb = grp * 8 + i2;
            const unsigned pa = atomicAdd(&cnt[ea * CNT_STRIDE], 1u); list[(size_t)ea * NTOK + pa] = r * 2;
            const unsigned pb = atomicAdd(&cnt[eb * CNT_STRIDE], 1u); list[(size_t)eb * NTOK + pb] = r * 2 + 1;
            wt[r * 2] = w1; wt[r * 2 + 1] = w2;
        }
    }
    asm volatile("s_waitcnt vmcnt(0)" ::: "memory");
    __syncthreads();
}

__device__ void ph_convmoe(KParams p, int l, float* sm) {
    const int tid = tid_opaque();
    bf16* WGU = (bf16*)(p->ws + WS_WGU);
    bf16* WDT = (bf16*)(p->ws + WS_WDT);
    conv_stream([&](int it) {
        const int e = it / 384, r = it % 384, kind = r >> 7, q = r & 127;
        ConvItem c;
        if (kind < 2) {
            c.src = p->in[kind == 0 ? I_WGATE : I_WUP] + ((size_t)(l * 32 + e) * D) * 512; c.dst = WGU + (size_t)e * D * D; c.ldsrc = 512; c.nvalid = 512;
            c.k0 = (q >> 3) * 64; c.n0 = (q & 7) * 64; c.lddst = D; c.kind = 2 + kind;
        } else {
            c.src = p->in[I_WDOWN] + ((size_t)(l * 32 + e) * 512) * D; c.dst = WDT + (size_t)e * D * 512; c.ldsrc = D; c.nvalid = D;
            c.k0 = (q >> 4) * 64; c.n0 = (q & 15) * 64; c.lddst = 512; c.kind = 0;
        }
        return c;
    }, 32 * 384, (unsigned char*)sm, tid);
}

constexpr int LDS_MOE_TAB = 65536;
__device__ __forceinline__ int moe_build_table(const unsigned* cnt, unsigned char* lds, const int tid) {
    int* TS = (int*)(lds + LDS_MOE_TAB); int* CN = TS + 40;
    __syncthreads();
    if (tid < 32) CN[tid] = (int)cnt[tid * CNT_STRIDE];
    __syncthreads();
    if (tid == 0) { int acc = 0; for (int q = 0; q < 32; ++q) { TS[q] = acc; acc += (CN[q] + 127) >> 7; } TS[32] = acc; }
    __syncthreads();
    return TS[32];
}
__device__ __forceinline__ void moe_tile_lookup(const unsigned char* lds, int trow, int& e, int& i0, int& ce) {
    const int* TS = (const int*)(lds + LDS_MOE_TAB); const int* CN = TS + 40;
    int lo = 0;
#pragma unroll
    for (int step = 16; step >= 1; step >>= 1) if (TS[lo + step] <= trow) lo += step;
    e = lo; i0 = (trow - TS[lo]) * 128; ce = CN[lo];
}

__device__ void ph_moe1(KParams p, int l, unsigned char* lds) {
    const bf16* H = (const bf16*)(p->ws + WS_H);
    bf16* ACT = (bf16*)(p->ws + WS_ACT);
    const bf16* WGU = (const bf16*)(p->ws + WS_WGU);
    const unsigned* cnt = (const unsigned*)(p->ws + WS_CTL) + CNT_BASE + l * 32 * CNT_STRIDE;
    const int* list = (const int*)(p->ws + WS_LIST);
    const int tid = tid_opaque(), lane = tid & 63, wid = tid >> 6, wr = wid >> 1, wc = wid & 1, fr = lane & 15, fq = lane >> 4;
    const int ntiles = moe_build_table(cnt, lds, tid), G = gridDim.x;
    auto issue = [&](int it_) {
        int e_, i0_, ce_; moe_tile_lookup(lds, it_ >> 3, e_, i0_, ce_);
        const int* le_ = list + (size_t)e_ * NTOK; const bf16* W_ = WGU + (size_t)e_ * D * D + (size_t)(it_ & 7) * 128 * D;
        gemm_issue0([&](int r) { const int ii = min(i0_ + r, ce_ - 1); return H + (size_t)(le_[ii] >> 1) * D; }, [&](int r) { return W_ + (size_t)r * D; }, lds, tid);
    };
    const TileQ tq{(unsigned*)(p->ws + WS_CTL) + CW_TQ + (l * 5 + 3) * 512, ntiles * 8};
    volatile int* slot = (volatile int*)(lds + LDS_TQ_OFF);
    __syncthreads();
    if (tid == 0) slot[0] = tq_next(tq);
    __syncthreads();
    int it = slot[0];
    if (it >= 0) issue(it);
    for (int n_ = 0; it >= 0; ++n_) {
        if (tid == 0) slot[(n_ + 1) & 1] = tq_next(tq);
        const int trow = it >> 3, tn = it & 7;
        int e, i0, ce; moe_tile_lookup(lds, trow, e, i0, ce);
        const int* le = list + (size_t)e * NTOK;
        const bf16* WT = WGU + (size_t)e * D * D;
        f32x4 acc[4][4]; zero_acc4(acc);
        gemm_tile<false>(acc, [&](int r) { const int ii = min(i0 + r, ce - 1); return H + (size_t)(le[ii] >> 1) * D; },
                  [&](int r) { return WT + (size_t)(tn * 128 + r) * D; }, D, lds, tid, [&]() { const int nx = slot[(n_ + 1) & 1]; if (nx >= 0) issue(nx); });
        __syncthreads();
#pragma unroll
        for (int i = 0; i < 4; ++i)
#pragma unroll
            for (int jp = 0; jp < 2; ++jp) {
                const f32x4 g = acc[i][2 * jp], u = acc[i][2 * jp + 1];
                stg_put<8>(lds, wr * 64 + i * 16 + fr, (wc * 32 + jp * 16 + fq * 4) * 2, pk_bf16(silu_f(g[0]) * u[0], silu_f(g[1]) * u[1]), pk_bf16(silu_f(g[2]) * u[2], silu_f(g[3]) * u[3]));
            }
        __syncthreads();
        stg_flush<8>(lds, tid, [&](int row, int ch) -> bf16* { const int ii = i0 + row; return ii < ce ? ACT + (size_t)le[ii] * 512 + tn * 64 + ch * 8 : nullptr; });
        it = slot[(n_ + 1) & 1];
    }
}

__device__ void ph_moe2(KParams p, int l, unsigned char* lds) {
    const bf16* ACT = (const bf16*)(p->ws + WS_ACT);
    const bf16* WDT = (const bf16*)(p->ws + WS_WDT);
    const unsigned* cnt = (const unsigned*)(p->ws + WS_CTL) + CNT_BASE + l * 32 * CNT_STRIDE;
    const int* list = (const int*)(p->ws + WS_LIST);
    const float* wt = (const float*)(p->ws + WS_WT);
    const int tid = tid_opaque(), lane = tid & 63, wid = tid >> 6, wr = wid >> 1, wc = wid & 1, fr = lane & 15, fq = lane >> 4;
    const int ntiles = moe_build_table(cnt, lds, tid), G = gridDim.x;
    auto issue = [&](int it_) {
        int e_, i0_, ce_; moe_tile_lookup(lds, it_ >> 3, e_, i0_, ce_);
        const int* le_ = list + (size_t)e_ * NTOK; const bf16* W_ = WDT + (size_t)e_ * D * 512 + (size_t)(it_ & 7) * 128 * 512;
        gemm_issue0([&](int r) { const int ii = min(i0_ + r, ce_ - 1); return ACT + (size_t)le_[ii] * 512; }, [&](int r) { return W_ + (size_t)r * 512; }, lds, tid);
    };
    const TileQ tq{(unsigned*)(p->ws + WS_CTL) + CW_TQ + (l * 5 + 4) * 512, ntiles * 8};
    volatile int* slot = (volatile int*)(lds + LDS_TQ_OFF);
    __syncthreads();
    if (tid == 0) slot[0] = tq_next(tq);
    __syncthreads();
    int it = slot[0];
    if (it >= 0) issue(it);
    for (int n_ = 0; it >= 0; ++n_) {
        if (tid == 0) slot[(n_ + 1) & 1] = tq_next(tq);
        const int trow = it >> 3, tn = it & 7;
        int e, i0, ce; moe_tile_lookup(lds, trow, e, i0, ce);
        const int* le = list + (size_t)e * NTOK;
        const bf16* WT = WDT + (size_t)e * D * 512;
        int asg[4]; float wv[4];
#pragma unroll
        for (int i = 0; i < 4; ++i) { asg[i] = le[min(i0 + wr * 64 + i * 16 + fr, ce - 1)]; wv[i] = wt[asg[i]]; }
        f32x4 acc[4][4]; zero_acc4(acc);
        gemm_tile<false>(acc, [&](int r) { const int ii = min(i0 + r, ce - 1); return ACT + (size_t)le[ii] * 512; },
                  [&](int r) { return WT + (size_t)(tn * 128 + r) * 512; }, 512, lds, tid, [&]() { const int nx = slot[(n_ + 1) & 1]; if (nx >= 0) issue(nx); });
        __syncthreads();
#pragma unroll
        for (int i = 0; i < 4; ++i) {
            const float w = wv[i];
#pragma unroll
            for (int j = 0; j < 4; ++j)
                stg_put<16>(lds, wr * 64 + i * 16 + fr, (wc * 64 + j * 16 + fq * 4) * 2, pk_bf16(w * acc[i][j][0], w * acc[i][j][1]), pk_bf16(w * acc[i][j][2], w * acc[i][j][3]));
        }
        __syncthreads();
        stg_flush<16>(lds, tid, [&](int row, int ch) -> bf16* {
            const int ii = i0 + row; if (ii >= ce) return nullptr;
            const int a = le[ii]; return (bf16*)(p->ws + ((a & 1) ? WS_Y1 : WS_Y0)) + (size_t)(a >> 1) * D + tn * 128 + ch * 8; });
        it = slot[(n_ + 1) & 1];
    }
}

__device__ void ph_combine(KParams p, int l) {
    const int tid = tid_opaque(), lane = tid & 63, gw = blockIdx.x * 4 + (tid >> 6), ngw = gridDim.x * 4;
    const bf16* Y0 = (const bf16*)(p->ws + WS_Y0);
    const bf16* Y1 = (const bf16*)(p->ws + WS_Y1);
    bf16* H = (bf16*)(p->ws + WS_H);
    const int nrows = (l == 0) ? NTOK : NL;
    const float* ng = (l == 0) ? p->in[I_N1G] + D : p->in[I_FING];
    for (int r0 = gw * 2; r0 < nrows; r0 += ngw * 2) {
        float4 xv[2][4]; uint2 ya[2][4], yb[2][4];
#pragma unroll
        for (int q = 0; q < 2; ++q) {
            const int r = r0 + q;
            const float* x = x1row(p, r);
#pragma unroll
            for (int j = 0; j < 4; ++j) {
                const int c = j * 256 + lane * 4;
                xv[q][j] = *(const float4*)(x + c); ya[q][j] = *(const uint2*)(Y0 + (size_t)r * D + c); yb[q][j] = *(const uint2*)(Y1 + (size_t)r * D + c);
            }
        }
#pragma unroll
        for (int q = 0; q < 2; ++q) {
            const int r = r0 + q, mb = modrow(r);
            float* xo = r < NL ? p->out + (size_t)r * D : (float*)(p->ws + WS_XC) + (size_t)(r - NL) * D;
            const float* g2 = modv(p, l, mb, 5);
            float4 v[4]; float ss = 0.f;
#pragma unroll
            for (int j = 0; j < 4; ++j) {
                const int c = j * 256 + lane * 4;
                const float4 gg = *(const float4*)(g2 + c);
                const float a0 = __uint_as_float(ya[q][j].x << 16) + __uint_as_float(yb[q][j].x << 16), a1 = __uint_as_float(ya[q][j].x & 0xffff0000u) + __uint_as_float(yb[q][j].x & 0xffff0000u);
                const float a2 = __uint_as_float(ya[q][j].y << 16) + __uint_as_float(yb[q][j].y << 16), a3 = __uint_as_float(ya[q][j].y & 0xffff0000u) + __uint_as_float(yb[q][j].y & 0xffff0000u);
                v[j] = make_float4(xv[q][j].x + gg.x * a0, xv[q][j].y + gg.y * a1, xv[q][j].z + gg.z * a2, xv[q][j].w + gg.w * a3);
                ss += v[j].x * v[j].x + v[j].y * v[j].y + v[j].z * v[j].z + v[j].w * v[j].w;
            }
            const float inv = rsqrtf(wave_sum(ss) * (1.f / D) + EPS);
            if (l == 0) {
                const float* sh = modv(p, 1, mb, 0); const float* sc = modv(p, 1, mb, 1);
#pragma unroll
                for (int j = 0; j < 4; ++j) {
                    const int c = j * 256 + lane * 4;
                    *(float4*)(xo + c) = v[j];
                    const float4 gg = *(const float4*)(ng + c), s1 = *(const float4*)(sh + c), s2 = *(const float4*)(sc + c);
                    st_bf4(H + (size_t)r * D + c, v[j].x * inv * gg.x * (1.f + s2.x) + s1.x, v[j].y * inv * gg.y * (1.f + s2.y) + s1.y,
                           v[j].z * inv * gg.z * (1.f + s2.z) + s1.z, v[j].w * inv * gg.w * (1.f + s2.w) + s1.w);
                }
            } else {
#pragma unroll
                for (int j = 0; j < 4; ++j) {
                    const int c = j * 256 + lane * 4;
                    const float4 gg = *(const float4*)(ng + c);
                    *(float4*)(xo + c) = make_float4(v[j].x * inv * gg.x, v[j].y * inv * gg.y, v[j].z * inv * gg.z, v[j].w * inv * gg.w);
                }
            }
        }
    }
}

#define XB_TMO      128
#define XB_XCNT(j)  (256  + 64 * (j))
#define XB_XSUB(j)  (1280 + 64 * (j))
#define XB_XGEN(j)  (2304 + 64 * (j))
#define XB_TOP      3328
#define XB_TOPGEN   3392
#define XB_SPIN_CAP (1u << 22)
constexpr int CW_BAR = 4096;
__device__ __forceinline__ unsigned xb_ld(unsigned* p)              { return __hip_atomic_load(p, __ATOMIC_RELAXED, __HIP_MEMORY_SCOPE_AGENT); }
__device__ __forceinline__ unsigned xb_add(unsigned* p, unsigned v) { return __hip_atomic_fetch_add(p, v, __ATOMIC_RELAXED, __HIP_MEMORY_SCOPE_AGENT); }
__device__ __forceinline__ unsigned xb_xcc_id() { return (unsigned)__builtin_amdgcn_s_getreg((3 << 11) | 20) & 0xFu; }
#define XB_SPIN(cond, bar) do { unsigned _sp = 0; while (cond) { __builtin_amdgcn_s_sleep(1); \
    if ((++_sp & 255u) == 0u) { if (xb_ld(&(bar)[XB_TMO])) break; if (_sp > XB_SPIN_CAP) { atomicAdd(&(bar)[XB_TMO], 1u); break; } } } } while (0)
constexpr int LDS_BAR_OFF = 79 * 1024 + 16;
__device__ __forceinline__ void xcd_barrier_post(unsigned* bar) {
    if (threadIdx.x == 0) (void)xb_add(&bar[XB_XCNT(xb_xcc_id())], 1u);
}
__device__ __forceinline__ void xcd_barrier_census(unsigned* bar, volatile unsigned* st) {
    if (threadIdx.x == 0) {
        const unsigned x = xb_xcc_id();
        unsigned cnt = 0, mine = 0;
#pragma unroll
        for (unsigned j = 0; j < 16; ++j) { const unsigned c = xb_ld(&bar[XB_XCNT(j)]); cnt += (c > 0u) ? 1u : 0u; mine = (j == x) ? c : mine; }
        st[0] = mine > 0u ? mine : 1u; st[1] = cnt > 0u ? cnt : 1u;
    }
    __syncthreads();
}
__device__ __forceinline__ void xcd_barrier(KParams kp, unsigned char* lds) {
    asm volatile("s_waitcnt vmcnt(0)" ::: "memory");
    __syncthreads();
    if (threadIdx.x == 0) {
        unsigned* bar = (unsigned*)(kp->ws + WS_CTL) + CW_BAR;
        volatile unsigned* st = (volatile unsigned*)(lds + LDS_BAR_OFF);
        __builtin_amdgcn_s_waitcnt(0);
        const unsigned x = xb_xcc_id();
        const unsigned nloc = st[0], nx = st[1];
        const unsigned old = xb_add(&bar[XB_XSUB(x)], 1u);
        const unsigned gen = old / nloc;
        if (old + 1u == (gen + 1u) * nloc) {
            __builtin_amdgcn_fence(__ATOMIC_RELEASE, "agent");
            asm volatile("s_waitcnt vmcnt(0)" ::: "memory");
            const unsigned og = xb_add(&bar[XB_TOP], 1u);
            const unsigned tg = og / nx;
            if (og + 1u == (tg + 1u) * nx) xb_add(&bar[XB_TOPGEN], 1u);
            else XB_SPIN(xb_ld(&bar[XB_TOPGEN]) == tg, bar);
            __builtin_amdgcn_fence(__ATOMIC_ACQUIRE, "agent");
            xb_add(&bar[XB_XGEN(x)], 1u);
            asm volatile("s_waitcnt vmcnt(0)" ::: "memory");
        } else {
            XB_SPIN(xb_ld(&bar[XB_XGEN(x)]) == gen, bar);
            __builtin_amdgcn_fence(__ATOMIC_ACQUIRE, "agent");
            asm volatile("s_waitcnt vmcnt(0)" ::: "memory");
        }
    }
    __syncthreads();
}

constexpr int LDS_BYTES = 80 * 1024;
__global__ void __launch_bounds__(256, 2) mega_fwd(Params p_unused) {
    const KParams kp = (KParams)__builtin_amdgcn_kernarg_segment_ptr();
    extern __shared__ __attribute__((aligned(16))) unsigned char smem_raw[];
    float* sm = (float*)smem_raw;
    cg::grid_group grid = cg::this_grid();
#ifndef PROBE_SEL
#define PROBE_SEL 0ull
#endif
#if PROBE_SEL
    volatile unsigned long long* stamps = (volatile unsigned long long*)(smem_raw + 79 * 1024 + 64);
    int n_stamp = 0;
#define STAMP() do { if (blockIdx.x == 0 && threadIdx.x == 0) stamps[n_stamp] = __builtin_amdgcn_s_memrealtime(); ++n_stamp; } while (0)
#else
#define STAMP() do { } while (0)
#endif
    xcd_barrier_post((unsigned*)(kp->ws + WS_CTL) + CW_BAR);
    STAMP();
    ph_init(fresh(kp), sm);
    grid.sync();
    xcd_barrier_census((unsigned*)(kp->ws + WS_CTL) + CW_BAR, (volatile unsigned*)(smem_raw + LDS_BAR_OFF));
    STAMP();
#define GSYNC() do { xcd_barrier(fresh(kp), smem_raw); STAMP(); } while (0)
#pragma unroll 1
    for (int l = 0; l < 2; ++l) {
        if (l == 0) { ph_norm1(fresh(kp), l); GSYNC(); }
        ph_gemm_in(fresh(kp), l, smem_raw); GSYNC();
        ph_prep(fresh(kp), l, sm);
        ph_gla_local(fresh(kp), l, smem_raw); GSYNC();
        ph_mix(fresh(kp), l, smem_raw);     GSYNC();
        ph_gla_out(fresh(kp), l, smem_raw); GSYNC();
        ph_merge(fresh(kp), l, smem_raw);   GSYNC();
        ph_outproj(fresh(kp), l, smem_raw); GSYNC();
        ph_router(fresh(kp), l, smem_raw);
        ph_convmoe(fresh(kp), l, sm);       GSYNC();
        ph_moe1(fresh(kp), l, smem_raw);    GSYNC();
        ph_moe2(fresh(kp), l, smem_raw);    GSYNC();
        ph_combine(fresh(kp), l);           GSYNC();
    }
#if PROBE_SEL
    if (blockIdx.x == 0 && threadIdx.x == 0) {
        unsigned long long dt = 0;
        for (int i = 0; i < 23; ++i) if ((PROBE_SEL >> i) & 1ull) dt += stamps[i + 1] - stamps[i];
        const unsigned long long t0 = __builtin_amdgcn_s_memrealtime();
        while (__builtin_amdgcn_s_memrealtime() - t0 < dt) __builtin_amdgcn_s_sleep(8);
    }
#endif
}

extern "C" void kernel_launch(void* const* d_in, const int* in_sizes, int n_in, void* d_out, int out_size, void* d_ws, size_t ws_size,
                              hipStream_t stream) {
    if (n_in != 28 || ws_size < WS_END) { fprintf(stderr, "kernel_launch: bad n_in %d or ws_size %zu (< %zu)\n", n_in, ws_size, (size_t)WS_END); return; }
    static int grid_blocks = 0;
    if (!grid_blocks) {
        int dev = 0, cus = 0, per_cu = 0;
        (void)hipGetDevice(&dev);
        (void)hipDeviceGetAttribute(&cus, hipDeviceAttributeMultiprocessorCount, dev);
        (void)hipFuncSetAttribute((const void*)mega_fwd, hipFuncAttributeMaxDynamicSharedMemorySize, LDS_BYTES);
        (void)hipOccupancyMaxActiveBlocksPerMultiprocessor(&per_cu, (const void*)mega_fwd, 256, LDS_BYTES);
        if (per_cu < 1) per_cu = 1;
        grid_blocks = cus * per_cu;
        fprintf(stderr, "kernel_launch: cus %d per_cu %d grid %d ws_size %zu\n", cus, per_cu, grid_blocks, ws_size);
    }
    Params p{};
    for (int i = 0; i < 28; ++i) p.in[i] = (const float*)d_in[i];
    p.out = (float*)d_out; p.ws = (unsigned char*)d_ws;
    (void)hipMemsetAsync((char*)d_ws + WS_CTL, 0, 1 * MiB, stream);
    void* args[] = {&p};
    hipError_t e = hipLaunchCooperativeKernel((const void*)mega_fwd, dim3(grid_blocks), dim3(256), args, LDS_BYTES, stream);
    if (e != hipSuccess) fprintf(stderr, "cooperative launch failed: %s (grid %d)\n", hipGetErrorString(e), grid_blocks);
}
```

```cpp
#include <hip/hip_runtime.h>
#include <hip/hip_cooperative_groups.h>
namespace cg = cooperative_groups;
#include <cstdio>
#include <cstdint>

typedef unsigned short bf16;

constexpr int D = 1024, NB = 8, T = 4096, CL = 256, NL = NB * T, NC = NB * CL, NTOK = NL + NC;
constexpr int INW = 5920;
constexpr int O_GQ = 0, O_GK = 256, O_GV = 512, O_GR = 1024, O_AQ = 1536, O_AK = 2048, O_AV = 2176, O_PU = 2304, O_GT = 2816, O_GLF = 5888, O_GLB = 5904;
__host__ __device__ constexpr int win_nmap(int n) { return n < 1536 ? n : (n < 1568 ? n + 4352 : (n < 5920 ? n - 32 : n)); }
constexpr float EPS = 1e-6f;
constexpr int CNT_BASE = 8192, CNT_STRIDE = 64;

constexpr size_t MiB = 1u << 20;
constexpr size_t WS_CTL = 0;
constexpr size_t WS_MODV = 1 * MiB;
constexpr size_t WS_ROPE = 1 * MiB + 512 * 1024;
constexpr size_t WS_WT = 2 * MiB;
constexpr size_t WS_LIST = 3 * MiB;
constexpr size_t WS_RWT = 7 * MiB + 256 * 1024;
constexpr size_t WS_XC = 8 * MiB;
constexpr size_t WS_H = 16 * MiB;
constexpr size_t WS_PROJ = 84 * MiB;
constexpr size_t WS_R2 = 478 * MiB;
constexpr size_t WS_WGU = WS_R2;
constexpr size_t WS_WDT = WS_R2 + 64 * MiB;
constexpr size_t WS_WSM = 580 * MiB;
constexpr size_t SZ_WINT = (size_t)6016 * 1024 * 2, SZ_WBT = (size_t)1024 * 512 * 2, SZ_WOUTT = (size_t)1024 * 1024 * 2;
constexpr size_t SZ_WSM_L = SZ_WINT + 3 * SZ_WBT + SZ_WOUTT;
constexpr size_t WS_VT = 614 * MiB;
constexpr int NKEY = T + CL;
constexpr size_t WS_END = 623 * MiB;
static_assert(WS_WSM + 2 * SZ_WSM_L <= WS_END, "ws map");
constexpr size_t SZ_Y512 = (size_t)NTOK * 512 * 2;
constexpr size_t WS_ACT = WS_PROJ;
constexpr size_t WS_Y0 = WS_PROJ + 68 * MiB;
constexpr size_t WS_Y1 = WS_PROJ + 136 * MiB;

struct Params {
    const float* in[28];
    float* out;
    unsigned char* ws;
};
typedef const __attribute__((address_space(4))) Params* KParams;
__device__ __forceinline__ KParams fresh(KParams k) { asm volatile("" : "+s"(k)); return k; }
enum { I_X = 0, I_C, I_CTX, I_CCTX, I_WMOD, I_BMOD, I_N1G, I_N2G, I_WIN, I_UPF, I_BIASF, I_UPB, I_BIASB, I_GLANG, I_QNG, I_KNG,
       I_POOLW, I_POOLS, I_WBR, I_WOUT, I_WGRP, I_BGRP, I_WEXP, I_BEXP, I_WGATE, I_WUP, I_WDOWN, I_FING };

__device__ __forceinline__ float bf2f(bf16 v) { return __uint_as_float(((unsigned)v) << 16); }
__device__ __forceinline__ bf16 f2bf(float f) { unsigned u = __float_as_uint(f); return (bf16)((u + 0x7fffu + ((u >> 16) & 1u)) >> 16); }
__device__ __forceinline__ float4 ld_bf4(const bf16* p) {
    uint2 u = *(const uint2*)p;
    return make_float4(__uint_as_float(u.x << 16), __uint_as_float(u.x & 0xffff0000u), __uint_as_float(u.y << 16), __uint_as_float(u.y & 0xffff0000u));
}
typedef float f32x2_t __attribute__((ext_vector_type(2)));
typedef __bf16 bf16x2_t __attribute__((ext_vector_type(2)));
__device__ __forceinline__ unsigned pk_bf16(float a, float b) { f32x2_t v = {a, b}; return __builtin_bit_cast(unsigned, __builtin_convertvector(v, bf16x2_t)); }
__device__ __forceinline__ void st_bf4(bf16* p, float a, float b, float c, float d) {
    uint2 u; u.x = pk_bf16(a, b); u.y = pk_bf16(c, d);
    *(uint2*)p = u;
}
__device__ __forceinline__ int tid_opaque() { int t = threadIdx.x; asm volatile("" : "+v"(t)); return t; }
#define DPP_ADD(v, ctrl) v += __builtin_bit_cast(float, __builtin_amdgcn_update_dpp(0, __builtin_bit_cast(int, v), (ctrl), 0xf, 0xf, true))
__device__ __forceinline__ float sum16(float v) {
    DPP_ADD(v, 0xB1);
    DPP_ADD(v, 0x4E);
    DPP_ADD(v, 0x141);
    DPP_ADD(v, 0x140);
    return v;
}
__device__ __forceinline__ float wave_sum(float v) {
#pragma unroll
    for (int o = 1; o < 64; o <<= 1) v += __shfl_xor(v, o);
    return v;
}
__device__ __forceinline__ float silu_f(float x) { return x * __builtin_amdgcn_rcpf(1.f + __expf(-x)); }
__device__ __forceinline__ float sigmoid_f(float x) { return __builtin_amdgcn_rcpf(1.f + __expf(-x)); }
__device__ __forceinline__ int modrow(int r) { return r < NL ? r / T : 8; }
__device__ __forceinline__ const float* xrow(KParams p, int l, int r) {
    if (l == 0) return r < NL ? p->in[I_X] + (size_t)r * D : p->in[I_CTX] + (size_t)(r - NL) * D;
    return r < NL ? p->out + (size_t)r * D : (const float*)(p->ws + WS_XC) + (size_t)(r - NL) * D;
}
__device__ __forceinline__ const float* modv(KParams p, int l, int mb, int which) {
    return (const float*)(p->ws + WS_MODV) + ((size_t)(l * 9 + mb) * 6 + which) * D;
}

template <class AF, class BF>
__device__ __forceinline__ void gemm64(float (&acc)[4][4], int K, AF aload, BF bload, float* sA, float* sB, const int tid) {
    const int ty = tid >> 4, tx = tid & 15;
    const int am = tid >> 2, ak = (tid & 3) * 4;
    const int bk = tid >> 4, bn = (tid & 15) * 4;
    for (int k0 = 0; k0 < K; k0 += 16) {
        float4 av = aload(am, k0 + ak);
        float4 bv = bload(k0 + bk, bn);
        __syncthreads();
        sA[(ak + 0) * 68 + am] = av.x; sA[(ak + 1) * 68 + am] = av.y; sA[(ak + 2) * 68 + am] = av.z; sA[(ak + 3) * 68 + am] = av.w;
        *(float4*)&sB[bk * 64 + bn] = bv;
        __syncthreads();
#pragma unroll
        for (int kk = 0; kk < 16; ++kk) {
            float4 a = *(float4*)&sA[kk * 68 + ty * 4];
            float4 b = *(float4*)&sB[kk * 64 + tx * 4];
            float aa[4] = {a.x, a.y, a.z, a.w}, bb[4] = {b.x, b.y, b.z, b.w};
#pragma unroll
            for (int i = 0; i < 4; ++i)
#pragma unroll
                for (int j = 0; j < 4; ++j) acc[i][j] += aa[i] * bb[j];
        }
    }
    __syncthreads();
}
__device__ __forceinline__ void zero_acc(float (&acc)[4][4]) {
#pragma unroll
    for (int i = 0; i < 4; ++i)
#pragma unroll
        for (int j = 0; j < 4; ++j) acc[i][j] = 0.f;
}

typedef short bf16x8 __attribute__((ext_vector_type(8)));
typedef float f32x4 __attribute__((ext_vector_type(4)));
constexpr int GT_BYTES = 16384;
__device__ __forceinline__ void zero_acc4(f32x4 (&acc)[4][4]) {
#pragma unroll
    for (int i = 0; i < 4; ++i)
#pragma unroll
        for (int j = 0; j < 4; ++j) acc[i][j] = (f32x4){0.f, 0.f, 0.f, 0.f};
}
template <class FA, class FB>
__device__ __forceinline__ void gemm_issue0(FA arow, FB brow, unsigned char* lds, const int tid) {
    const int srow = tid >> 3, sc = ((tid & 7) ^ ((tid >> 4) & 7)) * 8;
#pragma unroll
    for (int j = 0; j < 4; ++j) {
        __builtin_amdgcn_global_load_lds((const unsigned*)(arow(j * 32 + srow) + sc), (unsigned*)(lds + j * 4096 + tid * 16), 16, 0, 0);
        __builtin_amdgcn_global_load_lds((const unsigned*)(brow(j * 32 + srow) + sc), (unsigned*)(lds + GT_BYTES + j * 4096 + tid * 16), 16, 0, 0);
    }
}
template <bool AFF, bool LEAN, class FA, class FB, class NF>
__device__ __forceinline__ void gemm_tile(f32x4 (&acc)[4][4], FA arow, FB brow, int K, unsigned char* lds, const int tid, NF next) {
    const int lane = tid & 63, wid = tid >> 6, wr = wid >> 1, wc = wid & 1, fr = lane & 15, fq = lane >> 4;
    const int srow = tid >> 3, sc = ((tid & 7) ^ ((tid >> 4) & 7)) * 8;
    const bf16* ap[4]; const bf16* bp[4];
    if (AFF) {
        const bf16* a0 = arow(srow) + sc; const long astep = (long)(arow(32) - arow(0));
#pragma unroll
        for (int j = 0; j < 4; ++j) ap[j] = a0 + j * astep;
    } else {
#pragma unroll
        for (int j = 0; j < 4; ++j) ap[j] = arow(j * 32 + srow) + sc;
    }
    {
        const bf16* b0 = brow(srow) + sc; const long bstep = (long)(brow(32) - brow(0));
#pragma unroll
        for (int j = 0; j < 4; ++j) bp[j] = b0 + j * bstep;
    }
    const int KT = K >> 6;
#pragma unroll 1
    for (int kt = 0; kt < KT; ++kt) {
        asm volatile("s_waitcnt vmcnt(0)" ::: "memory");
        __syncthreads();
        if (kt + 1 < KT) {
            unsigned char* sa = lds + ((kt + 1) & 1) * 2 * GT_BYTES;
#pragma unroll
            for (int j = 0; j < 4; ++j) {
                __builtin_amdgcn_global_load_lds((const unsigned*)(ap[j] + (kt + 1) * 64), (unsigned*)(sa + j * 4096 + tid * 16), 16, 0, 0);
                __builtin_amdgcn_global_load_lds((const unsigned*)(bp[j] + (kt + 1) * 64), (unsigned*)(sa + GT_BYTES + j * 4096 + tid * 16), 16, 0, 0);
            }
        } else {
            next();
        }
        const unsigned char* sa = lds + (kt & 1) * 2 * GT_BYTES;
        const unsigned char* sb = sa + GT_BYTES;
        if (LEAN) {
#pragma unroll
            for (int ks = 0; ks < 2; ++ks) {
                const int phys = ((ks * 4 + fq) ^ (fr >> 1)) * 16;
                bf16x8 bq[4];
#pragma unroll
                for (int j = 0; j < 4; ++j) bq[j] = *(const bf16x8*)(sb + (wc * 64 + j * 16 + fr) * 128 + phys);
#pragma unroll
                for (int i = 0; i < 4; ++i) {
                    const bf16x8 af = *(const bf16x8*)(sa + (wr * 64 + i * 16 + fr) * 128 + phys);
#pragma unroll
                    for (int j = 0; j < 4; ++j) acc[i][j] = __builtin_amdgcn_mfma_f32_16x16x32_bf16(bq[j], af, acc[i][j], 0, 0, 0);
                }
            }
        } else {
            bf16x8 af[2][4], bq[2][4];
#pragma unroll
            for (int ks = 0; ks < 2; ++ks) {
                const int phys = ((ks * 4 + fq) ^ (fr >> 1)) * 16;
#pragma unroll
                for (int j = 0; j < 4; ++j) bq[ks][j] = *(const bf16x8*)(sb + (wc * 64 + j * 16 + fr) * 128 + phys);
#pragma unroll
                for (int i = 0; i < 4; ++i) af[ks][i] = *(const bf16x8*)(sa + (wr * 64 + i * 16 + fr) * 128 + phys);
            }
            __builtin_amdgcn_sched_barrier(0);
#pragma unroll
            for (int ks = 0; ks < 2; ++ks)
#pragma unroll
                for (int i = 0; i < 4; ++i)
#pragma unroll
                    for (int j = 0; j < 4; ++j) acc[i][j] = __builtin_amdgcn_mfma_f32_16x16x32_bf16(bq[ks][j], af[ks][i], acc[i][j], 0, 0, 0);
        }
    }
}
__device__ __forceinline__ void tile_coords(int it, int nM, int nN, int& tm, int& tn) {
    const int GM = 8, per = GM * nN, grp = it / per, fm = grp * GM, gsz = min(nM - fm, GM), rem = it - grp * per;
    tm = fm + rem % gsz; tn = rem / gsz;
}
constexpr int CW_TQ = 32768;
constexpr int LDS_TQ_OFF = 79 * 1024 + 32;
struct TileQ { unsigned* ctr; int ntiles; };
__device__ __forceinline__ int tq_next(const TileQ& q) {
    const int x = (int)(__builtin_amdgcn_s_getreg((3 << 11) | 20) & 7u);
    for (int s = 0; s < 8; ++s) {
        const int c = (x + s) & 7;
        const int b = (int)(((long)q.ntiles * c) >> 3), e = (int)(((long)q.ntiles * (c + 1)) >> 3);
        if (b >= e) continue;
        if ((int)__hip_atomic_load(q.ctr + c * 64, __ATOMIC_RELAXED, __HIP_MEMORY_SCOPE_AGENT) >= e - b) continue;
        const int t = (int)__hip_atomic_fetch_add(q.ctr + c * 64, 1u, __ATOMIC_RELAXED, __HIP_MEMORY_SCOPE_AGENT);
        if (b + t < e) return b + t;
    }
    return -1;
}
constexpr int STG_OFF = 32768;
template <int NCH>
__device__ __forceinline__ void stg_put(unsigned char* lds, int row, int colbyte, unsigned lo, unsigned hi) {
    *(uint2*)(lds + STG_OFF + row * (NCH * 16) + ((((colbyte >> 4) ^ row) & (NCH - 1)) << 4) + (colbyte & 15)) = make_uint2(lo, hi);
}
template <int NCH, class RP>
__device__ __forceinline__ void stg_flush(unsigned char* lds, const int tid, RP rowptr) {
#pragma unroll
    for (int k = 0; k < NCH / 2; ++k) {
        const int idx = k * 256 + tid, row = idx / NCH, ch = idx % NCH;
        bf16* dst = rowptr(row, ch);
        if (dst) *(uint4*)dst = *(const uint4*)(lds + STG_OFF + row * (NCH * 16) + (((ch ^ row) & (NCH - 1)) << 4));
    }
}
__device__ __forceinline__ int vblock() { const int G = gridDim.x, b = blockIdx.x; return (G & 7) == 0 ? (b & 7) * (G >> 3) + (b >> 3) : b; }

struct ConvItem { const float* src; bf16* dst; int ldsrc, nvalid, k0, n0, lddst, kind; };
__device__ __forceinline__ int conv_nmap(int kind, int n) {
    return kind == 0 ? n : (kind == 1 ? win_nmap(n) : 32 * (n >> 4) + (kind == 3 ? 16 : 0) + (n & 15));
}
template <class Dec>
__device__ __forceinline__ void conv_stream(Dec decode, int nitems, unsigned char* lds, const int tid) {
    auto issue = [&](const ConvItem& it, int buf) {
#pragma unroll
        for (int j = 0; j < 4; ++j) {
            const int k = j * 16 + (tid >> 4), pc = tid & 15, c = pc ^ ((k >> 4) & 3), n = it.n0 + c * 4;
            if (n < it.nvalid)
                __builtin_amdgcn_global_load_lds((const unsigned*)(it.src + (size_t)(it.k0 + k) * it.ldsrc + n), (unsigned*)(lds + buf * 16384 + j * 4096 + tid * 16), 16, 0, 0);
        }
    };
    int i = blockIdx.x;
    __syncthreads();
    ConvItem cur{};
    if (i < nitems) { cur = decode(i); issue(cur, 0); }
    int buf = 0;
    for (; i < nitems; i += gridDim.x) {
        asm volatile("s_waitcnt vmcnt(0)" ::: "memory");
        __syncthreads();
        ConvItem nxt{};
        const bool has_next = i + (int)gridDim.x < nitems;
        if (has_next) { nxt = decode(i + gridDim.x); issue(nxt, buf ^ 1); }
        {
            const float* sm = (const float*)(lds + buf * 16384);
            const int n = tid >> 2, kq = (tid & 3) * 16;
            const bool valid = cur.n0 + n < cur.nvalid;
            const int cidx = ((((n >> 2) ^ (kq >> 4)) & 15) << 2) + (n & 3);
            unsigned w[8];
#pragma unroll
            for (int q = 0; q < 8; ++q) {
                const float a = valid ? sm[(kq + 2 * q) * 64 + cidx] : 0.f, b = valid ? sm[(kq + 2 * q + 1) * 64 + cidx] : 0.f;
                w[q] = pk_bf16(a, b);
            }
            bf16* d = cur.dst + (size_t)conv_nmap(cur.kind, cur.n0 + n) * cur.lddst + cur.k0 + kq;
            *(uint4*)d = make_uint4(w[0], w[1], w[2], w[3]);
            *(uint4*)(d + 8) = make_uint4(w[4], w[5], w[6], w[7]);
        }
        cur = nxt; buf ^= 1;
    }
    asm volatile("s_waitcnt vmcnt(0)" ::: "memory");
    __syncthreads();
}
__device__ __forceinline__ bf16* wsm_int(KParams p, int l) { return (bf16*)(p->ws + WS_WSM + (size_t)l * SZ_WSM_L); }
__device__ __forceinline__ bf16* wsm_bt(KParams p, int l, int br) { return (bf16*)(p->ws + WS_WSM + (size_t)l * SZ_WSM_L + SZ_WINT + (size_t)br * SZ_WBT); }
__device__ __forceinline__ bf16* wsm_outt(KParams p, int l) { return (bf16*)(p->ws + WS_WSM + (size_t)l * SZ_WSM_L + SZ_WINT + 3 * SZ_WBT); }

__device__ void ph_init(KParams p, float* sm) {
    const int tid = tid_opaque();
    unsigned char* lds = (unsigned char*)sm;
    conv_stream([&](int it) {
        const int l = it / 2016; int r = it % 2016;
        ConvItem c;
        if (r < 1504) { c.src = p->in[I_WIN] + (size_t)l * D * INW; c.dst = wsm_int(p, l); c.ldsrc = INW; c.nvalid = INW; c.k0 = (r / 94) * 64; c.n0 = (r % 94) * 64; c.lddst = D; c.kind = 1; return c; }
        r -= 1504;
        if (r < 256) { const int br = r >> 7, q = r & 127;
            c.src = p->in[I_WBR] + ((size_t)(l * 3 + br) * 512) * D; c.dst = wsm_bt(p, l, br); c.ldsrc = D; c.nvalid = D; c.k0 = (q >> 4) * 64; c.n0 = (q & 15) * 64; c.lddst = 512; c.kind = 0; return c; }
        r -= 256;
        c.src = p->in[I_WOUT] + (size_t)l * D * D; c.dst = wsm_outt(p, l); c.ldsrc = D; c.nvalid = D; c.k0 = (r >> 4) * 64; c.n0 = (r & 15) * 64; c.lddst = D; c.kind = 0; return c;
    }, 2 * 2016, lds, tid);
    for (int it = blockIdx.x; it < 2 * 96; it += gridDim.x) {
        const int l = it / 96, cb = it % 96;
        __syncthreads();
        for (int e = tid; e < 9 * D; e += 256) {
            const int mb = e / D, k = e % D;
            sm[e] = silu_f(mb < 8 ? p->in[I_C][mb * D + k] : p->in[I_CCTX][k]);
        }
        __syncthreads();
        const int col = cb * 64 + (tid & 63), kq = tid >> 6;
        const float* w = p->in[I_WMOD] + (size_t)l * D * 6144 + (size_t)kq * 256 * 6144 + col;
        float acc[9];
#pragma unroll
        for (int m = 0; m < 9; ++m) acc[m] = 0.f;
#pragma unroll 8
        for (int k = 0; k < 256; ++k) {
            const float wv = w[(size_t)k * 6144];
#pragma unroll
            for (int m = 0; m < 9; ++m) acc[m] += sm[m * D + kq * 256 + k] * wv;
        }
        __syncthreads();
#pragma unroll
        for (int m = 0; m < 9; ++m) sm[9 * D + (kq * 9 + m) * 64 + (tid & 63)] = acc[m];
        __syncthreads();
        if (tid < 64) {
            const float bias = p->in[I_BMOD][l * 6144 + col];
            float* mv = (float*)(p->ws + WS_MODV);
#pragma unroll
            for (int m = 0; m < 9; ++m)
                mv[(size_t)(l * 9 + m) * 6144 + col] = sm[9 * D + (0 * 9 + m) * 64 + tid] + sm[9 * D + (1 * 9 + m) * 64 + tid] + sm[9 * D + (2 * 9 + m) * 64 + tid] + sm[9 * D + (3 * 9 + m) * 64 + tid] + bias;
        }
    }
    for (int it = blockIdx.x; it < 1 + 72 + 2 * 128; it += gridDim.x) {
        if (it == 0) {
            float2* rope = (float2*)(p->ws + WS_ROPE);
            for (int e = tid; e < 64 * 16; e += 256) {
                const int pos = e >> 4, i = e & 15;
                const float invf = powf(10000.0f, -(float)(2 * i) / 32.0f);
                const float angf = (float)pos * invf;
                const double ang = (double)angf;
                const double twopi = 6.283185307179586476925286766559;
                const double n = rint(ang / twopi);
                const double r = ang - n * twopi, r2 = r * r;
                double sn = 1.0, cs = 1.0;
                for (int q = 14; q >= 1; --q) { sn = 1.0 - r2 / (double)((2 * q) * (2 * q + 1)) * sn; cs = 1.0 - r2 / (double)((2 * q - 1) * (2 * q)) * cs; }
                sn *= r;
                rope[e] = make_float2((float)cs, (float)sn);
            }
        } else if (it < 73) {
            const int q = it - 1, l = q / 36, o = q % 36;
            float* dst = (float*)(p->ws + WS_RWT) + (size_t)(l * 36 + o) * D;
            for (int k = tid; k < D; k += 256) dst[k] = o < 4 ? p->in[I_WGRP][((size_t)l * D + k) * 4 + o] : p->in[I_WEXP][((size_t)l * D + k) * 32 + (o - 4)];
        } else {
            const int q = it - 73, l = q >> 7, r = q & 127;
            const int m0 = (r >> 4) * 64, n0 = (r & 15) * 64, g = m0 >> 7;
            const float* PW = p->in[I_POOLW] + ((size_t)(l * 4 + g) * 128) * 128;
            const float* PS = p->in[I_POOLS] + l * 512 + g * 128;
            const float* WB = p->in[I_WBR] + ((size_t)(l * 3 + 2) * 512 + g * 128) * D;
            float acc[4][4]; zero_acc(acc);
            gemm64(acc, 128,
                   [&](int m, int k) { const float4 a = *(const float4*)(PW + (size_t)((m0 + m) & 127) * 128 + k); const float4 sc = *(const float4*)(PS + k);
                                       return make_float4(a.x * sc.x, a.y * sc.y, a.z * sc.z, a.w * sc.w); },
                   [&](int k, int n) { return *(const float4*)(WB + (size_t)k * D + n0 + n); }, sm, sm + 16 * 68, tid);
            const int ty = tid >> 4, tx = tid & 15;
            bf16* dst = wsm_bt(p, l, 2);
#pragma unroll
            for (int j = 0; j < 4; ++j) st_bf4(dst + (size_t)(n0 + tx * 4 + j) * 512 + m0 + ty * 4, acc[0][j], acc[1][j], acc[2][j], acc[3][j]);
        }
    }
}

__device__ void ph_norm1(KParams p, int l) {
    const int tid = tid_opaque(), lane = tid & 63, gw = blockIdx.x * 4 + (tid >> 6), ngw = gridDim.x * 4;
    bf16* H = (bf16*)(p->ws + WS_H);
    const float* g = p->in[I_N1G] + l * D;
    for (int r0 = gw * 2; r0 < NTOK; r0 += ngw * 2) {
        float4 v[2][4];
#pragma unroll
        for (int q = 0; q < 2; ++q) {
            const float* x = xrow(p, l, r0 + q);
#pragma unroll
            for (int j = 0; j < 4; ++j) v[q][j] = *(const float4*)(x + j * 256 + lane * 4);
        }
#pragma unroll
        for (int q = 0; q < 2; ++q) {
            const int r = r0 + q, mb = modrow(r);
            const float* sh = modv(p, l, mb, 0); const float* sc = modv(p, l, mb, 1);
            float ss = 0.f;
#pragma unroll
            for (int j = 0; j < 4; ++j) ss += v[q][j].x * v[q][j].x + v[q][j].y * v[q][j].y + v[q][j].z * v[q][j].z + v[q][j].w * v[q][j].w;
            const float inv = rsqrtf(wave_sum(ss) * (1.f / D) + EPS);
#pragma unroll
            for (int j = 0; j < 4; ++j) {
                const int c = j * 256 + lane * 4;
                const float4 gg = *(const float4*)(g + c), s1 = *(const float4*)(sh + c), s2 = *(const float4*)(sc + c);
                st_bf4(H + (size_t)r * D + c, v[q][j].x * inv * gg.x * (1.f + s2.x) + s1.x, v[q][j].y * inv * gg.y * (1.f + s2.y) + s1.y,
                       v[q][j].z * inv * gg.z * (1.f + s2.z) + s1.z, v[q][j].w * inv * gg.w * (1.f + s2.w) + s1.w);
            }
        }
    }
}

__device__ void ph_gemm_in(KParams p, int l, unsigned char* lds) {
    const bf16* H = (const bf16*)(p->ws + WS_H);
    bf16* PROJ = (bf16*)(p->ws + WS_PROJ);
    const bf16* WT = wsm_int(p, l);
    const float2* rope = (const float2*)(p->ws + WS_ROPE);
    const int nN = 47, nM = NTOK / 128;
    const int tid = tid_opaque(), lane = tid & 63, wid = tid >> 6, wr = wid >> 1, wc = wid & 1, fr = lane & 15, fq = lane >> 4;
    const TileQ tq{(unsigned*)(p->ws + WS_CTL) + CW_TQ + (l * 5 + 0) * 512, nM * nN};
    volatile int* slot = (volatile int*)(lds + LDS_TQ_OFF);
    auto issue = [&](int it_) { int tm_, tn_; tile_coords(it_, nM, nN, tm_, tn_);
        gemm_issue0([&](int r) { return H + (size_t)(tm_ * 128 + r) * D; }, [&](int r) { return WT + (size_t)(tn_ * 128 + r) * D; }, lds, tid); };
    __syncthreads();
    if (tid == 0) slot[0] = tq_next(tq);
    __syncthreads();
    int it = slot[0];
    if (it >= 0) issue(it);
    for (int n_ = 0; it >= 0; ++n_) {
        if (tid == 0) slot[(n_ + 1) & 1] = tq_next(tq);
        int tm, tn; tile_coords(it, nM, nN, tm, tn);
        f32x4 acc[4][4]; zero_acc4(acc);
        gemm_tile<true, false>(acc, [&](int r) { return H + (size_t)(tm * 128 + r) * D; }, [&](int r) { return WT + (size_t)(tn * 128 + r) * D; }, D, lds, tid,
                  [&]() { const int nx = slot[(n_ + 1) & 1]; if (nx >= 0) issue(nx); });
        it = slot[(n_ + 1) & 1];
        __syncthreads();
        if (tn >= 12 && tn <= 16) {
            const bool isq = tn < 16;
            const float* gsrc = p->in[isq ? I_QNG : I_KNG] + l * 64 + fq * 4;
            float4 g[4];
#pragma unroll
            for (int j = 0; j < 4; ++j) g[j] = *(const float4*)(gsrc + j * 16);
            const float qs = isq ? 0.125f * 1.4426950408889634f : 1.f;
#pragma unroll
            for (int i = 0; i < 4; ++i) {
                float ss = 0.f;
#pragma unroll
                for (int j = 0; j < 4; ++j) ss += acc[i][j][0] * acc[i][j][0] + acc[i][j][1] * acc[i][j][1] + acc[i][j][2] * acc[i][j][2] + acc[i][j][3] * acc[i][j][3];
                ss += __shfl_xor(ss, 16); ss += __shfl_xor(ss, 32);
                const float inv = rsqrtf(ss * (1.f / 64.f) + EPS);
                const int row = tm * 128 + wr * 64 + i * 16 + fr;
                f32x4 v[4];
#pragma unroll
                for (int j = 0; j < 4; ++j) { v[j][0] = acc[i][j][0] * inv * g[j].x; v[j][1] = acc[i][j][1] * inv * g[j].y; v[j][2] = acc[i][j][2] * inv * g[j].z; v[j][3] = acc[i][j][3] * inv * g[j].w; }
                if (row < NL) {
                    const int t = row & (T - 1), prow = t >> 6, pcol = t & 63;
#pragma unroll
                    for (int e = 0; e < 4; ++e) {
                        const float2 a = rope[prow * 16 + fq * 4 + e], b2 = rope[pcol * 16 + fq * 4 + e];
                        const float x1 = v[0][e], x2 = v[1][e], y1 = v[2][e], y2 = v[3][e];
                        v[0][e] = x1 * a.x - x2 * a.y; v[1][e] = x1 * a.y + x2 * a.x;
                        v[2][e] = y1 * b2.x - y2 * b2.y; v[3][e] = y1 * b2.y + y2 * b2.x;
                    }
                }
#pragma unroll
                for (int j = 0; j < 4; ++j)
                    stg_put<16>(lds, wr * 64 + i * 16 + fr, (wc * 64 + j * 16 + fq * 4) * 2, pk_bf16(v[j][0] * qs, v[j][1] * qs), pk_bf16(v[j][2] * qs, v[j][3] * qs));
            }
        } else {
#pragma unroll
            for (int i = 0; i < 4; ++i)
#pragma unroll
                for (int j = 0; j < 4; ++j)
                    stg_put<16>(lds, wr * 64 + i * 16 + fr, (wc * 64 + j * 16 + fq * 4) * 2, pk_bf16(acc[i][j][0], acc[i][j][1]), pk_bf16(acc[i][j][2], acc[i][j][3]));
        }
        __syncthreads();
        stg_flush<16>(lds, tid, [&](int row, int ch) -> bf16* { return (tn * 128 + ch * 8 < INW) ? PROJ + (size_t)(tm * 128 + row) * INW + tn * 128 + ch * 8 : nullptr; });
    }
}

__device__ void ph_prep(KParams p, int l, float* smf) {
    const int tid = tid_opaque();
    bf16* PROJ = (bf16*)(p->ws + WS_PROJ);
    {
        bf16* DP = (bf16*)(p->ws + WS_R2 + 2 * SZ_Y512);
        const int lane = tid & 63, gw = blockIdx.x * 4 + (tid >> 6), ngw = gridDim.x * 4;
        const int ch = lane * 8, hw = 1 << (lane >> 4);
        const int nrows = (l == 0) ? NTOK : NL;
        for (int r = gw; r < nrows; r += ngw) {
            int t, tl;
            if (r < NL) { t = r & (T - 1); tl = T; } else { t = (r - NL) & (CL - 1); tl = CL; }
            const bf16* src = PROJ + (size_t)r * INW + O_PU + ch;
            const int lo = max(t - hw, 0), hi = min(t + hw, tl);
            uint4 nb[16];
#pragma unroll
            for (int u = 0; u < 16; ++u) {
                const int tt = t - 8 + u;
                nb[u] = (tt >= lo && tt < hi) ? *(const uint4*)(src + (long)(u - 8) * INW) : make_uint4(0u, 0u, 0u, 0u);
            }
            float sacc[8] = {0.f, 0.f, 0.f, 0.f, 0.f, 0.f, 0.f, 0.f};
#pragma unroll
            for (int u = 0; u < 16; ++u) {
                const unsigned w[4] = {nb[u].x, nb[u].y, nb[u].z, nb[u].w};
#pragma unroll
                for (int q = 0; q < 4; ++q) { sacc[2 * q] += __uint_as_float(w[q] << 16); sacc[2 * q + 1] += __uint_as_float(w[q] & 0xffff0000u); }
            }
            const float inv = 1.f / (float)(hi - lo);
            const uint4 cc = nb[8];
            const unsigned cw[4] = {cc.x, cc.y, cc.z, cc.w};
            unsigned o[4];
#pragma unroll
            for (int q = 0; q < 4; ++q) o[q] = pk_bf16(sacc[2 * q] * inv - __uint_as_float(cw[q] << 16), sacc[2 * q + 1] * inv - __uint_as_float(cw[q] & 0xffff0000u));
            *(uint4*)(DP + (size_t)r * 512 + ch) = make_uint4(o[0], o[1], o[2], o[3]);
        }
    }
    {
        bf16* VT = (bf16*)(p->ws + WS_VT);
        unsigned short* st = (unsigned short*)smf;
        for (int it = blockIdx.x; it < (NTOK / 64) * 2; it += gridDim.x) {
            const int rt = it >> 1, kvh = it & 1;
            int b, key0;
            if (rt < NL / 64) { b = rt / 64; key0 = (rt % 64) * 64; } else { const int j = rt - NL / 64; b = j / 4; key0 = T + (j % 4) * 64; }
            __syncthreads();
            {
                const int k = tid >> 2, dq = (tid & 3) * 16;
                const bf16* src = PROJ + (size_t)(rt * 64 + k) * INW + O_AV + kvh * 64 + dq;
                const uint4 a = *(const uint4*)src, c = *(const uint4*)(src + 8);
                unsigned* d = (unsigned*)(st + k * 66 + dq);
                d[0] = a.x; d[1] = a.y; d[2] = a.z; d[3] = a.w; d[4] = c.x; d[5] = c.y; d[6] = c.z; d[7] = c.w;
            }
            __syncthreads();
            {
                const int d = tid >> 2, kq = (tid & 3) * 16;
                unsigned w[8];
#pragma unroll
                for (int i = 0; i < 8; ++i) w[i] = (unsigned)st[(kq + 2 * i) * 66 + d] | ((unsigned)st[(kq + 2 * i + 1) * 66 + d] << 16);
                bf16* dst = VT + ((size_t)(b * 2 + kvh) * 64 + d) * NKEY + key0 + kq;
                *(uint4*)dst = make_uint4(w[0], w[1], w[2], w[3]);
                *(uint4*)(dst + 8) = make_uint4(w[4], w[5], w[6], w[7]);
            }
        }
    }
}

typedef float f32x16 __attribute__((ext_vector_type(16)));
typedef short s16x4 __attribute__((ext_vector_type(4)));
#define MFMA32(a, b, c) __builtin_amdgcn_mfma_f32_32x32x16_bf16((a), (b), (c), 0, 0, 0)
__device__ __forceinline__ bf16x8 pack8(const f32x16& x, int s) {
    typedef unsigned u32x4_t __attribute__((ext_vector_type(4)));
    u32x4_t r;
    r[0] = pk_bf16(x[8 * s + 0], x[8 * s + 1]); r[1] = pk_bf16(x[8 * s + 2], x[8 * s + 3]);
    r[2] = pk_bf16(x[8 * s + 4], x[8 * s + 5]); r[3] = pk_bf16(x[8 * s + 6], x[8 * s + 7]);
    return __builtin_bit_cast(bf16x8, r);
}
__device__ __forceinline__ void attn_item(KParams p, int l, int it, unsigned char* lds, const int tid_) {
    const int tid = tid_opaque();
    const int lane = tid & 63, wid = tid >> 6, r32 = lane & 31, h = lane >> 5;
    bf16* PROJ = (bf16*)(p->ws + WS_PROJ);
    const bf16* VT = (const bf16*)(p->ws + WS_VT);
    float mq = 0.f, mk = 0.f;
    for (int d = 0; d < 64; ++d) { mq = fmaxf(mq, fabsf(p->in[I_QNG][l * 64 + d])); mk = fmaxf(mk, fabsf(p->in[I_KNG][l * 64 + d])); }
    const float shift2 = 8.f * mq * mk * 1.4426950408889634f;
    const int srow = tid >> 3, sc = ((tid & 7) ^ ((tid >> 4) & 7)) * 8, sw = (r32 >> 1) & 7;
    const int nlat = NB * 8 * 16;
    {
        int b, head, qrow0, nkt, vkey0;
        const bool lat = it < nlat;
        if (lat) { b = it >> 7; head = (it >> 4) & 7; qrow0 = b * T + (it & 15) * 256; nkt = 68; vkey0 = 0; }
        else { const int j = it - nlat; b = j >> 3; head = j & 7; qrow0 = NL + b * CL; nkt = 4; vkey0 = T; }
        const int kvh = head >> 2;
        bf16x8 qf[2][4];
#pragma unroll
        for (int qb = 0; qb < 2; ++qb)
#pragma unroll
            for (int ks = 0; ks < 4; ++ks)
                qf[qb][ks] = *(const bf16x8*)(PROJ + (size_t)(qrow0 + wid * 64 + qb * 32 + r32) * INW + O_AQ + head * 64 + ks * 16 + h * 8);
        const bf16* vsrc[2];
#pragma unroll
        for (int j = 0; j < 2; ++j) vsrc[j] = VT + ((size_t)(b * 2 + kvh) * 64 + j * 32 + srow) * NKEY + vkey0 + sc;
        const bf16* kbase = PROJ + O_AK + kvh * 64 + sc;
        auto krow = [&](int kt, int r) { return lat ? (kt < 64 ? b * T + kt * 64 + r : NL + b * CL + (kt - 64) * 64 + r) : NL + b * CL + kt * 64 + r; };
        auto stage = [&](int kt, int buf) {
            unsigned char* base = lds + buf * 16384;
#pragma unroll
            for (int j = 0; j < 2; ++j) {
                __builtin_amdgcn_global_load_lds((const unsigned*)(kbase + (size_t)krow(kt, j * 32 + srow) * INW), (unsigned*)(base + j * 4096 + tid * 16), 16, 0, 0);
                __builtin_amdgcn_global_load_lds((const unsigned*)(vsrc[j] + kt * 64), (unsigned*)(base + 8192 + j * 4096 + tid * 16), 16, 0, 0);
            }
        };
        f32x16 o[2][2];
#pragma unroll
        for (int a = 0; a < 2; ++a)
#pragma unroll
            for (int c = 0; c < 2; ++c)
#pragma unroll
                for (int e = 0; e < 16; ++e) o[a][c][e] = 0.f;
        f32x16 lacc0, lacc1;
#pragma unroll
        for (int e = 0; e < 16; ++e) { lacc0[e] = 0.f; lacc1[e] = 0.f; }
        bf16x8 ones;
#pragma unroll
        for (int e = 0; e < 8; ++e) ones[e] = (r32 == 0) ? (short)0x3f80 : (short)0;
        stage(0, 0);
#pragma unroll 1
        for (int kt = 0; kt < nkt; ++kt) {
            asm volatile("s_waitcnt vmcnt(0)" ::: "memory");
            __syncthreads();
            if (kt + 1 < nkt) stage(kt + 1, (kt + 1) & 1);
            const unsigned char* kb_ = lds + (kt & 1) * 16384;
            const unsigned char* vb_ = kb_ + 8192;
            bf16x8 kf[2][4];
#pragma unroll
            for (int kb = 0; kb < 2; ++kb)
#pragma unroll
                for (int ks = 0; ks < 4; ++ks) kf[kb][ks] = *(const bf16x8*)(kb_ + (kb * 32 + r32) * 128 + (((2 * ks + h) ^ sw) * 16));
            __builtin_amdgcn_sched_barrier(0);
#pragma unroll
            for (int kb = 0; kb < 2; ++kb) {
                f32x16 s0, s1;
#pragma unroll
                for (int e = 0; e < 16; ++e) { s0[e] = -shift2; s1[e] = -shift2; }
#pragma unroll
                for (int ks = 0; ks < 4; ++ks) {
                    s0 = MFMA32(kf[kb][ks], qf[0][ks], s0);
                    s1 = MFMA32(kf[kb][ks], qf[1][ks], s1);
                }
                bf16x8 vf[2][2];
#pragma unroll
                for (int s2 = 0; s2 < 2; ++s2)
#pragma unroll
                    for (int db = 0; db < 2; ++db) {
                        const int ksv = kb * 2 + s2;
                        const unsigned char* vr = vb_ + (db * 32 + r32) * 128 + 8 * h;
                        const s16x4 lo = *(const s16x4*)(vr + (((2 * ksv) ^ sw) * 16));
                        const s16x4 hi = *(const s16x4*)(vr + (((2 * ksv + 1) ^ sw) * 16));
                        vf[s2][db] = __builtin_shufflevector(lo, hi, 0, 1, 2, 3, 4, 5, 6, 7);
                    }
                __builtin_amdgcn_sched_barrier(0);
#pragma unroll
                for (int e = 0; e < 16; ++e) { s0[e] = __builtin_amdgcn_exp2f(s0[e]); s1[e] = __builtin_amdgcn_exp2f(s1[e]); }
#pragma unroll
                for (int s2 = 0; s2 < 2; ++s2) {
                    const bf16x8 p0 = pack8(s0, s2), p1 = pack8(s1, s2);
                    lacc0 = MFMA32(ones, p0, lacc0);
                    lacc1 = MFMA32(ones, p1, lacc1);
#pragma unroll
                    for (int db = 0; db < 2; ++db) {
                        o[db][0] = MFMA32(vf[s2][db], p0, o[db][0]);
                        o[db][1] = MFMA32(vf[s2][db], p1, o[db][1]);
                    }
                }
            }
        }
        float l0 = lacc0[0], l1 = lacc1[0];
        l0 = __shfl(l0, r32); l1 = __shfl(l1, r32);
        const float i0 = 1.f / l0, i1 = 1.f / l1;
#pragma unroll
        for (int qb = 0; qb < 2; ++qb) {
            const float inv = qb ? i1 : i0;
            bf16* orow = PROJ + (size_t)(qrow0 + wid * 64 + qb * 32 + r32) * INW + O_AQ + head * 64;
#pragma unroll
            for (int db = 0; db < 2; ++db)
#pragma unroll
                for (int g = 0; g < 4; ++g)
                    st_bf4(orow + db * 32 + 8 * g + 4 * h, o[db][qb][4 * g] * inv, o[db][qb][4 * g + 1] * inv, o[db][qb][4 * g + 2] * inv, o[db][qb][4 * g + 3] * inv);
        }
    }
}

constexpr int GL_QS = 0, GL_KS = 8192, GL_KDT = 16384, GL_VT = 24576, GL_GLS = 40960, GL_TOT = 45056, GL_FIRST = 47104,
              GL_RAWQ = 47872, GL_RAWK = 56064, GL_RAWV = 64256;
constexpr size_t WS_DST = WS_H;
constexpr size_t WS_EBL = WS_LIST;
__device__ __forceinline__ int swz(int row, int byte) { return row * 128 + ((((byte >> 4) ^ (row >> 1)) & 7) << 4) + (byte & 15); }
__device__ __forceinline__ int gla_chunk_base(int b, int c) { return c < 4 ? NL + b * CL + c * 64 : b * T + (c - 4) * 64; }

__device__ __forceinline__ void gla_local_item(KParams p, int l, int item, unsigned char* lds, const int tid_) {
    const int tid = tid_opaque();
    const int lane = tid & 63, w = tid >> 6, r32 = lane & 31, h = lane >> 5;
    const int hd = item & 3, c = (item >> 2) % 68, b = (item >> 2) / 68;
    bf16* PROJ = (bf16*)(p->ws + WS_PROJ);
    const int base = gla_chunk_base(b, c);
    const int dk2 = (tid & 31) * 2, seg = tid >> 5;
    const int dv2 = (tid & 63) * 2, vq = tid >> 6;
    __syncthreads();
    {
#pragma unroll
        for (int j = 0; j < 2; ++j) {
            const size_t tok = base + j * 32 + (tid >> 3);
            __builtin_amdgcn_global_load_lds((const unsigned*)(PROJ + tok * INW + O_GQ + hd * 64 + (tid & 7) * 8), (unsigned*)(lds + GL_RAWQ + j * 4096 + tid * 16), 16, 0, 0);
            __builtin_amdgcn_global_load_lds((const unsigned*)(PROJ + tok * INW + O_GK + hd * 64 + (tid & 7) * 8), (unsigned*)(lds + GL_RAWK + j * 4096 + tid * 16), 16, 0, 0);
        }
#pragma unroll
        for (int j = 0; j < 4; ++j) {
            const size_t tok = base + j * 16 + (tid >> 4);
            __builtin_amdgcn_global_load_lds((const unsigned*)(PROJ + tok * INW + O_GV + hd * 128 + (tid & 15) * 8), (unsigned*)(lds + GL_RAWV + j * 4096 + tid * 16), 16, 0, 0);
        }
        {
            const int t2 = tid & 127; const size_t tok = base + (t2 >> 1);
            __builtin_amdgcn_global_load_lds((const unsigned*)(PROJ + tok * INW + (tid < 128 ? O_GLF : O_GLB) + (t2 & 1) * 8), (unsigned*)(lds + GL_GLS + tid * 16), 16, 0, 0);
        }
    }
#pragma unroll 1
    for (int dir = 0; dir < 2; ++dir) {
        const float* up = p->in[dir ? I_UPB : I_UPF] + (size_t)l * 16 * 256 + hd * 64;
        const float2 bia = *(const float2*)(p->in[dir ? I_BIASB : I_BIASF] + l * 256 + hd * 64 + dk2);
        const int id2 = (((b * 68 + c) * 4 + hd) << 1) + dir;
        asm volatile("s_waitcnt vmcnt(0)" ::: "memory");
        __syncthreads();
        float la0[8], la1[8];
        {
            float up0[16], up1[16];
#pragma unroll
            for (int j = 0; j < 16; ++j) { const float2 t = *(const float2*)(up + j * 256 + dk2); up0[j] = t.x; up1[j] = t.y; }
            const unsigned char* gls = lds + GL_GLS + dir * 2048;
#pragma unroll
            for (int u = 0; u < 8; ++u) {
                const int i = seg * 8 + u, ti = dir ? 63 - i : i;
                const uint4 g0 = *(const uint4*)(gls + ti * 32), g1 = *(const uint4*)(gls + ti * 32 + 16);
                const unsigned gw[8] = {g0.x, g0.y, g0.z, g0.w, g1.x, g1.y, g1.z, g1.w};
                float a0 = bia.x, a1 = bia.y;
#pragma unroll
                for (int j = 0; j < 8; ++j) {
                    const float glo = __uint_as_float(gw[j] << 16), ghi = __uint_as_float(gw[j] & 0xffff0000u);
                    a0 += glo * up0[2 * j]; a1 += glo * up1[2 * j];
                    a0 += ghi * up0[2 * j + 1]; a1 += ghi * up1[2 * j + 1];
                }
                la0[u] = (fminf(a0, 0.f) - __logf(1.f + __expf(-fabsf(a0)))) * (1.f / 16.f);
                la1[u] = (fminf(a1, 0.f) - __logf(1.f + __expf(-fabsf(a1)))) * (1.f / 16.f);
            }
#pragma unroll
            for (int u = 1; u < 8; ++u) { la0[u] += la0[u - 1]; la1[u] += la1[u - 1]; }
            *(float2*)(lds + GL_TOT + (seg * 64 + dk2) * 4) = make_float2(la0[7], la1[7]);
            if (seg == 4) *(float2*)(lds + GL_FIRST + dk2 * 4) = make_float2(la0[0], la1[0]);
        }
        __syncthreads();
        {
            float off0 = 0.f, off1 = 0.f, pre0 = 0.f, pre1 = 0.f, all0 = 0.f, all1 = 0.f;
#pragma unroll
            for (int sg = 0; sg < 8; ++sg) {
                const float2 t = *(const float2*)(lds + GL_TOT + (sg * 64 + dk2) * 4);
                if (sg < seg) { off0 += t.x; off1 += t.y; }
                if (sg < 4) { pre0 += t.x; pre1 += t.y; }
                all0 += t.x; all1 += t.y;
            }
            const float2 f4 = *(const float2*)(lds + GL_FIRST + dk2 * 4);
            const float bref0 = pre0 + f4.x, bref1 = pre1 + f4.y;
            const float c0 = __expf(all0 - bref0), c1 = __expf(all1 - bref1);
            const float er0 = __expf(bref0), er1 = __expf(bref1);
            bf16* qdst = PROJ + (size_t)base * INW + (dir ? O_GK : O_GQ) + hd * 64 + dk2;
            unsigned kd0[4], kd1[4];
#pragma unroll
            for (int u = 0; u < 8; u += 2) {
                float kdv[2][2];
#pragma unroll
                for (int uu = 0; uu < 2; ++uu) {
                    const int i = seg * 8 + u + uu, ti = dir ? 63 - i : i;
                    const float e0 = __expf(off0 + la0[u + uu] - bref0), e1 = __expf(off1 + la1[u + uu] - bref1);
                    const float r0 = __builtin_amdgcn_rcpf(e0), r1 = __builtin_amdgcn_rcpf(e1);
                    const unsigned rqv = *(const unsigned*)(lds + GL_RAWQ + ti * 128 + dk2 * 2), rkv = *(const unsigned*)(lds + GL_RAWK + ti * 128 + dk2 * 2);
                    const float q0 = __uint_as_float(rqv << 16) * 0.125f * e0, q1 = __uint_as_float(rqv & 0xffff0000u) * 0.125f * e1;
                    const float k0 = __uint_as_float(rkv << 16), k1 = __uint_as_float(rkv & 0xffff0000u);
                    const float ks0 = k0 * r0, ks1 = k1 * r1;
                    *(unsigned*)(lds + GL_QS + swz(i, dk2 * 2)) = pk_bf16(q0, q1);
                    *(unsigned*)(lds + GL_KS + swz(i, dk2 * 2)) = pk_bf16(ks0, ks1);
                    *(unsigned*)(qdst + (size_t)ti * INW) = pk_bf16(q0 * er0, q1 * er1);
                    kdv[uu][0] = ks0 * c0; kdv[uu][1] = ks1 * c1;
                }
                kd0[u >> 1] = pk_bf16(kdv[0][0], kdv[1][0]); kd1[u >> 1] = pk_bf16(kdv[0][1], kdv[1][1]);
            }
            *(uint4*)(lds + GL_KDT + swz(dk2, seg * 16)) = make_uint4(kd0[0], kd0[1], kd0[2], kd0[3]);
            *(uint4*)(lds + GL_KDT + swz(dk2 + 1, seg * 16)) = make_uint4(kd1[0], kd1[1], kd1[2], kd1[3]);
            unsigned va[8], vb[8], rv[16];
#pragma unroll
            for (int u = 0; u < 16; ++u) { const int i = vq * 16 + u, ti = dir ? 63 - i : i; rv[u] = *(const unsigned*)(lds + GL_RAWV + ti * 256 + dv2 * 2); }
#pragma unroll
            for (int m = 0; m < 8; ++m) { va[m] = (rv[2 * m] & 0xffffu) | (rv[2 * m + 1] << 16); vb[m] = (rv[2 * m] >> 16) | (rv[2 * m + 1] & 0xffff0000u); }
            *(uint4*)(lds + GL_VT + swz(dv2, vq * 32)) = make_uint4(va[0], va[1], va[2], va[3]);
            *(uint4*)(lds + GL_VT + swz(dv2, vq * 32 + 16)) = make_uint4(va[4], va[5], va[6], va[7]);
            *(uint4*)(lds + GL_VT + swz(dv2 + 1, vq * 32)) = make_uint4(vb[0], vb[1], vb[2], vb[3]);
            *(uint4*)(lds + GL_VT + swz(dv2 + 1, vq * 32 + 16)) = make_uint4(vb[4], vb[5], vb[6], vb[7]);
            if (seg == 0) *(float2*)((float*)(p->ws + WS_EBL) + (size_t)id2 * 64 + dk2) = make_float2(__expf(all0), __expf(all1));
        }
        __syncthreads();
        {
            const unsigned char* QS = lds + GL_QS; const unsigned char* KS = lds + GL_KS; const unsigned char* KDT = lds + GL_KDT; const unsigned char* VTL = lds + GL_VT;
            f32x16 ot[2];
#pragma unroll
            for (int e = 0; e < 16; ++e) { ot[0][e] = 0.f; ot[1][e] = 0.f; }
#pragma unroll
            for (int tI = 0; tI < 3; ++tI) {
                const int sb = tI == 2 ? 1 : 0, ib = tI == 0 ? 0 : 1;
                f32x16 pt;
#pragma unroll
                for (int e = 0; e < 16; ++e) pt[e] = 0.f;
#pragma unroll
                for (int ks = 0; ks < 4; ++ks) {
                    const bf16x8 kf = *(const bf16x8*)(KS + swz(32 * sb + r32, (2 * ks + h) * 16));
                    const bf16x8 qf = *(const bf16x8*)(QS + swz(32 * ib + r32, (2 * ks + h) * 16));
                    pt = MFMA32(kf, qf, pt);
                }
                if (sb == ib) {
#pragma unroll
                    for (int e = 0; e < 16; ++e) { const int sl = (e & 3) + 8 * (e >> 2) + 4 * h; if (sl > r32) pt[e] = 0.f; }
                }
#pragma unroll
                for (int s2 = 0; s2 < 2; ++s2) {
                    const int ksv = 2 * sb + s2, row = 32 * w + r32;
                    const s16x4 lo = *(const s16x4*)(VTL + swz(row, 32 * ksv + 8 * h));
                    const s16x4 hi = *(const s16x4*)(VTL + swz(row, 32 * ksv + 16 + 8 * h));
                    const bf16x8 vp = __builtin_shufflevector(lo, hi, 0, 1, 2, 3, 4, 5, 6, 7);
                    ot[ib] = MFMA32(vp, pack8(pt, s2), ot[ib]);
                }
            }
            bf16* OG = (bf16*)(p->ws + WS_R2 + (size_t)dir * SZ_Y512);
#pragma unroll
            for (int ib = 0; ib < 2; ++ib) {
                const int i = 32 * ib + r32; const size_t tok = base + (dir ? 63 - i : i);
                bf16* dst = OG + tok * 512 + hd * 128 + 32 * w + 4 * h;
#pragma unroll
                for (int g = 0; g < 4; ++g) st_bf4(dst + 8 * g, ot[ib][4 * g], ot[ib][4 * g + 1], ot[ib][4 * g + 2], ot[ib][4 * g + 3]);
            }
            f32x16 dS[2];
#pragma unroll
            for (int e = 0; e < 16; ++e) { dS[0][e] = 0.f; dS[1][e] = 0.f; }
#pragma unroll
            for (int ks = 0; ks < 4; ++ks) {
                const bf16x8 vn = *(const bf16x8*)(VTL + swz(32 * w + r32, (2 * ks + h) * 16));
#pragma unroll
                for (int dkb = 0; dkb < 2; ++dkb) {
                    const bf16x8 kd = *(const bf16x8*)(KDT + swz(32 * dkb + r32, (2 * ks + h) * 16));
                    dS[dkb] = MFMA32(kd, vn, dS[dkb]);
                }
            }
            bf16* dd = (bf16*)(p->ws + WS_DST) + (((size_t)id2 * 4 + w) * 64 + lane) * 32;
#pragma unroll
            for (int dkb = 0; dkb < 2; ++dkb)
#pragma unroll
                for (int g = 0; g < 2; ++g)
                    *(uint4*)(dd + dkb * 16 + g * 8) = make_uint4(pk_bf16(dS[dkb][8 * g], dS[dkb][8 * g + 1]), pk_bf16(dS[dkb][8 * g + 2], dS[dkb][8 * g + 3]),
                                                                  pk_bf16(dS[dkb][8 * g + 4], dS[dkb][8 * g + 5]), pk_bf16(dS[dkb][8 * g + 6], dS[dkb][8 * g + 7]));
        }
    }
}

__device__ __forceinline__ void gla_chain(KParams p, int l, int task, unsigned char* lds, const int tid_) {
    const int tid = tid_opaque();
    const int lane = tid & 63, w = tid >> 6, h = lane >> 5;
    const int b = task >> 3, hd = (task >> 1) & 3, dir = task & 1;
    bf16* DST = (bf16*)(p->ws + WS_DST);
    const float* EBL = (const float*)(p->ws + WS_EBL);
    f32x16 S[2];
#pragma unroll
    for (int e = 0; e < 16; ++e) { S[0][e] = 0.f; S[1][e] = 0.f; }
    auto id2_of = [&](int n) { const int c = n < 4 ? (dir ? 3 - n : n) : 4 + (dir ? 63 - (n - 4) : (n - 4)); return (size_t)((((b * 68 + c) * 4 + hd) << 1) + dir); };
    typedef unsigned u32x4_t __attribute__((ext_vector_type(4)));
    u32x4_t d0[4], d1[4], d2[4], d3[4];
    auto load_ds = [&](u32x4_t (&d)[4], int n) {
        const bf16* dd = DST + ((id2_of(n) * 4 + w) * 64 + lane) * 32;
#pragma unroll
        for (int q = 0; q < 4; ++q) d[q] = *(const u32x4_t*)(dd + q * 8);
    };
    load_ds(d0, 0); load_ds(d1, 1); load_ds(d2, 2); load_ds(d3, 3);
    __syncthreads();
    for (int n = w; n < 68; n += 4)
        __builtin_amdgcn_global_load_lds((const unsigned*)(EBL + id2_of(n) * 64 + lane), (unsigned*)(lds + n * 256 + lane * 4), 4, 0, 0);
    asm volatile("s_waitcnt vmcnt(0)" ::: "memory");
    __syncthreads();
    auto step = [&](u32x4_t (&d)[4], int n) {
        const size_t id2 = id2_of(n);
        float4 eb[2][4];
#pragma unroll
        for (int dkb = 0; dkb < 2; ++dkb)
#pragma unroll
            for (int g = 0; g < 4; ++g) eb[dkb][g] = *(const float4*)(lds + n * 256 + (32 * dkb + 8 * g + 4 * h) * 4);
        bf16* dd = DST + ((id2 * 4 + w) * 64 + lane) * 32;
#pragma unroll
        for (int dkb = 0; dkb < 2; ++dkb)
#pragma unroll
            for (int s2 = 0; s2 < 2; ++s2) *(bf16x8*)(dd + (dkb * 2 + s2) * 8) = pack8(S[dkb], s2);
        const unsigned dw[16] = {d[0][0], d[0][1], d[0][2], d[0][3], d[1][0], d[1][1], d[1][2], d[1][3], d[2][0], d[2][1], d[2][2], d[2][3], d[3][0], d[3][1], d[3][2], d[3][3]};
#pragma unroll
        for (int dkb = 0; dkb < 2; ++dkb)
#pragma unroll
            for (int g = 0; g < 4; ++g) {
                const float4 e = eb[dkb][g];
                const unsigned w0 = dw[dkb * 8 + g * 2], w1 = dw[dkb * 8 + g * 2 + 1];
                S[dkb][4 * g]     = S[dkb][4 * g] * e.x     + __uint_as_float(w0 << 16);
                S[dkb][4 * g + 1] = S[dkb][4 * g + 1] * e.y + __uint_as_float(w0 & 0xffff0000u);
                S[dkb][4 * g + 2] = S[dkb][4 * g + 2] * e.z + __uint_as_float(w1 << 16);
                S[dkb][4 * g + 3] = S[dkb][4 * g + 3] * e.w + __uint_as_float(w1 & 0xffff0000u);
            }
        if (n + 4 < 68) load_ds(d, n + 4);
    };
#pragma unroll 1
    for (int n = 0; n < 68; n += 4) { step(d0, n); step(d1, n + 1); step(d2, n + 2); step(d3, n + 3); }
}

__device__ __forceinline__ void gla_out_item(KParams p, int l, int item, unsigned char* lds, const int tid_) {
    const int tid = tid_opaque();
    const int lane = tid & 63, w = tid >> 6, r32 = lane & 31, h = lane >> 5;
    const int hd = item & 3, c = (item >> 2) % 68, b = (item >> 2) / 68;
    const bf16* PROJ = (const bf16*)(p->ws + WS_PROJ);
    const bf16* DST = (const bf16*)(p->ws + WS_DST);
    bf16* YG = (bf16*)(p->ws + WS_R2);
    const int base = gla_chunk_base(b, c);
    __syncthreads();
#pragma unroll
    for (int k = 0; k < 4; ++k) {
        const int id = k * 256 + tid, row = id >> 4, cc = (id & 15) ^ (row & 15);
        __builtin_amdgcn_global_load_lds((const unsigned*)(YG + (size_t)(base + row) * 512 + hd * 128 + cc * 8), (unsigned*)(lds + k * 4096 + tid * 16), 16, 0, 0);
        __builtin_amdgcn_global_load_lds((const unsigned*)((const bf16*)(p->ws + WS_R2 + SZ_Y512) + (size_t)(base + row) * 512 + hd * 128 + cc * 8), (unsigned*)(lds + 16384 + k * 4096 + tid * 16), 16, 0, 0);
        __builtin_amdgcn_global_load_lds((const unsigned*)(PROJ + (size_t)(base + row) * INW + O_GR + hd * 128 + cc * 8), (unsigned*)(lds + 32768 + k * 4096 + tid * 16), 16, 0, 0);
    }
#pragma unroll
    for (int k = 0; k < 2; ++k) {
        const int id = k * 256 + tid, row = id >> 3, cc = (id & 7) ^ ((row >> 1) & 7);
        __builtin_amdgcn_global_load_lds((const unsigned*)(PROJ + (size_t)(base + row) * INW + O_GQ + hd * 64 + cc * 8), (unsigned*)(lds + 49152 + k * 4096 + tid * 16), 16, 0, 0);
        __builtin_amdgcn_global_load_lds((const unsigned*)(PROJ + (size_t)(base + row) * INW + O_GK + hd * 64 + cc * 8), (unsigned*)(lds + 57344 + k * 4096 + tid * 16), 16, 0, 0);
    }
    bf16x8 sp[2][4];
#pragma unroll
    for (int dir = 0; dir < 2; ++dir) {
        const size_t id2 = (size_t)((((b * 68 + c) * 4 + hd) << 1) + dir);
        const bf16* dd = DST + ((id2 * 4 + w) * 64 + lane) * 32;
#pragma unroll
        for (int q = 0; q < 4; ++q) sp[dir][q] = *(const bf16x8*)(dd + q * 8);
    }
    asm volatile("s_waitcnt vmcnt(0)" ::: "memory");
    __syncthreads();
    f32x16 ot[2];
#pragma unroll
    for (int e = 0; e < 16; ++e) { ot[0][e] = 0.f; ot[1][e] = 0.f; }
#pragma unroll
    for (int dir = 0; dir < 2; ++dir)
#pragma unroll
        for (int ib = 0; ib < 2; ++ib) {
            const int row = 32 * ib + r32, sw = (row >> 1) & 7;
            const unsigned char* qr = lds + (dir ? 57344 : 49152) + row * 128 + 8 * h;
#pragma unroll
            for (int ksv = 0; ksv < 4; ++ksv) {
                const s16x4 lo = *(const s16x4*)(qr + (((2 * ksv) ^ sw) << 4)), hi = *(const s16x4*)(qr + (((2 * ksv + 1) ^ sw) << 4));
                const bf16x8 qp = __builtin_shufflevector(lo, hi, 0, 1, 2, 3, 4, 5, 6, 7);
                ot[ib] = MFMA32(sp[dir][ksv], qp, ot[ib]);
            }
        }
    float ssq[2]; uint2 grv[2][4];
#pragma unroll
    for (int ib = 0; ib < 2; ++ib) {
        const int row = 32 * ib + r32;
        float a = 0.f;
#pragma unroll
        for (int g = 0; g < 4; ++g) {
            const int off = row * 256 + ((((4 * w + g) ^ row) & 15) << 4) + 8 * h;
            const uint2 x0 = *(const uint2*)(lds + off), x1 = *(const uint2*)(lds + 16384 + off);
            grv[ib][g] = *(const uint2*)(lds + 32768 + off);
            ot[ib][4 * g]     += __uint_as_float(x0.x << 16) + __uint_as_float(x1.x << 16);
            ot[ib][4 * g + 1] += __uint_as_float(x0.x & 0xffff0000u) + __uint_as_float(x1.x & 0xffff0000u);
            ot[ib][4 * g + 2] += __uint_as_float(x0.y << 16) + __uint_as_float(x1.y << 16);
            ot[ib][4 * g + 3] += __uint_as_float(x0.y & 0xffff0000u) + __uint_as_float(x1.y & 0xffff0000u);
            a += ot[ib][4 * g] * ot[ib][4 * g] + ot[ib][4 * g + 1] * ot[ib][4 * g + 1] + ot[ib][4 * g + 2] * ot[ib][4 * g + 2] + ot[ib][4 * g + 3] * ot[ib][4 * g + 3];
        }
        a += __shfl_xor(a, 32);
        ssq[ib] = a;
    }
    float* red = (float*)(lds + 65536);
    if (h == 0) { red[w * 64 + r32] = ssq[0]; red[w * 64 + 32 + r32] = ssq[1]; }
    __syncthreads();
    const float* gn = p->in[I_GLANG] + l * 128 + 32 * w + 4 * h;
#pragma unroll
    for (int ib = 0; ib < 2; ++ib) {
        const int t = 32 * ib + r32;
        const float inv = rsqrtf((red[t] + red[64 + t] + red[128 + t] + red[192 + t]) * (1.f / 128.f) + EPS);
#pragma unroll
        for (int g = 0; g < 4; ++g) {
            const float4 gg = *(const float4*)(gn + 8 * g);
            const float r0 = __uint_as_float(grv[ib][g].x << 16), r1 = __uint_as_float(grv[ib][g].x & 0xffff0000u), r2 = __uint_as_float(grv[ib][g].y << 16), r3 = __uint_as_float(grv[ib][g].y & 0xffff0000u);
            *(uint2*)(lds + t * 256 + ((((4 * w + g) ^ t) & 15) << 4) + 8 * h) =
                make_uint2(pk_bf16(ot[ib][4 * g] * inv * gg.x * silu_f(r0), ot[ib][4 * g + 1] * inv * gg.y * silu_f(r1)),
                           pk_bf16(ot[ib][4 * g + 2] * inv * gg.z * silu_f(r2), ot[ib][4 * g + 3] * inv * gg.w * silu_f(r3)));
        }
    }
    __syncthreads();
#pragma unroll
    for (int k = 0; k < 4; ++k) {
        const int id = k * 256 + tid, row = id >> 4, ch = id & 15;
        *(uint4*)(YG + (size_t)(base + row) * 512 + hd * 128 + ch * 8) = *(const uint4*)(lds + row * 256 + (((ch ^ row) & 15) << 4));
    }
}
__device__ void ph_gla_out(KParams p, int l, unsigned char* lds) {
    const int tid = tid_opaque();
    const int nchunk = (l == 0) ? 68 : 64;
    for (int it = blockIdx.x; it < NB * nchunk * 4; it += gridDim.x) {
        const int hd = it & 3, q = it >> 2, bb = q / nchunk, cc = q % nchunk + (68 - nchunk);
        gla_out_item(p, l, ((bb * 68 + cc) << 2) + hd, lds, tid);
    }
}

__device__ void ph_gla_local(KParams p, int l, unsigned char* lds) {
    const int tid = tid_opaque();
    for (int it = blockIdx.x; it < NB * 68 * 4; it += gridDim.x) gla_local_item(p, l, it, lds, tid);
    __syncthreads();
}

constexpr int CW_WORK = 64;
constexpr int LDS_ITEM_OFF = 79 * 1024;
__device__ void ph_mix(KParams p, int l, unsigned char* lds) {
    const int tid = tid_opaque();
    unsigned* ctr = (unsigned*)(p->ws + WS_CTL) + CW_WORK + l;
    volatile int* slot = (volatile int*)(lds + LDS_ITEM_OFF);
    const int nitems = 64 + NB * 8 * 16 + ((l == 0) ? NB * 8 : 0);
    for (;;) {
        __syncthreads();
        if (tid == 0) *slot = (int)__hip_atomic_fetch_add(ctr, 1u, __ATOMIC_RELAXED, __HIP_MEMORY_SCOPE_AGENT);
        __syncthreads();
        const int it = *slot;
        if (it >= nitems) break;
        if (it < 64) gla_chain(p, l, it, lds, tid);
        else attn_item(p, l, it - 64, lds, tid);
    }
}

__device__ void ph_ygla(KParams p, int l) {
    const int tid = tid_opaque(), lane = tid & 63, gw = blockIdx.x * 4 + (tid >> 6), ngw = gridDim.x * 4;
    bf16* O0 = (bf16*)(p->ws + WS_R2);
    const bf16* O1 = (const bf16*)(p->ws + WS_R2 + SZ_Y512);
    const bf16* PROJ = (const bf16*)(p->ws + WS_PROJ);
    const int nrows = (l == 0) ? NTOK : NL;
    const int c = lane * 8;
    const float4 g0 = *(const float4*)(p->in[I_GLANG] + l * 128 + (c & 127)), g1 = *(const float4*)(p->in[I_GLANG] + l * 128 + (c & 127) + 4);
    const float g[8] = {g0.x, g0.y, g0.z, g0.w, g1.x, g1.y, g1.z, g1.w};
    for (int r0 = gw * 4; r0 < nrows; r0 += ngw * 4) {
        uint4 a[4], b[4], gr[4];
#pragma unroll
        for (int q = 0; q < 4; ++q) {
            a[q] = *(const uint4*)(O0 + (size_t)(r0 + q) * 512 + c); b[q] = *(const uint4*)(O1 + (size_t)(r0 + q) * 512 + c);
            gr[q] = *(const uint4*)(PROJ + (size_t)(r0 + q) * INW + O_GR + c);
        }
#pragma unroll
        for (int q = 0; q < 4; ++q) {
            const unsigned aw[4] = {a[q].x, a[q].y, a[q].z, a[q].w}, bw[4] = {b[q].x, b[q].y, b[q].z, b[q].w}, gw_[4] = {gr[q].x, gr[q].y, gr[q].z, gr[q].w};
            float v[8], grf[8];
#pragma unroll
            for (int e = 0; e < 4; ++e) {
                v[2 * e] = __uint_as_float(aw[e] << 16) + __uint_as_float(bw[e] << 16);
                v[2 * e + 1] = __uint_as_float(aw[e] & 0xffff0000u) + __uint_as_float(bw[e] & 0xffff0000u);
                grf[2 * e] = __uint_as_float(gw_[e] << 16); grf[2 * e + 1] = __uint_as_float(gw_[e] & 0xffff0000u);
            }
            float ss = 0.f;
#pragma unroll
            for (int e = 0; e < 8; ++e) ss += v[e] * v[e];
            ss += __shfl_xor(ss, 1); ss += __shfl_xor(ss, 2); ss += __shfl_xor(ss, 4); ss += __shfl_xor(ss, 8);
            const float inv = rsqrtf(ss * (1.f / 128.f) + EPS);
            unsigned o[4];
#pragma unroll
            for (int e = 0; e < 4; ++e) o[e] = pk_bf16(v[2 * e] * inv * g[2 * e] * silu_f(grf[2 * e]), v[2 * e + 1] * inv * g[2 * e + 1] * silu_f(grf[2 * e + 1]));
            *(uint4*)(O0 + (size_t)(r0 + q) * 512 + c) = make_uint4(o[0], o[1], o[2], o[3]);
        }
    }
}

__device__ void ph_merge(KParams p, int l, unsigned char* lds) {
    const bf16* PROJ = (const bf16*)(p->ws + WS_PROJ);
    const bf16* YG = (const bf16*)(p->ws + WS_R2);
    const bf16* DP = (const bf16*)(p->ws + WS_R2 + 2 * SZ_Y512);
    bf16* Z = (bf16*)(p->ws + WS_H);
    const int nrows = (l == 0) ? NTOK : NL, nM = nrows / 128, nN = 8, G = gridDim.x;
    const int tid = tid_opaque(), lane = tid & 63, wid = tid >> 6, wr = wid >> 1, wc = wid & 1, fr = lane & 15, fq = lane >> 4;
    const bf16* WT0 = wsm_bt(p, l, 0);
    auto issue = [&](int it_, int br_) {
        int tm_, tn_; tile_coords(it_, nM, nN, tm_, tn_);
        const bf16* Ab_ = br_ == 0 ? YG : (br_ == 1 ? PROJ + O_AQ : DP);
        const size_t lda_ = br_ == 1 ? (size_t)INW : (size_t)512;
        const bf16* W_ = WT0 + (size_t)br_ * (SZ_WBT / 2);
        gemm_issue0([&](int r) { return Ab_ + (size_t)(tm_ * 128 + r) * lda_; }, [&](int r) { return W_ + (size_t)(tn_ * 128 + r) * 512; }, lds, tid);
    };
    const TileQ tq{(unsigned*)(p->ws + WS_CTL) + CW_TQ + (l * 5 + 1) * 512, nM * nN};
    volatile int* slot = (volatile int*)(lds + LDS_TQ_OFF);
    __syncthreads();
    if (tid == 0) slot[0] = tq_next(tq);
    __syncthreads();
    int it = slot[0];
    if (it >= 0) issue(it, 0);
    for (int n_ = 0; it >= 0; ++n_) {
        if (tid == 0) slot[(n_ + 1) & 1] = tq_next(tq);
        int tm, tn; tile_coords(it, nM, nN, tm, tn);
        f32x4 acc[4][4]; zero_acc4(acc);
        uint2 ga[4][4], gb[4][4];
        const bf16* gbase = PROJ + (size_t)(tm * 128 + wr * 64 + fr) * INW + O_GT + tn * 128 + wc * 64 + fq * 4;
#pragma unroll
        for (int i = 0; i < 4; ++i)
#pragma unroll
            for (int j = 0; j < 4; ++j) ga[i][j] = *(const uint2*)(gbase + (size_t)i * 16 * INW + j * 16);
#pragma unroll 1
        for (int br = 0; br < 3; ++br) {
            const bf16* WT = WT0 + (size_t)br * (SZ_WBT / 2);
            const bf16* Ab = br == 0 ? YG : (br == 1 ? PROJ + O_AQ : DP);
            const size_t lda = br == 1 ? (size_t)INW : (size_t)512;
            if (br < 2) {
#pragma unroll
                for (int i = 0; i < 4; ++i)
#pragma unroll
                    for (int j = 0; j < 4; ++j) gb[i][j] = *(const uint2*)(gbase + (size_t)i * 16 * INW + (br + 1) * D + j * 16);
            }
            gemm_tile<true, true>(acc, [&](int r) { return Ab + (size_t)(tm * 128 + r) * lda; }, [&](int r) { return WT + (size_t)(tn * 128 + r) * 512; }, 512, lds, tid,
                      [&]() { if (br < 2) issue(it, br + 1); else { const int nx = slot[(n_ + 1) & 1]; if (nx >= 0) issue(nx, 0); } });
#pragma unroll
            for (int i = 0; i < 4; ++i)
#pragma unroll
                for (int j = 0; j < 4; ++j) {
                    const float a0 = __uint_as_float(ga[i][j].x << 16), a1 = __uint_as_float(ga[i][j].x & 0xffff0000u), a2 = __uint_as_float(ga[i][j].y << 16), a3 = __uint_as_float(ga[i][j].y & 0xffff0000u);
                    float r0 = sigmoid_f(a0), r1 = sigmoid_f(a1), r2 = sigmoid_f(a2), r3 = sigmoid_f(a3);
                    if (br < 2) {
                        const float b0 = __uint_as_float(gb[i][j].x << 16), b1 = __uint_as_float(gb[i][j].x & 0xffff0000u), b2 = __uint_as_float(gb[i][j].y << 16), b3 = __uint_as_float(gb[i][j].y & 0xffff0000u);
                        r0 *= 1.f + __expf(-b0); r1 *= 1.f + __expf(-b1); r2 *= 1.f + __expf(-b2); r3 *= 1.f + __expf(-b3);
                    }
                    acc[i][j][0] *= r0; acc[i][j][1] *= r1; acc[i][j][2] *= r2; acc[i][j][3] *= r3;
                    ga[i][j] = gb[i][j];
                }
        }
#pragma unroll
        for (int i = 0; i < 4; ++i)
#pragma unroll
            for (int j = 0; j < 4; ++j) {
                const int row = tm * 128 + wr * 64 + i * 16 + fr, col = tn * 128 + wc * 64 + j * 16 + fq * 4;
                st_bf4(Z + (size_t)row * D + col, acc[i][j][0], acc[i][j][1], acc[i][j][2], acc[i][j][3]);
            }
        it = slot[(n_ + 1) & 1];
    }
}

__device__ void ph_outproj(KParams p, int l, unsigned char* lds) {
    const bf16* Z = (const bf16*)(p->ws + WS_H);
    const bf16* WT = wsm_outt(p, l);
    const int nrows = (l == 0) ? NTOK : NL, nM = nrows / 128, nN = 8, G = gridDim.x;
    const int tid = tid_opaque(), lane = tid & 63, wid = tid >> 6, wr = wid >> 1, wc = wid & 1, fr = lane & 15, fq = lane >> 4;
    auto issue = [&](int it_) { int tm_, tn_; tile_coords(it_, nM, nN, tm_, tn_);
        gemm_issue0([&](int r) { return Z + (size_t)(tm_ * 128 + r) * D; }, [&](int r) { return WT + (size_t)(tn_ * 128 + r) * D; }, lds, tid); };
    const TileQ tq{(unsigned*)(p->ws + WS_CTL) + CW_TQ + (l * 5 + 2) * 512, nM * nN};
    volatile int* slot = (volatile int*)(lds + LDS_TQ_OFF);
    __syncthreads();
    if (tid == 0) slot[0] = tq_next(tq);
    __syncthreads();
    int it = slot[0];
    if (it >= 0) issue(it);
    for (int n_ = 0; it >= 0; ++n_) {
        if (tid == 0) slot[(n_ + 1) & 1] = tq_next(tq);
        int tm, tn; tile_coords(it, nM, nN, tm, tn);
        float4 xo[4][4];
#pragma unroll
        for (int i = 0; i < 4; ++i) {
            const float* xr = xrow(p, l, tm * 128 + wr * 64 + i * 16 + fr);
#pragma unroll
            for (int j = 0; j < 4; ++j) xo[i][j] = *(const float4*)(xr + tn * 128 + wc * 64 + j * 16 + fq * 4);
        }
        f32x4 acc[4][4]; zero_acc4(acc);
        gemm_tile<true, false>(acc, [&](int r) { return Z + (size_t)(tm * 128 + r) * D; }, [&](int r) { return WT + (size_t)(tn * 128 + r) * D; }, D, lds, tid,
                  [&]() { const int nx = slot[(n_ + 1) & 1]; if (nx >= 0) issue(nx); });
#pragma unroll
        for (int i = 0; i < 4; ++i) {
            const int r = tm * 128 + wr * 64 + i * 16 + fr;
            const float* g1 = modv(p, l, modrow(r), 2);
            float* dr = r < NL ? p->out + (size_t)r * D : (float*)(p->ws + WS_XC) + (size_t)(r - NL) * D;
#pragma unroll
            for (int j = 0; j < 4; ++j) {
                const int c = tn * 128 + wc * 64 + j * 16 + fq * 4;
                const float4 gg = *(const float4*)(g1 + c);
                *(float4*)(dr + c) = make_float4(xo[i][j].x + gg.x * acc[i][j][0], xo[i][j].y + gg.y * acc[i][j][1], xo[i][j].z + gg.z * acc[i][j][2], xo[i][j].w + gg.w * acc[i][j][3]);
            }
        }
        it = slot[(n_ + 1) & 1];
    }
}

__device__ __forceinline__ const float* x1row(KParams p, int r) {
    return r < NL ? p->out + (size_t)r * D : (const float*)(p->ws + WS_XC) + (size_t)(r - NL) * D;
}
__device__ void ph_router(KParams p, int l, unsigned char* lds) {
    const int tid = tid_opaque(), lane = tid & 63, wid = tid >> 6;
    bf16* H = (bf16*)(p->ws + WS_H);
    const float* g = p->in[I_N2G] + l * D;
    const float* wt_ = (const float*)(p->ws + WS_RWT) + (size_t)l * 36 * D;
    unsigned* cnt = (unsigned*)(p->ws + WS_CTL) + CNT_BASE + l * 32 * CNT_STRIDE;
    int* list = (int*)(p->ws + WS_LIST);
    float* wt = (float*)(p->ws + WS_WT);
    const int nrows = (l == 0) ? NTOK : NL, ngrp = nrows / 16;
    float* LG = (float*)(lds + 65536) + wid * 4 * 40;
    const int myidx = (int)(__builtin_bitreverse32((unsigned)(lane & 31)) >> 27);
    auto issue_chunk = [&](int c, int buf) {
#pragma unroll
        for (int j = 0; j < 8; ++j)
            __builtin_amdgcn_global_load_lds((const unsigned*)(wt_ + (size_t)c * 8 * D + j * 1024 + tid * 4), (unsigned*)(lds + buf * 32768 + j * 4096 + tid * 16), 16, 0, 0);
    };
    __syncthreads();
    if ((int)blockIdx.x < ngrp) issue_chunk(0, 0);
    int kk = 0;
    for (int gi = blockIdx.x; gi < ngrp; gi += gridDim.x) {
        const int r0 = gi * 16 + wid * 4;
        float hv[4][16];
        {
            float4 xv[4][4];
#pragma unroll
            for (int q = 0; q < 4; ++q) {
                const float* x = x1row(p, r0 + q);
#pragma unroll
                for (int j = 0; j < 4; ++j) xv[q][j] = *(const float4*)(x + j * 256 + lane * 4);
            }
            float inv[4];
#pragma unroll
            for (int q = 0; q < 4; ++q) {
                float ss = 0.f;
#pragma unroll
                for (int j = 0; j < 4; ++j) ss += xv[q][j].x * xv[q][j].x + xv[q][j].y * xv[q][j].y + xv[q][j].z * xv[q][j].z + xv[q][j].w * xv[q][j].w;
                inv[q] = ss;
            }
#pragma unroll
            for (int o = 1; o < 64; o <<= 1) {
#pragma unroll
                for (int q = 0; q < 4; ++q) inv[q] += __shfl_xor(inv[q], o);
            }
#pragma unroll
            for (int q = 0; q < 4; ++q) {
                const int r = r0 + q, mb = modrow(r);
                const float iv = rsqrtf(inv[q] * (1.f / D) + EPS);
                const float* sh = modv(p, l, mb, 3); const float* sc = modv(p, l, mb, 4);
#pragma unroll
                for (int j = 0; j < 4; ++j) {
                    const int c = j * 256 + lane * 4;
                    const float4 gg = *(const float4*)(g + c), s1 = *(const float4*)(sh + c), s2 = *(const float4*)(sc + c);
                    hv[q][j * 4 + 0] = xv[q][j].x * iv * gg.x * (1.f + s2.x) + s1.x; hv[q][j * 4 + 1] = xv[q][j].y * iv * gg.y * (1.f + s2.y) + s1.y;
                    hv[q][j * 4 + 2] = xv[q][j].z * iv * gg.z * (1.f + s2.z) + s1.z; hv[q][j * 4 + 3] = xv[q][j].w * iv * gg.w * (1.f + s2.w) + s1.w;
                }
            }
#pragma unroll
            for (int q = 0; q < 4; ++q)
#pragma unroll
                for (int j = 0; j < 4; ++j)
                    st_bf4(H + (size_t)(r0 + q) * D + j * 256 + lane * 4, hv[q][j * 4], hv[q][j * 4 + 1], hv[q][j * 4 + 2], hv[q][j * 4 + 3]);
        }
#pragma unroll 1
        for (int c = 0; c < 5; ++c) {
            asm volatile("s_waitcnt vmcnt(0)" ::: "memory");
            __syncthreads();
            issue_chunk(c == 4 ? 0 : c + 1, (kk + 1) & 1);
            const unsigned char* wb = lds + (kk & 1) * 32768;
            ++kk;
            float v[32];
#pragma unroll
            for (int e = 0; e < 32; ++e) v[e] = 0.f;
#pragma unroll
            for (int oo = 0; oo < 8; ++oo)
#pragma unroll
                for (int j = 0; j < 4; ++j) {
                    const float4 w = *(const float4*)(wb + oo * 4096 + j * 1024 + lane * 16);
#pragma unroll
                    for (int q = 0; q < 4; ++q) v[oo * 4 + q] += hv[q][j * 4] * w.x + hv[q][j * 4 + 1] * w.y + hv[q][j * 4 + 2] * w.z + hv[q][j * 4 + 3] * w.w;
                }
#pragma unroll
            for (int st = 0; st < 5; ++st) {
                const int n = 16 >> st;
                const bool up = (lane >> st) & 1;
#pragma unroll
                for (int i = 0; i < n; ++i) {
                    const float keep = up ? v[i + n] : v[i], send = up ? v[i] : v[i + n];
                    v[i] = keep + __shfl_xor(send, 1 << st);
                }
            }
            const float val = v[0] + __shfl_xor(v[0], 32);
            const int o = c * 8 + (myidx >> 2);
            if (lane < 32 && o < 36) LG[(myidx & 3) * 40 + o] = val;
        }
        __syncthreads();
        if (lane < 4) {
            const float* lgq = LG + lane * 40;
            float lg[4];
#pragma unroll
            for (int z = 0; z < 4; ++z) lg[z] = lgq[z] + p->in[I_BGRP][l * 4 + z];
            float gmax = lg[0]; int grp = 0;
#pragma unroll
            for (int z = 1; z < 4; ++z) if (lg[z] > gmax) { gmax = lg[z]; grp = z; }
            float gden = 0.f;
#pragma unroll
            for (int z = 0; z < 4; ++z) gden += __expf(lg[z] - gmax);
            const float ptg = 1.f / gden;
            float le[8];
#pragma unroll
            for (int z = 0; z < 8; ++z) le[z] = lgq[4 + grp * 8 + z] + p->in[I_BEXP][l * 32 + grp * 8 + z];
            int i1 = 0; float m1 = le[0];
#pragma unroll
            for (int z = 1; z < 8; ++z) if (le[z] > m1) { m1 = le[z]; i1 = z; }
            int i2 = -1; float m2 = -3.0e38f;
#pragma unroll
            for (int z = 0; z < 8; ++z) if (z != i1 && le[z] > m2) { m2 = le[z]; i2 = z; }
            const float e2 = __expf(m2 - m1);
            const float w1 = ptg / (1.f + e2), w2 = ptg * e2 / (1.f + e2);
            const int r = r0 + lane, ea = grp * 8 + i1, eb = grp * 8 + i2;
            const unsigned pa = atomicAdd(&cnt[ea * CNT_STRIDE], 1u); list[(size_t)ea * NTOK + pa] = r * 2;
            const unsigned pb = atomicAdd(&cnt[eb * CNT_STRIDE], 1u); list[(size_t)eb * NTOK + pb] = r * 2 + 1;
            wt[r * 2] = w1; wt[r * 2 + 1] = w2;
        }
    }
    asm volatile("s_waitcnt vmcnt(0)" ::: "memory");
    __syncthreads();
}

__device__ void ph_convmoe(KParams p, int l, float* sm) {
    const int tid = tid_opaque();
    bf16* WGU = (bf16*)(p->ws + WS_WGU);
    bf16* WDT = (bf16*)(p->ws + WS_WDT);
    conv_stream([&](int it) {
        const int e = it / 384, r = it % 384, kind = r >> 7, q = r & 127;
        ConvItem c;
        if (kind < 2) {
            c.src = p->in[kind == 0 ? I_WGATE : I_WUP] + ((size_t)(l * 32 + e) * D) * 512; c.dst = WGU + (size_t)e * D * D; c.ldsrc = 512; c.nvalid = 512;
            c.k0 = (q >> 3) * 64; c.n0 = (q & 7) * 64; c.lddst = D; c.kind = 2 + kind;
        } else {
            c.src = p->in[I_WDOWN] + ((size_t)(l * 32 + e) * 512) * D; c.dst = WDT + (size_t)e * D * 512; c.ldsrc = D; c.nvalid = D;
            c.k0 = (q >> 4) * 64; c.n0 = (q & 15) * 64; c.lddst = 512; c.kind = 0;
        }
        return c;
    }, 32 * 384, (unsigned char*)sm, tid);
}

constexpr int LDS_MOE_TAB = 65536;
__device__ __forceinline__ int moe_build_table(const unsigned* cnt, unsigned char* lds, const int tid) {
    int* TS = (int*)(lds + LDS_MOE_TAB); int* CN = TS + 40;
    __syncthreads();
    if (tid < 32) CN[tid] = (int)cnt[tid * CNT_STRIDE];
    __syncthreads();
    if (tid == 0) { int acc = 0; for (int q = 0; q < 32; ++q) { TS[q] = acc; acc += (CN[q] + 127) >> 7; } TS[32] = acc; }
    __syncthreads();
    return TS[32];
}
__device__ __forceinline__ void moe_tile_lookup(const unsigned char* lds, int trow, int& e, int& i0, int& ce) {
    const int* TS = (const int*)(lds + LDS_MOE_TAB); const int* CN = TS + 40;
    int lo = 0;
#pragma unroll
    for (int step = 16; step >= 1; step >>= 1) if (TS[lo + step] <= trow) lo += step;
    e = lo; i0 = (trow - TS[lo]) * 128; ce = CN[lo];
}

__device__ void ph_moe1(KParams p, int l, unsigned char* lds) {
    const bf16* H = (const bf16*)(p->ws + WS_H);
    bf16* ACT = (bf16*)(p->ws + WS_ACT);
    const bf16* WGU = (const bf16*)(p->ws + WS_WGU);
    const unsigned* cnt = (const unsigned*)(p->ws + WS_CTL) + CNT_BASE + l * 32 * CNT_STRIDE;
    const int* list = (const int*)(p->ws + WS_LIST);
    const int tid = tid_opaque(), lane = tid & 63, wid = tid >> 6, wr = wid >> 1, wc = wid & 1, fr = lane & 15, fq = lane >> 4;
    const int ntiles = moe_build_table(cnt, lds, tid), G = gridDim.x;
    auto issue = [&](int it_) {
        int e_, i0_, ce_; moe_tile_lookup(lds, it_ >> 3, e_, i0_, ce_);
        const int* le_ = list + (size_t)e_ * NTOK; const bf16* W_ = WGU + (size_t)e_ * D * D + (size_t)(it_ & 7) * 128 * D;
        gemm_issue0([&](int r) { const int ii = min(i0_ + r, ce_ - 1); return H + (size_t)(le_[ii] >> 1) * D; }, [&](int r) { return W_ + (size_t)r * D; }, lds, tid);
    };
    const TileQ tq{(unsigned*)(p->ws + WS_CTL) + CW_TQ + (l * 5 + 3) * 512, ntiles * 8};
    volatile int* slot = (volatile int*)(lds + LDS_TQ_OFF);
    __syncthreads();
    if (tid == 0) slot[0] = tq_next(tq);
    __syncthreads();
    int it = slot[0];
    if (it >= 0) issue(it);
    for (int n_ = 0; it >= 0; ++n_) {
        if (tid == 0) slot[(n_ + 1) & 1] = tq_next(tq);
        const int trow = it >> 3, tn = it & 7;
        int e, i0, ce; moe_tile_lookup(lds, trow, e, i0, ce);
        const int* le = list + (size_t)e * NTOK;
        const bf16* WT = WGU + (size_t)e * D * D;
        f32x4 acc[4][4]; zero_acc4(acc);
        gemm_tile<false, false>(acc, [&](int r) { const int ii = min(i0 + r, ce - 1); return H + (size_t)(le[ii] >> 1) * D; },
                  [&](int r) { return WT + (size_t)(tn * 128 + r) * D; }, D, lds, tid, [&]() { const int nx = slot[(n_ + 1) & 1]; if (nx >= 0) issue(nx); });
        __syncthreads();
#pragma unroll
        for (int i = 0; i < 4; ++i)
#pragma unroll
            for (int jp = 0; jp < 2; ++jp) {
                const f32x4 g = acc[i][2 * jp], u = acc[i][2 * jp + 1];
                stg_put<8>(lds, wr * 64 + i * 16 + fr, (wc * 32 + jp * 16 + fq * 4) * 2, pk_bf16(silu_f(g[0]) * u[0], silu_f(g[1]) * u[1]), pk_bf16(silu_f(g[2]) * u[2], silu_f(g[3]) * u[3]));
            }
        __syncthreads();
        stg_flush<8>(lds, tid, [&](int row, int ch) -> bf16* { const int ii = i0 + row; return ii < ce ? ACT + (size_t)le[ii] * 512 + tn * 64 + ch * 8 : nullptr; });
        it = slot[(n_ + 1) & 1];
    }
}

__device__ void ph_moe2(KParams p, int l, unsigned char* lds) {
    const bf16* ACT = (const bf16*)(p->ws + WS_ACT);
    const bf16* WDT = (const bf16*)(p->ws + WS_WDT);
    const unsigned* cnt = (const unsigned*)(p->ws + WS_CTL) + CNT_BASE + l * 32 * CNT_STRIDE;
    const int* list = (const int*)(p->ws + WS_LIST);
    const float* wt = (const float*)(p->ws + WS_WT);
    const int tid = tid_opaque(), lane = tid & 63, wid = tid >> 6, wr = wid >> 1, wc = wid & 1, fr = lane & 15, fq = lane >> 4;
    const int ntiles = moe_build_table(cnt, lds, tid), G = gridDim.x;
    auto issue = [&](int it_) {
        int e_, i0_, ce_; moe_tile_lookup(lds, it_ >> 3, e_, i0_, ce_);
        const int* le_ = list + (size_t)e_ * NTOK; const bf16* W_ = WDT + (size_t)e_ * D * 512 + (size_t)(it_ & 7) * 128 * 512;
        gemm_issue0([&](int r) { const int ii = min(i0_ + r, ce_ - 1); return ACT + (size_t)le_[ii] * 512; }, [&](int r) { return W_ + (size_t)r * 512; }, lds, tid);
    };
    const TileQ tq{(unsigned*)(p->ws + WS_CTL) + CW_TQ + (l * 5 + 4) * 512, ntiles * 8};
    volatile int* slot = (volatile int*)(lds + LDS_TQ_OFF);
    __syncthreads();
    if (tid == 0) slot[0] = tq_next(tq);
    __syncthreads();
    int it = slot[0];
    if (it >= 0) issue(it);
    for (int n_ = 0; it >= 0; ++n_) {
        if (tid == 0) slot[(n_ + 1) & 1] = tq_next(tq);
        const int trow = it >> 3, tn = it & 7;
        int e, i0, ce; moe_tile_lookup(lds, trow, e, i0, ce);
        const int* le = list + (size_t)e * NTOK;
        const bf16* WT = WDT + (size_t)e * D * 512;
        int asg[4]; float wv[4];
#pragma unroll
        for (int i = 0; i < 4; ++i) { asg[i] = le[min(i0 + wr * 64 + i * 16 + fr, ce - 1)]; wv[i] = wt[asg[i]]; }
        f32x4 acc[4][4]; zero_acc4(acc);
        gemm_tile<false, false>(acc, [&](int r) { const int ii = min(i0 + r, ce - 1); return ACT + (size_t)le[ii] * 512; },
                  [&](int r) { return WT + (size_t)(tn * 128 + r) * 512; }, 512, lds, tid, [&]() { const int nx = slot[(n_ + 1) & 1]; if (nx >= 0) issue(nx); });
        __syncthreads();
#pragma unroll
        for (int i = 0; i < 4; ++i) {
            const float w = wv[i];
#pragma unroll
            for (int j = 0; j < 4; ++j)
                stg_put<16>(lds, wr * 64 + i * 16 + fr, (wc * 64 + j * 16 + fq * 4) * 2, pk_bf16(w * acc[i][j][0], w * acc[i][j][1]), pk_bf16(w * acc[i][j][2], w * acc[i][j][3]));
        }
        __syncthreads();
        stg_flush<16>(lds, tid, [&](int row, int ch) -> bf16* {
            const int ii = i0 + row; if (ii >= ce) return nullptr;
            const int a = le[ii]; return (bf16*)(p->ws + ((a & 1) ? WS_Y1 : WS_Y0)) + (size_t)(a >> 1) * D + tn * 128 + ch * 8; });
        it = slot[(n_ + 1) & 1];
    }
}

__device__ void ph_combine(KParams p, int l) {
    const int tid = tid_opaque(), lane = tid & 63, gw = blockIdx.x * 4 + (tid >> 6), ngw = gridDim.x * 4;
    const bf16* Y0 = (const bf16*)(p->ws + WS_Y0);
    const bf16* Y1 = (const bf16*)(p->ws + WS_Y1);
    bf16* H = (bf16*)(p->ws + WS_H);
    const int nrows = (l == 0) ? NTOK : NL;
    const float* ng = (l == 0) ? p->in[I_N1G] + D : p->in[I_FING];
    for (int r0 = gw * 2; r0 < nrows; r0 += ngw * 2) {
        float4 xv[2][4]; uint2 ya[2][4], yb[2][4];
#pragma unroll
        for (int q = 0; q < 2; ++q) {
            const int r = r0 + q;
            const float* x = x1row(p, r);
#pragma unroll
            for (int j = 0; j < 4; ++j) {
                const int c = j * 256 + lane * 4;
                xv[q][j] = *(const float4*)(x + c); ya[q][j] = *(const uint2*)(Y0 + (size_t)r * D + c); yb[q][j] = *(const uint2*)(Y1 + (size_t)r * D + c);
            }
        }
#pragma unroll
        for (int q = 0; q < 2; ++q) {
            const int r = r0 + q, mb = modrow(r);
            float* xo = r < NL ? p->out + (size_t)r * D : (float*)(p->ws + WS_XC) + (size_t)(r - NL) * D;
            const float* g2 = modv(p, l, mb, 5);
            float4 v[4]; float ss = 0.f;
#pragma unroll
            for (int j = 0; j < 4; ++j) {
                const int c = j * 256 + lane * 4;
                const float4 gg = *(const float4*)(g2 + c);
                const float a0 = __uint_as_float(ya[q][j].x << 16) + __uint_as_float(yb[q][j].x << 16), a1 = __uint_as_float(ya[q][j].x & 0xffff0000u) + __uint_as_float(yb[q][j].x & 0xffff0000u);
                const float a2 = __uint_as_float(ya[q][j].y << 16) + __uint_as_float(yb[q][j].y << 16), a3 = __uint_as_float(ya[q][j].y & 0xffff0000u) + __uint_as_float(yb[q][j].y & 0xffff0000u);
                v[j] = make_float4(xv[q][j].x + gg.x * a0, xv[q][j].y + gg.y * a1, xv[q][j].z + gg.z * a2, xv[q][j].w + gg.w * a3);
                ss += v[j].x * v[j].x + v[j].y * v[j].y + v[j].z * v[j].z + v[j].w * v[j].w;
            }
            const float inv = rsqrtf(wave_sum(ss) * (1.f / D) + EPS);
            if (l == 0) {
                const float* sh = modv(p, 1, mb, 0); const float* sc = modv(p, 1, mb, 1);
#pragma unroll
                for (int j = 0; j < 4; ++j) {
                    const int c = j * 256 + lane * 4;
                    *(float4*)(xo + c) = v[j];
                    const float4 gg = *(const float4*)(ng + c), s1 = *(const float4*)(sh + c), s2 = *(const float4*)(sc + c);
                    st_bf4(H + (size_t)r * D + c, v[j].x * inv * gg.x * (1.f + s2.x) + s1.x, v[j].y * inv * gg.y * (1.f + s2.y) + s1.y,
                           v[j].z * inv * gg.z * (1.f + s2.z) + s1.z, v[j].w * inv * gg.w * (1.f + s2.w) + s1.w);
                }
            } else {
#pragma unroll
                for (int j = 0; j < 4; ++j) {
                    const int c = j * 256 + lane * 4;
                    const float4 gg = *(const float4*)(ng + c);
                    *(float4*)(xo + c) = make_float4(v[j].x * inv * gg.x, v[j].y * inv * gg.y, v[j].z * inv * gg.z, v[j].w * inv * gg.w);
                }
            }
        }
    }
}

#define XB_TMO      128
#define XB_XCNT(j)  (256  + 64 * (j))
#define XB_XSUB(j)  (1280 + 64 * (j))
#define XB_XGEN(j)  (2304 + 64 * (j))
#define XB_TOP      3328
#define XB_TOPGEN   3392
#define XB_SPIN_CAP (1u << 22)
constexpr int CW_BAR = 4096;
__device__ __forceinline__ unsigned xb_ld(unsigned* p)              { return __hip_atomic_load(p, __ATOMIC_RELAXED, __HIP_MEMORY_SCOPE_AGENT); }
__device__ __forceinline__ unsigned xb_add(unsigned* p, unsigned v) { return __hip_atomic_fetch_add(p, v, __ATOMIC_RELAXED, __HIP_MEMORY_SCOPE_AGENT); }
__device__ __forceinline__ unsigned xb_xcc_id() { return (unsigned)__builtin_amdgcn_s_getreg((3 << 11) | 20) & 0xFu; }
#define XB_SPIN(cond, bar) do { unsigned _sp = 0; while (cond) { __builtin_amdgcn_s_sleep(1); \
    if ((++_sp & 255u) == 0u) { if (xb_ld(&(bar)[XB_TMO])) break; if (_sp > XB_SPIN_CAP) { atomicAdd(&(bar)[XB_TMO], 1u); break; } } } } while (0)
constexpr int LDS_BAR_OFF = 79 * 1024 + 16;
__device__ __forceinline__ void xcd_barrier_post(unsigned* bar) {
    if (threadIdx.x == 0) (void)xb_add(&bar[XB_XCNT(xb_xcc_id())], 1u);
}
__device__ __forceinline__ void xcd_barrier_census(unsigned* bar, volatile unsigned* st) {
    if (threadIdx.x == 0) {
        const unsigned x = xb_xcc_id();
        unsigned cnt = 0, mine = 0;
#pragma unroll
        for (unsigned j = 0; j < 16; ++j) { const unsigned c = xb_ld(&bar[XB_XCNT(j)]); cnt += (c > 0u) ? 1u : 0u; mine = (j == x) ? c : mine; }
        st[0] = mine > 0u ? mine : 1u; st[1] = cnt > 0u ? cnt : 1u;
    }
    __syncthreads();
}
__device__ __forceinline__ void xcd_barrier(KParams kp, unsigned char* lds) {
    asm volatile("s_waitcnt vmcnt(0)" ::: "memory");
    __syncthreads();
    if (threadIdx.x == 0) {
        unsigned* bar = (unsigned*)(kp->ws + WS_CTL) + CW_BAR;
        volatile unsigned* st = (volatile unsigned*)(lds + LDS_BAR_OFF);
        __builtin_amdgcn_s_waitcnt(0);
        const unsigned x = xb_xcc_id();
        const unsigned nloc = st[0], nx = st[1];
        const unsigned old = xb_add(&bar[XB_XSUB(x)], 1u);
        const unsigned gen = old / nloc;
        if (old + 1u == (gen + 1u) * nloc) {
            __builtin_amdgcn_fence(__ATOMIC_RELEASE, "agent");
            asm volatile("s_waitcnt vmcnt(0)" ::: "memory");
            const unsigned og = xb_add(&bar[XB_TOP], 1u);
            const unsigned tg = og / nx;
            if (og + 1u == (tg + 1u) * nx) xb_add(&bar[XB_TOPGEN], 1u);
            else XB_SPIN(xb_ld(&bar[XB_TOPGEN]) == tg, bar);
            __builtin_amdgcn_fence(__ATOMIC_ACQUIRE, "agent");
            xb_add(&bar[XB_XGEN(x)], 1u);
            asm volatile("s_waitcnt vmcnt(0)" ::: "memory");
        } else {
            XB_SPIN(xb_ld(&bar[XB_XGEN(x)]) == gen, bar);
            __builtin_amdgcn_fence(__ATOMIC_ACQUIRE, "agent");
            asm volatile("s_waitcnt vmcnt(0)" ::: "memory");
        }
    }
    __syncthreads();
}

constexpr int LDS_BYTES = 80 * 1024;
__global__ void __launch_bounds__(256, 2) mega_fwd(Params p_unused) {
    const KParams kp = (KParams)__builtin_amdgcn_kernarg_segment_ptr();
    extern __shared__ __attribute__((aligned(16))) unsigned char smem_raw[];
    float* sm = (float*)smem_raw;
    cg::grid_group grid = cg::this_grid();
#ifndef PROBE_SEL
#define PROBE_SEL 0ull
#endif
#if PROBE_SEL
    volatile unsigned long long* stamps = (volatile unsigned long long*)(smem_raw + 79 * 1024 + 64);
    int n_stamp = 0;
#define STAMP() do { if (blockIdx.x == 0 && threadIdx.x == 0) stamps[n_stamp] = __builtin_amdgcn_s_memrealtime(); ++n_stamp; } while (0)
#else
#define STAMP() do { } while (0)
#endif
    xcd_barrier_post((unsigned*)(kp->ws + WS_CTL) + CW_BAR);
    STAMP();
    ph_init(fresh(kp), sm);
    grid.sync();
    xcd_barrier_census((unsigned*)(kp->ws + WS_CTL) + CW_BAR, (volatile unsigned*)(smem_raw + LDS_BAR_OFF));
    STAMP();
#define GSYNC() do { xcd_barrier(fresh(kp), smem_raw); STAMP(); } while (0)
#pragma unroll 1
    for (int l = 0; l < 2; ++l) {
        if (l == 0) { ph_norm1(fresh(kp), l); GSYNC(); }
        ph_gemm_in(fresh(kp), l, smem_raw); GSYNC();
        ph_prep(fresh(kp), l, sm);
        ph_gla_local(fresh(kp), l, smem_raw); GSYNC();
        ph_mix(fresh(kp), l, smem_raw);     GSYNC();
        ph_gla_out(fresh(kp), l, smem_raw); GSYNC();
        ph_merge(fresh(kp), l, smem_raw);   GSYNC();
        ph_outproj(fresh(kp), l, smem_raw); GSYNC();
        ph_router(fresh(kp), l, smem_raw);
        ph_convmoe(fresh(kp), l, sm);       GSYNC();
        ph_moe1(fresh(kp), l, smem_raw);    GSYNC();
        ph_moe2(fresh(kp), l, smem_raw);    GSYNC();
        ph_combine(fresh(kp), l);           GSYNC();
    }
#if PROBE_SEL
    if (blockIdx.x == 0 && threadIdx.x == 0) {
        unsigned long long dt = 0;
        for (int i = 0; i < 23; ++i) if ((PROBE_SEL >> i) & 1ull) dt += stamps[i + 1] - stamps[i];
        const unsigned long long t0 = __builtin_amdgcn_s_memrealtime();
        while (__builtin_amdgcn_s_memrealtime() - t0 < dt) __builtin_amdgcn_s_sleep(8);
    }
#endif
}

extern "C" void kernel_launch(void* const* d_in, const int* in_sizes, int n_in, void* d_out, int out_size, void* d_ws, size_t ws_size,
                              hipStream_t stream) {
    if (n_in != 28 || ws_size < WS_END) { fprintf(stderr, "kernel_launch: bad n_in %d or ws_size %zu (< %zu)\n", n_in, ws_size, (size_t)WS_END); return; }
    static int grid_blocks = 0;
    if (!grid_blocks) {
        int dev = 0, cus = 0, per_cu = 0;
        (void)hipGetDevice(&dev);
        (void)hipDeviceGetAttribute(&cus, hipDeviceAttributeMultiprocessorCount, dev);
        (void)hipFuncSetAttribute((const void*)mega_fwd, hipFuncAttributeMaxDynamicSharedMemorySize, LDS_BYTES);
        (void)hipOccupancyMaxActiveBlocksPerMultiprocessor(&per_cu, (const void*)mega_fwd, 256, LDS_BYTES);
        if (per_cu < 1) per_cu = 1;
        grid_blocks = cus * per_cu;
        fprintf(stderr, "kernel_launch: cus %d per_cu %d grid %d ws_size %zu\n", cus, per_cu, grid_blocks, ws_size);
    }
    Params p{};
    for (int i = 0; i < 28; ++i) p.in[i] = (const float*)d_in[i];
    p.out = (float*)d_out; p.ws = (unsigned char*)d_ws;
    (void)hipMemsetAsync((char*)d_ws + WS_CTL, 0, 1 * MiB, stream);
    void* args[] = {&p};
    hipError_t e = hipLaunchCooperativeKernel((const void*)mega_fwd, dim3(grid_blocks), dim3(256), args, LDS_BYTES, stream);
    if (e != hipSuccess) fprintf(stderr, "cooperative launch failed: %s (grid %d)\n", hipGetErrorString(e), grid_blocks);
}
```

```cpp
#include <hip/hip_runtime.h>
#include <hip/hip_cooperative_groups.h>
namespace cg = cooperative_groups;
#include <cstdio>
#include <cstdint>

typedef unsigned short bf16;

constexpr int D = 1024, NB = 8, T = 4096, CL = 256, NL = NB * T, NC = NB * CL, NTOK = NL + NC;
constexpr int INW = 5920;
constexpr int O_GQ = 0, O_GK = 256, O_GV = 512, O_GR = 1024, O_AQ = 1536, O_AK = 2048, O_AV = 2176, O_PU = 2304, O_GT = 2816, O_GLF = 5888, O_GLB = 5904;
__host__ __device__ constexpr int win_nmap(int n) { return n < 1536 ? n : (n < 1568 ? n + 4352 : (n < 5920 ? n - 32 : n)); }
constexpr float EPS = 1e-6f;
constexpr int CNT_BASE = 8192, CNT_STRIDE = 64;

constexpr size_t MiB = 1u << 20;
constexpr size_t WS_CTL = 0;
constexpr size_t WS_MODV = 1 * MiB;
constexpr size_t WS_ROPE = 1 * MiB + 512 * 1024;
constexpr size_t WS_WT = 2 * MiB;
constexpr size_t WS_LIST = 3 * MiB;
constexpr size_t WS_RWT = 7 * MiB + 256 * 1024;
constexpr size_t WS_XC = 8 * MiB;
constexpr size_t WS_H = 16 * MiB;
constexpr size_t WS_PROJ = 84 * MiB;
constexpr size_t WS_R2 = 478 * MiB;
constexpr size_t WS_WGU = WS_R2;
constexpr size_t WS_WDT = WS_R2 + 64 * MiB;
constexpr size_t WS_WSM = 580 * MiB;
constexpr size_t SZ_WINT = (size_t)6016 * 1024 * 2, SZ_WBT = (size_t)1024 * 512 * 2, SZ_WOUTT = (size_t)1024 * 1024 * 2;
constexpr size_t SZ_WSM_L = SZ_WINT + 3 * SZ_WBT + SZ_WOUTT;
constexpr size_t WS_VT = 614 * MiB;
constexpr int NKEY = T + CL;
constexpr size_t WS_H8 = WS_R2;
constexpr size_t WS_W8 = 623 * MiB;
constexpr size_t WS_H28 = WS_PROJ + 210 * MiB;
constexpr size_t WS_WGU8 = WS_PROJ + 250 * MiB;
constexpr size_t WS_WDT8 = WS_PROJ + 284 * MiB;
constexpr size_t WS_END = 632 * MiB;
static_assert(WS_WSM + 2 * SZ_WSM_L <= WS_END, "ws map");
constexpr size_t SZ_Y512 = (size_t)NTOK * 512 * 2;
constexpr size_t WS_ACT = WS_PROJ;
constexpr size_t WS_Y0 = WS_PROJ + 68 * MiB;
constexpr size_t WS_Y1 = WS_PROJ + 136 * MiB;

struct Params {
    const float* in[28];
    float* out;
    unsigned char* ws;
};
typedef const __attribute__((address_space(4))) Params* KParams;
__device__ __forceinline__ KParams fresh(KParams k) { asm volatile("" : "+s"(k)); return k; }
enum { I_X = 0, I_C, I_CTX, I_CCTX, I_WMOD, I_BMOD, I_N1G, I_N2G, I_WIN, I_UPF, I_BIASF, I_UPB, I_BIASB, I_GLANG, I_QNG, I_KNG,
       I_POOLW, I_POOLS, I_WBR, I_WOUT, I_WGRP, I_BGRP, I_WEXP, I_BEXP, I_WGATE, I_WUP, I_WDOWN, I_FING };

__device__ __forceinline__ float bf2f(bf16 v) { return __uint_as_float(((unsigned)v) << 16); }
__device__ __forceinline__ bf16 f2bf(float f) { unsigned u = __float_as_uint(f); return (bf16)((u + 0x7fffu + ((u >> 16) & 1u)) >> 16); }
__device__ __forceinline__ float4 ld_bf4(const bf16* p) {
    uint2 u = *(const uint2*)p;
    return make_float4(__uint_as_float(u.x << 16), __uint_as_float(u.x & 0xffff0000u), __uint_as_float(u.y << 16), __uint_as_float(u.y & 0xffff0000u));
}
typedef float f32x2_t __attribute__((ext_vector_type(2)));
typedef __bf16 bf16x2_t __attribute__((ext_vector_type(2)));
__device__ __forceinline__ unsigned pk_bf16(float a, float b) { f32x2_t v = {a, b}; return __builtin_bit_cast(unsigned, __builtin_convertvector(v, bf16x2_t)); }
__device__ __forceinline__ void st_bf4(bf16* p, float a, float b, float c, float d) {
    uint2 u; u.x = pk_bf16(a, b); u.y = pk_bf16(c, d);
    *(uint2*)p = u;
}
__device__ __forceinline__ unsigned pk_fp8x4(float a, float b, float c, float d) {
    int v = __builtin_amdgcn_cvt_pk_fp8_f32(a, b, 0, false);
    v = __builtin_amdgcn_cvt_pk_fp8_f32(c, d, v, true);
    return (unsigned)v;
}
__device__ __forceinline__ void st_h4(bf16* H, unsigned char* H8, size_t idx, float a, float b, float c, float d) {
    st_bf4(H + idx, a, b, c, d);
    *(unsigned*)(H8 + idx) = pk_fp8x4(a, b, c, d);
}
__device__ __forceinline__ int tid_opaque() { int t = threadIdx.x; asm volatile("" : "+v"(t)); return t; }
#define DPP_ADD(v, ctrl) v += __builtin_bit_cast(float, __builtin_amdgcn_update_dpp(0, __builtin_bit_cast(int, v), (ctrl), 0xf, 0xf, true))
__device__ __forceinline__ float sum16(float v) {
    DPP_ADD(v, 0xB1);
    DPP_ADD(v, 0x4E);
    DPP_ADD(v, 0x141);
    DPP_ADD(v, 0x140);
    return v;
}
__device__ __forceinline__ float wave_sum(float v) {
#pragma unroll
    for (int o = 1; o < 64; o <<= 1) v += __shfl_xor(v, o);
    return v;
}
__device__ __forceinline__ float silu_f(float x) { return x * __builtin_amdgcn_rcpf(1.f + __expf(-x)); }
__device__ __forceinline__ float sigmoid_f(float x) { return __builtin_amdgcn_rcpf(1.f + __expf(-x)); }
__device__ __forceinline__ int modrow(int r) { return r < NL ? r / T : 8; }
__device__ __forceinline__ const float* xrow(KParams p, int l, int r) {
    if (l == 0) return r < NL ? p->in[I_X] + (size_t)r * D : p->in[I_CTX] + (size_t)(r - NL) * D;
    return r < NL ? p->out + (size_t)r * D : (const float*)(p->ws + WS_XC) + (size_t)(r - NL) * D;
}
__device__ __forceinline__ const float* modv(KParams p, int l, int mb, int which) {
    return (const float*)(p->ws + WS_MODV) + ((size_t)(l * 9 + mb) * 6 + which) * D;
}

template <class AF, class BF>
__device__ __forceinline__ void gemm64(float (&acc)[4][4], int K, AF aload, BF bload, float* sA, float* sB, const int tid) {
    const int ty = tid >> 4, tx = tid & 15;
    const int am = tid >> 2, ak = (tid & 3) * 4;
    const int bk = tid >> 4, bn = (tid & 15) * 4;
    for (int k0 = 0; k0 < K; k0 += 16) {
        float4 av = aload(am, k0 + ak);
        float4 bv = bload(k0 + bk, bn);
        __syncthreads();
        sA[(ak + 0) * 68 + am] = av.x; sA[(ak + 1) * 68 + am] = av.y; sA[(ak + 2) * 68 + am] = av.z; sA[(ak + 3) * 68 + am] = av.w;
        *(float4*)&sB[bk * 64 + bn] = bv;
        __syncthreads();
#pragma unroll
        for (int kk = 0; kk < 16; ++kk) {
            float4 a = *(float4*)&sA[kk * 68 + ty * 4];
            float4 b = *(float4*)&sB[kk * 64 + tx * 4];
            float aa[4] = {a.x, a.y, a.z, a.w}, bb[4] = {b.x, b.y, b.z, b.w};
#pragma unroll
            for (int i = 0; i < 4; ++i)
#pragma unroll
                for (int j = 0; j < 4; ++j) acc[i][j] += aa[i] * bb[j];
        }
    }
    __syncthreads();
}
__device__ __forceinline__ void zero_acc(float (&acc)[4][4]) {
#pragma unroll
    for (int i = 0; i < 4; ++i)
#pragma unroll
        for (int j = 0; j < 4; ++j) acc[i][j] = 0.f;
}

typedef short bf16x8 __attribute__((ext_vector_type(8)));
typedef float f32x4 __attribute__((ext_vector_type(4)));
constexpr int GT_BYTES = 16384;
__device__ __forceinline__ void zero_acc4(f32x4 (&acc)[4][4]) {
#pragma unroll
    for (int i = 0; i < 4; ++i)
#pragma unroll
        for (int j = 0; j < 4; ++j) acc[i][j] = (f32x4){0.f, 0.f, 0.f, 0.f};
}
__device__ __forceinline__ const char* uni_ptr(const void* p) {
    const unsigned long long v = (unsigned long long)p;
    const unsigned lo = __builtin_amdgcn_readfirstlane((unsigned)v), hi = __builtin_amdgcn_readfirstlane((unsigned)(v >> 32));
    return (const char*)(((unsigned long long)hi << 32) | lo);
}
template <class FA, class FB>
__device__ __forceinline__ void gemm_issue0(FA arow, FB brow, const bf16* aorg, unsigned char* lds, const int tid) {
    const int srow = tid >> 3, sc = ((tid & 7) ^ ((tid >> 4) & 7)) * 8;
    const int wb = __builtin_amdgcn_readfirstlane((tid >> 6) * 1024);
    const char* ab = uni_ptr(aorg); const char* bb = uni_ptr(brow(0));
#pragma unroll
    for (int j = 0; j < 4; ++j) {
        const unsigned ao = (unsigned)((const char*)(arow(j * 32 + srow) + sc) - ab), bo = (unsigned)((const char*)(brow(j * 32 + srow) + sc) - bb);
        __builtin_amdgcn_global_load_lds((const unsigned*)(ab + ao), (unsigned*)(lds + j * 4096 + wb), 16, 0, 0);
        __builtin_amdgcn_global_load_lds((const unsigned*)(bb + bo), (unsigned*)(lds + GT_BYTES + j * 4096 + wb), 16, 0, 0);
    }
}
template <bool AFF, bool LEAN, bool F8, class FA, class FB, class NF, class MF>
__device__ __forceinline__ void gemm_tile(f32x4 (&acc)[4][4], FA arow, FB brow, const bf16* aorg, int K, unsigned char* lds, const int tid, NF next, MF mid) {
    const int lane = tid & 63, wid = tid >> 6, wr = wid >> 1, wc = wid & 1, fr = lane & 15, fq = lane >> 4;
    const int srow = tid >> 3, sc = ((tid & 7) ^ ((tid >> 4) & 7)) * 8;
    const char* ab = uni_ptr(aorg); const char* bb = uni_ptr(brow(0));
    unsigned ao[4], bo[4];
#pragma unroll
    for (int j = 0; j < 4; ++j) { ao[j] = (unsigned)((const char*)(arow(j * 32 + srow) + sc) - ab); bo[j] = (unsigned)((const char*)(brow(j * 32 + srow) + sc) - bb); }
    const int KT = K >> 6;
    const int wb = __builtin_amdgcn_readfirstlane((tid >> 6) * 1024);
#pragma unroll 1
    for (int kt = 0; kt < KT; ++kt) {
        asm volatile("s_waitcnt vmcnt(0)" ::: "memory");
        __syncthreads();
        if (kt + 1 < KT) {
            unsigned char* sa = lds + ((kt + 1) & 1) * 2 * GT_BYTES;
#pragma unroll
            for (int j = 0; j < 4; ++j) {
                unsigned aoj = ao[j], boj = bo[j];
                asm volatile("" : "+v"(aoj), "+v"(boj));
                __builtin_amdgcn_global_load_lds((const unsigned*)(ab + (size_t)(kt + 1) * 128 + aoj), (unsigned*)(sa + j * 4096 + wb), 16, 0, 0);
                __builtin_amdgcn_global_load_lds((const unsigned*)(bb + (size_t)(kt + 1) * 128 + boj), (unsigned*)(sa + GT_BYTES + j * 4096 + wb), 16, 0, 0);
            }
        } else {
            next();
        }
        mid(kt, KT);
        const unsigned char* sa = lds + (kt & 1) * 2 * GT_BYTES;
        const unsigned char* sb = sa + GT_BYTES;
        if (LEAN && !F8) {
#pragma unroll
            for (int ks = 0; ks < 2; ++ks) {
                const int phys = ((ks * 4 + fq) ^ (fr >> 1)) * 16;
                bf16x8 bq[4];
#pragma unroll
                for (int j = 0; j < 4; ++j) bq[j] = *(const bf16x8*)(sb + (wc * 64 + j * 16 + fr) * 128 + phys);
#pragma unroll
                for (int i = 0; i < 4; ++i) {
                    const bf16x8 af = *(const bf16x8*)(sa + (wr * 64 + i * 16 + fr) * 128 + phys);
#pragma unroll
                    for (int j = 0; j < 4; ++j) acc[i][j] = __builtin_amdgcn_mfma_f32_16x16x32_bf16(bq[j], af, acc[i][j], 0, 0, 0);
                }
            }
        } else if (F8 && LEAN) {
            typedef int i32x4_t __attribute__((ext_vector_type(4)));
            typedef int i32x8_t __attribute__((ext_vector_type(8)));
            const int ph0 = ((fq) ^ (fr >> 1)) * 16, ph1 = ((4 + fq) ^ (fr >> 1)) * 16;
            i32x8_t b8[4];
#pragma unroll
            for (int j = 0; j < 4; ++j)
                b8[j] = __builtin_shufflevector(*(const i32x4_t*)(sb + (wc * 64 + j * 16 + fr) * 128 + ph0), *(const i32x4_t*)(sb + (wc * 64 + j * 16 + fr) * 128 + ph1), 0, 1, 2, 3, 4, 5, 6, 7);
#pragma unroll
            for (int i = 0; i < 4; ++i) {
                const i32x8_t a8 = __builtin_shufflevector(*(const i32x4_t*)(sa + (wr * 64 + i * 16 + fr) * 128 + ph0), *(const i32x4_t*)(sa + (wr * 64 + i * 16 + fr) * 128 + ph1), 0, 1, 2, 3, 4, 5, 6, 7);
#pragma unroll
                for (int j = 0; j < 4; ++j)
                    acc[i][j] = __builtin_amdgcn_mfma_scale_f32_16x16x128_f8f6f4(b8[j], a8, acc[i][j], 0, 0, 0, 0x7f7f7f7f, 0, 0x7f7f7f7f);
            }
        } else if (F8) {
            typedef long l64x2 __attribute__((ext_vector_type(2)));
            l64x2 af8[2][4], bq8[2][4];
#pragma unroll
            for (int ks = 0; ks < 2; ++ks) {
                const int phys = ((ks * 4 + fq) ^ (fr >> 1)) * 16;
#pragma unroll
                for (int j = 0; j < 4; ++j) bq8[ks][j] = *(const l64x2*)(sb + (wc * 64 + j * 16 + fr) * 128 + phys);
#pragma unroll
                for (int i = 0; i < 4; ++i) af8[ks][i] = *(const l64x2*)(sa + (wr * 64 + i * 16 + fr) * 128 + phys);
            }
            __builtin_amdgcn_sched_barrier(0);
            {
                typedef int i32x4_t __attribute__((ext_vector_type(4)));
                typedef int i32x8_t __attribute__((ext_vector_type(8)));
                i32x8_t a8[4], b8[4];
#pragma unroll
                for (int i = 0; i < 4; ++i) a8[i] = __builtin_shufflevector(__builtin_bit_cast(i32x4_t, af8[0][i]), __builtin_bit_cast(i32x4_t, af8[1][i]), 0, 1, 2, 3, 4, 5, 6, 7);
#pragma unroll
                for (int j = 0; j < 4; ++j) b8[j] = __builtin_shufflevector(__builtin_bit_cast(i32x4_t, bq8[0][j]), __builtin_bit_cast(i32x4_t, bq8[1][j]), 0, 1, 2, 3, 4, 5, 6, 7);
#pragma unroll
                for (int i = 0; i < 4; ++i)
#pragma unroll
                    for (int j = 0; j < 4; ++j)
                        acc[i][j] = __builtin_amdgcn_mfma_scale_f32_16x16x128_f8f6f4(b8[j], a8[i], acc[i][j], 0, 0, 0, 0x7f7f7f7f, 0, 0x7f7f7f7f);
            }
        } else {
            bf16x8 af[2][4], bq[2][4];
#pragma unroll
            for (int ks = 0; ks < 2; ++ks) {
                const int phys = ((ks * 4 + fq) ^ (fr >> 1)) * 16;
#pragma unroll
                for (int j = 0; j < 4; ++j) bq[ks][j] = *(const bf16x8*)(sb + (wc * 64 + j * 16 + fr) * 128 + phys);
#pragma unroll
                for (int i = 0; i < 4; ++i) af[ks][i] = *(const bf16x8*)(sa + (wr * 64 + i * 16 + fr) * 128 + phys);
            }
            __builtin_amdgcn_sched_barrier(0);
#pragma unroll
            for (int ks = 0; ks < 2; ++ks)
#pragma unroll
                for (int i = 0; i < 4; ++i)
#pragma unroll
                    for (int j = 0; j < 4; ++j) acc[i][j] = __builtin_amdgcn_mfma_f32_16x16x32_bf16(bq[ks][j], af[ks][i], acc[i][j], 0, 0, 0);
        }
    }
}
__device__ __forceinline__ void tile_coords(int it, int nM, int nN, int& tm, int& tn) {
    const int GM = 8, per = GM * nN, grp = it / per, fm = grp * GM, gsz = min(nM - fm, GM), rem = it - grp * per;
    tm = fm + rem % gsz; tn = rem / gsz;
}
constexpr int CW_TQ = 32768;
constexpr int LDS_TQ_OFF = 79 * 1024 + 32;
struct TileQ { unsigned* ctr; int ntiles; };
__device__ __forceinline__ int tq_next(const TileQ& q) {
    const int x = (int)(__builtin_amdgcn_s_getreg((3 << 11) | 20) & 7u);
    for (int s = 0; s < 8; ++s) {
        const int c = (x + s) & 7;
        const int b = (int)(((long)q.ntiles * c) >> 3), e = (int)(((long)q.ntiles * (c + 1)) >> 3);
        if (b >= e) continue;
        if ((int)__hip_atomic_load(q.ctr + c * 64, __ATOMIC_RELAXED, __HIP_MEMORY_SCOPE_AGENT) >= e - b) continue;
        const int t = (int)__hip_atomic_fetch_add(q.ctr + c * 64, 1u, __ATOMIC_RELAXED, __HIP_MEMORY_SCOPE_AGENT);
        if (b + t < e) return b + t;
    }
    return -1;
}
__device__ __forceinline__ int tq_fetch(const TileQ& q) {
    const int c = (int)(__builtin_amdgcn_s_getreg((3 << 11) | 20) & 7u);
    return (int)__hip_atomic_fetch_add(q.ctr + c * 64, 1u, __ATOMIC_RELAXED, __HIP_MEMORY_SCOPE_AGENT);
}
__device__ __forceinline__ int tq_resolve(const TileQ& q, int t) {
    const int c = (int)(__builtin_amdgcn_s_getreg((3 << 11) | 20) & 7u);
    const int b = (int)(((long)q.ntiles * c) >> 3), e = (int)(((long)q.ntiles * (c + 1)) >> 3);
    if ((unsigned)t < (unsigned)(e - b)) return b + t;
    return tq_next(q);
}
constexpr int STG_OFF = 32768;
template <int NCH>
__device__ __forceinline__ void stg_put(unsigned char* lds, int row, int colbyte, unsigned lo, unsigned hi) {
    *(uint2*)(lds + STG_OFF + row * (NCH * 16) + ((((colbyte >> 4) ^ row) & (NCH - 1)) << 4) + (colbyte & 15)) = make_uint2(lo, hi);
}
template <int NCH, class RP>
__device__ __forceinline__ void stg_flush(unsigned char* lds, const int tid, RP rowptr) {
#pragma unroll
    for (int k = 0; k < NCH / 2; ++k) {
        const int idx = k * 256 + tid, row = idx / NCH, ch = idx % NCH;
        bf16* dst = rowptr(row, ch);
        if (dst) *(uint4*)dst = *(const uint4*)(lds + STG_OFF + row * (NCH * 16) + (((ch ^ row) & (NCH - 1)) << 4));
    }
}
__device__ __forceinline__ int vblock() { const int G = gridDim.x, b = blockIdx.x; return (G & 7) == 0 ? (b & 7) * (G >> 3) + (b >> 3) : b; }

struct ConvItem { const float* src; bf16* dst; int ldsrc, nvalid, k0, n0, lddst, kind; unsigned char* dst8; int base8, n8, ld8; };
__device__ __forceinline__ int conv_nmap(int kind, int n) {
    return kind == 0 ? n : (kind == 1 ? win_nmap(n) : 32 * (n >> 4) + (kind == 3 ? 16 : 0) + (n & 15));
}
template <class Dec>
__device__ __forceinline__ void conv_stream(Dec decode, int nitems, unsigned char* lds, const int tid) {
    auto issue = [&](const ConvItem& it, int buf) {
#pragma unroll
        for (int j = 0; j < 4; ++j) {
            const int k = j * 16 + (tid >> 4), pc = tid & 15, c = pc ^ ((k >> 4) & 3), n = it.n0 + c * 4;
            if (n < it.nvalid)
                __builtin_amdgcn_global_load_lds((const unsigned*)(it.src + (size_t)(it.k0 + k) * it.ldsrc + n), (unsigned*)(lds + buf * 16384 + j * 4096 + __builtin_amdgcn_readfirstlane((tid >> 6) * 1024)), 16, 0, 0);
        }
    };
    int i = blockIdx.x;
    __syncthreads();
    ConvItem cur{};
    if (i < nitems) { cur = decode(i); issue(cur, 0); }
    int buf = 0;
    for (; i < nitems; i += gridDim.x) {
        asm volatile("s_waitcnt vmcnt(0)" ::: "memory");
        __syncthreads();
        ConvItem nxt{};
        const bool has_next = i + (int)gridDim.x < nitems;
        if (has_next) { nxt = decode(i + gridDim.x); issue(nxt, buf ^ 1); }
        {
            const float* sm = (const float*)(lds + buf * 16384);
            const int n = tid >> 2, kq = (tid & 3) * 16;
            const bool valid = cur.n0 + n < cur.nvalid;
            const int cidx = ((((n >> 2) ^ (kq >> 4)) & 15) << 2) + (n & 3);
            unsigned w[8];
#pragma unroll
            for (int q = 0; q < 8; ++q) {
                const float a = valid ? sm[(kq + 2 * q) * 64 + cidx] : 0.f, b = valid ? sm[(kq + 2 * q + 1) * 64 + cidx] : 0.f;
                w[q] = pk_bf16(a, b);
            }
            const int mcol = conv_nmap(cur.kind, cur.n0 + n);
            if (cur.dst) {
                bf16* d = cur.dst + (size_t)mcol * cur.lddst + cur.k0 + kq;
                *(uint4*)d = make_uint4(w[0], w[1], w[2], w[3]);
                *(uint4*)(d + 8) = make_uint4(w[4], w[5], w[6], w[7]);
            }
            if (cur.dst8 && valid && mcol >= cur.base8 && mcol < cur.base8 + cur.n8) {
                unsigned f[4];
#pragma unroll
                for (int q = 0; q < 4; ++q)
                    f[q] = pk_fp8x4(32.f * sm[(kq + 4 * q) * 64 + cidx], 32.f * sm[(kq + 4 * q + 1) * 64 + cidx], 32.f * sm[(kq + 4 * q + 2) * 64 + cidx], 32.f * sm[(kq + 4 * q + 3) * 64 + cidx]);
                *(uint4*)(cur.dst8 + (size_t)(mcol - cur.base8) * cur.ld8 + cur.k0 + kq) = make_uint4(f[0], f[1], f[2], f[3]);
            }
        }
        cur = nxt; buf ^= 1;
    }
    asm volatile("s_waitcnt vmcnt(0)" ::: "memory");
    __syncthreads();
}
__device__ __forceinline__ bf16* wsm_int(KParams p, int l) { return (bf16*)(p->ws + WS_WSM + (size_t)l * SZ_WSM_L); }
__device__ __forceinline__ bf16* wsm_bt(KParams p, int l, int br) { return (bf16*)(p->ws + WS_WSM + (size_t)l * SZ_WSM_L + SZ_WINT + (size_t)br * SZ_WBT); }
__device__ __forceinline__ bf16* wsm_outt(KParams p, int l) { return (bf16*)(p->ws + WS_WSM + (size_t)l * SZ_WSM_L + SZ_WINT + 3 * SZ_WBT); }

__device__ __forceinline__ void ph_init(KParams p, float* sm) {
    const int tid = tid_opaque();
    unsigned char* lds = (unsigned char*)sm;
    conv_stream([&](int it) {
        const int l = it / 2016; int r = it % 2016;
        ConvItem c; c.dst8 = nullptr; c.base8 = 0; c.n8 = 0; c.ld8 = D;
        if (r < 1504) { c.dst8 = (unsigned char*)(p->ws + WS_W8) + (size_t)l * 4352 * D; c.base8 = 1536; c.n8 = 4352; c.src = p->in[I_WIN] + (size_t)l * D * INW; c.dst = wsm_int(p, l); c.ldsrc = INW; c.nvalid = INW; c.k0 = (r / 94) * 64; c.n0 = (r % 94) * 64; c.lddst = D; c.kind = 1; return c; }
        r -= 1504;
        if (r < 256) { const int br = r >> 7, q = r & 127;
            c.src = p->in[I_WBR] + ((size_t)(l * 3 + br) * 512) * D; c.dst = wsm_bt(p, l, br); c.ldsrc = D; c.nvalid = D; c.k0 = (q >> 4) * 64; c.n0 = (q & 15) * 64; c.lddst = 512; c.kind = 0; return c; }
        r -= 256;
        c.src = p->in[I_WOUT] + (size_t)l * D * D; c.dst = nullptr; c.dst8 = (unsigned char*)wsm_outt(p, l); c.base8 = 0; c.n8 = D; c.ldsrc = D; c.nvalid = D; c.k0 = (r >> 4) * 64; c.n0 = (r & 15) * 64; c.lddst = D; c.kind = 0; return c;
    }, 2 * 2016, lds, tid);
    for (int it = blockIdx.x; it < 2 * 192; it += gridDim.x) {
        const int l = it / 192, cb = it % 192;
        __syncthreads();
        for (int e = tid; e < 9 * D; e += 256) {
            const int mb = e / D, k = e % D;
            sm[e] = silu_f(mb < 8 ? p->in[I_C][mb * D + k] : p->in[I_CCTX][k]);
        }
        __syncthreads();
        const int cl = tid & 31, col = cb * 32 + cl, ks = tid >> 5;
        const float* w = p->in[I_WMOD] + (size_t)l * D * 6144 + (size_t)ks * 128 * 6144 + col;
        float acc[9];
#pragma unroll
        for (int m = 0; m < 9; ++m) acc[m] = 0.f;
#pragma unroll 1
        for (int k0 = 0; k0 < 128; k0 += 32) {
            float wv[32];
#pragma unroll
            for (int k = 0; k < 32; ++k) wv[k] = w[(size_t)(k0 + k) * 6144];
#pragma unroll
            for (int k = 0; k < 32; ++k)
#pragma unroll
                for (int m = 0; m < 9; ++m) acc[m] += sm[m * D + ks * 128 + k0 + k] * wv[k];
        }
        __syncthreads();
#pragma unroll
        for (int m = 0; m < 9; ++m) sm[9 * D + (ks * 9 + m) * 32 + cl] = acc[m];
        __syncthreads();
        if (tid < 32) {
            const float bias = p->in[I_BMOD][l * 6144 + col];
            float* mv = (float*)(p->ws + WS_MODV);
#pragma unroll
            for (int m = 0; m < 9; ++m) {
                float t = bias;
#pragma unroll
                for (int q = 0; q < 8; ++q) t += sm[9 * D + (q * 9 + m) * 32 + tid];
                mv[(size_t)(l * 9 + m) * 6144 + col] = t;
            }
        }
    }
    for (int it = blockIdx.x; it < 1 + 72 + 2 * 128; it += gridDim.x) {
        if (it == 0) {
            float2* rope = (float2*)(p->ws + WS_ROPE);
            for (int e = tid; e < 64 * 16; e += 256) {
                const int pos = e >> 4, i = e & 15;
                const float invf = powf(10000.0f, -(float)(2 * i) / 32.0f);
                const float angf = (float)pos * invf;
                const double ang = (double)angf;
                const double twopi = 6.283185307179586476925286766559;
                const double n = rint(ang / twopi);
                const double r = ang - n * twopi, r2 = r * r;
                double sn = 1.0, cs = 1.0;
                for (int q = 14; q >= 1; --q) { sn = 1.0 - r2 / (double)((2 * q) * (2 * q + 1)) * sn; cs = 1.0 - r2 / (double)((2 * q - 1) * (2 * q)) * cs; }
                sn *= r;
                rope[e] = make_float2((float)cs, (float)sn);
            }
        } else if (it < 73) {
            const int q = it - 1, l = q / 36, o = q % 36;
            float* dst = (float*)(p->ws + WS_RWT) + (size_t)(l * 36 + o) * D;
            for (int k = tid; k < D; k += 256) dst[k] = o < 4 ? p->in[I_WGRP][((size_t)l * D + k) * 4 + o] : p->in[I_WEXP][((size_t)l * D + k) * 32 + (o - 4)];
        } else {
            const int q = it - 73, l = q >> 7, r = q & 127;
            const int m0 = (r >> 4) * 64, n0 = (r & 15) * 64, g = m0 >> 7;
            const float* PW = p->in[I_POOLW] + ((size_t)(l * 4 + g) * 128) * 128;
            const float* PS = p->in[I_POOLS] + l * 512 + g * 128;
            const float* WB = p->in[I_WBR] + ((size_t)(l * 3 + 2) * 512 + g * 128) * D;
            float acc[4][4]; zero_acc(acc);
            gemm64(acc, 128,
                   [&](int m, int k) { const float4 a = *(const float4*)(PW + (size_t)((m0 + m) & 127) * 128 + k); const float4 sc = *(const float4*)(PS + k);
                                       return make_float4(a.x * sc.x, a.y * sc.y, a.z * sc.z, a.w * sc.w); },
                   [&](int k, int n) { return *(const float4*)(WB + (size_t)k * D + n0 + n); }, sm, sm + 16 * 68, tid);
            const int ty = tid >> 4, tx = tid & 15;
            bf16* dst = wsm_bt(p, l, 2);
#pragma unroll
            for (int j = 0; j < 4; ++j) st_bf4(dst + (size_t)(n0 + tx * 4 + j) * 512 + m0 + ty * 4, acc[0][j], acc[1][j], acc[2][j], acc[3][j]);
        }
    }
}

__device__ __forceinline__ void ph_norm1(KParams p, int l) {
    const int tid = tid_opaque(), lane = tid & 63, gw = blockIdx.x * 4 + (tid >> 6), ngw = gridDim.x * 4;
    bf16* H = (bf16*)(p->ws + WS_H);
    const float* g = p->in[I_N1G] + l * D;
    for (int r0 = gw * 2; r0 < NTOK; r0 += ngw * 2) {
        float4 v[2][4];
#pragma unroll
        for (int q = 0; q < 2; ++q) {
            const float* x = xrow(p, l, r0 + q);
#pragma unroll
            for (int j = 0; j < 4; ++j) v[q][j] = *(const float4*)(x + j * 256 + lane * 4);
        }
#pragma unroll
        for (int q = 0; q < 2; ++q) {
            const int r = r0 + q, mb = modrow(r);
            const float* sh = modv(p, l, mb, 0); const float* sc = modv(p, l, mb, 1);
            float ss = 0.f;
#pragma unroll
            for (int j = 0; j < 4; ++j) ss += v[q][j].x * v[q][j].x + v[q][j].y * v[q][j].y + v[q][j].z * v[q][j].z + v[q][j].w * v[q][j].w;
            const float inv = rsqrtf(wave_sum(ss) * (1.f / D) + EPS);
#pragma unroll
            for (int j = 0; j < 4; ++j) {
                const int c = j * 256 + lane * 4;
                const float4 gg = *(const float4*)(g + c), s1 = *(const float4*)(sh + c), s2 = *(const float4*)(sc + c);
                st_h4(H, (unsigned char*)(p->ws + WS_H8), (size_t)r * D + c, v[q][j].x * inv * gg.x * (1.f + s2.x) + s1.x, v[q][j].y * inv * gg.y * (1.f + s2.y) + s1.y,
                      v[q][j].z * inv * gg.z * (1.f + s2.z) + s1.z, v[q][j].w * inv * gg.w * (1.f + s2.w) + s1.w);
            }
        }
    }
}

template <bool F8>
__device__ __forceinline__ void gemm_in_pass(KParams p, int l, unsigned char* lds) {
    const bf16* H = (const bf16*)(p->ws + WS_H);
    bf16* PROJ = (bf16*)(p->ws + WS_PROJ);
    const bf16* WT = wsm_int(p, l);
    const float2* rope = (const float2*)(p->ws + WS_ROPE);
    const int nN = F8 ? 30 : 17, nM = NTOK / 128;
    auto tnmap = [](int t) { return F8 ? (t < 6 ? 12 + t : 16 + t) : (t < 12 ? t : (t < 16 ? 6 + t : 46)); };
    const int tid = tid_opaque(), lane = tid & 63, wid = tid >> 6, wr = wid >> 1, wc = wid & 1, fr = lane & 15, fq = lane >> 4;
    const TileQ tq{(unsigned*)(p->ws + WS_CTL) + CW_TQ + (F8 ? (10 + l) : (l * 5 + 0)) * 512, nM * nN};
    volatile int* slot = (volatile int*)(lds + LDS_TQ_OFF);
    const bf16* H8 = (const bf16*)(p->ws + WS_H8);
    const bf16* W8 = (const bf16*)(p->ws + WS_W8 + (size_t)l * 4352 * D) - (size_t)1536 * 512;
    auto issue = [&](int it_) { int tm_, tn_; tile_coords(it_, nM, nN, tm_, tn_); tn_ = tnmap(tn_);
        if (F8)
            gemm_issue0([&](int r) { return H8 + (size_t)(tm_ * 128 + r) * 512; }, [&](int r) { return W8 + (size_t)(tn_ * 128 + r) * 512; }, H8 + (size_t)(tm_ * 128) * 512, lds, tid);
        else
            gemm_issue0([&](int r) { return H + (size_t)(tm_ * 128 + r) * D; }, [&](int r) { return WT + (size_t)(tn_ * 128 + r) * D; }, H + (size_t)(tm_ * 128) * D, lds, tid); };
    __syncthreads();
    if (tid == 0) slot[0] = tq_next(tq);
    __syncthreads();
    int it = __builtin_amdgcn_readfirstlane(slot[0]);
    if (it >= 0) issue(it);
    for (int n_ = 0; it >= 0; ++n_) {
        int traw = 0;
        if (tid == 0) traw = tq_fetch(tq);
        int tm, tn; tile_coords(it, nM, nN, tm, tn); tn = tnmap(tn);
        f32x4 acc[4][4]; zero_acc4(acc);
        if (F8) {
            gemm_tile<true, false, true>(acc, [&](int r) { return H8 + (size_t)(tm * 128 + r) * 512; }, [&](int r) { return W8 + (size_t)(tn * 128 + r) * 512; }, H8 + (size_t)(tm * 128) * 512, 512, lds, tid,
                      [&]() { const int nx = __builtin_amdgcn_readfirstlane(slot[(n_ + 1) & 1]); if (nx >= 0) issue(nx); }, [&](int kt_, int KT_) { if (kt_ == KT_ - 2 && tid == 0) slot[(n_ + 1) & 1] = tq_resolve(tq, traw); });
#pragma unroll
            for (int i = 0; i < 4; ++i)
#pragma unroll
                for (int j = 0; j < 4; ++j) { acc[i][j][0] *= 0.03125f; acc[i][j][1] *= 0.03125f; acc[i][j][2] *= 0.03125f; acc[i][j][3] *= 0.03125f; }
        } else
        gemm_tile<true, false, false>(acc, [&](int r) { return H + (size_t)(tm * 128 + r) * D; }, [&](int r) { return WT + (size_t)(tn * 128 + r) * D; }, H + (size_t)(tm * 128) * D, D, lds, tid,
                  [&]() { const int nx = __builtin_amdgcn_readfirstlane(slot[(n_ + 1) & 1]); if (nx >= 0) issue(nx); }, [&](int kt_, int KT_) { if (kt_ == KT_ - 2 && tid == 0) slot[(n_ + 1) & 1] = tq_resolve(tq, traw); });
        it = __builtin_amdgcn_readfirstlane(slot[(n_ + 1) & 1]);
        __syncthreads();
        if (F8 && tn >= 12 && tn <= 16) {
            const bool isq = tn < 16;
            const float* gsrc = p->in[isq ? I_QNG : I_KNG] + l * 64 + fq * 4;
            float4 g[4];
#pragma unroll
            for (int j = 0; j < 4; ++j) g[j] = *(const float4*)(gsrc + j * 16);
            const float qs = isq ? 0.125f * 1.4426950408889634f : 1.f;
#pragma unroll
            for (int i = 0; i < 4; ++i) {
                float ss = 0.f;
#pragma unroll
                for (int j = 0; j < 4; ++j) ss += acc[i][j][0] * acc[i][j][0] + acc[i][j][1] * acc[i][j][1] + acc[i][j][2] * acc[i][j][2] + acc[i][j][3] * acc[i][j][3];
                ss += __shfl_xor(ss, 16); ss += __shfl_xor(ss, 32);
                const float inv = rsqrtf(ss * (1.f / 64.f) + EPS);
                const int row = tm * 128 + wr * 64 + i * 16 + fr;
                f32x4 v[4];
#pragma unroll
                for (int j = 0; j < 4; ++j) { v[j][0] = acc[i][j][0] * inv * g[j].x; v[j][1] = acc[i][j][1] * inv * g[j].y; v[j][2] = acc[i][j][2] * inv * g[j].z; v[j][3] = acc[i][j][3] * inv * g[j].w; }
                if (row < NL) {
                    const int t = row & (T - 1), prow = t >> 6, pcol = t & 63;
#pragma unroll
                    for (int e = 0; e < 4; ++e) {
                        const float2 a = rope[prow * 16 + fq * 4 + e], b2 = rope[pcol * 16 + fq * 4 + e];
                        const float x1 = v[0][e], x2 = v[1][e], y1 = v[2][e], y2 = v[3][e];
                        v[0][e] = x1 * a.x - x2 * a.y; v[1][e] = x1 * a.y + x2 * a.x;
                        v[2][e] = y1 * b2.x - y2 * b2.y; v[3][e] = y1 * b2.y + y2 * b2.x;
                    }
                }
#pragma unroll
                for (int j = 0; j < 4; ++j)
                    stg_put<16>(lds, wr * 64 + i * 16 + fr, (wc * 64 + j * 16 + fq * 4) * 2, pk_bf16(v[j][0] * qs, v[j][1] * qs), pk_bf16(v[j][2] * qs, v[j][3] * qs));
            }
        } else if (F8 && tn >= 22) {
#pragma unroll
            for (int i = 0; i < 4; ++i)
#pragma unroll
                for (int j = 0; j < 4; ++j) {
                    const int row = wr * 64 + i * 16 + fr, cb = wc * 64 + j * 16 + fq * 4;
                    *(unsigned*)(lds + STG_OFF + row * 128 + ((((cb >> 4) ^ (row >> 1)) & 7) << 4) + (cb & 15)) = pk_fp8x4(acc[i][j][0], acc[i][j][1], acc[i][j][2], acc[i][j][3]);
                }
        } else {
#pragma unroll
            for (int i = 0; i < 4; ++i)
#pragma unroll
                for (int j = 0; j < 4; ++j)
                    stg_put<16>(lds, wr * 64 + i * 16 + fr, (wc * 64 + j * 16 + fq * 4) * 2, pk_bf16(acc[i][j][0], acc[i][j][1]), pk_bf16(acc[i][j][2], acc[i][j][3]));
        }
        __syncthreads();
        if (F8 && tn >= 22) {
#pragma unroll
            for (int k = 0; k < 4; ++k) {
                const int idx = k * 256 + tid, row = idx >> 3, ch = idx & 7;
                *(uint4*)((unsigned char*)PROJ + ((size_t)(tm * 128 + row) * INW + O_GT) * 2 + (tn - 22) * 128 + ch * 16) = *(const uint4*)(lds + STG_OFF + row * 128 + (((ch ^ (row >> 1)) & 7) << 4));
            }
        } else
        stg_flush<16>(lds, tid, [&](int row, int ch) -> bf16* { return (tn * 128 + ch * 8 < INW) ? PROJ + (size_t)(tm * 128 + row) * INW + tn * 128 + ch * 8 : nullptr; });
    }
}
__device__ __forceinline__ void ph_gemm_in(KParams p, int l, unsigned char* lds) { gemm_in_pass<false>(p, l, lds); }
__device__ __forceinline__ void ph_gemm_in8(KParams p, int l, unsigned char* lds) { gemm_in_pass<true>(p, l, lds); }

__device__ __forceinline__ void ph_prep(KParams p, int l, float* smf) {
    const int tid = tid_opaque();
    bf16* PROJ = (bf16*)(p->ws + WS_PROJ);
    {
        bf16* DP = (bf16*)(p->ws + WS_R2 + 2 * SZ_Y512);
        const int lane = tid & 63, gw = blockIdx.x * 4 + (tid >> 6), ngw = gridDim.x * 4;
        const int ch = lane * 8, hw = 1 << (lane >> 4);
        const int nrows = (l == 0) ? NTOK : NL;
        for (int r = gw; r < nrows; r += ngw) {
            int t, tl;
            if (r < NL) { t = r & (T - 1); tl = T; } else { t = (r - NL) & (CL - 1); tl = CL; }
            const bf16* src = PROJ + (size_t)r * INW + O_PU + ch;
            const int lo = max(t - hw, 0), hi = min(t + hw, tl);
            uint4 nb[16];
#pragma unroll
            for (int u = 0; u < 16; ++u) {
                const int tt = t - 8 + u;
                nb[u] = (tt >= lo && tt < hi) ? *(const uint4*)(src + (long)(u - 8) * INW) : make_uint4(0u, 0u, 0u, 0u);
            }
            float sacc[8] = {0.f, 0.f, 0.f, 0.f, 0.f, 0.f, 0.f, 0.f};
#pragma unroll
            for (int u = 0; u < 16; ++u) {
                const unsigned w[4] = {nb[u].x, nb[u].y, nb[u].z, nb[u].w};
#pragma unroll
                for (int q = 0; q < 4; ++q) { sacc[2 * q] += __uint_as_float(w[q] << 16); sacc[2 * q + 1] += __uint_as_float(w[q] & 0xffff0000u); }
            }
            const float inv = 1.f / (float)(hi - lo);
            const uint4 cc = nb[8];
            const unsigned cw[4] = {cc.x, cc.y, cc.z, cc.w};
            unsigned o[4];
#pragma unroll
            for (int q = 0; q < 4; ++q) o[q] = pk_bf16(sacc[2 * q] * inv - __uint_as_float(cw[q] << 16), sacc[2 * q + 1] * inv - __uint_as_float(cw[q] & 0xffff0000u));
            *(uint4*)(DP + (size_t)r * 512 + ch) = make_uint4(o[0], o[1], o[2], o[3]);
        }
    }
    {
        bf16* VT = (bf16*)(p->ws + WS_VT);
        unsigned short* st = (unsigned short*)smf;
        for (int it = blockIdx.x; it < (NTOK / 64) * 2; it += gridDim.x) {
            const int rt = it >> 1, kvh = it & 1;
            int b, key0;
            if (rt < NL / 64) { b = rt / 64; key0 = (rt % 64) * 64; } else { const int j = rt - NL / 64; b = j / 4; key0 = T + (j % 4) * 64; }
            __syncthreads();
            {
                const int k = tid >> 2, dq = (tid & 3) * 16;
                const bf16* src = PROJ + (size_t)(rt * 64 + k) * INW + O_AV + kvh * 64 + dq;
                const uint4 a = *(const uint4*)src, c = *(const uint4*)(src + 8);
                unsigned* d = (unsigned*)(st + k * 66 + dq);
                d[0] = a.x; d[1] = a.y; d[2] = a.z; d[3] = a.w; d[4] = c.x; d[5] = c.y; d[6] = c.z; d[7] = c.w;
            }
            __syncthreads();
            {
                const int d = tid >> 2, kq = (tid & 3) * 16;
                unsigned w[8];
#pragma unroll
                for (int i = 0; i < 8; ++i) w[i] = (unsigned)st[(kq + 2 * i) * 66 + d] | ((unsigned)st[(kq + 2 * i + 1) * 66 + d] << 16);
                bf16* dst = VT + ((size_t)(b * 2 + kvh) * 64 + d) * NKEY + key0 + kq;
                *(uint4*)dst = make_uint4(w[0], w[1], w[4], w[5]);
                *(uint4*)(dst + 8) = make_uint4(w[2], w[3], w[6], w[7]);
            }
        }
    }
}

typedef float f32x16 __attribute__((ext_vector_type(16)));
typedef short s16x4 __attribute__((ext_vector_type(4)));
#define MFMA32(a, b, c) __builtin_amdgcn_mfma_f32_32x32x16_bf16((a), (b), (c), 0, 0, 0)
__device__ __forceinline__ bf16x8 pack8(const f32x16& x, int s) {
    typedef unsigned u32x4_t __attribute__((ext_vector_type(4)));
    u32x4_t r;
    r[0] = pk_bf16(x[8 * s + 0], x[8 * s + 1]); r[1] = pk_bf16(x[8 * s + 2], x[8 * s + 3]);
    r[2] = pk_bf16(x[8 * s + 4], x[8 * s + 5]); r[3] = pk_bf16(x[8 * s + 6], x[8 * s + 7]);
    return __builtin_bit_cast(bf16x8, r);
}
__device__ __forceinline__ void attn_item(KParams p, int l, int it, unsigned char* lds, const int tid_) {
    const int tid = tid_opaque();
    const int lane = tid & 63, wid = tid >> 6, r32 = lane & 31, h = lane >> 5;
    bf16* PROJ = (bf16*)(p->ws + WS_PROJ);
    const bf16* VT = (const bf16*)(p->ws + WS_VT);
    float mq = 0.f, mk = 0.f;
    for (int d = 0; d < 64; ++d) { mq = fmaxf(mq, fabsf(p->in[I_QNG][l * 64 + d])); mk = fmaxf(mk, fabsf(p->in[I_KNG][l * 64 + d])); }
    const float shift2 = 8.f * mq * mk * 1.4426950408889634f;
    const int srow = tid >> 3, sc = ((tid & 7) ^ ((tid >> 4) & 7)) * 8, sw = (r32 >> 1) & 7;
    const int nlat = NB * 8 * 16;
    {
        int b, head, qrow0, nkt, vkey0;
        const bool lat = it < nlat;
        if (lat) { b = it >> 7; head = (it >> 4) & 7; qrow0 = b * T + (it & 15) * 256; nkt = 68; vkey0 = 0; }
        else { const int j = it - nlat; b = j >> 3; head = j & 7; qrow0 = NL + b * CL; nkt = 4; vkey0 = T; }
        const int kvh = head >> 2;
        bf16x8 qf[2][4];
#pragma unroll
        for (int qb = 0; qb < 2; ++qb)
#pragma unroll
            for (int ks = 0; ks < 4; ++ks)
                qf[qb][ks] = *(const bf16x8*)(PROJ + (size_t)(qrow0 + wid * 64 + qb * 32 + r32) * INW + O_AQ + head * 64 + ks * 16 + h * 8);
        const char* vbase = uni_ptr(VT + ((size_t)(b * 2 + kvh) * 64) * NKEY + vkey0);
        const char* kbase = uni_ptr(PROJ + O_AK + kvh * 64);
        unsigned vo[2], ko[2];
#pragma unroll
        for (int j = 0; j < 2; ++j) { vo[j] = (unsigned)(((j * 32 + srow) * NKEY + sc) * 2); ko[j] = (unsigned)(((j * 32 + srow) * INW + sc) * 2); }
        auto krow0 = [&](int kt) { return lat ? (kt < 64 ? b * T + kt * 64 : NL + b * CL + (kt - 64) * 64) : NL + b * CL + kt * 64; };
        const int wb = __builtin_amdgcn_readfirstlane((tid >> 6) * 1024);
        auto stage = [&](int kt, int buf) {
            unsigned char* base = lds + buf * 16384 + wb;
            const char* kb = kbase + (size_t)__builtin_amdgcn_readfirstlane(krow0(kt)) * (INW * 2);
            const char* vb = vbase + (size_t)kt * 128;
#pragma unroll
            for (int j = 0; j < 2; ++j) {
                unsigned koj = ko[j], voj = vo[j];
                asm volatile("" : "+v"(koj), "+v"(voj));
                __builtin_amdgcn_global_load_lds((const unsigned*)(kb + koj), (unsigned*)(base + j * 4096), 16, 0, 0);
                __builtin_amdgcn_global_load_lds((const unsigned*)(vb + voj), (unsigned*)(base + 8192 + j * 4096), 16, 0, 0);
            }
        };
        f32x16 o[2][2];
#pragma unroll
        for (int a = 0; a < 2; ++a)
#pragma unroll
            for (int c = 0; c < 2; ++c)
#pragma unroll
                for (int e = 0; e < 16; ++e) o[a][c][e] = 0.f;
        float ls0 = 0.f, ls1 = 0.f;
        f32x16 cshift;
#pragma unroll
        for (int e = 0; e < 16; ++e) cshift[e] = -shift2;
        asm volatile("" : "+v"(cshift));
        stage(0, 0);
#pragma unroll 1
        for (int kt = 0; kt < nkt; ++kt) {
            asm volatile("s_waitcnt vmcnt(0)" ::: "memory");
            __syncthreads();
            if (kt + 1 < nkt) stage(kt + 1, (kt + 1) & 1);
            const unsigned char* kb_ = lds + (kt & 1) * 16384;
            const unsigned char* vb_ = kb_ + 8192;
            bf16x8 kf[2][4];
#pragma unroll
            for (int kb = 0; kb < 2; ++kb)
#pragma unroll
                for (int ks = 0; ks < 4; ++ks) kf[kb][ks] = *(const bf16x8*)(kb_ + (kb * 32 + r32) * 128 + (((2 * ks + h) ^ sw) * 16));
            __builtin_amdgcn_sched_barrier(0);
#pragma unroll
            for (int kb = 0; kb < 2; ++kb) {
                f32x16 s0 = MFMA32(kf[kb][0], qf[0][0], cshift), s1 = MFMA32(kf[kb][0], qf[1][0], cshift);
#pragma unroll
                for (int ks = 1; ks < 4; ++ks) {
                    s0 = MFMA32(kf[kb][ks], qf[0][ks], s0);
                    s1 = MFMA32(kf[kb][ks], qf[1][ks], s1);
                }
                bf16x8 vf[2][2];
#pragma unroll
                for (int s2 = 0; s2 < 2; ++s2)
#pragma unroll
                    for (int db = 0; db < 2; ++db) {
                        const int ksv = kb * 2 + s2;
                        vf[s2][db] = *(const bf16x8*)(vb_ + (db * 32 + r32) * 128 + (((2 * ksv + h) ^ sw) * 16));
                    }
                __builtin_amdgcn_sched_barrier(0);
#pragma unroll
                for (int e = 0; e < 16; ++e) { s0[e] = __builtin_amdgcn_exp2f(s0[e]); s1[e] = __builtin_amdgcn_exp2f(s1[e]); }
                {
                    auto add1 = [](float x, float y) { float r; asm("v_add_f32 %0, %1, %2" : "=v"(r) : "v"(x), "v"(y)); return r; };
                    float a0 = add1(add1(s0[0], s0[1]), add1(s0[2], s0[3])), a1 = add1(add1(s1[0], s1[1]), add1(s1[2], s1[3]));
#pragma unroll
                    for (int e = 4; e < 16; e += 4) { a0 = add1(a0, add1(add1(s0[e], s0[e + 1]), add1(s0[e + 2], s0[e + 3]))); a1 = add1(a1, add1(add1(s1[e], s1[e + 1]), add1(s1[e + 2], s1[e + 3]))); }
                    ls0 = add1(ls0, a0); ls1 = add1(ls1, a1);
                }
#pragma unroll
                for (int s2 = 0; s2 < 2; ++s2) {
                    const bf16x8 p0 = pack8(s0, s2), p1 = pack8(s1, s2);
#pragma unroll
                    for (int db = 0; db < 2; ++db) {
                        o[db][0] = MFMA32(vf[s2][db], p0, o[db][0]);
                        o[db][1] = MFMA32(vf[s2][db], p1, o[db][1]);
                    }
                }
            }
        }
        float l0 = ls0 + __shfl_xor(ls0, 32), l1 = ls1 + __shfl_xor(ls1, 32);
        const float i0 = 1.f / l0, i1 = 1.f / l1;
#pragma unroll
        for (int qb = 0; qb < 2; ++qb) {
            const float inv = qb ? i1 : i0;
            bf16* orow = PROJ + (size_t)(qrow0 + wid * 64 + qb * 32 + r32) * INW + O_AQ + head * 64;
#pragma unroll
            for (int db = 0; db < 2; ++db)
#pragma unroll
                for (int g = 0; g < 4; ++g)
                    st_bf4(orow + db * 32 + 8 * g + 4 * h, o[db][qb][4 * g] * inv, o[db][qb][4 * g + 1] * inv, o[db][qb][4 * g + 2] * inv, o[db][qb][4 * g + 3] * inv);
        }
    }
}

constexpr int GL_QS = 0, GL_KS = 8192, GL_KDT = 16384, GL_VT = 24576, GL_GLS = 40960, GL_TOT = 45056, GL_FIRST = 47104,
              GL_RAWQ = 47872, GL_RAWK = 56064, GL_RAWV = 64256;
constexpr size_t WS_DST = WS_H;
constexpr size_t WS_EBL = WS_LIST;
__device__ __forceinline__ int swz(int row, int byte) { return row * 128 + ((((byte >> 4) ^ (row >> 1)) & 7) << 4) + (byte & 15); }
__device__ __forceinline__ int gla_chunk_base(int b, int c) { return c < 4 ? NL + b * CL + c * 64 : b * T + (c - 4) * 64; }

__device__ __forceinline__ void gla_local_item(KParams p, int l, int item, unsigned char* lds, const int tid_) {
    const int tid = tid_opaque();
    const int lane = tid & 63, w = tid >> 6, r32 = lane & 31, h = lane >> 5;
    const int hd = item & 3, c = (item >> 2) % 68, b = (item >> 2) / 68;
    bf16* PROJ = (bf16*)(p->ws + WS_PROJ);
    const int base = gla_chunk_base(b, c);
    const int dk2 = (tid & 31) * 2, seg = tid >> 5;
    const int dv2 = (tid & 63) * 2, vq = tid >> 6;
    __syncthreads();
    {
#pragma unroll
        for (int j = 0; j < 2; ++j) {
            const size_t tok = base + j * 32 + (tid >> 3);
            __builtin_amdgcn_global_load_lds((const unsigned*)(PROJ + tok * INW + O_GQ + hd * 64 + (tid & 7) * 8), (unsigned*)(lds + GL_RAWQ + j * 4096 + __builtin_amdgcn_readfirstlane((tid >> 6) * 1024)), 16, 0, 0);
            __builtin_amdgcn_global_load_lds((const unsigned*)(PROJ + tok * INW + O_GK + hd * 64 + (tid & 7) * 8), (unsigned*)(lds + GL_RAWK + j * 4096 + __builtin_amdgcn_readfirstlane((tid >> 6) * 1024)), 16, 0, 0);
        }
#pragma unroll
        for (int j = 0; j < 4; ++j) {
            const size_t tok = base + j * 16 + (tid >> 4);
            __builtin_amdgcn_global_load_lds((const unsigned*)(PROJ + tok * INW + O_GV + hd * 128 + (tid & 15) * 8), (unsigned*)(lds + GL_RAWV + j * 4096 + __builtin_amdgcn_readfirstlane((tid >> 6) * 1024)), 16, 0, 0);
        }
        {
            const int t2 = tid & 127; const size_t tok = base + (t2 >> 1);
            __builtin_amdgcn_global_load_lds((const unsigned*)(PROJ + tok * INW + (tid < 128 ? O_GLF : O_GLB) + (t2 & 1) * 8), (unsigned*)(lds + GL_GLS + __builtin_amdgcn_readfirstlane((tid >> 6) * 1024)), 16, 0, 0);
        }
    }
#pragma unroll 1
    for (int dir = 0; dir < 2; ++dir) {
        const float* up = p->in[dir ? I_UPB : I_UPF] + (size_t)l * 16 * 256 + hd * 64;
        const float2 bia = *(const float2*)(p->in[dir ? I_BIASB : I_BIASF] + l * 256 + hd * 64 + dk2);
        const int id2 = (((b * 68 + c) * 4 + hd) << 1) + dir;
        asm volatile("s_waitcnt vmcnt(0)" ::: "memory");
        __syncthreads();
        float la0[8], la1[8];
        {
            float up0[16], up1[16];
#pragma unroll
            for (int j = 0; j < 16; ++j) { const float2 t = *(const float2*)(up + j * 256 + dk2); up0[j] = t.x; up1[j] = t.y; }
            const unsigned char* gls = lds + GL_GLS + dir * 2048;
#pragma unroll
            for (int u = 0; u < 8; ++u) {
                const int i = seg * 8 + u, ti = dir ? 63 - i : i;
                const uint4 g0 = *(const uint4*)(gls + ti * 32), g1 = *(const uint4*)(gls + ti * 32 + 16);
                const unsigned gw[8] = {g0.x, g0.y, g0.z, g0.w, g1.x, g1.y, g1.z, g1.w};
                float a0 = bia.x, a1 = bia.y;
#pragma unroll
                for (int j = 0; j < 8; ++j) {
                    const float glo = __uint_as_float(gw[j] << 16), ghi = __uint_as_float(gw[j] & 0xffff0000u);
                    a0 += glo * up0[2 * j]; a1 += glo * up1[2 * j];
                    a0 += ghi * up0[2 * j + 1]; a1 += ghi * up1[2 * j + 1];
                }
                la0[u] = (fminf(a0, 0.f) - __logf(1.f + __expf(-fabsf(a0)))) * (1.f / 16.f);
                la1[u] = (fminf(a1, 0.f) - __logf(1.f + __expf(-fabsf(a1)))) * (1.f / 16.f);
            }
#pragma unroll
            for (int u = 1; u < 8; ++u) { la0[u] += la0[u - 1]; la1[u] += la1[u - 1]; }
            *(float2*)(lds + GL_TOT + (seg * 64 + dk2) * 4) = make_float2(la0[7], la1[7]);
            if (seg == 4) *(float2*)(lds + GL_FIRST + dk2 * 4) = make_float2(la0[0], la1[0]);
        }
        __syncthreads();
        {
            float off0 = 0.f, off1 = 0.f, pre0 = 0.f, pre1 = 0.f, all0 = 0.f, all1 = 0.f;
#pragma unroll
            for (int sg = 0; sg < 8; ++sg) {
                const float2 t = *(const float2*)(lds + GL_TOT + (sg * 64 + dk2) * 4);
                if (sg < seg) { off0 += t.x; off1 += t.y; }
                if (sg < 4) { pre0 += t.x; pre1 += t.y; }
                all0 += t.x; all1 += t.y;
            }
            const float2 f4 = *(const float2*)(lds + GL_FIRST + dk2 * 4);
            const float bref0 = pre0 + f4.x, bref1 = pre1 + f4.y;
            const float c0 = __expf(all0 - bref0), c1 = __expf(all1 - bref1);
            const float er0 = __expf(bref0), er1 = __expf(bref1);
            bf16* qdst = PROJ + (size_t)base * INW + (dir ? O_GK : O_GQ) + hd * 64 + dk2;
            unsigned kd0[4], kd1[4];
#pragma unroll
            for (int u = 0; u < 8; u += 2) {
                float kdv[2][2];
#pragma unroll
                for (int uu = 0; uu < 2; ++uu) {
                    const int i = seg * 8 + u + uu, ti = dir ? 63 - i : i;
                    const float e0 = __expf(off0 + la0[u + uu] - bref0), e1 = __expf(off1 + la1[u + uu] - bref1);
                    const float r0 = __builtin_amdgcn_rcpf(e0), r1 = __builtin_amdgcn_rcpf(e1);
                    const unsigned rqv = *(const unsigned*)(lds + GL_RAWQ + ti * 128 + dk2 * 2), rkv = *(const unsigned*)(lds + GL_RAWK + ti * 128 + dk2 * 2);
                    const float q0 = __uint_as_float(rqv << 16) * 0.125f * e0, q1 = __uint_as_float(rqv & 0xffff0000u) * 0.125f * e1;
                    const float k0 = __uint_as_float(rkv << 16), k1 = __uint_as_float(rkv & 0xffff0000u);
                    const float ks0 = k0 * r0, ks1 = k1 * r1;
                    *(unsigned*)(lds + GL_QS + swz(i, dk2 * 2)) = pk_bf16(q0, q1);
                    *(unsigned*)(lds + GL_KS + swz(i, dk2 * 2)) = pk_bf16(ks0, ks1);
                    *(unsigned*)(qdst + (size_t)ti * INW) = pk_bf16(q0 * er0, q1 * er1);
                    kdv[uu][0] = ks0 * c0; kdv[uu][1] = ks1 * c1;
                }
                kd0[u >> 1] = pk_bf16(kdv[0][0], kdv[1][0]); kd1[u >> 1] = pk_bf16(kdv[0][1], kdv[1][1]);
            }
            *(uint4*)(lds + GL_KDT + swz(dk2, seg * 16)) = make_uint4(kd0[0], kd0[1], kd0[2], kd0[3]);
            *(uint4*)(lds + GL_KDT + swz(dk2 + 1, seg * 16)) = make_uint4(kd1[0], kd1[1], kd1[2], kd1[3]);
            unsigned va[8], vb[8], rv[16];
#pragma unroll
            for (int u = 0; u < 16; ++u) { const int i = vq * 16 + u, ti = dir ? 63 - i : i; rv[u] = *(const unsigned*)(lds + GL_RAWV + ti * 256 + dv2 * 2); }
#pragma unroll
            for (int m = 0; m < 8; ++m) { va[m] = (rv[2 * m] & 0xffffu) | (rv[2 * m + 1] << 16); vb[m] = (rv[2 * m] >> 16) | (rv[2 * m + 1] & 0xffff0000u); }
            *(uint4*)(lds + GL_VT + swz(dv2, vq * 32)) = make_uint4(va[0], va[1], va[2], va[3]);
            *(uint4*)(lds + GL_VT + swz(dv2, vq * 32 + 16)) = make_uint4(va[4], va[5], va[6], va[7]);
            *(uint4*)(lds + GL_VT + swz(dv2 + 1, vq * 32)) = make_uint4(vb[0], vb[1], vb[2], vb[3]);
            *(uint4*)(lds + GL_VT + swz(dv2 + 1, vq * 32 + 16)) = make_uint4(vb[4], vb[5], vb[6], vb[7]);
            if (seg == 0) *(float2*)((float*)(p->ws + WS_EBL) + (size_t)id2 * 64 + dk2) = make_float2(__expf(all0), __expf(all1));
        }
        __syncthreads();
        {
            const unsigned char* QS = lds + GL_QS; const unsigned char* KS = lds + GL_KS; const unsigned char* KDT = lds + GL_KDT; const unsigned char* VTL = lds + GL_VT;
            f32x16 ot[2];
#pragma unroll
            for (int e = 0; e < 16; ++e) { ot[0][e] = 0.f; ot[1][e] = 0.f; }
            bf16x8 kfr[2][4], qfr[2][4], vpr[4];
#pragma unroll
            for (int blk = 0; blk < 2; ++blk)
#pragma unroll
                for (int ks = 0; ks < 4; ++ks) {
                    kfr[blk][ks] = *(const bf16x8*)(KS + swz(32 * blk + r32, (2 * ks + h) * 16));
                    qfr[blk][ks] = *(const bf16x8*)(QS + swz(32 * blk + r32, (2 * ks + h) * 16));
                }
#pragma unroll
            for (int ksv = 0; ksv < 4; ++ksv) {
                const int row = 32 * w + r32;
                const s16x4 lo = *(const s16x4*)(VTL + swz(row, 32 * ksv + 8 * h));
                const s16x4 hi = *(const s16x4*)(VTL + swz(row, 32 * ksv + 16 + 8 * h));
                vpr[ksv] = __builtin_shufflevector(lo, hi, 0, 1, 2, 3, 4, 5, 6, 7);
            }
            __builtin_amdgcn_sched_barrier(0);
#pragma unroll
            for (int tI = 0; tI < 3; ++tI) {
                const int sb = tI == 2 ? 1 : 0, ib = tI == 0 ? 0 : 1;
                f32x16 pt;
#pragma unroll
                for (int e = 0; e < 16; ++e) pt[e] = 0.f;
#pragma unroll
                for (int ks = 0; ks < 4; ++ks) pt = MFMA32(kfr[sb][ks], qfr[ib][ks], pt);
                if (sb == ib) {
#pragma unroll
                    for (int e = 0; e < 16; ++e) { const int sl = (e & 3) + 8 * (e >> 2) + 4 * h; if (sl > r32) pt[e] = 0.f; }
                }
#pragma unroll
                for (int s2 = 0; s2 < 2; ++s2) ot[ib] = MFMA32(vpr[2 * sb + s2], pack8(pt, s2), ot[ib]);
            }
            bf16* OG = (bf16*)(p->ws + WS_R2 + (size_t)dir * SZ_Y512);
#pragma unroll
            for (int ib = 0; ib < 2; ++ib) {
                const int i = 32 * ib + r32; const size_t tok = base + (dir ? 63 - i : i);
                bf16* dst = OG + tok * 512 + hd * 128 + 32 * w + 4 * h;
#pragma unroll
                for (int g = 0; g < 4; ++g) st_bf4(dst + 8 * g, ot[ib][4 * g], ot[ib][4 * g + 1], ot[ib][4 * g + 2], ot[ib][4 * g + 3]);
            }
            f32x16 dS[2];
#pragma unroll
            for (int e = 0; e < 16; ++e) { dS[0][e] = 0.f; dS[1][e] = 0.f; }
            bf16x8 vnr[4], kdr[2][4];
#pragma unroll
            for (int ks = 0; ks < 4; ++ks) {
                vnr[ks] = *(const bf16x8*)(VTL + swz(32 * w + r32, (2 * ks + h) * 16));
                kdr[0][ks] = *(const bf16x8*)(KDT + swz(r32, (2 * ks + h) * 16));
                kdr[1][ks] = *(const bf16x8*)(KDT + swz(32 + r32, (2 * ks + h) * 16));
            }
            __builtin_amdgcn_sched_barrier(0);
#pragma unroll
            for (int ks = 0; ks < 4; ++ks)
#pragma unroll
                for (int dkb = 0; dkb < 2; ++dkb) dS[dkb] = MFMA32(kdr[dkb][ks], vnr[ks], dS[dkb]);
            bf16* dd = (bf16*)(p->ws + WS_DST) + (((size_t)id2 * 4 + w) * 64 + lane) * 32;
#pragma unroll
            for (int dkb = 0; dkb < 2; ++dkb)
#pragma unroll
                for (int g = 0; g < 2; ++g)
                    *(uint4*)(dd + dkb * 16 + g * 8) = make_uint4(pk_bf16(dS[dkb][8 * g], dS[dkb][8 * g + 1]), pk_bf16(dS[dkb][8 * g + 2], dS[dkb][8 * g + 3]),
                                                                  pk_bf16(dS[dkb][8 * g + 4], dS[dkb][8 * g + 5]), pk_bf16(dS[dkb][8 * g + 6], dS[dkb][8 * g + 7]));
        }
    }
}

__device__ __forceinline__ void gla_chain(KParams p, int l, int task, unsigned char* lds, const int tid_) {
    const int tid = tid_opaque();
    const int lane = tid & 63, w = tid >> 6, h = lane >> 5;
    const int b = task >> 3, hd = (task >> 1) & 3, dir = task & 1;
    bf16* DST = (bf16*)(p->ws + WS_DST);
    const float* EBL = (const float*)(p->ws + WS_EBL);
    f32x16 S[2];
#pragma unroll
    for (int e = 0; e < 16; ++e) { S[0][e] = 0.f; S[1][e] = 0.f; }
    auto id2_of = [&](int n) { const int c = n < 4 ? (dir ? 3 - n : n) : 4 + (dir ? 63 - (n - 4) : (n - 4)); return (size_t)((((b * 68 + c) * 4 + hd) << 1) + dir); };
    typedef unsigned u32x4_t __attribute__((ext_vector_type(4)));
    u32x4_t d0[4], d1[4], d2[4], d3[4];
    auto load_ds = [&](u32x4_t (&d)[4], int n) {
        const bf16* dd = DST + ((id2_of(n) * 4 + w) * 64 + lane) * 32;
#pragma unroll
        for (int q = 0; q < 4; ++q) d[q] = *(const u32x4_t*)(dd + q * 8);
    };
    load_ds(d0, 0); load_ds(d1, 1); load_ds(d2, 2); load_ds(d3, 3);
    __syncthreads();
    for (int n = w; n < 68; n += 4)
        __builtin_amdgcn_global_load_lds((const unsigned*)(EBL + id2_of(n) * 64 + lane), (unsigned*)(lds + __builtin_amdgcn_readfirstlane(n) * 256), 4, 0, 0);
    asm volatile("s_waitcnt vmcnt(0)" ::: "memory");
    __syncthreads();
    auto step = [&](u32x4_t (&d)[4], int n) {
        const size_t id2 = id2_of(n);
        float4 eb[2][4];
#pragma unroll
        for (int dkb = 0; dkb < 2; ++dkb)
#pragma unroll
            for (int g = 0; g < 4; ++g) eb[dkb][g] = *(const float4*)(lds + n * 256 + (32 * dkb + 8 * g + 4 * h) * 4);
        bf16* dd = DST + ((id2 * 4 + w) * 64 + lane) * 32;
#pragma unroll
        for (int dkb = 0; dkb < 2; ++dkb)
#pragma unroll
            for (int s2 = 0; s2 < 2; ++s2) *(bf16x8*)(dd + (dkb * 2 + s2) * 8) = pack8(S[dkb], s2);
        const unsigned dw[16] = {d[0][0], d[0][1], d[0][2], d[0][3], d[1][0], d[1][1], d[1][2], d[1][3], d[2][0], d[2][1], d[2][2], d[2][3], d[3][0], d[3][1], d[3][2], d[3][3]};
#pragma unroll
        for (int dkb = 0; dkb < 2; ++dkb)
#pragma unroll
            for (int g = 0; g < 4; ++g) {
                const float4 e = eb[dkb][g];
                const unsigned w0 = dw[dkb * 8 + g * 2], w1 = dw[dkb * 8 + g * 2 + 1];
                S[dkb][4 * g]     = S[dkb][4 * g] * e.x     + __uint_as_float(w0 << 16);
                S[dkb][4 * g + 1] = S[dkb][4 * g + 1] * e.y + __uint_as_float(w0 & 0xffff0000u);
                S[dkb][4 * g + 2] = S[dkb][4 * g + 2] * e.z + __uint_as_float(w1 << 16);
                S[dkb][4 * g + 3] = S[dkb][4 * g + 3] * e.w + __uint_as_float(w1 & 0xffff0000u);
            }
        if (n + 4 < 68) load_ds(d, n + 4);
    };
#pragma unroll 1
    for (int n = 0; n < 68; n += 4) { step(d0, n); step(d1, n + 1); step(d2, n + 2); step(d3, n + 3); }
}

__device__ __forceinline__ void gla_out_item(KParams p, int l, int item, unsigned char* lds, const int tid_) {
    const int tid = tid_opaque();
    const int lane = tid & 63, w = tid >> 6, r32 = lane & 31, h = lane >> 5;
    const int hd = item & 3, c = (item >> 2) % 68, b = (item >> 2) / 68;
    const bf16* PROJ = (const bf16*)(p->ws + WS_PROJ);
    const bf16* DST = (const bf16*)(p->ws + WS_DST);
    bf16* YG = (bf16*)(p->ws + WS_R2);
    const int base = gla_chunk_base(b, c);
    __syncthreads();
#pragma unroll
    for (int k = 0; k < 4; ++k) {
        const int id = k * 256 + tid, row = id >> 4, cc = (id & 15) ^ (row & 15);
        __builtin_amdgcn_global_load_lds((const unsigned*)(YG + (size_t)(base + row) * 512 + hd * 128 + cc * 8), (unsigned*)(lds + k * 4096 + __builtin_amdgcn_readfirstlane((tid >> 6) * 1024)), 16, 0, 0);
        __builtin_amdgcn_global_load_lds((const unsigned*)((const bf16*)(p->ws + WS_R2 + SZ_Y512) + (size_t)(base + row) * 512 + hd * 128 + cc * 8), (unsigned*)(lds + 16384 + k * 4096 + __builtin_amdgcn_readfirstlane((tid >> 6) * 1024)), 16, 0, 0);
        __builtin_amdgcn_global_load_lds((const unsigned*)(PROJ + (size_t)(base + row) * INW + O_GR + hd * 128 + cc * 8), (unsigned*)(lds + 32768 + k * 4096 + __builtin_amdgcn_readfirstlane((tid >> 6) * 1024)), 16, 0, 0);
    }
#pragma unroll
    for (int k = 0; k < 2; ++k) {
        const int id = k * 256 + tid, row = id >> 3, cc = (id & 7) ^ ((row >> 1) & 7);
        __builtin_amdgcn_global_load_lds((const unsigned*)(PROJ + (size_t)(base + row) * INW + O_GQ + hd * 64 + cc * 8), (unsigned*)(lds + 49152 + k * 4096 + __builtin_amdgcn_readfirstlane((tid >> 6) * 1024)), 16, 0, 0);
        __builtin_amdgcn_global_load_lds((const unsigned*)(PROJ + (size_t)(base + row) * INW + O_GK + hd * 64 + cc * 8), (unsigned*)(lds + 57344 + k * 4096 + __builtin_amdgcn_readfirstlane((tid >> 6) * 1024)), 16, 0, 0);
    }
    bf16x8 sp[2][4];
#pragma unroll
    for (int dir = 0; dir < 2; ++dir) {
        const size_t id2 = (size_t)((((b * 68 + c) * 4 + hd) << 1) + dir);
        const bf16* dd = DST + ((id2 * 4 + w) * 64 + lane) * 32;
#pragma unroll
        for (int q = 0; q < 4; ++q) sp[dir][q] = *(const bf16x8*)(dd + q * 8);
    }
    asm volatile("s_waitcnt vmcnt(0)" ::: "memory");
    __syncthreads();
    f32x16 ot[2];
#pragma unroll
    for (int e = 0; e < 16; ++e) { ot[0][e] = 0.f; ot[1][e] = 0.f; }
#pragma unroll
    for (int dir = 0; dir < 2; ++dir)
#pragma unroll
        for (int ib = 0; ib < 2; ++ib) {
            const int row = 32 * ib + r32, sw = (row >> 1) & 7;
            const unsigned char* qr = lds + (dir ? 57344 : 49152) + row * 128 + 8 * h;
#pragma unroll
            for (int ksv = 0; ksv < 4; ++ksv) {
                const s16x4 lo = *(const s16x4*)(qr + (((2 * ksv) ^ sw) << 4)), hi = *(const s16x4*)(qr + (((2 * ksv + 1) ^ sw) << 4));
                const bf16x8 qp = __builtin_shufflevector(lo, hi, 0, 1, 2, 3, 4, 5, 6, 7);
                ot[ib] = MFMA32(sp[dir][ksv], qp, ot[ib]);
            }
        }
    float ssq[2]; uint2 grv[2][4];
#pragma unroll
    for (int ib = 0; ib < 2; ++ib) {
        const int row = 32 * ib + r32;
        float a = 0.f;
#pragma unroll
        for (int g = 0; g < 4; ++g) {
            const int off = row * 256 + ((((4 * w + g) ^ row) & 15) << 4) + 8 * h;
            const uint2 x0 = *(const uint2*)(lds + off), x1 = *(const uint2*)(lds + 16384 + off);
            grv[ib][g] = *(const uint2*)(lds + 32768 + off);
            ot[ib][4 * g]     += __uint_as_float(x0.x << 16) + __uint_as_float(x1.x << 16);
            ot[ib][4 * g + 1] += __uint_as_float(x0.x & 0xffff0000u) + __uint_as_float(x1.x & 0xffff0000u);
            ot[ib][4 * g + 2] += __uint_as_float(x0.y << 16) + __uint_as_float(x1.y << 16);
            ot[ib][4 * g + 3] += __uint_as_float(x0.y & 0xffff0000u) + __uint_as_float(x1.y & 0xffff0000u);
            a += ot[ib][4 * g] * ot[ib][4 * g] + ot[ib][4 * g + 1] * ot[ib][4 * g + 1] + ot[ib][4 * g + 2] * ot[ib][4 * g + 2] + ot[ib][4 * g + 3] * ot[ib][4 * g + 3];
        }
        a += __shfl_xor(a, 32);
        ssq[ib] = a;
    }
    float* red = (float*)(lds + 65536);
    if (h == 0) { red[w * 64 + r32] = ssq[0]; red[w * 64 + 32 + r32] = ssq[1]; }
    __syncthreads();
    const float* gn = p->in[I_GLANG] + l * 128 + 32 * w + 4 * h;
#pragma unroll
    for (int ib = 0; ib < 2; ++ib) {
        const int t = 32 * ib + r32;
        const float inv = rsqrtf((red[t] + red[64 + t] + red[128 + t] + red[192 + t]) * (1.f / 128.f) + EPS);
#pragma unroll
        for (int g = 0; g < 4; ++g) {
            const float4 gg = *(const float4*)(gn + 8 * g);
            const float r0 = __uint_as_float(grv[ib][g].x << 16), r1 = __uint_as_float(grv[ib][g].x & 0xffff0000u), r2 = __uint_as_float(grv[ib][g].y << 16), r3 = __uint_as_float(grv[ib][g].y & 0xffff0000u);
            *(uint2*)(lds + t * 256 + ((((4 * w + g) ^ t) & 15) << 4) + 8 * h) =
                make_uint2(pk_bf16(ot[ib][4 * g] * inv * gg.x * silu_f(r0), ot[ib][4 * g + 1] * inv * gg.y * silu_f(r1)),
                           pk_bf16(ot[ib][4 * g + 2] * inv * gg.z * silu_f(r2), ot[ib][4 * g + 3] * inv * gg.w * silu_f(r3)));
        }
    }
    __syncthreads();
#pragma unroll
    for (int k = 0; k < 4; ++k) {
        const int id = k * 256 + tid, row = id >> 4, ch = id & 15;
        *(uint4*)(YG + (size_t)(base + row) * 512 + hd * 128 + ch * 8) = *(const uint4*)(lds + row * 256 + (((ch ^ row) & 15) << 4));
    }
}
__device__ __forceinline__ void ph_gla_out(KParams p, int l, unsigned char* lds) {
    const int tid = tid_opaque();
    const int nchunk = (l == 0) ? 68 : 64;
    for (int it = blockIdx.x; it < NB * nchunk * 4; it += gridDim.x) {
        const int hd = it & 3, q = it >> 2, bb = q / nchunk, cc = q % nchunk + (68 - nchunk);
        gla_out_item(p, l, ((bb * 68 + cc) << 2) + hd, lds, tid);
    }
}

__device__ __forceinline__ void ph_gla_local(KParams p, int l, unsigned char* lds) {
    const int tid = tid_opaque();
    for (int it = blockIdx.x; it < NB * 68 * 4; it += gridDim.x) gla_local_item(p, l, it, lds, tid);
    __syncthreads();
}

constexpr int CW_WORK = 64;
constexpr int LDS_ITEM_OFF = 79 * 1024;
__device__ __forceinline__ void ph_mix(KParams p, int l, unsigned char* lds) {
    const int tid = tid_opaque();
    unsigned* ctr = (unsigned*)(p->ws + WS_CTL) + CW_WORK + l;
    volatile int* slot = (volatile int*)(lds + LDS_ITEM_OFF);
    const int nitems = 64 + NB * 8 * 16 + ((l == 0) ? NB * 8 : 0);
    for (;;) {
        __syncthreads();
        if (tid == 0) *slot = (int)__hip_atomic_fetch_add(ctr, 1u, __ATOMIC_RELAXED, __HIP_MEMORY_SCOPE_AGENT);
        __syncthreads();
        const int it = *slot;
        if (it >= nitems) break;
        if (it < 64) gla_chain(p, l, it, lds, tid);
        else attn_item(p, l, it - 64, lds, tid);
    }
}

constexpr int CW_ROWC = 74000;
constexpr int TQ_TYPE = 1 << 28, TQ_READY = 1 << 29, TQ_MASK = (1 << 28) - 1;
__device__ __forceinline__ int tq2_next(const TileQ& q, const unsigned* rowc, int nM, int nN) {
    const int x = (int)(__builtin_amdgcn_s_getreg((3 << 11) | 20) & 7u);
    for (int s = 0; s < 8; ++s) {
        const int c = (x + s) & 7;
        const int b = (int)(((long)q.ntiles * c) >> 3), e = (int)(((long)q.ntiles * (c + 1)) >> 3), n = e - b;
        if (n <= 0) continue;
        if ((int)__hip_atomic_load(q.ctr + c * 64, __ATOMIC_RELAXED, __HIP_MEMORY_SCOPE_AGENT) >= 2 * n) continue;
        const int t = (int)__hip_atomic_fetch_add(q.ctr + c * 64, 1u, __ATOMIC_RELAXED, __HIP_MEMORY_SCOPE_AGENT);
        if (t < n) return b + t;
        if (t < 2 * n) {
            const int it = b + t - n; int tm, tn; tile_coords(it, nM, nN, tm, tn);
            const int ready = __hip_atomic_load(rowc + tm, __ATOMIC_RELAXED, __HIP_MEMORY_SCOPE_AGENT) >= (unsigned)nN ? TQ_READY : 0;
            return it | TQ_TYPE | ready;
        }
    }
    return -1;
}
__device__ __forceinline__ void ph_mo(KParams p, int l, unsigned char* lds) {
    const bf16* PROJ = (const bf16*)(p->ws + WS_PROJ);
    const bf16* YG = (const bf16*)(p->ws + WS_R2);
    const bf16* DP = (const bf16*)(p->ws + WS_R2 + 2 * SZ_Y512);
    bf16* Z = (bf16*)(p->ws + WS_H);
    const bf16* WO = wsm_outt(p, l);
    const bf16* WT0 = wsm_bt(p, l, 0);
    const int nrows = (l == 0) ? NTOK : NL, nM = nrows / 128, nN = 8;
    const int tid = tid_opaque();
    unsigned* rowc = (unsigned*)(p->ws + WS_CTL) + CW_ROWC + l * 320;
    auto issue_m = [&](int it_, int br_) {
        int tm_, tn_; tile_coords(it_, nM, nN, tm_, tn_);
        const bf16* Ab_ = br_ == 0 ? YG : (br_ == 1 ? PROJ + O_AQ : DP);
        const size_t lda_ = br_ == 1 ? (size_t)INW : (size_t)512;
        const bf16* W_ = WT0 + (size_t)br_ * (SZ_WBT / 2);
        gemm_issue0([&](int r) { return Ab_ + (size_t)(tm_ * 128 + r) * lda_; }, [&](int r) { return W_ + (size_t)(tn_ * 128 + r) * 512; }, Ab_ + (size_t)(tm_ * 128) * lda_, lds, tid);
    };
    auto issue_o = [&](int it_) { int tm_, tn_; tile_coords(it_, nM, nN, tm_, tn_);
        gemm_issue0([&](int r) { return Z + (size_t)(tm_ * 128 + r) * 512; }, [&](int r) { return WO + (size_t)(tn_ * 128 + r) * 512; }, Z + (size_t)(tm_ * 128) * 512, lds, tid); };
    const TileQ tq{(unsigned*)(p->ws + WS_CTL) + CW_TQ + (l * 5 + 1) * 512, nM * nN};
    volatile int* slot = (volatile int*)(lds + LDS_TQ_OFF);
    int pend = -1;
    auto bump = [&]() { if (pend >= 0) { if (tid == 0) __hip_atomic_fetch_add(rowc + pend, 1u, __ATOMIC_RELAXED, __HIP_MEMORY_SCOPE_AGENT); pend = -1; } };
    auto flush_pend = [&]() { if (pend >= 0) { asm volatile("s_waitcnt vmcnt(0)" ::: "memory"); __syncthreads(); bump(); } };
    auto start_out = [&](int nx) {
        int tm_, tn_; tile_coords(nx & TQ_MASK, nM, nN, tm_, tn_);
        flush_pend();
        if (tid == 0) while (__hip_atomic_load(rowc + tm_, __ATOMIC_RELAXED, __HIP_MEMORY_SCOPE_AGENT) < (unsigned)nN) __builtin_amdgcn_s_sleep(2);
        __syncthreads();
        issue_o(nx & TQ_MASK);
    };
    auto prefetch_next = [&](int n_) { const int nx = __builtin_amdgcn_readfirstlane(slot[(n_ + 1) & 1]);
        if (nx >= 0) { if (!(nx & TQ_TYPE)) issue_m(nx & TQ_MASK, 0); else if (nx & TQ_READY) issue_o(nx & TQ_MASK); } };
    __syncthreads();
    if (tid == 0) slot[0] = tq2_next(tq, rowc, nM, nN);
    __syncthreads();
    int cur = __builtin_amdgcn_readfirstlane(slot[0]);
    if (cur >= 0) { if (!(cur & TQ_TYPE)) issue_m(cur & TQ_MASK, 0); else if (cur & TQ_READY) issue_o(cur & TQ_MASK); else start_out(cur); }
    for (int n_ = 0; cur >= 0; ++n_) {
        int traw = 0, rv = 0, rdyv = 0;
        if (tid == 0) traw = tq_fetch(tq);
        auto mid_q = [&](int kt_, int KT_) {
            if (tid == 0) {
                if (kt_ == KT_ - 3) {
                    const int c_ = (int)(__builtin_amdgcn_s_getreg((3 << 11) | 20) & 7u);
                    const int b_ = (int)(((long)tq.ntiles * c_) >> 3), e_ = (int)(((long)tq.ntiles * (c_ + 1)) >> 3), nn_ = e_ - b_;
                    if ((unsigned)traw < (unsigned)nn_) { rv = b_ + traw; rdyv = 0; }
                    else if ((unsigned)traw < (unsigned)(2 * nn_)) {
                        rv = (b_ + traw - nn_) | TQ_TYPE; int tm_, tn_; tile_coords(rv & TQ_MASK, nM, nN, tm_, tn_);
                        rdyv = (int)__hip_atomic_load(rowc + tm_, __ATOMIC_RELAXED, __HIP_MEMORY_SCOPE_AGENT);
                    } else { rv = tq2_next(tq, rowc, nM, nN); rdyv = -1; }
                } else if (kt_ == KT_ - 2) {
                    slot[(n_ + 1) & 1] = (rdyv >= 0 && (rv & TQ_TYPE) && rdyv >= nN) ? (rv | TQ_READY) : rv;
                }
            }
        };
        const int it = cur & TQ_MASK;
        int tm, tn; tile_coords(it, nM, nN, tm, tn);
        if (!(cur & TQ_TYPE)) {
            const int tid = tid_opaque(), lane = tid & 63, wid = tid >> 6, wr = wid >> 1, wc = wid & 1, fr = lane & 15, fq = lane >> 4;
            f32x4 acc[4][4]; zero_acc4(acc);
            unsigned ga[4][4], gb[4][4];
            const unsigned char* gbase = (const unsigned char*)PROJ + ((size_t)(tm * 128 + wr * 64 + fr) * INW + O_GT) * 2 + tn * 128 + wc * 64 + fq * 4;
#pragma unroll
            for (int i = 0; i < 4; ++i)
#pragma unroll
                for (int j = 0; j < 4; ++j) ga[i][j] = *(const unsigned*)(gbase + (size_t)i * 16 * INW * 2 + j * 16);
#pragma unroll 1
            for (int br = 0; br < 3; ++br) {
                const bf16* WT = WT0 + (size_t)br * (SZ_WBT / 2);
                const bf16* Ab = br == 0 ? YG : (br == 1 ? PROJ + O_AQ : DP);
                const size_t lda = br == 1 ? (size_t)INW : (size_t)512;
                if (br < 2) {
#pragma unroll
                    for (int i = 0; i < 4; ++i)
#pragma unroll
                        for (int j = 0; j < 4; ++j) gb[i][j] = *(const unsigned*)(gbase + (size_t)i * 16 * INW * 2 + (br + 1) * D + j * 16);
                }
                gemm_tile<true, false, false>(acc, [&](int r) { return Ab + (size_t)(tm * 128 + r) * lda; }, [&](int r) { return WT + (size_t)(tn * 128 + r) * 512; }, Ab + (size_t)(tm * 128) * lda, 512, lds, tid,
                          [&]() { bump(); if (br < 2) issue_m(it, br + 1); else prefetch_next(n_); }, [&](int kt_, int KT_) { if (br == 2) mid_q(kt_, KT_); });
#pragma unroll
                for (int i = 0; i < 4; ++i)
#pragma unroll
                    for (int j = 0; j < 4; ++j) {
                        const float a0 = __builtin_amdgcn_cvt_f32_fp8((int)ga[i][j], 0), a1 = __builtin_amdgcn_cvt_f32_fp8((int)ga[i][j], 1), a2 = __builtin_amdgcn_cvt_f32_fp8((int)ga[i][j], 2), a3 = __builtin_amdgcn_cvt_f32_fp8((int)ga[i][j], 3);
                        float r0 = sigmoid_f(a0), r1 = sigmoid_f(a1), r2 = sigmoid_f(a2), r3 = sigmoid_f(a3);
                        if (br < 2) {
                            const float b0 = __builtin_amdgcn_cvt_f32_fp8((int)gb[i][j], 0), b1 = __builtin_amdgcn_cvt_f32_fp8((int)gb[i][j], 1), b2 = __builtin_amdgcn_cvt_f32_fp8((int)gb[i][j], 2), b3 = __builtin_amdgcn_cvt_f32_fp8((int)gb[i][j], 3);
                            r0 *= 1.f + __expf(-b0); r1 *= 1.f + __expf(-b1); r2 *= 1.f + __expf(-b2); r3 *= 1.f + __expf(-b3);
                        }
                        acc[i][j][0] *= r0; acc[i][j][1] *= r1; acc[i][j][2] *= r2; acc[i][j][3] *= r3;
                        ga[i][j] = gb[i][j];
                    }
            }
            __syncthreads();
#pragma unroll
            for (int i = 0; i < 4; ++i)
#pragma unroll
                for (int j = 0; j < 4; ++j) {
                    const int row = wr * 64 + i * 16 + fr, cb = wc * 64 + j * 16 + fq * 4;
                    *(unsigned*)(lds + STG_OFF + row * 128 + ((((cb >> 4) ^ (row >> 1)) & 7) << 4) + (cb & 15)) = pk_fp8x4(acc[i][j][0], acc[i][j][1], acc[i][j][2], acc[i][j][3]);
                }
            __syncthreads();
#pragma unroll
            for (int k = 0; k < 8; ++k) {
                const int idx = k * 256 + tid, row = idx >> 4, c8 = idx & 15;
                const unsigned long long v = *(const unsigned long long*)(lds + STG_OFF + row * 128 + ((((c8 >> 1) ^ (row >> 1)) & 7) << 4) + (c8 & 1) * 8);
                __hip_atomic_store((unsigned long long*)((unsigned char*)Z + (size_t)(tm * 128 + row) * D + tn * 128 + c8 * 8), v, __ATOMIC_RELAXED, __HIP_MEMORY_SCOPE_AGENT);
            }
            pend = __builtin_amdgcn_readfirstlane(tm);
        } else {
            const int tid = tid_opaque(), lane = tid & 63, wid = tid >> 6, wr = wid >> 1, wc = wid & 1, fr = lane & 15, fq = lane >> 4;
            float4 xo[4][4];
#pragma unroll
            for (int i = 0; i < 4; ++i) {
                const float* xr = xrow(p, l, tm * 128 + wr * 64 + i * 16 + fr);
#pragma unroll
                for (int j = 0; j < 4; ++j) xo[i][j] = *(const float4*)(xr + tn * 128 + wc * 64 + j * 16 + fq * 4);
            }
            f32x4 acc[4][4]; zero_acc4(acc);
            gemm_tile<true, true, true>(acc, [&](int r) { return Z + (size_t)(tm * 128 + r) * 512; }, [&](int r) { return WO + (size_t)(tn * 128 + r) * 512; }, Z + (size_t)(tm * 128) * 512, 512, lds, tid,
                      [&]() { bump(); prefetch_next(n_); }, mid_q);
#pragma unroll
            for (int i = 0; i < 4; ++i) {
                const int r = tm * 128 + wr * 64 + i * 16 + fr;
                const float* g1 = modv(p, l, modrow(r), 2);
                float* dr = r < NL ? p->out + (size_t)r * D : (float*)(p->ws + WS_XC) + (size_t)(r - NL) * D;
#pragma unroll
                for (int j = 0; j < 4; ++j) {
                    const int c = tn * 128 + wc * 64 + j * 16 + fq * 4;
                    float4 gg = *(const float4*)(g1 + c); gg.x *= 0.03125f; gg.y *= 0.03125f; gg.z *= 0.03125f; gg.w *= 0.03125f;
                    *(float4*)(dr + c) = make_float4(xo[i][j].x + gg.x * acc[i][j][0], xo[i][j].y + gg.y * acc[i][j][1], xo[i][j].z + gg.z * acc[i][j][2], xo[i][j].w + gg.w * acc[i][j][3]);
                }
            }
        }
        const int nxt = __builtin_amdgcn_readfirstlane(slot[(n_ + 1) & 1]);
        if (nxt >= 0 && (nxt & TQ_TYPE) && !(nxt & TQ_READY)) start_out(nxt);
        cur = nxt;
    }
    flush_pend();
}

__device__ __forceinline__ const float* x1row(KParams p, int r) {
    return r < NL ? p->out + (size_t)r * D : (const float*)(p->ws + WS_XC) + (size_t)(r - NL) * D;
}
__device__ __forceinline__ void ph_router(KParams p, int l, unsigned char* lds) {
    const int tid = tid_opaque(), lane = tid & 63, wid = tid >> 6;
    bf16* H = (bf16*)(p->ws + WS_H);
    const float* g = p->in[I_N2G] + l * D;
    const float* wt_ = (const float*)(p->ws + WS_RWT) + (size_t)l * 36 * D;
    unsigned* cnt = (unsigned*)(p->ws + WS_CTL) + CNT_BASE + l * 32 * CNT_STRIDE;
    int* list = (int*)(p->ws + WS_LIST);
    float* wt = (float*)(p->ws + WS_WT);
    const int nrows = (l == 0) ? NTOK : NL, ngrp = nrows / 16;
    float* LG = (float*)(lds + 65536) + wid * 4 * 40;
    const int myidx = (int)(__builtin_bitreverse32((unsigned)(lane & 31)) >> 27);
    auto issue_chunk = [&](int c, int buf) {
#pragma unroll
        for (int j = 0; j < 8; ++j)
            __builtin_amdgcn_global_load_lds((const unsigned*)(wt_ + (size_t)c * 8 * D + j * 1024 + tid * 4), (unsigned*)(lds + buf * 32768 + j * 4096 + __builtin_amdgcn_readfirstlane((tid >> 6) * 1024)), 16, 0, 0);
    };
    __syncthreads();
    if ((int)blockIdx.x < ngrp) issue_chunk(0, 0);
    int kk = 0;
    for (int gi = blockIdx.x; gi < ngrp; gi += gridDim.x) {
        const int r0 = gi * 16 + wid * 4;
        float hv[4][16];
        {
            float4 xv[4][4];
#pragma unroll
            for (int q = 0; q < 4; ++q) {
                const float* x = x1row(p, r0 + q);
#pragma unroll
                for (int j = 0; j < 4; ++j) xv[q][j] = *(const float4*)(x + j * 256 + lane * 4);
            }
            float inv[4];
#pragma unroll
            for (int q = 0; q < 4; ++q) {
                float ss = 0.f;
#pragma unroll
                for (int j = 0; j < 4; ++j) ss += xv[q][j].x * xv[q][j].x + xv[q][j].y * xv[q][j].y + xv[q][j].z * xv[q][j].z + xv[q][j].w * xv[q][j].w;
                inv[q] = ss;
            }
#pragma unroll
            for (int o = 1; o < 64; o <<= 1) {
#pragma unroll
                for (int q = 0; q < 4; ++q) inv[q] += __shfl_xor(inv[q], o);
            }
#pragma unroll
            for (int q = 0; q < 4; ++q) {
                const int r = r0 + q, mb = modrow(r);
                const float iv = rsqrtf(inv[q] * (1.f / D) + EPS);
                const float* sh = modv(p, l, mb, 3); const float* sc = modv(p, l, mb, 4);
#pragma unroll
                for (int j = 0; j < 4; ++j) {
                    const int c = j * 256 + lane * 4;
                    const float4 gg = *(const float4*)(g + c), s1 = *(const float4*)(sh + c), s2 = *(const float4*)(sc + c);
                    hv[q][j * 4 + 0] = xv[q][j].x * iv * gg.x * (1.f + s2.x) + s1.x; hv[q][j * 4 + 1] = xv[q][j].y * iv * gg.y * (1.f + s2.y) + s1.y;
                    hv[q][j * 4 + 2] = xv[q][j].z * iv * gg.z * (1.f + s2.z) + s1.z; hv[q][j * 4 + 3] = xv[q][j].w * iv * gg.w * (1.f + s2.w) + s1.w;
                }
            }
#pragma unroll
            for (int q = 0; q < 4; ++q)
#pragma unroll
                for (int j = 0; j < 4; ++j)
                    *(unsigned*)((unsigned char*)(p->ws + WS_H28) + (size_t)(r0 + q) * D + j * 256 + lane * 4) = pk_fp8x4(hv[q][j * 4], hv[q][j * 4 + 1], hv[q][j * 4 + 2], hv[q][j * 4 + 3]);
        }
#pragma unroll 1
        for (int c = 0; c < 5; ++c) {
            asm volatile("s_waitcnt vmcnt(0)" ::: "memory");
            __syncthreads();
            issue_chunk(c == 4 ? 0 : c + 1, (kk + 1) & 1);
            const unsigned char* wb = lds + (kk & 1) * 32768;
            ++kk;
            float v[32];
#pragma unroll
            for (int e = 0; e < 32; ++e) v[e] = 0.f;
#pragma unroll
            for (int oo = 0; oo < 8; ++oo)
#pragma unroll
                for (int j = 0; j < 4; ++j) {
                    const float4 w = *(const float4*)(wb + oo * 4096 + j * 1024 + lane * 16);
#pragma unroll
                    for (int q = 0; q < 4; ++q) v[oo * 4 + q] += hv[q][j * 4] * w.x + hv[q][j * 4 + 1] * w.y + hv[q][j * 4 + 2] * w.z + hv[q][j * 4 + 3] * w.w;
                }
#pragma unroll
            for (int st = 0; st < 5; ++st) {
                const int n = 16 >> st;
                const bool up = (lane >> st) & 1;
#pragma unroll
                for (int i = 0; i < n; ++i) {
                    const float keep = up ? v[i + n] : v[i], send = up ? v[i] : v[i + n];
                    v[i] = keep + __shfl_xor(send, 1 << st);
                }
            }
            const float val = v[0] + __shfl_xor(v[0], 32);
            const int o = c * 8 + (myidx >> 2);
            if (lane < 32 && o < 36) LG[(myidx & 3) * 40 + o] = val;
        }
        __syncthreads();
        if (lane < 4) {
            const float* lgq = LG + lane * 40;
            float lg[4];
#pragma unroll
            for (int z = 0; z < 4; ++z) lg[z] = lgq[z] + p->in[I_BGRP][l * 4 + z];
            float gmax = lg[0]; int grp = 0;
#pragma unroll
            for (int z = 1; z < 4; ++z) if (lg[z] > gmax) { gmax = lg[z]; grp = z; }
            float gden = 0.f;
#pragma unroll
            for (int z = 0; z < 4; ++z) gden += __expf(lg[z] - gmax);
            const float ptg = 1.f / gden;
            float le[8];
#pragma unroll
            for (int z = 0; z < 8; ++z) le[z] = lgq[4 + grp * 8 + z] + p->in[I_BEXP][l * 32 + grp * 8 + z];
            int i1 = 0; float m1 = le[0];
#pragma unroll
            for (int z = 1; z < 8; ++z) if (le[z] > m1) { m1 = le[z]; i1 = z; }
            int i2 = -1; float m2 = -3.0e38f;
#pragma unroll
            for (int z = 0; z < 8; ++z) if (z != i1 && le[z] > m2) { m2 = le[z]; i2 = z; }
            const float e2 = __expf(m2 - m1);
            const float w1 = ptg / (1.f + e2), w2 = ptg * e2 / (1.f + e2);
            const int r = r0 + lane, ea = grp * 8 + i1, eb = grp * 8 + i2;
            const unsigned pa = atomicAdd(&cnt[ea * CNT_STRIDE], 1u); list[(size_t)ea * NTOK + pa] = r * 2;
            const unsigned pb = atomicAdd(&cnt[eb * CNT_STRIDE], 1u); list[(size_t)eb * NTOK + pb] = r * 2 + 1;
            wt[r * 2] = w1; wt[r * 2 + 1] = w2;
        }
    }
    asm volatile("s_waitcnt vmcnt(0)" ::: "memory");
    __syncthreads();
}

__device__ __forceinline__ void ph_convmoe(KParams p, int l, float* sm) {
    const int tid = tid_opaque();
    bf16* WGU = (bf16*)(p->ws + WS_WGU);
    bf16* WDT = (bf16*)(p->ws + WS_WDT);
    conv_stream([&](int it) {
        const int e = it / 384, r = it % 384, kind = r >> 7, q = r & 127;
        ConvItem c; c.dst8 = nullptr; c.base8 = 0; c.n8 = 0; c.ld8 = D;
        if (kind < 2) {
            c.src = p->in[kind == 0 ? I_WGATE : I_WUP] + ((size_t)(l * 32 + e) * D) * 512; c.dst = nullptr; c.dst8 = (unsigned char*)(p->ws + WS_WGU8) + (size_t)e * D * D; c.n8 = 1024; c.ldsrc = 512; c.nvalid = 512;
            c.k0 = (q >> 3) * 64; c.n0 = (q & 7) * 64; c.lddst = D; c.kind = 2 + kind;
        } else {
            c.src = p->in[I_WDOWN] + ((size_t)(l * 32 + e) * 512) * D; c.dst = nullptr; c.dst8 = (unsigned char*)(p->ws + WS_WDT8) + (size_t)e * D * 512; c.n8 = 1024; c.ld8 = 512; c.ldsrc = D; c.nvalid = D;
            c.k0 = (q >> 4) * 64; c.n0 = (q & 15) * 64; c.lddst = 512; c.kind = 0;
        }
        return c;
    }, 32 * 384, (unsigned char*)sm, tid);
}

constexpr int LDS_MOE_TAB = 65536;
__device__ __forceinline__ int moe_build_table(const unsigned* cnt, unsigned char* lds, const int tid) {
    int* TS = (int*)(lds + LDS_MOE_TAB); int* CN = TS + 40;
    __syncthreads();
    if (tid < 32) CN[tid] = (int)cnt[tid * CNT_STRIDE];
    __syncthreads();
    if (tid == 0) { int acc = 0; for (int q = 0; q < 32; ++q) { TS[q] = acc; acc += (CN[q] + 127) >> 7; } TS[32] = acc; }
    __syncthreads();
    return TS[32];
}
__device__ __forceinline__ void moe_tile_lookup(const unsigned char* lds, int trow, int& e, int& i0, int& ce) {
    const int* TS = (const int*)(lds + LDS_MOE_TAB); const int* CN = TS + 40;
    int lo = 0;
#pragma unroll
    for (int step = 16; step >= 1; step >>= 1) if (TS[lo + step] <= trow) lo += step;
    e = lo; i0 = (trow - TS[lo]) * 128; ce = CN[lo];
}

__device__ __forceinline__ void ph_moe1(KParams p, int l, unsigned char* lds) {
    const bf16* H = (const bf16*)(p->ws + WS_H28);
    bf16* ACT = (bf16*)(p->ws + WS_ACT);
    const bf16* WGU = (const bf16*)(p->ws + WS_WGU8);
    const unsigned* cnt = (const unsigned*)(p->ws + WS_CTL) + CNT_BASE + l * 32 * CNT_STRIDE;
    const int* list = (const int*)(p->ws + WS_LIST);
    const int tid = tid_opaque(), lane = tid & 63, wid = tid >> 6, wr = wid >> 1, wc = wid & 1, fr = lane & 15, fq = lane >> 4;
    const int ntiles = moe_build_table(cnt, lds, tid), G = gridDim.x;
    auto issue = [&](int it_) {
        int e_, i0_, ce_; moe_tile_lookup(lds, it_ >> 3, e_, i0_, ce_);
        const int* le_ = list + (size_t)e_ * NTOK; const bf16* W_ = WGU + (size_t)e_ * D * 512 + (size_t)(it_ & 7) * 128 * 512;
        gemm_issue0([&](int r) { const int ii = min(i0_ + r, ce_ - 1); return H + (size_t)(le_[ii] >> 1) * 512; }, [&](int r) { return W_ + (size_t)r * 512; }, H, lds, tid);
    };
    const TileQ tq{(unsigned*)(p->ws + WS_CTL) + CW_TQ + (l * 5 + 3) * 512, ntiles * 8};
    volatile int* slot = (volatile int*)(lds + LDS_TQ_OFF);
    __syncthreads();
    if (tid == 0) slot[0] = tq_next(tq);
    __syncthreads();
    int it = __builtin_amdgcn_readfirstlane(slot[0]);
    if (it >= 0) issue(it);
    for (int n_ = 0; it >= 0; ++n_) {
        int traw = 0;
        if (tid == 0) traw = tq_fetch(tq);
        const int trow = it >> 3, tn = it & 7;
        int e, i0, ce; moe_tile_lookup(lds, trow, e, i0, ce);
        const int* le = list + (size_t)e * NTOK;
        const bf16* WT = WGU + (size_t)e * D * 512;
        f32x4 acc[4][4]; zero_acc4(acc);
        gemm_tile<false, false, true>(acc, [&](int r) { const int ii = min(i0 + r, ce - 1); return H + (size_t)(le[ii] >> 1) * 512; },
                  [&](int r) { return WT + (size_t)(tn * 128 + r) * 512; }, H, 512, lds, tid, [&]() { const int nx = __builtin_amdgcn_readfirstlane(slot[(n_ + 1) & 1]); if (nx >= 0) issue(nx); }, [&](int kt_, int KT_) { if (kt_ == KT_ - 2 && tid == 0) slot[(n_ + 1) & 1] = tq_resolve(tq, traw); });
        __syncthreads();
#pragma unroll
        for (int i = 0; i < 4; ++i)
#pragma unroll
            for (int jp = 0; jp < 2; ++jp) {
                const f32x4 g = acc[i][2 * jp] * 0.03125f, u = acc[i][2 * jp + 1] * 0.03125f;
                const int row = wr * 64 + i * 16 + fr, cb = wc * 32 + jp * 16 + fq * 4;
                *(unsigned*)(lds + STG_OFF + row * 64 + ((((cb >> 4) ^ (row >> 1)) & 3) << 4) + (cb & 15)) = pk_fp8x4(silu_f(g[0]) * u[0], silu_f(g[1]) * u[1], silu_f(g[2]) * u[2], silu_f(g[3]) * u[3]);
            }
        __syncthreads();
#pragma unroll
        for (int k = 0; k < 2; ++k) {
            const int idx = k * 256 + tid, row = idx >> 2, ch = idx & 3, ii = i0 + row;
            if (ii < ce) *(uint4*)((unsigned char*)ACT + (size_t)le[ii] * 512 + tn * 64 + ch * 16) = *(const uint4*)(lds + STG_OFF + row * 64 + (((ch ^ (row >> 1)) & 3) << 4));
        }
        it = __builtin_amdgcn_readfirstlane(slot[(n_ + 1) & 1]);
    }
}

__device__ __forceinline__ void ph_moe2(KParams p, int l, unsigned char* lds) {
    const bf16* ACT = (const bf16*)(p->ws + WS_ACT);
    const bf16* WDT = (const bf16*)(p->ws + WS_WDT8);
    const unsigned* cnt = (const unsigned*)(p->ws + WS_CTL) + CNT_BASE + l * 32 * CNT_STRIDE;
    const int* list = (const int*)(p->ws + WS_LIST);
    const float* wt = (const float*)(p->ws + WS_WT);
    const int tid = tid_opaque(), lane = tid & 63, wid = tid >> 6, wr = wid >> 1, wc = wid & 1, fr = lane & 15, fq = lane >> 4;
    const int ntiles = moe_build_table(cnt, lds, tid), G = gridDim.x;
    auto issue = [&](int it_) {
        int e_, i0_, ce_; moe_tile_lookup(lds, it_ >> 3, e_, i0_, ce_);
        const int* le_ = list + (size_t)e_ * NTOK; const bf16* W_ = WDT + (size_t)e_ * D * 256 + (size_t)(it_ & 7) * 128 * 256;
        gemm_issue0([&](int r) { const int ii = min(i0_ + r, ce_ - 1); return ACT + (size_t)le_[ii] * 256; }, [&](int r) { return W_ + (size_t)r * 256; }, ACT, lds, tid);
    };
    const TileQ tq{(unsigned*)(p->ws + WS_CTL) + CW_TQ + (l * 5 + 4) * 512, ntiles * 8};
    volatile int* slot = (volatile int*)(lds + LDS_TQ_OFF);
    __syncthreads();
    if (tid == 0) slot[0] = tq_next(tq);
    __syncthreads();
    int it = __builtin_amdgcn_readfirstlane(slot[0]);
    if (it >= 0) issue(it);
    for (int n_ = 0; it >= 0; ++n_) {
        int traw = 0;
        if (tid == 0) traw = tq_fetch(tq);
        const int trow = it >> 3, tn = it & 7;
        int e, i0, ce; moe_tile_lookup(lds, trow, e, i0, ce);
        const int* le = list + (size_t)e * NTOK;
        const bf16* WT = WDT + (size_t)e * D * 256;
        int asg[4] = {0, 0, 0, 0}; float wv[4] = {0.f, 0.f, 0.f, 0.f};
        f32x4 acc[4][4]; zero_acc4(acc);
        gemm_tile<false, false, true>(acc, [&](int r) { const int ii = min(i0 + r, ce - 1); return ACT + (size_t)le[ii] * 256; },
                  [&](int r) { return WT + (size_t)(tn * 128 + r) * 256; }, ACT, 256, lds, tid, [&]() { const int nx = __builtin_amdgcn_readfirstlane(slot[(n_ + 1) & 1]); if (nx >= 0) issue(nx); }, [&](int kt_, int KT_) {
                      if (kt_ == 0) {
#pragma unroll
                          for (int i = 0; i < 4; ++i) asg[i] = le[min(i0 + wr * 64 + i * 16 + fr, ce - 1)];
                      } else if (kt_ == 1) {
#pragma unroll
                          for (int i = 0; i < 4; ++i) wv[i] = wt[asg[i]];
                      }
                      if (kt_ == KT_ - 2 && tid == 0) slot[(n_ + 1) & 1] = tq_resolve(tq, traw); });
        __syncthreads();
#pragma unroll
        for (int i = 0; i < 4; ++i) {
            const float w = wv[i] * 0.03125f;
#pragma unroll
            for (int j = 0; j < 4; ++j)
                stg_put<16>(lds, wr * 64 + i * 16 + fr, (wc * 64 + j * 16 + fq * 4) * 2, pk_bf16(w * acc[i][j][0], w * acc[i][j][1]), pk_bf16(w * acc[i][j][2], w * acc[i][j][3]));
        }
        __syncthreads();
        stg_flush<16>(lds, tid, [&](int row, int ch) -> bf16* {
            const int ii = i0 + row; if (ii >= ce) return nullptr;
            const int a = le[ii]; return (bf16*)(p->ws + ((a & 1) ? WS_Y1 : WS_Y0)) + (size_t)(a >> 1) * D + tn * 128 + ch * 8; });
        it = __builtin_amdgcn_readfirstlane(slot[(n_ + 1) & 1]);
    }
}

__device__ __forceinline__ void ph_combine(KParams p, int l) {
    const int tid = tid_opaque(), lane = tid & 63, gw = blockIdx.x * 4 + (tid >> 6), ngw = gridDim.x * 4;
    const bf16* Y0 = (const bf16*)(p->ws + WS_Y0);
    const bf16* Y1 = (const bf16*)(p->ws + WS_Y1);
    bf16* H = (bf16*)(p->ws + WS_H);
    const int nrows = (l == 0) ? NTOK : NL;
    const float* ng = (l == 0) ? p->in[I_N1G] + D : p->in[I_FING];
    for (int r0 = gw * 2; r0 < nrows; r0 += ngw * 2) {
        float4 xv[2][4]; uint2 ya[2][4], yb[2][4];
#pragma unroll
        for (int q = 0; q < 2; ++q) {
            const int r = r0 + q;
            const float* x = x1row(p, r);
#pragma unroll
            for (int j = 0; j < 4; ++j) {
                const int c = j * 256 + lane * 4;
                xv[q][j] = *(const float4*)(x + c); ya[q][j] = *(const uint2*)(Y0 + (size_t)r * D + c); yb[q][j] = *(const uint2*)(Y1 + (size_t)r * D + c);
            }
        }
#pragma unroll
        for (int q = 0; q < 2; ++q) {
            const int r = r0 + q, mb = modrow(r);
            float* xo = r < NL ? p->out + (size_t)r * D : (float*)(p->ws + WS_XC) + (size_t)(r - NL) * D;
            const float* g2 = modv(p, l, mb, 5);
            float4 v[4]; float ss = 0.f;
#pragma unroll
            for (int j = 0; j < 4; ++j) {
                const int c = j * 256 + lane * 4;
                const float4 gg = *(const float4*)(g2 + c);
                const float a0 = __uint_as_float(ya[q][j].x << 16) + __uint_as_float(yb[q][j].x << 16), a1 = __uint_as_float(ya[q][j].x & 0xffff0000u) + __uint_as_float(yb[q][j].x & 0xffff0000u);
                const float a2 = __uint_as_float(ya[q][j].y << 16) + __uint_as_float(yb[q][j].y << 16), a3 = __uint_as_float(ya[q][j].y & 0xffff0000u) + __uint_as_float(yb[q][j].y & 0xffff0000u);
                v[j] = make_float4(xv[q][j].x + gg.x * a0, xv[q][j].y + gg.y * a1, xv[q][j].z + gg.z * a2, xv[q][j].w + gg.w * a3);
                ss += v[j].x * v[j].x + v[j].y * v[j].y + v[j].z * v[j].z + v[j].w * v[j].w;
            }
            const float inv = rsqrtf(wave_sum(ss) * (1.f / D) + EPS);
            if (l == 0) {
                const float* sh = modv(p, 1, mb, 0); const float* sc = modv(p, 1, mb, 1);
#pragma unroll
                for (int j = 0; j < 4; ++j) {
                    const int c = j * 256 + lane * 4;
                    *(float4*)(xo + c) = v[j];
                    const float4 gg = *(const float4*)(ng + c), s1 = *(const float4*)(sh + c), s2 = *(const float4*)(sc + c);
                    st_h4(H, (unsigned char*)(p->ws + WS_H8), (size_t)r * D + c, v[j].x * inv * gg.x * (1.f + s2.x) + s1.x, v[j].y * inv * gg.y * (1.f + s2.y) + s1.y,
                          v[j].z * inv * gg.z * (1.f + s2.z) + s1.z, v[j].w * inv * gg.w * (1.f + s2.w) + s1.w);
                }
            } else {
#pragma unroll
                for (int j = 0; j < 4; ++j) {
                    const int c = j * 256 + lane * 4;
                    const float4 gg = *(const float4*)(ng + c);
                    *(float4*)(xo + c) = make_float4(v[j].x * inv * gg.x, v[j].y * inv * gg.y, v[j].z * inv * gg.z, v[j].w * inv * gg.w);
                }
            }
        }
    }
}

#define XB_TMO      128
#define XB_XCNT(j)  (256  + 64 * (j))
#define XB_XSUB(j)  (1280 + 64 * (j))
#define XB_XGEN(j)  (2304 + 64 * (j))
#define XB_TOP      3328
#define XB_TOPGEN   3392
#define XB_SPIN_CAP (1u << 22)
constexpr int CW_BAR = 4096;
__device__ __forceinline__ unsigned xb_ld(unsigned* p)              { return __hip_atomic_load(p, __ATOMIC_RELAXED, __HIP_MEMORY_SCOPE_AGENT); }
__device__ __forceinline__ unsigned xb_add(unsigned* p, unsigned v) { return __hip_atomic_fetch_add(p, v, __ATOMIC_RELAXED, __HIP_MEMORY_SCOPE_AGENT); }
__device__ __forceinline__ unsigned xb_xcc_id() { return (unsigned)__builtin_amdgcn_s_getreg((3 << 11) | 20) & 0xFu; }
#define XB_SPIN(cond, bar) do { unsigned _sp = 0; while (cond) { __builtin_amdgcn_s_sleep(1); \
    if ((++_sp & 255u) == 0u) { if (xb_ld(&(bar)[XB_TMO])) break; if (_sp > XB_SPIN_CAP) { atomicAdd(&(bar)[XB_TMO], 1u); break; } } } } while (0)
constexpr int LDS_BAR_OFF = 79 * 1024 + 16;
__device__ __forceinline__ void xcd_barrier_post(unsigned* bar) {
    if (threadIdx.x == 0) (void)xb_add(&bar[XB_XCNT(xb_xcc_id())], 1u);
}
__device__ __forceinline__ void xcd_barrier_census(unsigned* bar, volatile unsigned* st) {
    if (threadIdx.x == 0) {
        const unsigned x = xb_xcc_id();
        unsigned cnt = 0, mine = 0;
#pragma unroll
        for (unsigned j = 0; j < 16; ++j) { const unsigned c = xb_ld(&bar[XB_XCNT(j)]); cnt += (c > 0u) ? 1u : 0u; mine = (j == x) ? c : mine; }
        st[0] = mine > 0u ? mine : 1u; st[1] = cnt > 0u ? cnt : 1u;
    }
    __syncthreads();
}
__device__ __forceinline__ void xcd_barrier(KParams kp, unsigned char* lds) {
    asm volatile("s_waitcnt vmcnt(0)" ::: "memory");
    __syncthreads();
    if (threadIdx.x == 0) {
        unsigned* bar = (unsigned*)(kp->ws + WS_CTL) + CW_BAR;
        volatile unsigned* st = (volatile unsigned*)(lds + LDS_BAR_OFF);
        __builtin_amdgcn_s_waitcnt(0);
        const unsigned x = xb_xcc_id();
        const unsigned nloc = st[0], nx = st[1];
        const unsigned old = xb_add(&bar[XB_XSUB(x)], 1u);
        const unsigned gen = old / nloc;
        if (old + 1u == (gen + 1u) * nloc) {
            __builtin_amdgcn_fence(__ATOMIC_RELEASE, "agent");
            asm volatile("s_waitcnt vmcnt(0)" ::: "memory");
            const unsigned og = xb_add(&bar[XB_TOP], 1u);
            const unsigned tg = og / nx;
            if (og + 1u == (tg + 1u) * nx) xb_add(&bar[XB_TOPGEN], 1u);
            else XB_SPIN(xb_ld(&bar[XB_TOPGEN]) == tg, bar);
            __builtin_amdgcn_fence(__ATOMIC_ACQUIRE, "agent");
            xb_add(&bar[XB_XGEN(x)], 1u);
            asm volatile("s_waitcnt vmcnt(0)" ::: "memory");
        } else {
            XB_SPIN(xb_ld(&bar[XB_XGEN(x)]) == gen, bar);
            __builtin_amdgcn_fence(__ATOMIC_ACQUIRE, "agent");
            asm volatile("s_waitcnt vmcnt(0)" ::: "memory");
        }
    }
    __syncthreads();
}

constexpr int LDS_BYTES = 80 * 1024;
__global__ void __launch_bounds__(256, 2) mega_fwd(Params p_unused) {
    const KParams kp = (KParams)__builtin_amdgcn_kernarg_segment_ptr();
    extern __shared__ __attribute__((aligned(16))) unsigned char smem_raw[];
    float* sm = (float*)smem_raw;
    cg::grid_group grid = cg::this_grid();
#ifndef PROBE_SEL
#define PROBE_SEL 0ull
#endif
#if PROBE_SEL
    volatile unsigned long long* stamps = (volatile unsigned long long*)(smem_raw + 79 * 1024 + 64);
    int n_stamp = 0;
#define STAMP() do { if (blockIdx.x == 0 && threadIdx.x == 0) stamps[n_stamp] = __builtin_amdgcn_s_memrealtime(); ++n_stamp; } while (0)
#else
#define STAMP() do { } while (0)
#endif
    xcd_barrier_post((unsigned*)(kp->ws + WS_CTL) + CW_BAR);
    STAMP();
    ph_init(fresh(kp), sm);
    grid.sync();
    xcd_barrier_census((unsigned*)(kp->ws + WS_CTL) + CW_BAR, (volatile unsigned*)(smem_raw + LDS_BAR_OFF));
    STAMP();
#define GSYNC() do { xcd_barrier(fresh(kp), smem_raw); STAMP(); } while (0)
#pragma unroll 1
    for (int l = 0; l < 2; ++l) {
        if (l == 0) { ph_norm1(fresh(kp), l); GSYNC(); }
        ph_gemm_in(fresh(kp), l, smem_raw);
        ph_gemm_in8(fresh(kp), l, smem_raw); GSYNC();
        ph_prep(fresh(kp), l, sm);
        ph_gla_local(fresh(kp), l, smem_raw); GSYNC();
        ph_mix(fresh(kp), l, smem_raw);     GSYNC();
        ph_gla_out(fresh(kp), l, smem_raw); GSYNC();
        ph_mo(fresh(kp), l, smem_raw);      GSYNC();
        ph_router(fresh(kp), l, smem_raw);
        ph_convmoe(fresh(kp), l, sm);       GSYNC();
        ph_moe1(fresh(kp), l, smem_raw);    GSYNC();
        ph_moe2(fresh(kp), l, smem_raw);    GSYNC();
        ph_combine(fresh(kp), l);           if (l == 0) GSYNC();
    }
#if PROBE_SEL
    if (blockIdx.x == 0 && threadIdx.x == 0) {
        unsigned long long dt = 0;
        for (int i = 0; i < 23; ++i) if ((PROBE_SEL >> i) & 1ull) dt += stamps[i + 1] - stamps[i];
        const unsigned long long t0 = __builtin_amdgcn_s_memrealtime();
        while (__builtin_amdgcn_s_memrealtime() - t0 < dt) __builtin_amdgcn_s_sleep(8);
    }
#endif
}

extern "C" void kernel_launch(void* const* d_in, const int* in_sizes, int n_in, void* d_out, int out_size, void* d_ws, size_t ws_size,
                              hipStream_t stream) {
    if (n_in != 28 || ws_size < WS_END) { fprintf(stderr, "kernel_launch: bad n_in %d or ws_size %zu (< %zu)\n", n_in, ws_size, (size_t)WS_END); return; }
    static int grid_blocks = 0;
    if (!grid_blocks) {
        int dev = 0, cus = 0, per_cu = 0;
        (void)hipGetDevice(&dev);
        (void)hipDeviceGetAttribute(&cus, hipDeviceAttributeMultiprocessorCount, dev);
        (void)hipFuncSetAttribute((const void*)mega_fwd, hipFuncAttributeMaxDynamicSharedMemorySize, LDS_BYTES);
        (void)hipOccupancyMaxActiveBlocksPerMultiprocessor(&per_cu, (const void*)mega_fwd, 256, LDS_BYTES);
        if (per_cu < 1) per_cu = 1;
        grid_blocks = cus * per_cu;
        fprintf(stderr, "kernel_launch: cus %d per_cu %d grid %d ws_size %zu\n", cus, per_cu, grid_blocks, ws_size);
    }
    Params p{};
    for (int i = 0; i < 28; ++i) p.in[i] = (const float*)d_in[i];
    p.out = (float*)d_out; p.ws = (unsigned char*)d_ws;
    (void)hipMemsetAsync((char*)d_ws + WS_CTL, 0, 1 * MiB, stream);
    void* args[] = {&p};
    hipError_t e = hipLaunchCooperativeKernel((const void*)mega_fwd, dim3(grid_blocks), dim3(256), args, LDS_BYTES, stream);
    if (e != hipSuccess) fprintf(stderr, "cooperative launch failed: %s (grid %d)\n", hipGetErrorString(e), grid_blocks);
}
```
